# Optimizing an MI355X kernel written in HIP

```python
import jax, jax.numpy as jnp
from jax import lax
import numpy as np

D_MODEL = 2048
BATCH = 8
SEQ = 2048
DEPTH = 4

HEAD_DIM = 64
N_ATT_HEADS = 12
N_RWKV_HEADS = 12
D_ATT = N_ATT_HEADS * HEAD_DIM
D_RWKV = N_RWKV_HEADS * HEAD_DIM
D_POOL = D_MODEL - D_ATT - D_RWKV
N_POOL_GROUPS = 4
POOL_GROUP = D_POOL // N_POOL_GROUPS
POOL_WINDOWS = (2, 4, 8, 16)
DILATED_BRANCHES = ((128, 1), (512, 4), (2048, 16))
ATT_BLOCK = 128
ROPE_THETA = 10000.0
RWKV_DECAY_LORA = 96
RWKV_AAA_LORA = 96
RWKV_GATE_LORA = 256
D_RWKV_IN = 3 * D_RWKV + RWKV_DECAY_LORA + RWKV_AAA_LORA + RWKV_GATE_LORA
D_IN = 3 * D_ATT + D_RWKV_IN + D_POOL
D_FF = 256 * ((8 * D_MODEL // 3 + 255) // 256)
NORM_EPS = 1e-6
RWKV_GN_EPS = 64e-5

kernel_name = 'hybrid_dilated_rwkv7_pool_macaron'


def rms_norm(x, g):
    xf = x.astype(jnp.float32)
    y = xf * lax.rsqrt(jnp.mean(xf * xf, axis=-1, keepdims=True) + NORM_EPS)
    return (y * g.astype(jnp.float32)).astype(x.dtype)


def swiglu(h, w_gate, w_up, w_down):
    return (jax.nn.silu(h @ w_gate) * (h @ w_up)) @ w_down


def rope_tables(seq_len, dtype):
    inv_freq = ROPE_THETA ** (-jnp.arange(0, HEAD_DIM, 2, dtype=jnp.float32) / HEAD_DIM)
    ang = jnp.arange(seq_len, dtype=jnp.float32)[:, None] * inv_freq[None, :]
    return jnp.cos(ang).astype(dtype), jnp.sin(ang).astype(dtype)


def rotary(x, cos, sin):
    x1, x2 = jnp.split(x, 2, axis=-1)
    c = cos[None, :, None, :]
    s = sin[None, :, None, :]
    return jnp.concatenate([x1 * c - x2 * s, x2 * c + x1 * s], axis=-1)


def to_strided(x, d):
    b, s = x.shape[:2]
    rest = x.shape[2:]
    x = jnp.moveaxis(x.reshape((b, s // d, d) + rest), 2, 1)
    return x.reshape((b * d, s // d) + rest)


def from_strided(x, b, d):
    l = x.shape[1]
    rest = x.shape[2:]
    x = jnp.moveaxis(x.reshape((b, d, l) + rest), 1, 2)
    return x.reshape((b, l * d) + rest)


def dilated_branch(q, k, v, window, dilation):
    b, s, h, dh = q.shape
    n_back = window // dilation
    qs, ks, vs = (to_strided(t, dilation) for t in (q, k, v))
    n, l = qs.shape[:2]
    nblk = -(-l // ATT_BLOCK)
    lp = nblk * ATT_BLOCK
    pad = ((0, 0), (0, lp - l), (0, 0), (0, 0))
    qs, ks, vs = (jnp.pad(t, pad).reshape(n, nblk, ATT_BLOCK, h, dh) for t in (qs, ks, vs))

    def with_prev(t):
        prev = jnp.pad(t[:, :-1], ((0, 0), (1, 0), (0, 0), (0, 0), (0, 0)))
        return jnp.concatenate([prev, t], axis=2)

    kb, vb = with_prev(ks), with_prev(vs)
    scores = jnp.einsum('nbqhd,nbkhd->nbhqk', qs, kb).astype(jnp.float32) * (dh ** -0.5)
    qi = jnp.arange(ATT_BLOCK)[:, None]
    kj = jnp.arange(2 * ATT_BLOCK)[None, :]
    dist = ATT_BLOCK + qi - kj
    key_pos = jnp.arange(nblk)[:, None, None] * ATT_BLOCK + kj - ATT_BLOCK
    valid = (dist >= 0) & (dist <= n_back) & (key_pos >= 0)
    scores = jnp.where(valid[None, :, None], scores, -jnp.inf)
    m = jnp.max(scores, axis=-1, keepdims=True)
    p = jnp.exp(scores - m)
    den = jnp.sum(p, axis=-1, keepdims=True)
    o = jnp.einsum('nbhqk,nbkhd->nbqhd', (p / den).astype(v.dtype), vb)
    lse = jnp.moveaxis((m + jnp.log(den))[..., 0], 2, 3)
    o = o.reshape(n, lp, h, dh)[:, :l]
    lse = lse.reshape(n, lp, h)[:, :l]
    return from_strided(o, b, dilation), from_strided(lse, b, dilation)


def dilated_attention(q, k, v):
    outs, lses = [], []
    for window, dilation in DILATED_BRANCHES:
        o, lse = dilated_branch(q, k, v, window, dilation)
        outs.append(o)
        lses.append(lse)
    alpha = jax.nn.softmax(jnp.stack(lses, axis=0), axis=0)
    out = jnp.einsum('gbsh,gbshd->bshd', alpha, jnp.stack(outs, axis=0).astype(jnp.float32))
    return out.astype(q.dtype)


def token_shift(x):
    return jnp.pad(x[:, :-1], ((0, 0), (1, 0), (0, 0)))


def rwkv7_mixer(z, mu, w_up, w0, a_up, a0, g_up, k_k, k_a, r_k, gn_w, gn_b):
    out_dtype = z.dtype
    z = z.astype(jnp.float32)
    b, s, _ = z.shape
    z = z + (token_shift(z) - z) * mu
    splits = [D_RWKV, 2 * D_RWKV, 3 * D_RWKV, 3 * D_RWKV + RWKV_DECAY_LORA,
              3 * D_RWKV + RWKV_DECAY_LORA + RWKV_AAA_LORA]
    r, k, v, zw, za, zg = jnp.split(z, splits, axis=-1)
    log_w = -jax.nn.softplus(-(w0 + jnp.tanh(zw) @ w_up)) - 0.5
    decay = jnp.exp(-jnp.exp(log_w))
    a = jax.nn.sigmoid(a0 + za @ a_up)
    g = jax.nn.sigmoid(zg) @ g_up
    kk = k * k_k
    k = k * (1.0 + (a - 1.0) * k_a)

    def heads(t):
        return t.reshape(b, s, N_RWKV_HEADS, HEAD_DIM).astype(jnp.float32)

    r, k, v, kk, a, decay = (heads(t) for t in (r, k, v, kk, a, decay))
    kk = kk / jnp.maximum(jnp.sqrt(jnp.sum(kk * kk, axis=-1, keepdims=True)), 1e-12)

    def step(state, inp):
        r_t, w_t, k_t, v_t, kk_t, a_t = inp
        sa = jnp.einsum('bhvk,bhk->bhv', state, kk_t)
        state = (state * w_t[:, :, None, :]
                 - sa[..., None] * (kk_t * a_t)[:, :, None, :]
                 + v_t[..., None] * k_t[:, :, None, :])
        return state, jnp.einsum('bhvk,bhk->bhv', state, r_t)

    state0 = jnp.zeros((b, N_RWKV_HEADS, HEAD_DIM, HEAD_DIM), jnp.float32)
    xs = tuple(jnp.moveaxis(t, 1, 0) for t in (r, decay, k, v, kk, a))
    _, y = lax.scan(step, state0, xs)
    y = jnp.moveaxis(y, 0, 1)
    mean = jnp.mean(y, axis=-1, keepdims=True)
    var = jnp.mean(jnp.square(y - mean), axis=-1, keepdims=True)
    y = ((y - mean) * lax.rsqrt(var + RWKV_GN_EPS)).reshape(b, s, D_RWKV) * gn_w + gn_b
    bonus = jnp.sum(r * k * r_k, axis=-1, keepdims=True) * v
    y = (y + bonus.reshape(b, s, D_RWKV)) * g
    return y.astype(out_dtype)


def pool_mixer(u, pool_w, pool_scale):
    b, s, _ = u.shape
    uf = u.astype(jnp.float32).reshape(b, s, N_POOL_GROUPS, POOL_GROUP)
    c = jnp.cumsum(uf, axis=1)
    t = jnp.arange(1, s + 1, dtype=jnp.float32)
    outs = []
    for gi, w in enumerate(POOL_WINDOWS):
        cg = c[:, :, gi]
        prev = jnp.pad(cg[:, :-w], ((0, 0), (w, 0), (0, 0)))
        mean = (cg - prev) / jnp.minimum(t, float(w))[None, :, None]
        outs.append(mean - uf[:, :, gi])
    p = jnp.stack(outs, axis=2).astype(u.dtype)
    y = jnp.einsum('bsgc,gcd->bsgd', p, pool_w).reshape(b, s, D_POOL)
    return y * pool_scale


def setup_inputs(seed: int = 0) -> dict:
    key = jax.random.key(seed)
    ks = iter(jax.random.split(key, 32))
    f32 = jnp.float32

    def nrm(shape, scale):
        return jax.random.normal(next(ks), shape, f32) * scale

    def gain(shape):
        return 1.0 + 0.05 * jax.random.normal(next(ks), shape, f32)

    def unif(shape, lo, hi):
        return jax.random.uniform(next(ks), shape, f32, lo, hi)

    L, D, F = DEPTH, D_MODEL, D_FF
    return {
        'x': nrm((BATCH, SEQ, D), 1.0),
        'ffn1_norm_pre': gain((L, D)),
        'ffn1_norm_post': gain((L, D)),
        'ffn1_w_gate': nrm((L, D, F), D ** -0.5),
        'ffn1_w_up': nrm((L, D, F), D ** -0.5),
        'ffn1_w_down': nrm((L, F, D), F ** -0.5),
        'mix_norm_pre': gain((L, D)),
        'mix_norm_post': gain((L, D)),
        'w_in': nrm((L, D, D_IN), D ** -0.5),
        'w_out': nrm((L, D, D), D ** -0.5),
        'rwkv_mu': unif((L, D_RWKV_IN), 0.0, 1.0),
        'rwkv_w_up': nrm((L, RWKV_DECAY_LORA, D_RWKV), 0.5 * RWKV_DECAY_LORA ** -0.5),
        'rwkv_w0': unif((L, D_RWKV), -6.0, -1.0),
        'rwkv_a_up': nrm((L, RWKV_AAA_LORA, D_RWKV), RWKV_AAA_LORA ** -0.5),
        'rwkv_a0': nrm((L, D_RWKV), 0.1),
        'rwkv_g_up': nrm((L, RWKV_GATE_LORA, D_RWKV), RWKV_GATE_LORA ** -0.5),
        'rwkv_k_k': 0.85 + nrm((L, D_RWKV), 0.05),
        'rwkv_k_a': gain((L, D_RWKV)),
        'rwkv_r_k': nrm((L, N_RWKV_HEADS, HEAD_DIM), 0.1),
        'rwkv_gn_w': gain((L, D_RWKV)),
        'rwkv_gn_b': nrm((L, D_RWKV), 0.01),
        'pool_w': nrm((L, N_POOL_GROUPS, POOL_GROUP, POOL_GROUP), POOL_GROUP ** -0.5),
        'pool_scale': gain((L, D_POOL)),
        'ffn2_norm_pre': gain((L, D)),
        'ffn2_norm_post': gain((L, D)),
        'ffn2_w_gate': nrm((L, D, F), D ** -0.5),
        'ffn2_w_up': nrm((L, D, F), D ** -0.5),
        'ffn2_w_down': nrm((L, F, D), F ** -0.5),
    }


def reference(x, ffn1_norm_pre, ffn1_norm_post, ffn1_w_gate, ffn1_w_up, ffn1_w_down,
              mix_norm_pre, mix_norm_post, w_in, w_out, rwkv_mu, rwkv_w_up, rwkv_w0,
              rwkv_a_up, rwkv_a0, rwkv_g_up, rwkv_k_k, rwkv_k_a, rwkv_r_k, rwkv_gn_w,
              rwkv_gn_b, pool_w, pool_scale, ffn2_norm_pre, ffn2_norm_post, ffn2_w_gate,
              ffn2_w_up, ffn2_w_down):
    b, s, _ = x.shape
    cos, sin = rope_tables(s, x.dtype)
    for i in range(DEPTH):
        h = rms_norm(x, ffn1_norm_pre[i])
        x = x + 0.5 * rms_norm(swiglu(h, ffn1_w_gate[i], ffn1_w_up[i], ffn1_w_down[i]),
                               ffn1_norm_post[i])
        h = rms_norm(x, mix_norm_pre[i])
        z = h @ w_in[i]
        zq, zk, zv, zr, zp = jnp.split(
            z, [D_ATT, 2 * D_ATT, 3 * D_ATT, 3 * D_ATT + D_RWKV_IN], axis=-1)
        q = rotary(zq.reshape(b, s, N_ATT_HEADS, HEAD_DIM), cos, sin)
        k = rotary(zk.reshape(b, s, N_ATT_HEADS, HEAD_DIM), cos, sin)
        v = zv.reshape(b, s, N_ATT_HEADS, HEAD_DIM)
        y_att = dilated_attention(q, k, v).reshape(b, s, D_ATT)
        y_rwkv = rwkv7_mixer(zr, rwkv_mu[i], rwkv_w_up[i], rwkv_w0[i], rwkv_a_up[i],
                             rwkv_a0[i], rwkv_g_up[i], rwkv_k_k[i], rwkv_k_a[i],
                             rwkv_r_k[i], rwkv_gn_w[i], rwkv_gn_b[i])
        y_pool = pool_mixer(zp, pool_w[i], pool_scale[i])
        mix = jnp.concatenate([y_att, y_rwkv, y_pool], axis=-1) @ w_out[i]
        x = x + rms_norm(mix, mix_norm_post[i])
        h = rms_norm(x, ffn2_norm_pre[i])
        x = x + 0.5 * rms_norm(swiglu(h, ffn2_w_gate[i], ffn2_w_up[i], ffn2_w_down[i]),
                               ffn2_norm_post[i])
    return x
```

```cpp
#include <hip/hip_runtime.h>
#include <cstdio>
#include <cstdint>
#include <cmath>
namespace pg8 {
#define PG8_LAS __attribute__((address_space(3)))
typedef unsigned short bf16_t;
typedef short bf16x8 __attribute__((ext_vector_type(8)));
typedef float f32x4 __attribute__((ext_vector_type(4)));
typedef unsigned u32x4 __attribute__((ext_vector_type(4)));
constexpr int BM = 256, BK = 64, HALF = 128, HTB = HALF * BK * 2  , STAGE_BYTES = 8 * HTB, NXCD = 8, WGM = 8;

__host__ __device__ __forceinline__ int lds_byte(int r, int c) { const int st = (r >> 4) * 2 + (c >> 5), rr = r & 15, cc = c & 31, ob = rr * 64 + cc * 2; return st * 1024 + (ob ^ (((ob >> 9) & 1) << 5)); }
__host__ __device__ __forceinline__ void stage_rc(int b, int& R, int& C) { const int st = b / 1024, sb = b % 1024, swz = sb ^ (((sb >> 9) & 1) << 5); R = (st >> 1) * 16 + swz / 64; C = (st & 1) * 32 + (swz % 64) / 2; }
__host__ __device__ __forceinline__ int perm32(int rho) { const int n = rho >> 4, i = rho & 15; return 8 * (i >> 2) + 4 * n + (i & 3); }

struct Unit { int pm, pn; };
struct Gemm { const bf16_t* A; const bf16_t* Bt; int M, N, K; };

struct StaticOrder {
    int nM, nN, nwg, G, c;
    __host__ __device__ void init(int M, int N, int G_, int c_) { nM = M / BM; nN = N / BM; nwg = nM * nN; G = G_; c = c_; }
    __host__ __device__ bool next(int i, Unit& u) const {
        const long L = (long)i * G + c; if (L >= nwg) return false;
        int wgid = (int)L; { const int q = nwg / NXCD, r = nwg % NXCD, xcd = wgid % NXCD, off = wgid / NXCD; wgid = (xcd < r ? xcd * (q + 1) : r * (q + 1) + (xcd - r) * q) + off; }
        const int nig = WGM * nN, gid = wgid / nig, fm = gid * WGM, gsz = (nM - fm) < WGM ? (nM - fm) : WGM;
        u.pm = fm + ((wgid % nig) % gsz); u.pn = (wgid % nig) / gsz; return true;
    }
    __device__ __forceinline__ void a_ready(const Unit&) const {}
    __device__ __forceinline__ void done(const Unit&) const {}
};

__device__ __forceinline__ unsigned cvt_pk_bf16(float lo, float hi) { unsigned r; asm volatile("v_cvt_pk_bf16_f32 %0, %1, %2" : "=v"(r) : "v"(lo), "v"(hi)); return r; }
typedef float f32x2 __attribute__((ext_vector_type(2)));
typedef unsigned u32x2 __attribute__((ext_vector_type(2)));
__device__ __forceinline__ float silu_f(float x) { return x * __builtin_amdgcn_rcpf(1.0f + __builtin_amdgcn_exp2f(-1.4426950408889634f * x)); }
__device__ __forceinline__ u32x4 pack8(const f32x4 v0, const f32x4 v1) { u32x4 w; w.x = cvt_pk_bf16(v0[0], v0[1]); w.y = cvt_pk_bf16(v0[2], v0[3]); w.z = cvt_pk_bf16(v1[0], v1[1]); w.w = cvt_pk_bf16(v1[2], v1[3]); return w; }

struct EpiF32 {
    static constexpr bool PERM = false, AFTER_DRAIN = false;
    float* C; int ldc;
    __device__ __forceinline__ void operator()(const f32x4 (&acc)[2][2][4][2], const Unit& u, int wr, int wc, int fr, int fq) const {
        const int row0 = u.pm * BM + wr * 64 + fr, col0 = u.pn * BM + wc * 32 + 4 * fq;
#pragma unroll
        for (int ai = 0; ai < 2; ++ai)
#pragma unroll
            for (int m = 0; m < 4; ++m) { float* rowp = C + (size_t)(row0 + ai * HALF + m * 16) * ldc + col0;
#pragma unroll
                for (int bj = 0; bj < 2; ++bj)
#pragma unroll
                    for (int n = 0; n < 2; ++n) *(f32x4*)(rowp + bj * HALF + n * 16) = acc[ai][bj][m][n]; }
    }
};
struct EpiBf16Plain {
    static constexpr bool PERM = true, AFTER_DRAIN = false;
    bf16_t* O; int ldc;
    __device__ __forceinline__ void operator()(const f32x4 (&acc)[2][2][4][2], const Unit& u, int wr, int wc, int fr, int fq) const {
        const int row0 = u.pm * BM + wr * 64 + fr, col0 = u.pn * BM + wc * 32 + 8 * fq;
#pragma unroll
        for (int ai = 0; ai < 2; ++ai)
#pragma unroll
            for (int m = 0; m < 4; ++m) { bf16_t* rowp = O + (size_t)(row0 + ai * HALF + m * 16) * ldc + col0;
#pragma unroll
                for (int bj = 0; bj < 2; ++bj) *(u32x4*)(rowp + bj * HALF) = pack8(acc[ai][bj][m][0], acc[ai][bj][m][1]); }
    }
};
struct EpiBf16Scale {
    static constexpr bool PERM = true, AFTER_DRAIN = false;
    bf16_t* O; int ldc; const float* scale;
    __device__ __forceinline__ void operator()(const f32x4 (&acc)[2][2][4][2], const Unit& u, int wr, int wc, int fr, int fq) const {
        const int row0 = u.pm * BM + wr * 64 + fr, col0 = u.pn * BM + wc * 32 + 8 * fq;
        f32x4 sv[2][2];
#pragma unroll
        for (int bj = 0; bj < 2; ++bj)
#pragma unroll
            for (int n = 0; n < 2; ++n) sv[bj][n] = *(const f32x4*)(scale + col0 + bj * HALF + 4 * n);
#pragma unroll
        for (int ai = 0; ai < 2; ++ai)
#pragma unroll
            for (int m = 0; m < 4; ++m) { bf16_t* rowp = O + (size_t)(row0 + ai * HALF + m * 16) * ldc + col0;
#pragma unroll
                for (int bj = 0; bj < 2; ++bj) *(u32x4*)(rowp + bj * HALF) = pack8(acc[ai][bj][m][0] * sv[bj][0], acc[ai][bj][m][1] * sv[bj][1]); }
    }
};
struct EpiSwiglu {
    static constexpr bool PERM = true, AFTER_DRAIN = false;
    bf16_t* O; int ldc;
    __device__ __forceinline__ void operator()(const f32x4 (&acc)[2][2][4][2], const Unit& u, int wr, int wc, int fr, int fq) const {
        const int row0 = u.pm * BM + wr * 64 + fr, col0 = u.pn * HALF + wc * 32 + 8 * fq;
#pragma unroll
        for (int ai = 0; ai < 2; ++ai)
#pragma unroll
            for (int m = 0; m < 4; ++m) { bf16_t* rowp = O + (size_t)(row0 + ai * HALF + m * 16) * ldc + col0;
                f32x4 v0, v1;
#pragma unroll
                for (int e = 0; e < 4; ++e) { v0[e] = silu_f(acc[ai][0][m][0][e]) * acc[ai][1][m][0][e]; v1[e] = silu_f(acc[ai][0][m][1][e]) * acc[ai][1][m][1][e]; }
                *(u32x4*)rowp = pack8(v0, v1); }
    }
};
struct EpiWin {
    static constexpr bool PERM = true, AFTER_DRAIN = false;
    bf16_t *Q, *K, *V;
    bf16_t *ZR, *ZP;
    const float *cs, *sn;
    float qscale;
    __device__ __forceinline__ void operator()(const f32x4 (&acc)[2][2][4][2], const Unit& u, int wr, int wc, int fr, int fq) const {
        const int row0 = u.pm * BM + wr * 64 + fr, pn = u.pn;
        if (pn < 6) {
            bf16_t* dst = pn < 3 ? Q : K; const int pt = pn < 3 ? pn : pn - 3; const float sc = pn < 3 ? qscale : 1.0f;
            const int d0 = 16 * (wc & 1) + 4 * fq;
#pragma unroll
            for (int ai = 0; ai < 2; ++ai)
#pragma unroll
                for (int m = 0; m < 4; ++m) { const int row = row0 + ai * HALF + m * 16, b = row >> 11, s = row & 2047;
                    const f32x4 c4 = *(const f32x4*)(cs + s * 32 + d0), s4 = *(const f32x4*)(sn + s * 32 + d0);
#pragma unroll
                    for (int bj = 0; bj < 2; ++bj) { const int head = pt * 4 + bj * 2 + (wc >> 1);
                        const f32x4 x1 = acc[ai][bj][m][0], x2 = acc[ai][bj][m][1];
                        const f32x4 o1 = (x1 * c4 - x2 * s4) * sc, o2 = (x2 * c4 + x1 * s4) * sc;
                        bf16_t* p = dst + ((size_t)(b * 12 + head) * 2048 + s) * 64 + d0;
                        u32x2 w1, w2; w1.x = cvt_pk_bf16(o1[0], o1[1]); w1.y = cvt_pk_bf16(o1[2], o1[3]); w2.x = cvt_pk_bf16(o2[0], o2[1]); w2.y = cvt_pk_bf16(o2[2], o2[3]);
                        *(u32x2*)p = w1; *(u32x2*)(p + 32) = w2; } }
        } else if (pn < 9) {
            const int d0 = 32 * (wc & 1) + 8 * fq;
#pragma unroll
            for (int ai = 0; ai < 2; ++ai)
#pragma unroll
                for (int m = 0; m < 4; ++m) { const int row = row0 + ai * HALF + m * 16, b = row >> 11, s = row & 2047;
#pragma unroll
                    for (int bj = 0; bj < 2; ++bj) { const int head = (pn - 6) * 4 + bj * 2 + (wc >> 1);
                        *(u32x4*)(V + ((size_t)(b * 12 + head) * 2048 + s) * 64 + d0) = pack8(acc[ai][bj][m][0], acc[ai][bj][m][1]); } }
        } else {
            bf16_t* O; int ldc, colt;
            if (pn < 20) { O = ZR; ldc = 2816; colt = (pn - 9) * BM; } else { O = ZP; ldc = 512; colt = (pn - 20) * BM; }
            const int col0 = colt + wc * 32 + 8 * fq;
#pragma unroll
            for (int ai = 0; ai < 2; ++ai)
#pragma unroll
                for (int m = 0; m < 4; ++m) { bf16_t* rowp = O + (size_t)(row0 + ai * HALF + m * 16) * ldc + col0;
#pragma unroll
                    for (int bj = 0; bj < 2; ++bj) *(u32x4*)(rowp + bj * HALF) = pack8(acc[ai][bj][m][0], acc[ai][bj][m][1]); }
        }
    }
};

template <class Epi, class Sched, bool ALIGN_EPI = false, bool SP2 = false>
__device__ __forceinline__ void gemm_phase(PG8_LAS unsigned char* lds, const Gemm g, const Sched& S, const Epi& E) {
    int tid_ = threadIdx.x; asm volatile("" : "+v"(tid_));
    const int tid = tid_, wid = __builtin_amdgcn_readfirstlane(tid >> 6), lane = tid & 63, wr = wid >> 2, wc = wid & 3, fr = lane & 15, fq = lane >> 4;
    int K_ = g.K; asm volatile("" : "+s"(K_));
    const int K = K_, nt = K / BK;
    unsigned voffA[2], voffB[2];
#pragma unroll
    for (int i = 0; i < 2; ++i) { int R, C; stage_rc(tid * 16 + i * 8192, R, C); const int Rb = Epi::PERM ? ((R & ~31) + perm32(R & 31)) : R;
        voffA[i] = (unsigned)(R * K + C) * 2u; voffB[i] = (unsigned)(Rb * K + C) * 2u; }
    const size_t kstep = (size_t)(BK * 2);
    const size_t hstep = (size_t)HALF * K * 2;
    const size_t tstep = 2 * hstep;
    const unsigned ldsw = (unsigned)wid * 1024u;
    const int aoff = lds_byte(wr * 64 + fr, fq * 8), boff = lds_byte(wc * 32 + fr, fq * 8);
#define PG8_SA(b, h) (((b) * 2 + (h)) * HTB)
#define PG8_SB(b, h) ((4 + (b) * 2 + (h)) * HTB)
#define PG8_STAGE(bufoff, gbase, voff) do { _Pragma("unroll") for (int _i = 0; _i < 2; ++_i) \
        __builtin_amdgcn_global_load_lds((const unsigned*)((const char*)(gbase) + (voff)[_i]), (PG8_LAS unsigned*)(lds + (bufoff) + ldsw + _i * 8192), 16, 0, 0); } while (0)
#define PG8_LDA(dst, b, h) do { _Pragma("unroll") for (int m = 0; m < 4; ++m) _Pragma("unroll") for (int k = 0; k < 2; ++k) dst[m][k] = *(const PG8_LAS bf16x8*)(lds + PG8_SA(b, h) + aoff + m * 2048 + k * 1024); } while (0)
#define PG8_LDB(dst, b, h) do { _Pragma("unroll") for (int n = 0; n < 2; ++n) _Pragma("unroll") for (int k = 0; k < 2; ++k) dst[n][k] = *(const PG8_LAS bf16x8*)(lds + PG8_SB(b, h) + boff + n * 2048 + k * 1024); } while (0)
#define PG8_MMA(ai, bj, At, Bt) do { __builtin_amdgcn_s_setprio(1); _Pragma("unroll") for (int m = 0; m < 4; ++m) _Pragma("unroll") for (int n = 0; n < 2; ++n) _Pragma("unroll") for (int k = 0; k < 2; ++k) \
        acc[ai][bj][m][n] = __builtin_amdgcn_mfma_f32_16x16x32_bf16(Bt[n][k], At[m][k], acc[ai][bj][m][n], 0, 0, 0); __builtin_amdgcn_s_setprio(0); } while (0)
#define PG8_WAIT_V(n) asm volatile("s_waitcnt vmcnt(" #n ")" ::: "memory")
#define PG8_WAIT_L(n) asm volatile("s_waitcnt lgkmcnt(" #n ")" ::: "memory")
#define PG8_BAR __builtin_amdgcn_s_barrier()
#define PG8_SCHED __builtin_amdgcn_sched_barrier(0)
    Unit cur, nxt; int ui = 0;
    if (!S.next(0, cur)) return;
    f32x4 acc[2][2][4][2];
#pragma unroll
    for (int a = 0; a < 2; ++a)
#pragma unroll
        for (int b = 0; b < 2; ++b)
#pragma unroll
            for (int m = 0; m < 4; ++m)
#pragma unroll
                for (int n = 0; n < 2; ++n) acc[a][b][m][n] = (f32x4){0.f, 0.f, 0.f, 0.f};
    bf16x8 At[4][2], B0[2][2], B1[2][2];
    const char* cA = (const char*)g.A + (size_t)cur.pm * tstep; const char* cB = (const char*)g.Bt + (size_t)cur.pn * tstep;
    S.a_ready(cur);
    if constexpr (SP2) {
        PG8_STAGE(PG8_SB(0, 0), cB, voffB); PG8_STAGE(PG8_SB(0, 1), cB + hstep, voffB); PG8_STAGE(PG8_SA(0, 0), cA, voffA); PG8_STAGE(PG8_SA(0, 1), cA + hstep, voffA);
        if (wr == 1) PG8_BAR;
        PG8_WAIT_V(2); PG8_BAR;
        PG8_STAGE(PG8_SB(1, 0), cB + kstep, voffB); PG8_STAGE(PG8_SA(1, 0), cA + kstep, voffA); PG8_STAGE(PG8_SB(1, 1), cB + hstep + kstep, voffB);
        PG8_WAIT_V(6); PG8_BAR;
    } else {
        PG8_STAGE(PG8_SB(0, 0), cB, voffB); PG8_STAGE(PG8_SA(0, 0), cA, voffA); PG8_STAGE(PG8_SB(0, 1), cB + hstep, voffB); PG8_STAGE(PG8_SA(0, 1), cA + hstep, voffA);
        if (wr == 1) PG8_BAR;
        PG8_WAIT_V(4); PG8_BAR;
        PG8_STAGE(PG8_SB(1, 0), cB + kstep, voffB); PG8_STAGE(PG8_SA(1, 0), cA + kstep, voffA); PG8_STAGE(PG8_SB(1, 1), cB + hstep + kstep, voffB);
        PG8_WAIT_V(6); PG8_BAR;
    }
    for (;;) {
        const bool has_next = S.next(ui + 1, nxt);
        const char* nA = has_next ? (const char*)g.A + (size_t)nxt.pm * tstep : cA; const char* nB = has_next ? (const char*)g.Bt + (size_t)nxt.pn * tstep : cB;
        for (int t = 0; t < nt; t += 2) {
            const bool last = (t == nt - 2);
            const char* a1 = cA + (size_t)(t + 1) * kstep;
            const char* a2 = last ? nA : cA + (size_t)(t + 2) * kstep; const char* b2 = last ? nB : cB + (size_t)(t + 2) * kstep;
            const char* a3 = a2 + kstep; const char* b3 = b2 + kstep;
            if (last && has_next) S.a_ready(nxt);
            if constexpr (SP2) {
            PG8_LDB(B0, 0, 0); PG8_LDB(B1, 0, 1); PG8_SCHED; PG8_LDA(At, 0, 0); PG8_STAGE(PG8_SA(1, 1), a1 + hstep, voffA);
            PG8_WAIT_V(8); PG8_WAIT_L(0); PG8_BAR; PG8_MMA(0, 0, At, B0); PG8_MMA(0, 1, At, B1); PG8_BAR; PG8_SCHED;
            PG8_LDA(At, 0, 1); PG8_STAGE(PG8_SB(0, 0), b2, voffB); PG8_STAGE(PG8_SB(0, 1), b2 + hstep, voffB); PG8_STAGE(PG8_SA(0, 0), a2, voffA);
            PG8_WAIT_V(8); PG8_WAIT_L(0); PG8_BAR; PG8_MMA(1, 0, At, B0); PG8_MMA(1, 1, At, B1); PG8_BAR; PG8_SCHED;
            PG8_LDB(B0, 1, 0); PG8_LDB(B1, 1, 1); PG8_SCHED; PG8_LDA(At, 1, 0); PG8_STAGE(PG8_SA(0, 1), a2 + hstep, voffA);
            PG8_WAIT_V(8); PG8_WAIT_L(0); PG8_BAR; PG8_MMA(0, 0, At, B0); PG8_MMA(0, 1, At, B1); PG8_BAR; PG8_SCHED;
            PG8_LDA(At, 1, 1); PG8_STAGE(PG8_SB(1, 0), b3, voffB); PG8_STAGE(PG8_SB(1, 1), b3 + hstep, voffB); PG8_STAGE(PG8_SA(1, 0), a3, voffA);
            PG8_WAIT_V(8); PG8_WAIT_L(0); PG8_BAR; PG8_MMA(1, 0, At, B0); PG8_MMA(1, 1, At, B1); PG8_BAR; PG8_SCHED;
            } else {
            PG8_LDB(B0, 0, 0); PG8_SCHED; PG8_LDA(At, 0, 0); PG8_STAGE(PG8_SA(1, 1), a1 + hstep, voffA);
            PG8_WAIT_L(8); PG8_BAR; PG8_WAIT_L(0); PG8_MMA(0, 0, At, B0); PG8_BAR; PG8_SCHED;
            PG8_LDB(B1, 0, 1); PG8_STAGE(PG8_SB(0, 0), b2, voffB);
            PG8_BAR; PG8_WAIT_L(0); PG8_MMA(0, 1, At, B1); PG8_BAR;
            PG8_LDA(At, 0, 1); PG8_STAGE(PG8_SA(0, 0), a2, voffA);
            PG8_BAR; PG8_WAIT_L(0); PG8_MMA(1, 0, At, B0); PG8_BAR; PG8_SCHED;
            PG8_STAGE(PG8_SB(0, 1), b2 + hstep, voffB);
            PG8_WAIT_V(6); PG8_BAR; PG8_MMA(1, 1, At, B1); PG8_BAR;
            PG8_LDB(B0, 1, 0); PG8_SCHED; PG8_LDA(At, 1, 0); PG8_STAGE(PG8_SA(0, 1), a2 + hstep, voffA);
            PG8_WAIT_L(8); PG8_BAR; PG8_WAIT_L(0); PG8_MMA(0, 0, At, B0); PG8_BAR; PG8_SCHED;
            PG8_LDB(B1, 1, 1); PG8_STAGE(PG8_SB(1, 0), b3, voffB);
            PG8_BAR; PG8_WAIT_L(0); PG8_MMA(0, 1, At, B1); PG8_BAR;
            PG8_LDA(At, 1, 1); PG8_STAGE(PG8_SA(1, 0), a3, voffA);
            PG8_BAR; PG8_WAIT_L(0); PG8_MMA(1, 0, At, B0); PG8_BAR; PG8_SCHED;
            PG8_STAGE(PG8_SB(1, 1), b3 + hstep, voffB);
            PG8_WAIT_V(6); PG8_BAR; PG8_MMA(1, 1, At, B1); PG8_BAR;
            }
        }
        if constexpr (ALIGN_EPI) { if (wr == 0) PG8_BAR; }
        if constexpr (!Epi::AFTER_DRAIN) { E(acc, cur, wr, wc, fr, fq); S.done(cur); }
        if (!has_next) break;
#pragma unroll
        for (int a = 0; a < 2; ++a)
#pragma unroll
            for (int b = 0; b < 2; ++b)
#pragma unroll
                for (int m = 0; m < 4; ++m)
#pragma unroll
                    for (int n = 0; n < 2; ++n) acc[a][b][m][n] = (f32x4){0.f, 0.f, 0.f, 0.f};
        cur = nxt; cA = nA; cB = nB; ++ui;
        if constexpr (ALIGN_EPI) { if (wr == 1) PG8_BAR; }
    }
    PG8_WAIT_V(0);
    if constexpr (!ALIGN_EPI) { if (wr == 0) PG8_BAR; }
    PG8_BAR;
    if constexpr (Epi::AFTER_DRAIN) { E.fused(acc, cur, wr, wc, fr, fq, lds, wid, lane); S.done(cur); }
#undef PG8_SA
#undef PG8_SB
#undef PG8_STAGE
#undef PG8_LDA
#undef PG8_LDB
#undef PG8_MMA
#undef PG8_WAIT_V
#undef PG8_WAIT_L
#undef PG8_BAR
#undef PG8_SCHED
}
}
#define GAS __attribute__((address_space(1)))
#define LAS __attribute__((address_space(3)))
typedef unsigned short bf16;
typedef unsigned v4u __attribute__((ext_vector_type(4)));
typedef float f32x4 __attribute__((ext_vector_type(4)));
typedef short bf16x8 __attribute__((ext_vector_type(8)));
typedef GAS unsigned gu32;
typedef GAS unsigned long long gu64;
#define RLX_AGENT __ATOMIC_RELAXED, __HIP_MEMORY_SCOPE_AGENT
#define LDS_WAIT() asm volatile("s_waitcnt lgkmcnt(0)" ::: "memory")
#define VM_WAIT() asm volatile("s_waitcnt vmcnt(0)" ::: "memory")
__device__ __forceinline__ unsigned long long rt() { return __builtin_amdgcn_s_memrealtime(); }
__device__ __forceinline__ unsigned f2bf(float f) { unsigned u = __builtin_bit_cast(unsigned, f); return (u + 0x7fffu + ((u >> 16) & 1u)) >> 16; }
__device__ __forceinline__ unsigned pk2(float lo, float hi) { return f2bf(lo) | (f2bf(hi) << 16); }
#define XB_TMO      128
#define XB_XCNT(j)  (256  + 64 * (j))
#define XB_XSUB(j)  (1280 + 64 * (j))
#define XB_XGEN(j)  (2304 + 64 * (j))
#define XB_TOP      3328
#define XB_TOPGEN   3392
#define XCD_BAR_WORDS 3456
#define XB_SPIN_CAP (1u << 18)

__device__ __forceinline__ unsigned xb_ld(unsigned* p)              { return __hip_atomic_load(p, __ATOMIC_RELAXED, __HIP_MEMORY_SCOPE_AGENT); }
__device__ __forceinline__ unsigned xb_add(unsigned* p, unsigned v) { return __hip_atomic_fetch_add(p, v, __ATOMIC_RELAXED, __HIP_MEMORY_SCOPE_AGENT); }
__device__ __forceinline__ unsigned xb_xcc_id() { return (unsigned)__builtin_amdgcn_s_getreg((3 << 11) | 20) & 0xFu; }
#define XB_SPIN(cond, bar) do { unsigned _sp = 0; while (cond) { __builtin_amdgcn_s_sleep(1); \
    if ((++_sp & 255u) == 0u) { if (xb_ld(&(bar)[XB_TMO])) break; if (_sp > XB_SPIN_CAP) { atomicAdd(&(bar)[XB_TMO], 1u); break; } } } } while (0)

struct XcdBarrier {
    unsigned* bar; unsigned x;
    volatile LAS unsigned* st;
};

__device__ __forceinline__ XcdBarrier xcd_barrier_post(unsigned* bar, volatile LAS unsigned* st) {
    XcdBarrier b; b.bar = bar; b.x = xb_xcc_id(); b.st = st;
    if (threadIdx.x == 0) (void)xb_add(&bar[XB_XCNT(b.x)], 1u);
    return b;
}
__device__ __forceinline__ void xcd_barrier_complete(unsigned* bar, unsigned x, unsigned& nloc, unsigned& nx) {
    const unsigned G = gridDim.x * gridDim.y * gridDim.z;
    unsigned sum, cnt, mine, sp = 0u;
    for (;;) {
        sum = 0u; cnt = 0u; mine = 0u;
#pragma unroll
        for (unsigned j = 0; j < 16; ++j) { const unsigned c = xb_ld(&bar[XB_XCNT(j)]); sum += c; cnt += (c > 0u) ? 1u : 0u; mine = (j == x) ? c : mine; }
        if (sum == G) break;
        __builtin_amdgcn_s_sleep(1);
        if ((++sp & 255u) == 0u) { if (xb_ld(&bar[XB_TMO])) break; if (sp > XB_SPIN_CAP) { atomicAdd(&bar[XB_TMO], 1u); break; } }
    }
    nloc = mine > 0u ? mine : 1u; nx = cnt > 0u ? cnt : 1u;
}

__device__ __forceinline__ void xcd_barrier(const XcdBarrier& b) {
    asm volatile("s_waitcnt vmcnt(0)" ::: "memory");
    __syncthreads();
    if (threadIdx.x == 0) {
        unsigned* bar = b.bar;
        __builtin_amdgcn_s_waitcnt(0);
        unsigned nloc = b.st[0], nx = b.st[1];
        if (nloc == 0u) { xcd_barrier_complete(bar, b.x, nloc, nx); b.st[0] = nloc; b.st[1] = nx; }
        const unsigned old = xb_add(&bar[XB_XSUB(b.x)], 1u);
        const unsigned gen = old / nloc;
        if (old + 1u == (gen + 1u) * nloc) {
            __builtin_amdgcn_fence(__ATOMIC_RELEASE, "agent");
            asm volatile("s_waitcnt vmcnt(0)" ::: "memory");
            const unsigned og = xb_add(&bar[XB_TOP], 1u);
            const unsigned tg = og / nx;
            if (og + 1u == (tg + 1u) * nx) xb_add(&bar[XB_TOPGEN], 1u);
            else XB_SPIN(xb_ld(&bar[XB_TOPGEN]) == tg, bar);
            __builtin_amdgcn_fence(__ATOMIC_ACQUIRE, "agent");
            xb_add(&bar[XB_XGEN(b.x)], 1u);
            asm volatile("s_waitcnt vmcnt(0)" ::: "memory");
        } else {
            XB_SPIN(xb_ld(&bar[XB_XGEN(b.x)]) == gen, bar);
            __builtin_amdgcn_fence(__ATOMIC_ACQUIRE, "agent");
            asm volatile("s_waitcnt vmcnt(0)" ::: "memory");
        }
    }
    __syncthreads();
}

constexpr int NWAVES = 8;
#ifndef MK_MULTI
#define MK_MULTI 1
#endif
#ifndef SCAN_DPP
#define SCAN_DPP 0
#endif

constexpr int BATCH = 8, SEQ = 2048, D = 2048, M = BATCH * SEQ, FF = 5632, NL = 4;
constexpr int NH = 12, HD = 64, DATT = 768, DRW = 768, DPOOL = 512;
constexpr int DRWIN = 2752, DIN = 5568, DINP = 5632, ZRP = 2816;
constexpr int LORA_K = 512, LORA_N = 2304;
constexpr float NORM_EPS = 1e-6f, GN_EPS = 64e-5f;
constexpr float QSCALE = 0.125f * 1.4426950408889634f;
constexpr int NPH = 1 + 8 * 3 + 4 * 7;

constexpr size_t MiB = 1u << 20;
constexpr size_t WS_CTL = 0, CTL_ZERO_BYTES = 1 * MiB;
constexpr size_t WS_COS = 1 * MiB, WS_SIN = 1 * MiB + 256 * 1024;
constexpr size_t WS_W = 2 * MiB, LW = 165 * MiB;
constexpr size_t LW_GU1 = 0, LW_D1 = 44 * MiB, LW_IN = 66 * MiB, LW_OUT = 88 * MiB, LW_GU2 = 96 * MiB, LW_D2 = 140 * MiB, LW_LORA = 162 * MiB, LW_POOL = 164 * MiB + 256 * 1024;
constexpr size_t WS_H = WS_W + NL * LW;
constexpr size_t WS_HID = WS_H + 64 * MiB;
constexpr size_t WS_QH = WS_HID, WS_KH = WS_HID + 24 * MiB, WS_VH = WS_HID + 48 * MiB, WS_ZR = WS_HID + 72 * MiB, WS_ZP = WS_HID + 160 * MiB;
constexpr size_t WS_Y = WS_HID + 176 * MiB;
constexpr size_t WS_CAT = WS_Y + 64 * MiB;
constexpr size_t WS_OG = WS_CAT + 64 * MiB;
constexpr size_t WS_LSE = WS_OG + 72 * MiB;
constexpr size_t WS_LA = WS_LSE + 3 * MiB;
constexpr size_t WS_PP = WS_LA + 16 * MiB;
constexpr size_t WS_L = WS_PP + 16 * MiB;
constexpr size_t WS_END = WS_L + 144 * MiB;
static_assert(WS_ZP + (size_t)M * 512 * 2 <= WS_Y && LW_POOL + 512 * 512 * 2 <= LW && LW_LORA + (size_t)LORA_N * LORA_K * 2 <= LW_POOL, "d_ws map");
constexpr int CW_TMO = 0, CW_CODE = 1, CW_BAR = 4096;

constexpr int RING_OFF = 0, RING_BYTES = 131072;
constexpr int LDSCTL_OFF = RING_BYTES, MISC_OFF = LDSCTL_OFF + 320;
constexpr int LDS_BYTES = 147456;

struct Args { const float* in[28]; float* out; unsigned char* ws; int ph_lo, ph_hi; };
struct ArgsD { const __attribute__((address_space(1))) float* in[28]; __attribute__((address_space(1))) float* out; __attribute__((address_space(1))) unsigned char* ws; int ph_lo, ph_hi; };
static_assert(sizeof(ArgsD) == sizeof(Args), "Args views");
typedef const __attribute__((address_space(4))) ArgsD KArgs;
#define INP(A, k) ((const float*)(A)->in[k])

typedef unsigned long long u64t;
typedef float f32x2g __attribute__((ext_vector_type(2)));
struct Frame {
    LAS unsigned char* lds;
    int wave, vcu, G, tid;
    float* X;
    unsigned char* ws;
};
__device__ __forceinline__ float bf2f(bf16 u) { return __uint_as_float((unsigned)u << 16); }
__device__ __forceinline__ float wave_sum(float v) {
#pragma unroll
    for (int o = 1; o < 64; o <<= 1) v += __shfl_xor(v, o);
    return v;
}
__device__ __forceinline__ float sigmoid_f(float x) { return __builtin_amdgcn_rcpf(1.0f + __builtin_amdgcn_exp2f(-1.4426950408889634f * x)); }

template <class SrcF>
__device__ __forceinline__ void transpose_item(const SrcF src, int ldw, int K, bf16* WT, LAS float* scr, int item, int nblk, int lane) {
    const int kb = item / nblk, nb = item % nblk, k0 = 64 * kb, n0 = 32 * nb;
    const float* colp = src(n0 + (lane & 31));
#pragma unroll 8
    for (int i = 0; i < 32; ++i) { const int kk = 2 * i + (lane >> 5); scr[kk * 33 + (lane & 31)] = colp ? colp[(size_t)(k0 + kk) * ldw] : 0.f; }
    LDS_WAIT(); asm volatile("" ::: "memory");
    const int c = lane & 7;
#pragma unroll
    for (int j = 0; j < 4; ++j) { const int n = (lane >> 3) + 8 * j; const LAS float* s = scr + (8 * c) * 33 + n;
        v4u o; o.x = pk2(s[0 * 33], s[1 * 33]); o.y = pk2(s[2 * 33], s[3 * 33]); o.z = pk2(s[4 * 33], s[5 * 33]); o.w = pk2(s[6 * 33], s[7 * 33]);
        *(GAS v4u*)(WT + (size_t)(n0 + n) * K + k0 + 8 * c) = o; }
    LDS_WAIT(); asm volatile("" ::: "memory");
}
struct SrcGU { const float* g; long du;
    __device__ __forceinline__ const float* operator()(int n) const { const int col = 128 * (n >> 8) + (n & 127); const long off = ((n >> 7) & 1) ? du : 0l; return (const float*)((const char*)g + off) + col; } };
struct SrcPlain { const float* w; __device__ __forceinline__ const float* operator()(int n) const { return w + n; } };
struct SrcWin { const float* w;
    __device__ __forceinline__ const float* operator()(int n) const {
        if (n < 1536) { const int sec = n / 768, r = n % 768, h = r >> 6, j = r & 63, d = 4 * (j >> 3) + (j & 3) + 32 * ((j >> 2) & 1); return w + sec * 768 + h * 64 + d; }
        if (n < 2304 + DRWIN) return w + n;
        if (n < 2304 + ZRP) return nullptr;
        return w + (n - (ZRP - DRWIN));
    } };

__device__ __forceinline__ void rms_row_to_bf16(Frame& F, const float* xrow, float* xout, bf16* orow, const float* g) {
    const GAS f32x4* xr = (const GAS f32x4*)xrow + (F.tid & 63); const GAS f32x4* gr = (const GAS f32x4*)g + (F.tid & 63);
    f32x4 v[8]; float s = 0.f;
#pragma unroll
    for (int j = 0; j < 8; ++j) { v[j] = xr[64 * j]; s += (v[j].x * v[j].x + v[j].y * v[j].y) + (v[j].z * v[j].z + v[j].w * v[j].w); }
    const float rstd = 1.0f / sqrtf(wave_sum(s) * (1.f / D) + NORM_EPS);
    GAS f32x4* xo = (GAS f32x4*)xout + (F.tid & 63); GAS u64t* o8 = (GAS u64t*)orow + (F.tid & 63);
#pragma unroll
    for (int j = 0; j < 8; ++j) { xo[64 * j] = v[j]; const f32x4 gg = gr[64 * j];
        o8[64 * j] = (u64t)pk2(v[j].x * rstd * gg.x, v[j].y * rstd * gg.y) | ((u64t)pk2(v[j].z * rstd * gg.z, v[j].w * rstd * gg.w) << 32); }
}

__device__ __forceinline__ void p0_prologue(Frame& F, KArgs* A) {
    LAS float* scr = (LAS float*)(F.lds + RING_OFF + F.wave * 16384);
    const int gw = F.vcu * NWAVES + F.wave, NGW = F.G * NWAVES;
    constexpr int I_GU = (D / 64) * (2 * FF / 32), I_D = (FF / 64) * (D / 32), I_IN = (D / 64) * (DINP / 32), I_OUT = (D / 64) * (D / 32);
    constexpr int I_L = 2 * I_GU + 2 * I_D + I_IN + I_OUT;
    for (int it = gw; it < NL * I_L; it += NGW) {
        const int l = it / I_L; int r = it % I_L;
        unsigned char* wl = F.ws + WS_W + (size_t)l * LW;
        const size_t offF = (size_t)l * D * FF;
        if (r < I_GU) { transpose_item(SrcGU{INP(A, 3) + offF, (long)((const char*)INP(A, 4) - (const char*)INP(A, 3))}, FF, D, (bf16*)(wl + LW_GU1), scr, r, 2 * FF / 32, (F.tid & 63)); continue; } r -= I_GU;
        if (r < I_D) { transpose_item(SrcPlain{INP(A, 5) + offF}, D, FF, (bf16*)(wl + LW_D1), scr, r, D / 32, (F.tid & 63)); continue; } r -= I_D;
        if (r < I_IN) { transpose_item(SrcWin{INP(A, 8) + (size_t)l * D * DIN}, DIN, D, (bf16*)(wl + LW_IN), scr, r, DINP / 32, (F.tid & 63)); continue; } r -= I_IN;
        if (r < I_OUT) { transpose_item(SrcPlain{INP(A, 9) + (size_t)l * D * D}, D, D, (bf16*)(wl + LW_OUT), scr, r, D / 32, (F.tid & 63)); continue; } r -= I_OUT;
        if (r < I_GU) { transpose_item(SrcGU{INP(A, 25) + offF, (long)((const char*)INP(A, 26) - (const char*)INP(A, 25))}, FF, D, (bf16*)(wl + LW_GU2), scr, r, 2 * FF / 32, (F.tid & 63)); continue; } r -= I_GU;
        transpose_item(SrcPlain{INP(A, 27) + offF}, D, FF, (bf16*)(wl + LW_D2), scr, r, D / 32, (F.tid & 63));
    }
    const int gt = F.vcu * (NWAVES * 64) + F.tid, NGT = F.G * NWAVES * 64;
    constexpr int E_LORA = LORA_N * LORA_K, E_POOL = 512 * 512, E_L = E_LORA + E_POOL;
    for (int e = gt; e < NL * E_L; e += NGT) {
        const int l = e / E_L; int r = e % E_L;
        unsigned char* wl = F.ws + WS_W + (size_t)l * LW;
        if (r < E_LORA) { const int n = r / LORA_K, k = r % LORA_K; float v = 0.f;
            if (n < 768) { if (k < 96) v = INP(A, 11)[(size_t)l * 96 * 768 + k * 768 + n]; }
            else if (n < 1536) { if (k >= 96 && k < 192) v = INP(A, 13)[(size_t)l * 96 * 768 + (k - 96) * 768 + (n - 768)]; }
            else { if (k >= 192 && k < 448) v = INP(A, 15)[(size_t)l * 256 * 768 + (k - 192) * 768 + (n - 1536)]; }
            ((bf16*)(wl + LW_LORA))[r] = (bf16)f2bf(v);
        } else { r -= E_LORA; const int n = r / 512, k = r % 512; float v = 0.f;
            if ((n >> 7) == (k >> 7)) v = INP(A, 21)[(size_t)l * 4 * 128 * 128 + (size_t)(n >> 7) * 128 * 128 + (k & 127) * 128 + (n & 127)];
            ((bf16*)(wl + LW_POOL))[r] = (bf16)f2bf(v);
        }
    }
    for (int e = gt; e < SEQ * 32; e += NGT) {
        const int pos = e >> 5, i = e & 31;
        const float invf = powf(10000.0f, -(float)i / 32.0f);
        const double rev = (double)pos * (double)invf * 0.15915494309189535;
        const float fr = (float)(rev - rint(rev));
        ((float*)(F.ws + WS_COS))[e] = __builtin_amdgcn_cosf(fr); ((float*)(F.ws + WS_SIN))[e] = __builtin_amdgcn_sinf(fr);
    }
    for (int m = gw; m < M; m += NGW) rms_row_to_bf16(F, INP(A, 0) + (size_t)m * D, F.X + (size_t)m * D, ((bf16*)(F.ws + WS_H)) + (size_t)m * D, INP(A, 1));
}

__device__ __forceinline__ void row_pass(Frame& F, float coef, const float* gpost, const float* gpre) {
    const int gw = F.vcu * NWAVES + F.wave, NGW = F.G * NWAVES;
    for (int m = gw; m < M; m += NGW) {
        GAS f32x4* xr = (GAS f32x4*)(F.X + (size_t)m * D) + (F.tid & 63); const GAS u64t* yr = (const GAS u64t*)(((bf16*)(F.ws + WS_Y)) + (size_t)m * D) + (F.tid & 63);
        const GAS f32x4* gp = (const GAS f32x4*)gpost + (F.tid & 63);
        f32x4 xv[8], yv[8]; float s = 0.f;
#pragma unroll
        for (int j = 0; j < 8; ++j) { xv[j] = xr[64 * j]; const u64t w = yr[64 * j];
            yv[j].x = __uint_as_float((unsigned)(w << 16)); yv[j].y = __uint_as_float((unsigned)w & 0xffff0000u); yv[j].z = __uint_as_float((unsigned)(w >> 32) << 16); yv[j].w = __uint_as_float((unsigned)(w >> 32) & 0xffff0000u);
            s += (yv[j].x * yv[j].x + yv[j].y * yv[j].y) + (yv[j].z * yv[j].z + yv[j].w * yv[j].w); }
        const float cr = coef / sqrtf(wave_sum(s) * (1.f / D) + NORM_EPS); float s2 = 0.f;
#pragma unroll
        for (int j = 0; j < 8; ++j) { const f32x4 g = gp[64 * j]; xv[j] = xv[j] + yv[j] * g * cr; xr[64 * j] = xv[j];
            s2 += (xv[j].x * xv[j].x + xv[j].y * xv[j].y) + (xv[j].z * xv[j].z + xv[j].w * xv[j].w); }
        if (gpre) {
            const float rstd = 1.0f / sqrtf(wave_sum(s2) * (1.f / D) + NORM_EPS);
            const GAS f32x4* gq = (const GAS f32x4*)gpre + (F.tid & 63); GAS u64t* o8 = (GAS u64t*)(((bf16*)(F.ws + WS_H)) + (size_t)m * D) + (F.tid & 63);
#pragma unroll
            for (int j = 0; j < 8; ++j) { const f32x4 g = gq[64 * j];
                o8[64 * j] = (u64t)pk2(xv[j].x * rstd * g.x, xv[j].y * rstd * g.y) | ((u64t)pk2(xv[j].z * rstd * g.z, xv[j].w * rstd * g.w) << 32); }
        }
    }
}
__device__ __forceinline__ void mix_prep(Frame& F, KArgs* A, int l) {
    const int gw = F.vcu * NWAVES + F.wave, NGW = F.G * NWAVES;
    const float* mu = INP(A, 10) + (size_t)l * DRWIN + 2304;
    for (int m = gw; m < M; m += NGW) {
        const int s = m & (SEQ - 1);
        const bf16* zr = ((bf16*)(F.ws + WS_ZR)) + (size_t)m * ZRP + 2304; bf16* la = ((bf16*)(F.ws + WS_LA)) + (size_t)m * LORA_K;
#pragma unroll
        for (int jj = 0; jj < 7; ++jj) { const int c = (F.tid & 63) + 64 * jj;
            const float z = bf2f(zr[c]), zp = s > 0 ? bf2f(zr[c - ZRP]) : 0.f, zs = z + (zp - z) * mu[c];
            float v; if (c < 96) v = tanhf(zs); else if (c < 192) v = zs; else v = sigmoid_f(zs);
            la[c] = (bf16)f2bf(v); }
        la[448 + (F.tid & 63)] = 0;
        const bf16* zp = ((bf16*)(F.ws + WS_ZP)) + (size_t)m * 512; bf16* pp = ((bf16*)(F.ws + WS_PP)) + (size_t)m * 512;
#pragma unroll
        for (int jj = 0; jj < 8; ++jj) { const int c = (F.tid & 63) + 64 * jj, w = 2 << (jj >> 1), cnt = (s + 1 < w) ? s + 1 : w;
            const float u = bf2f(zp[c]); float acc = u;
            for (int i = 1; i < cnt; ++i) acc += bf2f(zp[c - i * 512]);
            pp[c] = (bf16)f2bf(acc / (float)cnt - u); }
    }
}
__device__ __forceinline__ void attn_combine(Frame& F) {
    const int gw = F.vcu * NWAVES + F.wave, NGW = F.G * NWAVES;
    for (int m = gw; m < M; m += NGW) {
#pragma unroll 4
        for (int h = 0; h < NH; ++h) {
            const float l0 = ((float*)(F.ws + WS_LSE))[(size_t)m * NH + h], l1 = ((float*)(F.ws + WS_LSE))[(size_t)(M + m) * NH + h], l2 = ((float*)(F.ws + WS_LSE))[(size_t)(2 * M + m) * NH + h];
            const float mx = fmaxf(l0, fmaxf(l1, l2));
            const float e0 = __builtin_amdgcn_exp2f(l0 - mx), e1 = __builtin_amdgcn_exp2f(l1 - mx), e2 = __builtin_amdgcn_exp2f(l2 - mx), inv = 1.0f / (e0 + e1 + e2);
            const size_t o = (size_t)m * DATT + h * 64 + (F.tid & 63);
            const float v = (e0 * bf2f(((bf16*)(F.ws + WS_OG))[o]) + e1 * bf2f(((bf16*)(F.ws + WS_OG))[(size_t)M * DATT + o]) + e2 * bf2f(((bf16*)(F.ws + WS_OG))[(size_t)2 * M * DATT + o])) * inv;
            ((bf16*)(F.ws + WS_CAT))[(size_t)m * D + h * 64 + (F.tid & 63)] = (bf16)f2bf(v);
        }
    }
}
constexpr int ATT_KROW = 72, ATT_VROW = 264;
constexpr int ATT_K_OFF = 0, ATT_V_OFF = 256 * ATT_KROW * 2;
constexpr int ATT_UNITS = 3 * BATCH * NH * 16;
static_assert(ATT_V_OFF + 64 * ATT_VROW * 2 <= RING_BYTES, "attention LDS");
typedef short s16x4v __attribute__((ext_vector_type(4)));

__device__ __forceinline__ void attn_unit(Frame& F, int unit) {
    const int g = unit / 1536, rem = unit % 1536, bh = rem >> 4, rb = rem & 15;
    int dl, r, blk;
    if (g == 0) { dl = 1; r = 0; blk = rb; } else if (g == 1) { dl = 4; r = rb & 3; blk = rb >> 2; } else { dl = 16; r = rb; blk = 0; }
    const bf16* Qh = ((bf16*)(F.ws + WS_QH)) + (size_t)bh * SEQ * 64; const bf16* Kh = ((bf16*)(F.ws + WS_KH)) + (size_t)bh * SEQ * 64; const bf16* Vh = ((bf16*)(F.ws + WS_VH)) + (size_t)bh * SEQ * 64;
    LAS bf16* KS = (LAS bf16*)(F.lds + ATT_K_OFF); LAS bf16* VT = (LAS bf16*)(F.lds + ATT_V_OFF);
#pragma unroll
    for (int it = 0; it < 4; ++it) {
        const int idx = F.tid + it * 512, j = idx >> 3, ch = idx & 7, lk = (blk - 1) * 128 + j;
        v4u kv = (v4u){0u, 0u, 0u, 0u}, vv = (v4u){0u, 0u, 0u, 0u};
        if (lk >= 0) { const size_t off = (size_t)(lk * dl + r) * 64 + ch * 8; kv = *(const GAS v4u*)(Kh + off); vv = *(const GAS v4u*)(Vh + off); }
        *(LAS v4u*)(KS + j * ATT_KROW + ch * 8) = kv;
#pragma unroll
        for (int e = 0; e < 8; ++e) { const unsigned wv = vv[e >> 1]; VT[(ch * 8 + e) * ATT_VROW + j] = (bf16)((e & 1) ? (wv >> 16) : (wv & 0xffffu)); }
    }
    __syncthreads();
    const int w = F.wave, fr = (F.tid & 63) & 15, fq = (F.tid & 63) >> 4;
    const int lq = blk * 128 + 16 * w + fr, tq = lq * dl + r;
    const bf16x8 q0 = *(const GAS bf16x8*)(Qh + (size_t)tq * 64 + 8 * fq), q1 = *(const GAS bf16x8*)(Qh + (size_t)tq * 64 + 32 + 8 * fq);
    f32x4 s[9];
#pragma unroll
    for (int u = 0; u < 9; ++u) { const LAS bf16* kp = KS + (16 * (w + u) + fr) * ATT_KROW + 8 * fq;
        const bf16x8 k0 = *(const LAS bf16x8*)kp, k1 = *(const LAS bf16x8*)(kp + 32);
        f32x4 z = (f32x4){0.f, 0.f, 0.f, 0.f};
        z = __builtin_amdgcn_mfma_f32_16x16x32_bf16(k0, q0, z, 0, 0, 0);
        s[u] = __builtin_amdgcn_mfma_f32_16x16x32_bf16(k1, q1, z, 0, 0, 0); }
    float mx = -INFINITY;
#pragma unroll
    for (int u = 0; u < 9; ++u)
#pragma unroll
        for (int i = 0; i < 4; ++i) { const int kk = 16 * u + 4 * fq + i;
            const bool valid = (kk >= fr) && (kk <= 128 + fr) && (blk > 0 || 16 * (w + u) + 4 * fq + i >= 128);
            s[u][i] = valid ? s[u][i] : -INFINITY; mx = fmaxf(mx, s[u][i]); }
    mx = fmaxf(mx, __shfl_xor(mx, 16)); mx = fmaxf(mx, __shfl_xor(mx, 32));
    float lsum = 0.f;
#pragma unroll
    for (int u = 0; u < 9; ++u)
#pragma unroll
        for (int i = 0; i < 4; ++i) { s[u][i] = __builtin_amdgcn_exp2f(s[u][i] - mx); lsum += s[u][i]; }
    lsum += __shfl_xor(lsum, 16); lsum += __shfl_xor(lsum, 32);
    f32x4 o[4];
#pragma unroll
    for (int c = 0; c < 4; ++c) o[c] = (f32x4){0.f, 0.f, 0.f, 0.f};
#pragma unroll
    for (int pp = 0; pp < 5; ++pp) {
        v4u pw; pw.x = pg8::cvt_pk_bf16(s[2 * pp][0], s[2 * pp][1]); pw.y = pg8::cvt_pk_bf16(s[2 * pp][2], s[2 * pp][3]);
        if (pp < 4) { pw.z = pg8::cvt_pk_bf16(s[2 * pp + 1][0], s[2 * pp + 1][1]); pw.w = pg8::cvt_pk_bf16(s[2 * pp + 1][2], s[2 * pp + 1][3]); } else { pw.z = 0u; pw.w = 0u; }
        const bf16x8 pb = __builtin_bit_cast(bf16x8, pw);
        const int ja = 16 * (w + 2 * pp) + 4 * fq, jb = (pp < 4) ? ja + 16 : ja;
#pragma unroll
        for (int c = 0; c < 4; ++c) { const LAS bf16* vp = VT + (16 * c + fr) * ATT_VROW;
            const s16x4v lo = *(const LAS s16x4v*)(vp + ja), hi = *(const LAS s16x4v*)(vp + jb);
            const bf16x8 va = (bf16x8){lo[0], lo[1], lo[2], lo[3], hi[0], hi[1], hi[2], hi[3]};
            o[c] = __builtin_amdgcn_mfma_f32_16x16x32_bf16(va, pb, o[c], 0, 0, 0); }
    }
    const float inv = 1.0f / lsum;
    const int b = bh / NH, h = bh % NH; const size_t mq = (size_t)b * SEQ + tq;
    bf16* op = ((bf16*)(F.ws + WS_OG)) + (size_t)g * M * DATT + mq * DATT + h * 64 + 4 * fq;
#pragma unroll
    for (int c = 0; c < 4; ++c) { pg8::u32x2 wv; wv.x = pg8::cvt_pk_bf16(o[c][0] * inv, o[c][1] * inv); wv.y = pg8::cvt_pk_bf16(o[c][2] * inv, o[c][3] * inv); *(GAS pg8::u32x2*)(op + 16 * c) = wv; }
    if (fq == 0) ((float*)(F.ws + WS_LSE))[((size_t)g * M + mq) * NH + h] = mx + __builtin_amdgcn_logf(lsum);
    __syncthreads();
}

constexpr int SC_T = 32;
static_assert(8 * SC_T * 64 * 4 + SC_T * 4 <= RING_BYTES, "scan LDS");
__device__ __forceinline__ float ar16(float x) {
#if SCAN_DPP
    x += __builtin_bit_cast(float, __builtin_amdgcn_update_dpp(0, __builtin_bit_cast(int, x), 0xB1, 0xF, 0xF, true));
    x += __builtin_bit_cast(float, __builtin_amdgcn_update_dpp(0, __builtin_bit_cast(int, x), 0x4E, 0xF, 0xF, true));
    x += __builtin_bit_cast(float, __builtin_amdgcn_update_dpp(0, __builtin_bit_cast(int, x), 0x141, 0xF, 0xF, true));
    x += __builtin_bit_cast(float, __builtin_amdgcn_update_dpp(0, __builtin_bit_cast(int, x), 0x140, 0xF, 0xF, true));
#else
    x += __shfl_xor(x, 1); x += __shfl_xor(x, 2); x += __shfl_xor(x, 4); x += __shfl_xor(x, 8);
#endif
    return x;
}
__device__ __forceinline__ void scan_head(Frame& F, KArgs* A, int l, int hb) {
    const int b = hb / NH, h = hb % NH, hc = h * 64 + (F.tid & 63);
    LAS float* KAP = (LAS float*)F.lds; LAS float* WW = KAP + SC_T * 64; LAS float* BB = WW + SC_T * 64; LAS float* KP = BB + SC_T * 64; LAS float* RR = KP + SC_T * 64;
    LAS float* VV = RR + SC_T * 64; LAS float* GG = VV + SC_T * 64; LAS float* YY = GG + SC_T * 64; LAS float* RK = YY + SC_T * 64;
    const float* mu = INP(A, 10) + (size_t)l * DRWIN;
    const float mu_r = mu[hc], mu_k = mu[768 + hc], mu_v = mu[1536 + hc];
    const size_t lo = (size_t)l * DRW + hc;
    const float w0 = INP(A, 12)[lo], a0 = INP(A, 14)[lo], k_k = INP(A, 16)[lo], k_a = INP(A, 17)[lo], r_k = INP(A, 18)[lo], gn_w = INP(A, 19)[lo], gn_b = INP(A, 20)[lo];
    const int ks = (F.tid & 63) & 15, rg = (F.tid & 63) >> 4, row0 = 8 * F.wave + 2 * rg;
    f32x4 S0 = (f32x4){0.f, 0.f, 0.f, 0.f}, S1 = (f32x4){0.f, 0.f, 0.f, 0.f};
    for (int t0 = 0; t0 < SEQ; t0 += SC_T) {
#pragma unroll
        for (int q = 0; q < 4; ++q) {
            const int tt = F.wave * 4 + q, sidx = t0 + tt; const size_t m = (size_t)b * SEQ + sidx;
            const bf16* zr = ((bf16*)(F.ws + WS_ZR)) + m * ZRP;
            const float zr_ = bf2f(zr[hc]), zk_ = bf2f(zr[768 + hc]), zv_ = bf2f(zr[1536 + hc]);
            float pr = 0.f, pk = 0.f, pv = 0.f;
            if (sidx > 0) { pr = bf2f(zr[hc - ZRP]); pk = bf2f(zr[768 + hc - ZRP]); pv = bf2f(zr[1536 + hc - ZRP]); }
            const float rr = zr_ + (pr - zr_) * mu_r, kk0 = zk_ + (pk - zk_) * mu_k, vv = zv_ + (pv - zv_) * mu_v;
            const float* Lr = ((float*)(F.ws + WS_L)) + m * LORA_N;
            const float dw = Lr[hc], da = Lr[768 + hc], gg = Lr[1536 + hc];
            const float wdec = __expf(-0.6065306597126334f * sigmoid_f(w0 + dw));
            const float aa = sigmoid_f(a0 + da);
            const float kkn = kk0 * k_k;
            const float n2 = wave_sum(kkn * kkn);
            const float kap = kkn / fmaxf(sqrtf(n2), 1e-12f);
            const float kp = kk0 * (1.0f + (aa - 1.0f) * k_a);
            const float rk = wave_sum(rr * kp * r_k);
            const int o = tt * 64 + (F.tid & 63);
            KAP[o] = kap; WW[o] = wdec; BB[o] = kap * aa; KP[o] = kp; RR[o] = rr; VV[o] = vv; GG[o] = gg;
            if ((F.tid & 63) == 0) RK[tt] = rk;
        }
        __syncthreads();
#pragma unroll 4
        for (int tt = 0; tt < SC_T; ++tt) {
            const f32x4 kap = *(const LAS f32x4*)(KAP + tt * 64 + 4 * ks), w4 = *(const LAS f32x4*)(WW + tt * 64 + 4 * ks), b4 = *(const LAS f32x4*)(BB + tt * 64 + 4 * ks);
            const f32x4 kp4 = *(const LAS f32x4*)(KP + tt * 64 + 4 * ks), r4 = *(const LAS f32x4*)(RR + tt * 64 + 4 * ks);
            const f32x2g vv = *(const LAS f32x2g*)(VV + tt * 64 + row0);
            float p0 = (S0.x * kap.x + S0.y * kap.y) + (S0.z * kap.z + S0.w * kap.w);
            float p1 = (S1.x * kap.x + S1.y * kap.y) + (S1.z * kap.z + S1.w * kap.w);
            p0 = ar16(p0); p1 = ar16(p1);
            S0 = S0 * w4 + (kp4 * vv.x - b4 * p0);
            S1 = S1 * w4 + (kp4 * vv.y - b4 * p1);
            float y0 = (S0.x * r4.x + S0.y * r4.y) + (S0.z * r4.z + S0.w * r4.w);
            float y1 = (S1.x * r4.x + S1.y * r4.y) + (S1.z * r4.z + S1.w * r4.w);
            y0 = ar16(y0); y1 = ar16(y1);
            if (ks == 0) *(LAS f32x2g*)(YY + tt * 64 + row0) = (f32x2g){y0, y1};
        }
        __syncthreads();
#pragma unroll
        for (int q = 0; q < 4; ++q) {
            const int tt = F.wave * 4 + q; const size_t m = (size_t)b * SEQ + t0 + tt; const int o = tt * 64 + (F.tid & 63);
            const float y = YY[o];
            const float mean = wave_sum(y) * (1.f / 64.f), dd = y - mean, var = wave_sum(dd * dd) * (1.f / 64.f);
            const float yn = dd * (1.0f / sqrtf(var + GN_EPS)) * gn_w + gn_b;
            const float outv = (yn + RK[tt] * VV[o]) * GG[o];
            ((bf16*)(F.ws + WS_CAT))[m * D + DATT + hc] = (bf16)f2bf(outv);
        }
        __syncthreads();
    }
}

__global__ void __launch_bounds__(NWAVES * 64, 2) fwd_kernel(Args args) {
    extern __shared__ __attribute__((aligned(16))) unsigned char lds[];
    Frame F;
    F.lds = (LAS unsigned char*)lds;
    F.wave = __builtin_amdgcn_readfirstlane(threadIdx.x >> 6); F.tid = threadIdx.x;
    F.G = gridDim.x; { const int bx = blockIdx.x; F.vcu = (F.G % 8 == 0) ? (bx % 8) * (F.G / 8) + bx / 8 : bx; }
    unsigned char* ws = args.ws; F.ws = ws;
    F.X = args.out;
    for (int u = threadIdx.x; u < (LDS_BYTES - LDSCTL_OFF) / 4; u += NWAVES * 64) ((LAS unsigned*)(F.lds + LDSCTL_OFF))[u] = 0u;
    __syncthreads();
    XcdBarrier bar = xcd_barrier_post((unsigned*)(ws + WS_CTL) + CW_BAR, (volatile LAS unsigned*)(F.lds + MISC_OFF) + 8);
    const int lo = args.ph_lo, hi = args.ph_hi;
    int ph = 0;
    const Frame F0 = F; KArgs* const ka0 = (KArgs*)__builtin_amdgcn_kernarg_segment_ptr();
#define PH_BEGIN if (ph >= lo && ph < hi) { Frame F = F0; KArgs* ka = ka0; F.tid = threadIdx.x; asm volatile("" : "+v"(F.tid)); GAS unsigned char* wsg_ = (GAS unsigned char*)F0.ws; GAS float* xg_ = (GAS float*)F0.X; asm volatile("" : "+s"(wsg_), "+s"(xg_), "+s"(F.wave), "+s"(F.vcu), "+s"(F.G), "+s"(ka)); F.ws = (unsigned char*)wsg_; F.X = (float*)xg_; unsigned char* const ws = F.ws; (void)ws;
#define PH_END   if (ph + 1 < hi) xcd_barrier(bar); } ++ph;

    PH_BEGIN p0_prologue(F, ka); PH_END

    for (int j = 0; j < 2 * NL; ++j) {
        const int l = j >> 1; const bool second = (j & 1) != 0;
        PH_BEGIN {
            pg8::Gemm g{((bf16*)(F.ws + WS_H)), (const bf16*)(ws + WS_W + (size_t)l * LW + (second ? LW_GU2 : LW_GU1)), M, 2 * FF, D}; pg8::StaticOrder S; S.init(M, 2 * FF, F.G, (int)blockIdx.x);
            pg8::EpiSwiglu E{((bf16*)(F.ws + WS_HID)), FF};
            pg8::gemm_phase<pg8::EpiSwiglu, pg8::StaticOrder, true, true>(F.lds + RING_OFF, g, S, E);
        } PH_END
        PH_BEGIN {
            pg8::Gemm g{((bf16*)(F.ws + WS_HID)), (const bf16*)(ws + WS_W + (size_t)l * LW + (second ? LW_D2 : LW_D1)), M, D, FF}; pg8::StaticOrder S; S.init(M, D, F.G, (int)blockIdx.x);
            pg8::EpiBf16Plain E{((bf16*)(F.ws + WS_Y)), D};
            pg8::gemm_phase<pg8::EpiBf16Plain, pg8::StaticOrder, true, true>(F.lds + RING_OFF, g, S, E);
        } PH_END
        PH_BEGIN {
            const float* gpost = (second ? INP(ka, 24) : INP(ka, 2)) + (size_t)l * D;
            const float* gpre = second ? (l + 1 < NL ? INP(ka, 1) + (size_t)(l + 1) * D : nullptr) : INP(ka, 6) + (size_t)l * D;
            row_pass(F, 0.5f, gpost, gpre);
        } PH_END
        if (!second) {
            PH_BEGIN {
                pg8::Gemm g{((bf16*)(F.ws + WS_H)), (const bf16*)(ws + WS_W + (size_t)l * LW + LW_IN), M, DINP, D}; pg8::StaticOrder S; S.init(M, DINP, F.G, (int)blockIdx.x);
                pg8::EpiWin E{((bf16*)(F.ws + WS_QH)), ((bf16*)(F.ws + WS_KH)), ((bf16*)(F.ws + WS_VH)), ((bf16*)(F.ws + WS_ZR)), ((bf16*)(F.ws + WS_ZP)), ((float*)(F.ws + WS_COS)), ((float*)(F.ws + WS_SIN)), QSCALE};
                pg8::gemm_phase<pg8::EpiWin, pg8::StaticOrder, true, true>(F.lds + RING_OFF, g, S, E);
            } PH_END
            PH_BEGIN mix_prep(F, ka, l); PH_END
            PH_BEGIN {
                { pg8::Gemm g{((bf16*)(F.ws + WS_LA)), (const bf16*)(ws + WS_W + (size_t)l * LW + LW_LORA), M, LORA_N, LORA_K}; pg8::StaticOrder S; S.init(M, LORA_N, F.G, (int)blockIdx.x);
                  pg8::EpiF32 E{((float*)(F.ws + WS_L)), LORA_N};
                  pg8::gemm_phase<pg8::EpiF32, pg8::StaticOrder, true, true>(F.lds + RING_OFF, g, S, E); }
                { pg8::Gemm g{((bf16*)(F.ws + WS_PP)), (const bf16*)(ws + WS_W + (size_t)l * LW + LW_POOL), M, DPOOL, 512}; pg8::StaticOrder S; S.init(M, DPOOL, F.G, (int)((blockIdx.x + F.G - (F.G >> 2)) % F.G));
                  pg8::EpiBf16Scale E{((bf16*)(F.ws + WS_CAT)) + DATT + DRW, D, INP(ka, 22) + (size_t)l * DPOOL};
                  pg8::gemm_phase<pg8::EpiBf16Scale, pg8::StaticOrder, true, true>(F.lds + RING_OFF, g, S, E); }
            } PH_END
            PH_BEGIN {
                const int nscan = F.G >= 192 ? 96 : F.G / 2; const int bx = (int)blockIdx.x;
                if (nscan == 0) { for (int hb = 0; hb < BATCH * NH; ++hb) scan_head(F, ka, l, hb); for (int u = 0; u < ATT_UNITS; ++u) attn_unit(F, u); }
                else if (bx < nscan) { for (int hb = bx; hb < BATCH * NH; hb += nscan) scan_head(F, ka, l, hb); }
                else { for (int u = bx - nscan; u < ATT_UNITS; u += F.G - nscan) attn_unit(F, u); }
            } PH_END
            PH_BEGIN attn_combine(F); PH_END
            PH_BEGIN {
                pg8::Gemm g{((bf16*)(F.ws + WS_CAT)), (const bf16*)(ws + WS_W + (size_t)l * LW + LW_OUT), M, D, D}; pg8::StaticOrder S; S.init(M, D, F.G, (int)blockIdx.x);
                pg8::EpiBf16Plain E{((bf16*)(F.ws + WS_Y)), D};
                pg8::gemm_phase<pg8::EpiBf16Plain, pg8::StaticOrder, true, true>(F.lds + RING_OFF, g, S, E);
            } PH_END
            PH_BEGIN row_pass(F, 1.0f, INP(ka, 7) + (size_t)l * D, INP(ka, 23) + (size_t)l * D); PH_END
        }
    }
#undef PH_BEGIN
#undef PH_END
}

extern "C" void kernel_launch(void* const* d_in, const int* in_sizes, int n_in, void* d_out, int out_size, void* d_ws, size_t ws_size, hipStream_t stream) {
    static int grid = 0;
    if (grid == 0) {
        if (n_in != 28 || in_sizes[0] != M * D || out_size != M * D || ws_size < WS_END) { fprintf(stderr, "kernel_launch: unexpected problem (n_in %d, in0 %d, out %d, ws %zu < %zu); nothing launched\n", n_in, n_in > 0 ? in_sizes[0] : -1, out_size, ws_size, (size_t)WS_END); grid = -1; return; }
        int dev = 0, cus = 0, per_cu = 0;
        if (hipGetDevice(&dev) != hipSuccess || hipDeviceGetAttribute(&cus, hipDeviceAttributeMultiprocessorCount, dev) != hipSuccess) { grid = -1; return; }
        if (hipFuncSetAttribute((const void*)fwd_kernel, hipFuncAttributeMaxDynamicSharedMemorySize, LDS_BYTES) != hipSuccess) { fprintf(stderr, "kernel_launch: hipFuncSetAttribute failed\n"); grid = -1; return; }
        if (hipOccupancyMaxActiveBlocksPerMultiprocessor(&per_cu, (const void*)fwd_kernel, NWAVES * 64, LDS_BYTES) != hipSuccess || per_cu < 1)
            fprintf(stderr, "kernel_launch: note: occupancy query reports %d workgroups per CU\n", per_cu);
        (void)hipGetLastError();
        grid = cus;
    }
    if (grid < 0) return;
    if (hipMemsetAsync((char*)d_ws + WS_CTL, 0, CTL_ZERO_BYTES, stream) != hipSuccess) return;
    Args a{};
    for (int i = 0; i < 28; ++i) a.in[i] = (const float*)d_in[i];
    a.out = (float*)d_out; a.ws = (unsigned char*)d_ws;
#if MK_MULTI
    for (int p = 0; p < NPH; ++p) { a.ph_lo = p; a.ph_hi = p + 1; hipLaunchKernelGGL(fwd_kernel, dim3(grid), dim3(NWAVES * 64), LDS_BYTES, stream, a); }
#else
    a.ph_lo = 0; a.ph_hi = NPH; hipLaunchKernelGGL(fwd_kernel, dim3(grid), dim3(NWAVES * 64), LDS_BYTES, stream, a);
#endif
}
```

```cpp
#include <hip/hip_runtime.h>
#include <cstdio>
#include <cstdint>
#include <cmath>
namespace pg8 {
#define PG8_LAS __attribute__((address_space(3)))
typedef unsigned short bf16_t;
typedef short bf16x8 __attribute__((ext_vector_type(8)));
typedef float f32x4 __attribute__((ext_vector_type(4)));
typedef unsigned u32x4 __attribute__((ext_vector_type(4)));
constexpr int BM = 256, BK = 64, HALF = 128, HTB = HALF * BK * 2  , STAGE_BYTES = 8 * HTB, NXCD = 8, WGM = 8;

__host__ __device__ __forceinline__ int lds_byte(int r, int c) { const int st = (r >> 4) * 2 + (c >> 5), rr = r & 15, cc = c & 31, ob = rr * 64 + cc * 2; return st * 1024 + (ob ^ (((ob >> 9) & 1) << 5)); }
__host__ __device__ __forceinline__ void stage_rc(int b, int& R, int& C) { const int st = b / 1024, sb = b % 1024, swz = sb ^ (((sb >> 9) & 1) << 5); R = (st >> 1) * 16 + swz / 64; C = (st & 1) * 32 + (swz % 64) / 2; }
__host__ __device__ __forceinline__ int perm32(int rho) { const int n = rho >> 4, i = rho & 15; return 8 * (i >> 2) + 4 * n + (i & 3); }

struct Unit { int pm, pn; };
struct Gemm { const bf16_t* A; const bf16_t* Bt; int M, N, K; };

struct StaticOrder {
    int nM, nN, nwg, G, c;
    __host__ __device__ void init(int M, int N, int G_, int c_) { nM = M / BM; nN = N / BM; nwg = nM * nN; G = G_; c = c_; }
    __host__ __device__ bool next(int i, Unit& u) const {
        const long L = (long)i * G + c; if (L >= nwg) return false;
        int wgid = (int)L; { const int q = nwg / NXCD, r = nwg % NXCD, xcd = wgid % NXCD, off = wgid / NXCD; wgid = (xcd < r ? xcd * (q + 1) : r * (q + 1) + (xcd - r) * q) + off; }
        const int nig = WGM * nN, gid = wgid / nig, fm = gid * WGM, gsz = (nM - fm) < WGM ? (nM - fm) : WGM;
        u.pm = fm + ((wgid % nig) % gsz); u.pn = (wgid % nig) / gsz; return true;
    }
    __device__ __forceinline__ void a_ready(const Unit&) const {}
    __device__ __forceinline__ void done(const Unit&) const {}
};

typedef float cvt_f32x2_t __attribute__((ext_vector_type(2))); typedef __bf16 cvt_bf16x2_t __attribute__((ext_vector_type(2)));
__device__ __forceinline__ unsigned cvt_pk_bf16(float lo, float hi) { const cvt_f32x2_t v = {lo, hi}; const cvt_bf16x2_t b = __builtin_convertvector(v, cvt_bf16x2_t); return __builtin_bit_cast(unsigned, b); }
typedef float f32x2 __attribute__((ext_vector_type(2)));
typedef unsigned u32x2 __attribute__((ext_vector_type(2)));
__device__ __forceinline__ float silu_f(float x) { return x * __builtin_amdgcn_rcpf(1.0f + __builtin_amdgcn_exp2f(-1.4426950408889634f * x)); }
__device__ __forceinline__ u32x4 pack8(const f32x4 v0, const f32x4 v1) { u32x4 w; w.x = cvt_pk_bf16(v0[0], v0[1]); w.y = cvt_pk_bf16(v0[2], v0[3]); w.z = cvt_pk_bf16(v1[0], v1[1]); w.w = cvt_pk_bf16(v1[2], v1[3]); return w; }

struct EpiF32 {
    static constexpr bool PERM = false, AFTER_DRAIN = false;
    float* C; int ldc;
    __device__ __forceinline__ void operator()(const f32x4 (&acc)[2][2][4][2], const Unit& u, int wr, int wc, int fr, int fq) const {
        asm volatile("" : "+v"(fr), "+v"(fq));
        const int row0 = u.pm * BM + wr * 64 + fr, col0 = u.pn * BM + wc * 32 + 4 * fq;
#pragma unroll
        for (int ai = 0; ai < 2; ++ai)
#pragma unroll
            for (int m = 0; m < 4; ++m) { float* rowp = C + (size_t)(row0 + ai * HALF + m * 16) * ldc + col0;
#pragma unroll
                for (int bj = 0; bj < 2; ++bj)
#pragma unroll
                    for (int n = 0; n < 2; ++n) *(f32x4*)(rowp + bj * HALF + n * 16) = acc[ai][bj][m][n]; }
    }
};
struct EpiBf16Plain {
    static constexpr bool PERM = true, AFTER_DRAIN = false;
    bf16_t* O; int ldc;
    __device__ __forceinline__ void operator()(const f32x4 (&acc)[2][2][4][2], const Unit& u, int wr, int wc, int fr, int fq) const {
        asm volatile("" : "+v"(fr), "+v"(fq));
        const int row0 = u.pm * BM + wr * 64 + fr, col0 = u.pn * BM + wc * 32 + 8 * fq;
#pragma unroll
        for (int ai = 0; ai < 2; ++ai)
#pragma unroll
            for (int m = 0; m < 4; ++m) { bf16_t* rowp = O + (size_t)(row0 + ai * HALF + m * 16) * ldc + col0;
#pragma unroll
                for (int bj = 0; bj < 2; ++bj) *(u32x4*)(rowp + bj * HALF) = pack8(acc[ai][bj][m][0], acc[ai][bj][m][1]); }
    }
};
struct EpiBf16Scale {
    static constexpr bool PERM = true, AFTER_DRAIN = false;
    bf16_t* O; int ldc; const float* scale;
    __device__ __forceinline__ void operator()(const f32x4 (&acc)[2][2][4][2], const Unit& u, int wr, int wc, int fr, int fq) const {
        asm volatile("" : "+v"(fr), "+v"(fq));
        const int row0 = u.pm * BM + wr * 64 + fr, col0 = u.pn * BM + wc * 32 + 8 * fq;
        f32x4 sv[2][2];
#pragma unroll
        for (int bj = 0; bj < 2; ++bj)
#pragma unroll
            for (int n = 0; n < 2; ++n) sv[bj][n] = *(const f32x4*)(scale + col0 + bj * HALF + 4 * n);
#pragma unroll
        for (int ai = 0; ai < 2; ++ai)
#pragma unroll
            for (int m = 0; m < 4; ++m) { bf16_t* rowp = O + (size_t)(row0 + ai * HALF + m * 16) * ldc + col0;
#pragma unroll
                for (int bj = 0; bj < 2; ++bj) *(u32x4*)(rowp + bj * HALF) = pack8(acc[ai][bj][m][0] * sv[bj][0], acc[ai][bj][m][1] * sv[bj][1]); }
    }
};
struct EpiSwiglu {
    static constexpr bool PERM = true, AFTER_DRAIN = false;
    bf16_t* O; int ldc; const float* rs;
    __device__ __forceinline__ void operator()(const f32x4 (&acc)[2][2][4][2], const Unit& u, int wr, int wc, int fr, int fq) const {
        asm volatile("" : "+v"(fr), "+v"(fq));
        const int row0 = u.pm * BM + wr * 64 + fr, col0 = u.pn * HALF + wc * 32 + 8 * fq;
#pragma unroll
        for (int ai = 0; ai < 2; ++ai)
#pragma unroll
            for (int m = 0; m < 4; ++m) { bf16_t* rowp = O + (size_t)(row0 + ai * HALF + m * 16) * ldc + col0; const float r = rs[row0 + ai * HALF + m * 16];
                f32x4 v0, v1;
#pragma unroll
                for (int e = 0; e < 4; ++e) { v0[e] = silu_f(acc[ai][0][m][0][e] * r) * (acc[ai][1][m][0][e] * r); v1[e] = silu_f(acc[ai][0][m][1][e] * r) * (acc[ai][1][m][1][e] * r); }
                *(u32x4*)rowp = pack8(v0, v1); }
    }
};
struct EpiWin {
    static constexpr bool PERM = true, AFTER_DRAIN = false;
    bf16_t *Q, *K, *V;
    bf16_t *ZR, *ZP;
    const float *cs, *sn;
    float qscale; const float* rs;
    __device__ __forceinline__ void operator()(const f32x4 (&acc)[2][2][4][2], const Unit& u, int wr, int wc, int fr, int fq) const {
        asm volatile("" : "+v"(fr), "+v"(fq));
        const int row0 = u.pm * BM + wr * 64 + fr, pn = u.pn;
        if (pn < 6) {
            bf16_t* dst = pn < 3 ? Q : K; const int pt = pn < 3 ? pn : pn - 3; const float sc = pn < 3 ? qscale : 1.0f;
            const int d0 = 16 * (wc & 1) + 4 * fq;
#pragma unroll
            for (int ai = 0; ai < 2; ++ai)
#pragma unroll
                for (int m = 0; m < 4; ++m) { const int row = row0 + ai * HALF + m * 16, b = row >> 11, s = row & 2047; const float rsc = rs[row] * sc;
                    const f32x4 c4 = *(const f32x4*)(cs + s * 32 + d0), s4 = *(const f32x4*)(sn + s * 32 + d0);
#pragma unroll
                    for (int bj = 0; bj < 2; ++bj) { const int head = pt * 4 + bj * 2 + (wc >> 1);
                        const f32x4 x1 = acc[ai][bj][m][0], x2 = acc[ai][bj][m][1];
                        const f32x4 o1 = (x1 * c4 - x2 * s4) * rsc, o2 = (x2 * c4 + x1 * s4) * rsc;
                        bf16_t* p = dst + ((size_t)(b * 12 + head) * 2048 + s) * 64 + d0;
                        u32x2 w1, w2; w1.x = cvt_pk_bf16(o1[0], o1[1]); w1.y = cvt_pk_bf16(o1[2], o1[3]); w2.x = cvt_pk_bf16(o2[0], o2[1]); w2.y = cvt_pk_bf16(o2[2], o2[3]);
                        *(u32x2*)p = w1; *(u32x2*)(p + 32) = w2; } }
        } else if (pn < 9) {
            const int d0 = 32 * (wc & 1) + 8 * fq;
#pragma unroll
            for (int ai = 0; ai < 2; ++ai)
#pragma unroll
                for (int m = 0; m < 4; ++m) { const int row = row0 + ai * HALF + m * 16, b = row >> 11, s = row & 2047; const float r = rs[row];
#pragma unroll
                    for (int bj = 0; bj < 2; ++bj) { const int head = (pn - 6) * 4 + bj * 2 + (wc >> 1);
                        *(u32x4*)(V + ((size_t)(b * 12 + head) * 2048 + s) * 64 + d0) = pack8(acc[ai][bj][m][0] * r, acc[ai][bj][m][1] * r); } }
        } else {
            bf16_t* O; int ldc, colt;
            if (pn < 20) { O = ZR; ldc = 2816; colt = (pn - 9) * BM; } else { O = ZP; ldc = 512; colt = (pn - 20) * BM; }
            const int col0 = colt + wc * 32 + 8 * fq;
#pragma unroll
            for (int ai = 0; ai < 2; ++ai)
#pragma unroll
                for (int m = 0; m < 4; ++m) { bf16_t* rowp = O + (size_t)(row0 + ai * HALF + m * 16) * ldc + col0; const float r = rs[row0 + ai * HALF + m * 16];
#pragma unroll
                    for (int bj = 0; bj < 2; ++bj) *(u32x4*)(rowp + bj * HALF) = pack8(acc[ai][bj][m][0] * r, acc[ai][bj][m][1] * r); }
        }
    }
};

struct PanelOrder {
    int slice;
    __device__ __forceinline__ bool next(int i, Unit& u) const { if (i) return false; const int c = blockIdx.x, x = c & 7, j = c >> 3; u.pm = 32 * slice + 4 * x + (j >> 3); u.pn = j & 7; return true; }
    __device__ __forceinline__ void a_ready(const Unit&) const {}
    __device__ __forceinline__ void done(const Unit&) const {}
};
struct EpiRes {
    static constexpr bool PERM = true, AFTER_DRAIN = true;
    bf16_t* X; float* OUT;
    const float* gpost; float coef; float* rs;
    float* slots;
    unsigned* cnt;
    unsigned* tmo;
    __device__ __forceinline__ float exchange(float part, int ex, const Unit& u, PG8_LAS float* P, PG8_LAS float* S, int wid, int lane, int wc, int rowl, bool writer) const {
        if (writer) P[rowl * 4 + wc] = part;
        asm volatile("s_waitcnt lgkmcnt(0)" ::: "memory"); __builtin_amdgcn_s_barrier(); asm volatile("" ::: "memory");
        const int tid = wid * 64 + lane;
        float* sl = slots + ((size_t)ex * 16384 * 8);
        if (tid < 256) { const float t4 = (P[tid * 4 + 0] + P[tid * 4 + 1]) + (P[tid * 4 + 2] + P[tid * 4 + 3]);
            __hip_atomic_store(sl + (size_t)(u.pm * BM + tid) * 8 + u.pn, t4, __ATOMIC_RELAXED, __HIP_MEMORY_SCOPE_AGENT);
            asm volatile("s_waitcnt vmcnt(0)" ::: "memory");
            if (lane == 0) __hip_atomic_fetch_add(cnt + 64 * (ex * 64 + u.pm), 1u, __ATOMIC_RELAXED, __HIP_MEMORY_SCOPE_AGENT); }
        if (wid == 0) { unsigned sp = 0;
            while ((unsigned)__builtin_amdgcn_readfirstlane(__hip_atomic_load(cnt + 64 * (ex * 64 + u.pm), __ATOMIC_RELAXED, __HIP_MEMORY_SCOPE_AGENT)) < 32u) {
                __builtin_amdgcn_s_sleep(1); if (++sp > (1u << 22)) { if (lane == 0) __hip_atomic_store(tmo, 1u, __ATOMIC_RELAXED, __HIP_MEMORY_SCOPE_AGENT); break; } } }
        asm volatile("s_waitcnt vmcnt(0) lgkmcnt(0)" ::: "memory"); __builtin_amdgcn_s_barrier(); asm volatile("" ::: "memory");
        if (tid < 256) { const float* q = sl + (size_t)(u.pm * BM + tid) * 8; float t = 0.f;
#pragma unroll
            for (int k = 0; k < 8; ++k) t += __hip_atomic_load(q + k, __ATOMIC_RELAXED, __HIP_MEMORY_SCOPE_AGENT);
            S[tid] = t; }
        asm volatile("s_waitcnt vmcnt(0) lgkmcnt(0)" ::: "memory"); __builtin_amdgcn_s_barrier(); asm volatile("" ::: "memory");
        return S[rowl];
    }
    __device__ __forceinline__ void fused(f32x4 (&acc)[2][2][4][2], const Unit& u, int wr, int wc, int fr, int fq, PG8_LAS unsigned char* lds, int wid, int lane) const {
        PG8_LAS float* P = (PG8_LAS float*)lds; PG8_LAS float* S = (PG8_LAS float*)(lds + 4096);
        const int col0 = u.pn * BM + wc * 32 + 8 * fq;
        f32x4 gv[2][2];
#pragma unroll
        for (int bj = 0; bj < 2; ++bj)
#pragma unroll
            for (int n = 0; n < 2; ++n) gv[bj][n] = *(const f32x4*)(gpost + col0 + bj * HALF + 4 * n);
        u32x4 xw_[2][4][2];
#pragma unroll
        for (int ai = 0; ai < 2; ++ai)
#pragma unroll
            for (int m = 0; m < 4; ++m)
#pragma unroll
                for (int bj = 0; bj < 2; ++bj) xw_[ai][m][bj] = *(const u32x4*)(X + ((size_t)u.pm * BM + ai * HALF + wr * 64 + m * 16 + fr) * 2048 + col0 + bj * HALF);
        float ssq[2][4];
#pragma unroll
        for (int ai = 0; ai < 2; ++ai)
#pragma unroll
            for (int m = 0; m < 4; ++m) { float s = 0.f;
#pragma unroll
                for (int bj = 0; bj < 2; ++bj)
#pragma unroll
                    for (int n = 0; n < 2; ++n) { const f32x4 v = acc[ai][bj][m][n]; s += (v[0] * v[0] + v[1] * v[1]) + (v[2] * v[2] + v[3] * v[3]); }
                s += __shfl_xor(s, 16); s += __shfl_xor(s, 32); ssq[ai][m] = s; }
#pragma unroll
        for (int ai = 0; ai < 2; ++ai)
#pragma unroll
            for (int m = 0; m < 4; ++m) if (fq == 0) P[(ai * HALF + wr * 64 + m * 16 + fr) * 4 + wc] = ssq[ai][m];
        const float dummy1 = exchange(0.f, 0, u, P, S, wid, lane, wc, 0, false); (void)dummy1;
        float ss2[2][4];
#pragma unroll
        for (int ai = 0; ai < 2; ++ai)
#pragma unroll
            for (int m = 0; m < 4; ++m) { const int rl = ai * HALF + wr * 64 + m * 16 + fr; const size_t row = (size_t)u.pm * BM + rl;
                const float cr = coef * __builtin_amdgcn_rsqf(S[rl] * (1.0f / 2048.0f) + 1e-6f); float s2 = 0.f;
#pragma unroll
                for (int bj = 0; bj < 2; ++bj) { bf16_t* xp = X + row * 2048 + col0 + bj * HALF; const u32x4 xw = xw_[ai][m][bj];
                    f32x4 x0 = {__uint_as_float(xw.x << 16), __uint_as_float(xw.x & 0xffff0000u), __uint_as_float(xw.y << 16), __uint_as_float(xw.y & 0xffff0000u)};
                    f32x4 x1 = {__uint_as_float(xw.z << 16), __uint_as_float(xw.z & 0xffff0000u), __uint_as_float(xw.w << 16), __uint_as_float(xw.w & 0xffff0000u)};
                    x0 = x0 + acc[ai][bj][m][0] * gv[bj][0] * cr; x1 = x1 + acc[ai][bj][m][1] * gv[bj][1] * cr;
                    if (OUT) { float* op = OUT + row * 2048 + col0 + bj * HALF; *(f32x4*)op = x0; *(f32x4*)(op + 4) = x1; }
                    else { const u32x4 w = pack8(x0, x1); *(u32x4*)xp = w;
                        const float a0 = __uint_as_float(w.x << 16), a1 = __uint_as_float(w.x & 0xffff0000u), a2 = __uint_as_float(w.y << 16), a3 = __uint_as_float(w.y & 0xffff0000u);
                        const float a4 = __uint_as_float(w.z << 16), a5 = __uint_as_float(w.z & 0xffff0000u), a6 = __uint_as_float(w.w << 16), a7 = __uint_as_float(w.w & 0xffff0000u);
                        s2 += ((a0 * a0 + a1 * a1) + (a2 * a2 + a3 * a3)) + ((a4 * a4 + a5 * a5) + (a6 * a6 + a7 * a7)); } }
                s2 += __shfl_xor(s2, 16); s2 += __shfl_xor(s2, 32); ss2[ai][m] = s2; }
        if (OUT) return;
        asm volatile("s_waitcnt lgkmcnt(0)" ::: "memory"); __builtin_amdgcn_s_barrier(); asm volatile("" ::: "memory");
#pragma unroll
        for (int ai = 0; ai < 2; ++ai)
#pragma unroll
            for (int m = 0; m < 4; ++m) if (fq == 0) P[(ai * HALF + wr * 64 + m * 16 + fr) * 4 + wc] = ss2[ai][m];
        const float dummy2 = exchange(0.f, 1, u, P, S, wid, lane, wc, 0, false); (void)dummy2;
        if (u.pn == 0) { const int tid = wid * 64 + lane; if (tid < 256) rs[(size_t)u.pm * BM + tid] = __builtin_amdgcn_rsqf(S[tid] * (1.0f / 2048.0f) + 1e-6f); }
    }
};

template <class Epi, class Sched, bool ALIGN_EPI = false, bool SP2 = false>
__device__ __forceinline__ void gemm_phase(PG8_LAS unsigned char* lds, const Gemm g, const Sched& S, const Epi& E) {
    int tid_ = threadIdx.x; asm volatile("" : "+v"(tid_));
    const int tid = tid_, wid = __builtin_amdgcn_readfirstlane(tid >> 6), lane = tid & 63, wr = wid >> 2, wc = wid & 3, fr = lane & 15, fq = lane >> 4;
    int K_ = g.K; asm volatile("" : "+s"(K_));
    const int K = K_, nt = K / BK;
    unsigned voffA[2], voffB[2];
#pragma unroll
    for (int i = 0; i < 2; ++i) { int R, C; stage_rc(tid * 16 + i * 8192, R, C); const int Rb = Epi::PERM ? ((R & ~31) + perm32(R & 31)) : R;
        voffA[i] = (unsigned)(R * K + C) * 2u; voffB[i] = (unsigned)(Rb * K + C) * 2u; }
    const size_t kstep = (size_t)(BK * 2);
    const size_t hstep = (size_t)HALF * K * 2;
    const size_t tstep = 2 * hstep;
    const unsigned ldsw = (unsigned)wid * 1024u;
    const int aoff = lds_byte(wr * 64 + fr, fq * 8), boff = lds_byte(wc * 32 + fr, fq * 8);
#define PG8_SA(b, h) (((b) * 2 + (h)) * HTB)
#define PG8_SB(b, h) ((4 + (b) * 2 + (h)) * HTB)
#define PG8_STAGE(bufoff, gbase, voff) do { _Pragma("unroll") for (int _i = 0; _i < 2; ++_i) \
        __builtin_amdgcn_global_load_lds((const unsigned*)((const char*)(gbase) + (voff)[_i]), (PG8_LAS unsigned*)(lds + (bufoff) + ldsw + _i * 8192), 16, 0, 0); } while (0)
#define PG8_LDA(dst, b, h) do { _Pragma("unroll") for (int m = 0; m < 4; ++m) _Pragma("unroll") for (int k = 0; k < 2; ++k) dst[m][k] = *(const PG8_LAS bf16x8*)(lds + PG8_SA(b, h) + aoff + m * 2048 + k * 1024); } while (0)
#define PG8_LDB(dst, b, h) do { _Pragma("unroll") for (int n = 0; n < 2; ++n) _Pragma("unroll") for (int k = 0; k < 2; ++k) dst[n][k] = *(const PG8_LAS bf16x8*)(lds + PG8_SB(b, h) + boff + n * 2048 + k * 1024); } while (0)
#define PG8_MMA(ai, bj, At, Bt) do { __builtin_amdgcn_s_setprio(1); _Pragma("unroll") for (int m = 0; m < 4; ++m) _Pragma("unroll") for (int n = 0; n < 2; ++n) _Pragma("unroll") for (int k = 0; k < 2; ++k) \
        acc[ai][bj][m][n] = __builtin_amdgcn_mfma_f32_16x16x32_bf16(Bt[n][k], At[m][k], acc[ai][bj][m][n], 0, 0, 0); __builtin_amdgcn_s_setprio(0); } while (0)
#define PG8_WAIT_V(n) asm volatile("s_waitcnt vmcnt(" #n ")" ::: "memory")
#define PG8_WAIT_L(n) asm volatile("s_waitcnt lgkmcnt(" #n ")" ::: "memory")
#define PG8_BAR __builtin_amdgcn_s_barrier()
#define PG8_SCHED __builtin_amdgcn_sched_barrier(0)
    Unit cur, nxt; int ui = 0;
    if (!S.next(0, cur)) return;
    f32x4 acc[2][2][4][2];
#pragma unroll
    for (int a = 0; a < 2; ++a)
#pragma unroll
        for (int b = 0; b < 2; ++b)
#pragma unroll
            for (int m = 0; m < 4; ++m)
#pragma unroll
                for (int n = 0; n < 2; ++n) acc[a][b][m][n] = (f32x4){0.f, 0.f, 0.f, 0.f};
    bf16x8 At[4][2], B0[2][2], B1[2][2];
    const char* cA = (const char*)g.A + (size_t)cur.pm * tstep; const char* cB = (const char*)g.Bt + (size_t)cur.pn * tstep;
    S.a_ready(cur);
    if constexpr (SP2) {
        PG8_STAGE(PG8_SB(0, 0), cB, voffB); PG8_STAGE(PG8_SB(0, 1), cB + hstep, voffB); PG8_STAGE(PG8_SA(0, 0), cA, voffA); PG8_STAGE(PG8_SA(0, 1), cA + hstep, voffA);
        if (wr == 1) PG8_BAR;
        PG8_WAIT_V(2); PG8_BAR;
        PG8_STAGE(PG8_SB(1, 0), cB + kstep, voffB); PG8_STAGE(PG8_SA(1, 0), cA + kstep, voffA); PG8_STAGE(PG8_SB(1, 1), cB + hstep + kstep, voffB);
        PG8_WAIT_V(6); PG8_BAR;
    } else {
        PG8_STAGE(PG8_SB(0, 0), cB, voffB); PG8_STAGE(PG8_SA(0, 0), cA, voffA); PG8_STAGE(PG8_SB(0, 1), cB + hstep, voffB); PG8_STAGE(PG8_SA(0, 1), cA + hstep, voffA);
        if (wr == 1) PG8_BAR;
        PG8_WAIT_V(4); PG8_BAR;
        PG8_STAGE(PG8_SB(1, 0), cB + kstep, voffB); PG8_STAGE(PG8_SA(1, 0), cA + kstep, voffA); PG8_STAGE(PG8_SB(1, 1), cB + hstep + kstep, voffB);
        PG8_WAIT_V(6); PG8_BAR;
    }
    for (;;) {
        const bool has_next = S.next(ui + 1, nxt);
        const char* nA = has_next ? (const char*)g.A + (size_t)nxt.pm * tstep : cA; const char* nB = has_next ? (const char*)g.Bt + (size_t)nxt.pn * tstep : cB;
        for (int t = 0; t < nt; t += 2) {
            const bool last = (t == nt - 2);
            const char* a1 = cA + (size_t)(t + 1) * kstep;
            const char* a2 = last ? nA : cA + (size_t)(t + 2) * kstep; const char* b2 = last ? nB : cB + (size_t)(t + 2) * kstep;
            const char* a3 = a2 + kstep; const char* b3 = b2 + kstep;
            if (last && has_next) S.a_ready(nxt);
            if constexpr (SP2) {
            PG8_LDB(B0, 0, 0); PG8_LDB(B1, 0, 1); PG8_SCHED; PG8_LDA(At, 0, 0); PG8_STAGE(PG8_SA(1, 1), a1 + hstep, voffA);
            PG8_WAIT_V(8); PG8_WAIT_L(0); PG8_BAR; PG8_MMA(0, 0, At, B0); PG8_MMA(0, 1, At, B1); PG8_BAR; PG8_SCHED;
            PG8_LDA(At, 0, 1); PG8_STAGE(PG8_SB(0, 0), b2, voffB); PG8_STAGE(PG8_SB(0, 1), b2 + hstep, voffB); PG8_STAGE(PG8_SA(0, 0), a2, voffA);
            PG8_WAIT_V(8); PG8_WAIT_L(0); PG8_BAR; PG8_MMA(1, 0, At, B0); PG8_MMA(1, 1, At, B1); PG8_BAR; PG8_SCHED;
            PG8_LDB(B0, 1, 0); PG8_LDB(B1, 1, 1); PG8_SCHED; PG8_LDA(At, 1, 0); PG8_STAGE(PG8_SA(0, 1), a2 + hstep, voffA);
            PG8_WAIT_V(8); PG8_WAIT_L(0); PG8_BAR; PG8_MMA(0, 0, At, B0); PG8_MMA(0, 1, At, B1); PG8_BAR; PG8_SCHED;
            PG8_LDA(At, 1, 1); PG8_STAGE(PG8_SB(1, 0), b3, voffB); PG8_STAGE(PG8_SB(1, 1), b3 + hstep, voffB); PG8_STAGE(PG8_SA(1, 0), a3, voffA);
            PG8_WAIT_V(8); PG8_WAIT_L(0); PG8_BAR; PG8_MMA(1, 0, At, B0); PG8_MMA(1, 1, At, B1); PG8_BAR; PG8_SCHED;
            } else {
            PG8_LDB(B0, 0, 0); PG8_SCHED; PG8_LDA(At, 0, 0); PG8_STAGE(PG8_SA(1, 1), a1 + hstep, voffA);
            PG8_WAIT_L(8); PG8_BAR; PG8_WAIT_L(0); PG8_MMA(0, 0, At, B0); PG8_BAR; PG8_SCHED;
            PG8_LDB(B1, 0, 1); PG8_STAGE(PG8_SB(0, 0), b2, voffB);
            PG8_BAR; PG8_WAIT_L(0); PG8_MMA(0, 1, At, B1); PG8_BAR;
            PG8_LDA(At, 0, 1); PG8_STAGE(PG8_SA(0, 0), a2, voffA);
            PG8_BAR; PG8_WAIT_L(0); PG8_MMA(1, 0, At, B0); PG8_BAR; PG8_SCHED;
            PG8_STAGE(PG8_SB(0, 1), b2 + hstep, voffB);
            PG8_WAIT_V(6); PG8_BAR; PG8_MMA(1, 1, At, B1); PG8_BAR;
            PG8_LDB(B0, 1, 0); PG8_SCHED; PG8_LDA(At, 1, 0); PG8_STAGE(PG8_SA(0, 1), a2 + hstep, voffA);
            PG8_WAIT_L(8); PG8_BAR; PG8_WAIT_L(0); PG8_MMA(0, 0, At, B0); PG8_BAR; PG8_SCHED;
            PG8_LDB(B1, 1, 1); PG8_STAGE(PG8_SB(1, 0), b3, voffB);
            PG8_BAR; PG8_WAIT_L(0); PG8_MMA(0, 1, At, B1); PG8_BAR;
            PG8_LDA(At, 1, 1); PG8_STAGE(PG8_SA(1, 0), a3, voffA);
            PG8_BAR; PG8_WAIT_L(0); PG8_MMA(1, 0, At, B0); PG8_BAR; PG8_SCHED;
            PG8_STAGE(PG8_SB(1, 1), b3 + hstep, voffB);
            PG8_WAIT_V(6); PG8_BAR; PG8_MMA(1, 1, At, B1); PG8_BAR;
            }
        }
        if constexpr (ALIGN_EPI) { if (wr == 0) PG8_BAR; }
        if constexpr (!Epi::AFTER_DRAIN) { E(acc, cur, wr, wc, fr, fq); S.done(cur); }
        if (!has_next) break;
#pragma unroll
        for (int a = 0; a < 2; ++a)
#pragma unroll
            for (int b = 0; b < 2; ++b)
#pragma unroll
                for (int m = 0; m < 4; ++m)
#pragma unroll
                    for (int n = 0; n < 2; ++n) acc[a][b][m][n] = (f32x4){0.f, 0.f, 0.f, 0.f};
        cur = nxt; cA = nA; cB = nB; ++ui;
        if constexpr (ALIGN_EPI) { if (wr == 1) PG8_BAR; }
    }
    PG8_WAIT_V(0);
    if constexpr (!ALIGN_EPI) { if (wr == 0) PG8_BAR; }
    PG8_BAR;
    if constexpr (Epi::AFTER_DRAIN) { E.fused(acc, cur, wr, wc, fr, fq, lds, wid, lane); S.done(cur); }
#undef PG8_SA
#undef PG8_SB
#undef PG8_STAGE
#undef PG8_LDA
#undef PG8_LDB
#undef PG8_MMA
#undef PG8_WAIT_V
#undef PG8_WAIT_L
#undef PG8_BAR
#undef PG8_SCHED
}
}
#define GAS __attribute__((address_space(1)))
#define LAS __attribute__((address_space(3)))
typedef unsigned short bf16;
typedef unsigned v4u __attribute__((ext_vector_type(4)));
typedef float f32x4 __attribute__((ext_vector_type(4)));
typedef short bf16x8 __attribute__((ext_vector_type(8)));
typedef GAS unsigned gu32;
typedef GAS unsigned long long gu64;
#define RLX_AGENT __ATOMIC_RELAXED, __HIP_MEMORY_SCOPE_AGENT
#define LDS_WAIT() asm volatile("s_waitcnt lgkmcnt(0)" ::: "memory")
#define VM_WAIT() asm volatile("s_waitcnt vmcnt(0)" ::: "memory")
__device__ __forceinline__ unsigned long long rt() { return __builtin_amdgcn_s_memrealtime(); }
__device__ __forceinline__ unsigned f2bf(float f) { unsigned u = __builtin_bit_cast(unsigned, f); return (u + 0x7fffu + ((u >> 16) & 1u)) >> 16; }
__device__ __forceinline__ unsigned pk2(float lo, float hi) { return f2bf(lo) | (f2bf(hi) << 16); }
#define XB_TMO      128
#define XB_XCNT(j)  (256  + 64 * (j))
#define XB_XSUB(j)  (1280 + 64 * (j))
#define XB_XGEN(j)  (2304 + 64 * (j))
#define XB_TOP      3328
#define XB_TOPGEN   3392
#define XCD_BAR_WORDS 3456
#define XB_SPIN_CAP (1u << 18)

__device__ __forceinline__ unsigned xb_ld(unsigned* p)              { return __hip_atomic_load(p, __ATOMIC_RELAXED, __HIP_MEMORY_SCOPE_AGENT); }
__device__ __forceinline__ unsigned xb_add(unsigned* p, unsigned v) { return __hip_atomic_fetch_add(p, v, __ATOMIC_RELAXED, __HIP_MEMORY_SCOPE_AGENT); }
__device__ __forceinline__ unsigned xb_xcc_id() { return (unsigned)__builtin_amdgcn_s_getreg((3 << 11) | 20) & 0xFu; }
#define XB_SPIN(cond, bar) do { unsigned _sp = 0; while (cond) { __builtin_amdgcn_s_sleep(1); \
    if ((++_sp & 255u) == 0u) { if (xb_ld(&(bar)[XB_TMO])) break; if (_sp > XB_SPIN_CAP) { atomicAdd(&(bar)[XB_TMO], 1u); break; } } } } while (0)

struct XcdBarrier {
    unsigned* bar; unsigned x;
    volatile LAS unsigned* st;
};

__device__ __forceinline__ XcdBarrier xcd_barrier_post(unsigned* bar, volatile LAS unsigned* st) {
    XcdBarrier b; b.bar = bar; b.x = xb_xcc_id(); b.st = st;
    if (threadIdx.x == 0) (void)xb_add(&bar[XB_XCNT(b.x)], 1u);
    return b;
}
__device__ __forceinline__ void xcd_barrier_complete(unsigned* bar, unsigned x, unsigned& nloc, unsigned& nx) {
    const unsigned G = gridDim.x * gridDim.y * gridDim.z;
    unsigned sum, cnt, mine, sp = 0u;
    for (;;) {
        sum = 0u; cnt = 0u; mine = 0u;
#pragma unroll
        for (unsigned j = 0; j < 16; ++j) { const unsigned c = xb_ld(&bar[XB_XCNT(j)]); sum += c; cnt += (c > 0u) ? 1u : 0u; mine = (j == x) ? c : mine; }
        if (sum == G) break;
        __builtin_amdgcn_s_sleep(1);
        if ((++sp & 255u) == 0u) { if (xb_ld(&bar[XB_TMO])) break; if (sp > XB_SPIN_CAP) { atomicAdd(&bar[XB_TMO], 1u); break; } }
    }
    nloc = mine > 0u ? mine : 1u; nx = cnt > 0u ? cnt : 1u;
}

__device__ __forceinline__ void xcd_barrier(const XcdBarrier& b) {
    asm volatile("s_waitcnt vmcnt(0)" ::: "memory");
    __syncthreads();
    if (threadIdx.x == 0) {
        unsigned* bar = b.bar;
        __builtin_amdgcn_s_waitcnt(0);
        unsigned nloc = b.st[0], nx = b.st[1];
        if (nloc == 0u) { xcd_barrier_complete(bar, b.x, nloc, nx); b.st[0] = nloc; b.st[1] = nx; }
        const unsigned old = xb_add(&bar[XB_XSUB(b.x)], 1u);
        const unsigned gen = old / nloc;
        if (old + 1u == (gen + 1u) * nloc) {
            __builtin_amdgcn_fence(__ATOMIC_RELEASE, "agent");
            asm volatile("s_waitcnt vmcnt(0)" ::: "memory");
            const unsigned og = xb_add(&bar[XB_TOP], 1u);
            const unsigned tg = og / nx;
            if (og + 1u == (tg + 1u) * nx) xb_add(&bar[XB_TOPGEN], 1u);
            else XB_SPIN(xb_ld(&bar[XB_TOPGEN]) == tg, bar);
            __builtin_amdgcn_fence(__ATOMIC_ACQUIRE, "agent");
            xb_add(&bar[XB_XGEN(b.x)], 1u);
            asm volatile("s_waitcnt vmcnt(0)" ::: "memory");
        } else {
            XB_SPIN(xb_ld(&bar[XB_XGEN(b.x)]) == gen, bar);
            __builtin_amdgcn_fence(__ATOMIC_ACQUIRE, "agent");
            asm volatile("s_waitcnt vmcnt(0)" ::: "memory");
        }
    }
    __syncthreads();
}

constexpr int NWAVES = 8;
#ifndef MK_MULTI
#define MK_MULTI 0
#endif
#ifndef SCAN_DPP
#define SCAN_DPP 1
#endif

#ifndef EXTRA_BAR
#define EXTRA_BAR 0
#endif
#ifndef REP_PRO
#define REP_PRO 1
#endif
#ifndef REP_GU
#define REP_GU 1
#endif
#ifndef REP_DN
#define REP_DN 1
#endif
#ifndef REP_ROW
#define REP_ROW 1
#endif
#ifndef REP_WIN
#define REP_WIN 1
#endif
#ifndef REP_PREP
#define REP_PREP 1
#endif
#ifndef REP_LORA
#define REP_LORA 1
#endif
#ifndef REP_MIX
#define REP_MIX 1
#endif
#ifndef REP_ATT
#define REP_ATT 1
#endif
#ifndef REP_S1
#define REP_S1 1
#endif
#ifndef REP_S2
#define REP_S2 1
#endif
#ifndef REP_S3
#define REP_S3 1
#endif
#ifndef REP_COMB
#define REP_COMB 1
#endif
#ifndef REP_WOUT
#define REP_WOUT 1
#endif

constexpr int BATCH = 8, SEQ = 2048, D = 2048, M = BATCH * SEQ, FF = 5632, NL = 4;
constexpr int NH = 12, HD = 64, DATT = 768, DRW = 768, DPOOL = 512;
constexpr int DRWIN = 2752, DIN = 5568, DINP = 5632, ZRP = 2816;
constexpr int LORA_K = 512, LORA_N = 2304;
constexpr float NORM_EPS = 1e-6f, GN_EPS = 64e-5f;
constexpr float QSCALE = 0.125f * 1.4426950408889634f;
constexpr int NPH = 1 + 8 * 2 + 4 * 7;

constexpr size_t MiB = 1u << 20;
constexpr size_t WS_CTL = 0, CTL_ZERO_BYTES = 1 * MiB;
constexpr size_t WS_COS = 1 * MiB, WS_SIN = 1 * MiB + 256 * 1024, WS_RS = 1 * MiB + 512 * 1024;
constexpr size_t WS_W = 2 * MiB, LW = 165 * MiB;
constexpr size_t LW_GU1 = 0, LW_D1 = 44 * MiB, LW_IN = 66 * MiB, LW_OUT = 88 * MiB, LW_GU2 = 96 * MiB, LW_D2 = 140 * MiB, LW_LORA = 162 * MiB, LW_POOL = 164 * MiB + 256 * 1024;
constexpr size_t WS_H = WS_W + NL * LW;
constexpr size_t WS_HID = WS_H + 64 * MiB;
constexpr size_t WS_QH = WS_HID, WS_KH = WS_HID + 24 * MiB, WS_VH = WS_HID + 48 * MiB, WS_ZR = WS_HID + 72 * MiB, WS_ZP = WS_HID + 160 * MiB;
constexpr size_t WS_Y = WS_HID + 176 * MiB;
constexpr size_t WS_CAT = WS_Y + 64 * MiB;
constexpr size_t WS_OG = WS_CAT + 64 * MiB;
constexpr size_t WS_LSE = WS_OG + 72 * MiB;
constexpr size_t WS_LA = WS_LSE + 3 * MiB;
constexpr size_t WS_PP = WS_LA + 16 * MiB;
constexpr size_t WS_L = WS_PP + 16 * MiB, WS_LB = WS_L, WS_XB = WS_L + 72 * MiB;
constexpr size_t WS_END = WS_L + 144 * MiB;
static_assert(WS_ZP + (size_t)M * 512 * 2 <= WS_Y && LW_POOL + 512 * 512 * 2 <= LW && LW_LORA + (size_t)LORA_N * LORA_K * 2 <= LW_POOL, "d_ws map");
constexpr int CW_TMO = 0, CW_CODE = 1, CW_BAR = 4096, CW_ATTQ = 8192, CW_XC = 16384, XC_USE = 2 * 64 * 64;
static_assert((CW_XC + 12 * XC_USE) * 4 <= (int)CTL_ZERO_BYTES, "control words");

constexpr int RING_OFF = 0, RING_BYTES = 131072;
constexpr int LDSCTL_OFF = RING_BYTES, MISC_OFF = LDSCTL_OFF + 320;
constexpr int LDS_BYTES = 147456;

struct Args { const float* in[28]; float* out; unsigned char* ws; int ph_lo, ph_hi; };
struct ArgsD { const __attribute__((address_space(1))) float* in[28]; __attribute__((address_space(1))) float* out; __attribute__((address_space(1))) unsigned char* ws; int ph_lo, ph_hi; };
static_assert(sizeof(ArgsD) == sizeof(Args), "Args views");
typedef const __attribute__((address_space(4))) ArgsD KArgs;
#define INP(A, k) ((const float*)(A)->in[k])

typedef unsigned long long u64t;
typedef float f32x2g __attribute__((ext_vector_type(2)));
struct Frame {
    LAS unsigned char* lds;
    int wave, vcu, G, tid;
    float* X;
    unsigned char* ws;
};
__device__ __forceinline__ float bf2f(bf16 u) { return __uint_as_float((unsigned)u << 16); }
__device__ __forceinline__ float wave_sum(float v) {
#pragma unroll
    for (int o = 1; o < 64; o <<= 1) v += __shfl_xor(v, o);
    return v;
}
__device__ __forceinline__ float sigmoid_f(float x) { return __builtin_amdgcn_rcpf(1.0f + __builtin_amdgcn_exp2f(-1.4426950408889634f * x)); }

template <class SrcF>
__device__ __forceinline__ void transpose_item(const SrcF src, int ldw, int K, bf16* WT, LAS float* scr, int item, int nblk, int lane, const float* kgain = nullptr) {
    const int kb = item / nblk, nb = item % nblk, k0 = 64 * kb, n0 = 32 * nb;
    const float* colp = src(n0 + (lane & 31));
    float tv[32];
    const GAS float* cp = (const GAS float*)colp + (size_t)(k0 + (lane >> 5)) * ldw;
#pragma unroll
    for (int i = 0; i < 32; ++i) tv[i] = colp ? cp[(size_t)(2 * i) * ldw] : 0.f;
#pragma unroll
    for (int i = 0; i < 32; ++i) scr[(2 * i + (lane >> 5)) * 33 + (lane & 31)] = tv[i];
    LDS_WAIT(); asm volatile("" ::: "memory");
    const int c = lane & 7;
    f32x4 g0 = (f32x4){1.f, 1.f, 1.f, 1.f}, g1 = g0;
    if (kgain) { g0 = *(const GAS f32x4*)(kgain + k0 + 8 * c); g1 = *(const GAS f32x4*)(kgain + k0 + 8 * c + 4); }
#pragma unroll
    for (int j = 0; j < 4; ++j) { const int n = (lane >> 3) + 8 * j; const LAS float* s = scr + (8 * c) * 33 + n;
        v4u o; o.x = pk2(s[0 * 33] * g0[0], s[1 * 33] * g0[1]); o.y = pk2(s[2 * 33] * g0[2], s[3 * 33] * g0[3]); o.z = pk2(s[4 * 33] * g1[0], s[5 * 33] * g1[1]); o.w = pk2(s[6 * 33] * g1[2], s[7 * 33] * g1[3]);
        *(GAS v4u*)(WT + (size_t)(n0 + n) * K + k0 + 8 * c) = o; }
    LDS_WAIT(); asm volatile("" ::: "memory");
}
struct SrcGU { const float* g; long du;
    __device__ __forceinline__ const float* operator()(int n) const { const int col = 128 * (n >> 8) + (n & 127); const long off = ((n >> 7) & 1) ? du : 0l; return (const float*)((const char*)g + off) + col; } };
struct SrcPlain { const float* w; __device__ __forceinline__ const float* operator()(int n) const { return w + n; } };
struct SrcWin { const float* w;
    __device__ __forceinline__ const float* operator()(int n) const {
        if (n < 1536) { const int sec = n / 768, r = n % 768, h = r >> 6, j = r & 63, d = 4 * (j >> 3) + (j & 3) + 32 * ((j >> 2) & 1); return w + sec * 768 + h * 64 + d; }
        if (n < 2304 + DRWIN) return w + n;
        if (n < 2304 + ZRP) return nullptr;
        return w + (n - (ZRP - DRWIN));
    } };

__device__ __forceinline__ void x_row_init(Frame& F, const float* xrow, bf16* xb, float* rs) {
    const GAS f32x4* xr = (const GAS f32x4*)xrow + (F.tid & 63);
    f32x4 v[8]; float s = 0.f;
#pragma unroll
    for (int j = 0; j < 8; ++j) { v[j] = xr[64 * j]; s += (v[j].x * v[j].x + v[j].y * v[j].y) + (v[j].z * v[j].z + v[j].w * v[j].w); }
    const float rstd = 1.0f / sqrtf(wave_sum(s) * (1.f / D) + NORM_EPS);
    GAS u64t* o8 = (GAS u64t*)xb + (F.tid & 63);
#pragma unroll
    for (int j = 0; j < 8; ++j) o8[64 * j] = (u64t)pk2(v[j].x, v[j].y) | ((u64t)pk2(v[j].z, v[j].w) << 32);
    if ((F.tid & 63) == 0) *rs = rstd;
}

__device__ __forceinline__ void p0_prologue_w(Frame& F, KArgs* A);
__device__ __forceinline__ void p0_prologue(Frame& F, KArgs* A) {
    p0_prologue_w(F, A);
    const int gw = F.vcu * NWAVES + F.wave, NGW = F.G * NWAVES;
    for (int m = gw; m < M; m += NGW) x_row_init(F, INP(A, 0) + (size_t)m * D, ((bf16*)(F.ws + WS_XB)) + (size_t)m * D, ((float*)(F.ws + WS_RS)) + m);
}
__device__ __forceinline__ void p0_prologue_w(Frame& F, KArgs* A) {
    LAS float* scr = (LAS float*)(F.lds + RING_OFF + F.wave * 16384);
    const int gw = F.vcu * NWAVES + F.wave, NGW = F.G * NWAVES;
    constexpr int I_GU = (D / 64) * (2 * FF / 32), I_D = (FF / 64) * (D / 32), I_IN = (D / 64) * (DINP / 32), I_OUT = (D / 64) * (D / 32);
    constexpr int I_L = 2 * I_GU + 2 * I_D + I_IN + I_OUT;
    for (int it = gw; it < NL * I_L; it += NGW) {
        const int l = it / I_L; int r = it % I_L;
        unsigned char* wl = F.ws + WS_W + (size_t)l * LW;
        const size_t offF = (size_t)l * D * FF;
        if (r < I_GU) { transpose_item(SrcGU{INP(A, 3) + offF, (long)((const char*)INP(A, 4) - (const char*)INP(A, 3))}, FF, D, (bf16*)(wl + LW_GU1), scr, r, 2 * FF / 32, (F.tid & 63), INP(A, 1) + (size_t)l * D); continue; } r -= I_GU;
        if (r < I_D) { transpose_item(SrcPlain{INP(A, 5) + offF}, D, FF, (bf16*)(wl + LW_D1), scr, r, D / 32, (F.tid & 63)); continue; } r -= I_D;
        if (r < I_IN) { transpose_item(SrcWin{INP(A, 8) + (size_t)l * D * DIN}, DIN, D, (bf16*)(wl + LW_IN), scr, r, DINP / 32, (F.tid & 63), INP(A, 6) + (size_t)l * D); continue; } r -= I_IN;
        if (r < I_OUT) { transpose_item(SrcPlain{INP(A, 9) + (size_t)l * D * D}, D, D, (bf16*)(wl + LW_OUT), scr, r, D / 32, (F.tid & 63)); continue; } r -= I_OUT;
        if (r < I_GU) { transpose_item(SrcGU{INP(A, 25) + offF, (long)((const char*)INP(A, 26) - (const char*)INP(A, 25))}, FF, D, (bf16*)(wl + LW_GU2), scr, r, 2 * FF / 32, (F.tid & 63), INP(A, 23) + (size_t)l * D); continue; } r -= I_GU;
        transpose_item(SrcPlain{INP(A, 27) + offF}, D, FF, (bf16*)(wl + LW_D2), scr, r, D / 32, (F.tid & 63));
    }
    const int gt = F.vcu * (NWAVES * 64) + F.tid, NGT = F.G * NWAVES * 64;
    constexpr int E_LORA = LORA_N * LORA_K, E_POOL = 512 * 512, E_L = E_LORA + E_POOL;
    for (int e = gt; e < NL * E_L; e += NGT) {
        const int l = e / E_L; int r = e % E_L;
        unsigned char* wl = F.ws + WS_W + (size_t)l * LW;
        if (r < E_LORA) { const int n = r / LORA_K, k = r % LORA_K; float v = 0.f;
            if (n < 768) { if (k < 96) v = INP(A, 11)[(size_t)l * 96 * 768 + k * 768 + n]; }
            else if (n < 1536) { if (k >= 96 && k < 192) v = INP(A, 13)[(size_t)l * 96 * 768 + (k - 96) * 768 + (n - 768)]; }
            else { if (k >= 192 && k < 448) v = INP(A, 15)[(size_t)l * 256 * 768 + (k - 192) * 768 + (n - 1536)]; }
            ((bf16*)(wl + LW_LORA))[r] = (bf16)f2bf(v);
        } else { r -= E_LORA; const int n = r / 512, k = r % 512; float v = 0.f;
            if ((n >> 7) == (k >> 7)) v = INP(A, 21)[(size_t)l * 4 * 128 * 128 + (size_t)(n >> 7) * 128 * 128 + (k & 127) * 128 + (n & 127)];
            ((bf16*)(wl + LW_POOL))[r] = (bf16)f2bf(v);
        }
    }
    for (int e = gt; e < SEQ * 32; e += NGT) {
        const int pos = e >> 5, i = e & 31;
        const float invf = powf(10000.0f, -(float)i / 32.0f);
        const double rev = (double)pos * (double)invf * 0.15915494309189535;
        const float fr = (float)(rev - rint(rev));
        ((float*)(F.ws + WS_COS))[e] = __builtin_amdgcn_cosf(fr); ((float*)(F.ws + WS_SIN))[e] = __builtin_amdgcn_sinf(fr);
    }
}

__device__ __forceinline__ void row_pass(Frame& F, float coef, const float* gpost, bool last) {
    const int gw = F.vcu * NWAVES + F.wave, NGW = F.G * NWAVES, lane = F.tid & 63;
    for (int m = gw; m < M; m += NGW) {
        GAS u64t* xr = (GAS u64t*)(((bf16*)(F.ws + WS_XB)) + (size_t)m * D) + lane; const GAS u64t* yr = (const GAS u64t*)(((bf16*)(F.ws + WS_Y)) + (size_t)m * D) + lane;
        const GAS f32x4* gp = (const GAS f32x4*)gpost + lane;
        f32x4 xv[8], yv[8]; float s = 0.f;
#pragma unroll
        for (int j = 0; j < 8; ++j) { const u64t xw = xr[64 * j], w = yr[64 * j];
            xv[j].x = __uint_as_float((unsigned)(xw << 16)); xv[j].y = __uint_as_float((unsigned)xw & 0xffff0000u); xv[j].z = __uint_as_float((unsigned)(xw >> 32) << 16); xv[j].w = __uint_as_float((unsigned)(xw >> 32) & 0xffff0000u);
            yv[j].x = __uint_as_float((unsigned)(w << 16)); yv[j].y = __uint_as_float((unsigned)w & 0xffff0000u); yv[j].z = __uint_as_float((unsigned)(w >> 32) << 16); yv[j].w = __uint_as_float((unsigned)(w >> 32) & 0xffff0000u);
            s += (yv[j].x * yv[j].x + yv[j].y * yv[j].y) + (yv[j].z * yv[j].z + yv[j].w * yv[j].w); }
        const float cr = coef / sqrtf(wave_sum(s) * (1.f / D) + NORM_EPS); float s2 = 0.f;
        if (last) {
            GAS f32x4* xo = (GAS f32x4*)(F.X + (size_t)m * D) + lane;
#pragma unroll
            for (int j = 0; j < 8; ++j) { const f32x4 g = gp[64 * j]; xo[64 * j] = xv[j] + yv[j] * g * cr; }
        } else {
#pragma unroll
            for (int j = 0; j < 8; ++j) { const f32x4 g = gp[64 * j]; xv[j] = xv[j] + yv[j] * g * cr;
                const unsigned lo = pk2(xv[j].x, xv[j].y), hi = pk2(xv[j].z, xv[j].w); xr[64 * j] = (u64t)lo | ((u64t)hi << 32);
                const float a0 = __uint_as_float(lo << 16), a1 = __uint_as_float(lo & 0xffff0000u), a2 = __uint_as_float(hi << 16), a3 = __uint_as_float(hi & 0xffff0000u);
                s2 += (a0 * a0 + a1 * a1) + (a2 * a2 + a3 * a3); }
            const float rstd = 1.0f / sqrtf(wave_sum(s2) * (1.f / D) + NORM_EPS);
            if (lane == 0) ((float*)(F.ws + WS_RS))[m] = rstd;
        }
    }
}
__device__ __forceinline__ float tanh_f(float x) { return 1.0f - 2.0f * __builtin_amdgcn_rcpf(1.0f + __builtin_amdgcn_exp2f(2.8853900817779268f * x)); }
__device__ __forceinline__ void unpack8(const v4u z, float (&f)[8]) {
#pragma unroll
    for (int e = 0; e < 4; ++e) { f[2 * e] = __uint_as_float(z[e] << 16); f[2 * e + 1] = __uint_as_float(z[e] & 0xffff0000u); }
}
__device__ __forceinline__ void mix_prep(Frame& F, KArgs* A, int l, int bidx, int nblk) {
    const int gw = bidx * NWAVES + F.wave, NGW = nblk * NWAVES, lane = F.tid & 63;
    const float* mu = INP(A, 10) + (size_t)l * DRWIN + 2304;
    f32x4 mu0 = (f32x4){0.f, 0.f, 0.f, 0.f}, mu1 = mu0;
    if (lane < 56) { mu0 = *(const GAS f32x4*)(mu + 8 * lane); mu1 = *(const GAS f32x4*)(mu + 8 * lane + 4); }
    const int pw = 2 << (lane >> 4);
    const int per = (M + NGW - 1) / NGW, m_lo = gw * per, m_hi = (m_lo + per < M) ? m_lo + per : M;
    for (int m = m_lo; m < m_hi; ++m) {
        const int s = m & (SEQ - 1);
        const bf16* zr = ((bf16*)(F.ws + WS_ZR)) + (size_t)m * ZRP + 2304 + 8 * (lane < 56 ? lane : 0);
        const bf16* zp = ((bf16*)(F.ws + WS_ZP)) + (size_t)m * 512 + 8 * lane;
        const int cnt = (s + 1 < pw) ? s + 1 : pw;
        v4u zc = (v4u){0u, 0u, 0u, 0u}, zq = zc, zw[16];
        if (lane < 56) { zc = *(const GAS v4u*)zr; if (s > 0) zq = *(const GAS v4u*)(zr - ZRP); }
#pragma unroll
        for (int i = 0; i < 16; ++i) { zw[i] = (v4u){0u, 0u, 0u, 0u}; if (i < cnt) zw[i] = *(const GAS v4u*)(zp - (size_t)i * 512); }
        v4u outv = (v4u){0u, 0u, 0u, 0u};
        if (lane < 56) {
            float z[8], zpv[8], v[8]; unpack8(zc, z); unpack8(zq, zpv);
#pragma unroll
            for (int e = 0; e < 8; ++e) { const float mm = e < 4 ? mu0[e] : mu1[e - 4], zs = z[e] + (zpv[e] - z[e]) * mm; v[e] = lane < 12 ? tanh_f(zs) : (lane < 24 ? zs : sigmoid_f(zs)); }
            outv.x = pk2(v[0], v[1]); outv.y = pk2(v[2], v[3]); outv.z = pk2(v[4], v[5]); outv.w = pk2(v[6], v[7]);
        }
        *(GAS v4u*)(((bf16*)(F.ws + WS_LA)) + (size_t)m * LORA_K + 8 * lane) = outv;
        float acc[8], u[8]; unpack8(zw[0], u);
#pragma unroll
        for (int e = 0; e < 8; ++e) acc[e] = u[e];
#pragma unroll
        for (int i = 1; i < 16; ++i) { float t[8]; unpack8(zw[i], t);
#pragma unroll
            for (int e = 0; e < 8; ++e) acc[e] += t[e]; }
        const float ic = 1.0f / (float)cnt;
        v4u pv; pv.x = pk2(acc[0] * ic - u[0], acc[1] * ic - u[1]); pv.y = pk2(acc[2] * ic - u[2], acc[3] * ic - u[3]); pv.z = pk2(acc[4] * ic - u[4], acc[5] * ic - u[5]); pv.w = pk2(acc[6] * ic - u[6], acc[7] * ic - u[7]);
        *(GAS v4u*)(((bf16*)(F.ws + WS_PP)) + (size_t)m * 512 + 8 * lane) = pv;
    }
}
__device__ __forceinline__ void attn_combine(Frame& F) {
    const int gw = F.vcu * NWAVES + F.wave, NGW = F.G * NWAVES, lane = F.tid & 63;
    const float* LSE = (const float*)(F.ws + WS_LSE); const bf16* OG = (const bf16*)(F.ws + WS_OG); bf16* CAT = (bf16*)(F.ws + WS_CAT);
    const int per = (M + NGW - 1) / NGW, m_lo = gw * per, m_hi = (m_lo + per < M) ? m_lo + per : M;
    constexpr int RB = 4;
    for (int m0 = m_lo; m0 < m_hi; m0 += RB) {
        u64t a[RB][3], b[RB][3], c[RB][3]; float l0[RB][3], l1[RB][3], l2[RB][3];
#pragma unroll
        for (int r = 0; r < RB; ++r) { const int m = (m0 + r < m_hi) ? m0 + r : m_hi - 1;
#pragma unroll
            for (int p = 0; p < 3; ++p) {
                const int h = 4 * p + (lane >> 4); const size_t o = (size_t)m * DATT + 256 * p + 4 * lane;
                l0[r][p] = LSE[(size_t)m * NH + h]; l1[r][p] = LSE[(size_t)(M + m) * NH + h]; l2[r][p] = LSE[(size_t)(2 * M + m) * NH + h];
                a[r][p] = *(const GAS u64t*)(OG + o); b[r][p] = *(const GAS u64t*)(OG + (size_t)M * DATT + o); c[r][p] = *(const GAS u64t*)(OG + (size_t)2 * M * DATT + o); } }
#pragma unroll
        for (int r = 0; r < RB; ++r) { if (m0 + r >= m_hi) break; const int m = m0 + r;
#pragma unroll
            for (int p = 0; p < 3; ++p) {
                const float mx = fmaxf(l0[r][p], fmaxf(l1[r][p], l2[r][p]));
                float e0 = __builtin_amdgcn_exp2f(l0[r][p] - mx), e1 = __builtin_amdgcn_exp2f(l1[r][p] - mx), e2 = __builtin_amdgcn_exp2f(l2[r][p] - mx); const float inv = __builtin_amdgcn_rcpf(e0 + e1 + e2);
                e0 *= inv; e1 *= inv; e2 *= inv;
                float rr[4];
#pragma unroll
                for (int e = 0; e < 4; ++e) rr[e] = e0 * bf2f((bf16)(a[r][p] >> (16 * e))) + e1 * bf2f((bf16)(b[r][p] >> (16 * e))) + e2 * bf2f((bf16)(c[r][p] >> (16 * e)));
                *(GAS u64t*)(CAT + (size_t)m * D + 256 * p + 4 * lane) = (u64t)pk2(rr[0], rr[1]) | ((u64t)pk2(rr[2], rr[3]) << 32); } }
    }
}
constexpr int MP = 64;
__device__ __forceinline__ int swz(int row, int col) { return row * MP + ((((col >> 3) ^ (row >> 1)) & 7) << 3) + (col & 7); }
constexpr int ATT_K_OFF = 0, ATT_V_OFF = 256 * 64 * 2;
constexpr int ATT_UNITS = 3 * BATCH * NH * 16;
static_assert(ATT_V_OFF + 256 * 64 * 2 <= RING_BYTES, "attention LDS");
typedef short s16x4v __attribute__((ext_vector_type(4)));
__device__ __forceinline__ int swzv(int key, int d) { return key * 64 + ((((d >> 3) ^ (2 * ((key >> 1) & 3))) & 7) << 3) + (d & 7); }
struct AttnIn { v4u kv[4], vv[4]; bf16x8 q0, q1; };
struct AttnUnit { int g, bh, dl, r, blk; };
__device__ __forceinline__ AttnUnit attn_decode(int unit) { AttnUnit u; u.g = unit / 1536; const int rem = unit % 1536, rb = rem & 15; u.bh = rem >> 4;
    if (u.g == 0) { u.dl = 1; u.r = 0; u.blk = rb; } else if (u.g == 1) { u.dl = 4; u.r = rb & 3; u.blk = rb >> 2; } else { u.dl = 16; u.r = rb; u.blk = 0; } return u; }
__device__ __forceinline__ void attn_fetch(Frame& F, const AttnUnit& u, AttnIn& R) {
    const bf16* Qh = ((bf16*)(F.ws + WS_QH)) + (size_t)u.bh * SEQ * 64; const bf16* Kh = ((bf16*)(F.ws + WS_KH)) + (size_t)u.bh * SEQ * 64; const bf16* Vh = ((bf16*)(F.ws + WS_VH)) + (size_t)u.bh * SEQ * 64;
#pragma unroll
    for (int it = 0; it < 4; ++it) { const int idx = F.tid + it * 512, j = idx >> 3, ch = idx & 7, lk = (u.blk - 1) * 128 + j;
        R.kv[it] = (v4u){0u, 0u, 0u, 0u}; R.vv[it] = (v4u){0u, 0u, 0u, 0u};
        if (lk >= 0) { const size_t off = (size_t)(lk * u.dl + u.r) * 64 + ch * 8; R.kv[it] = *(const GAS v4u*)(Kh + off); R.vv[it] = *(const GAS v4u*)(Vh + off); } }
    const int fr = (F.tid & 63) & 15, fq = (F.tid & 63) >> 4, tq = (u.blk * 128 + 16 * F.wave + fr) * u.dl + u.r;
    R.q0 = *(const GAS bf16x8*)(Qh + (size_t)tq * 64 + 8 * fq); R.q1 = *(const GAS bf16x8*)(Qh + (size_t)tq * 64 + 32 + 8 * fq);
}
__device__ __forceinline__ void attn_stage(Frame& F, const AttnIn& R) {
    LAS bf16* KS = (LAS bf16*)(F.lds + ATT_K_OFF); LAS bf16* VS = (LAS bf16*)(F.lds + ATT_V_OFF);
#pragma unroll
    for (int it = 0; it < 4; ++it) { const int idx = F.tid + it * 512, j = idx >> 3, ch = idx & 7;
        *(LAS v4u*)(KS + swz(j, 8 * ch)) = R.kv[it]; *(LAS v4u*)(VS + swzv(j, 8 * ch)) = R.vv[it]; }
}
__device__ __forceinline__ void attn_compute(Frame& F, const AttnUnit& u, const bf16x8 q0, const bf16x8 q1) {
    const LAS bf16* KS = (const LAS bf16*)(F.lds + ATT_K_OFF); const LAS bf16* VS = (const LAS bf16*)(F.lds + ATT_V_OFF);
    const int w = F.wave, lane = F.tid & 63, fr = lane & 15, fq = lane >> 4, blk = u.blk;
    const int tq = (blk * 128 + 16 * w + fr) * u.dl + u.r;
    const int ko0 = swz(fr, 8 * fq), ko1 = swz(fr, 32 + 8 * fq);
    f32x4 s[9];
#pragma unroll
    for (int t = 0; t < 9; ++t) { const LAS bf16* kp = KS + 16 * (w + t) * 64;
        f32x4 z = (f32x4){0.f, 0.f, 0.f, 0.f};
        z = __builtin_amdgcn_mfma_f32_16x16x32_bf16(*(const LAS bf16x8*)(kp + ko0), q0, z, 0, 0, 0);
        s[t] = __builtin_amdgcn_mfma_f32_16x16x32_bf16(*(const LAS bf16x8*)(kp + ko1), q1, z, 0, 0, 0); }
    float mx = -INFINITY;
#pragma unroll
    for (int t = 0; t < 9; ++t)
#pragma unroll
        for (int i = 0; i < 4; ++i) { const int kk = 16 * t + 4 * fq + i;
            const bool valid = (kk >= fr) && (kk <= 128 + fr) && (blk > 0 || 16 * (w + t) + 4 * fq + i >= 128);
            s[t][i] = valid ? s[t][i] : -INFINITY; mx = fmaxf(mx, s[t][i]); }
    mx = fmaxf(mx, __shfl_xor(mx, 16)); mx = fmaxf(mx, __shfl_xor(mx, 32));
    float lsum = 0.f;
#pragma unroll
    for (int t = 0; t < 9; ++t)
#pragma unroll
        for (int i = 0; i < 4; ++i) { s[t][i] = __builtin_amdgcn_exp2f(s[t][i] - mx); lsum += s[t][i]; }
    lsum += __shfl_xor(lsum, 16); lsum += __shfl_xor(lsum, 32);
    f32x4 o[4];
#pragma unroll
    for (int c = 0; c < 4; ++c) o[c] = (f32x4){0.f, 0.f, 0.f, 0.f};
    const int tq_ = (lane >> 2) & 3, tp = lane & 3;
#pragma unroll
    for (int pp = 0; pp < 5; ++pp) {
        v4u pw; pw.x = pg8::cvt_pk_bf16(s[2 * pp][0], s[2 * pp][1]); pw.y = pg8::cvt_pk_bf16(s[2 * pp][2], s[2 * pp][3]);
        if (pp < 4) { pw.z = pg8::cvt_pk_bf16(s[2 * pp + 1][0], s[2 * pp + 1][1]); pw.w = pg8::cvt_pk_bf16(s[2 * pp + 1][2], s[2 * pp + 1][3]); } else { pw.z = 0u; pw.w = 0u; }
        const bf16x8 pb = __builtin_bit_cast(bf16x8, pw);
        const int ka = 16 * (w + 2 * pp) + 4 * fq + tq_, kb = (pp < 4) ? ka + 16 : ka;
#pragma unroll
        for (int c = 0; c < 4; ++c) {
            const s16x4v lo = __builtin_bit_cast(s16x4v, __builtin_amdgcn_ds_read_tr16_b64_v4i16((LAS s16x4v*)(VS + swzv(ka, 16 * c + 4 * tp))));
            const s16x4v hi = __builtin_bit_cast(s16x4v, __builtin_amdgcn_ds_read_tr16_b64_v4i16((LAS s16x4v*)(VS + swzv(kb, 16 * c + 4 * tp))));
            const bf16x8 va = (bf16x8){lo[0], lo[1], lo[2], lo[3], hi[0], hi[1], hi[2], hi[3]};
            o[c] = __builtin_amdgcn_mfma_f32_16x16x32_bf16(va, pb, o[c], 0, 0, 0); }
    }
    const float inv = 1.0f / lsum;
    const int b = u.bh / NH, h = u.bh % NH; const size_t mq = (size_t)b * SEQ + tq;
    bf16* op = ((bf16*)(F.ws + WS_OG)) + (size_t)u.g * M * DATT + mq * DATT + h * 64 + 4 * fq;
#pragma unroll
    for (int c = 0; c < 4; ++c) { pg8::u32x2 wv; wv.x = pg8::cvt_pk_bf16(o[c][0] * inv, o[c][1] * inv); wv.y = pg8::cvt_pk_bf16(o[c][2] * inv, o[c][3] * inv); *(GAS pg8::u32x2*)(op + 16 * c) = wv; }
    if (fq == 0) ((float*)(F.ws + WS_LSE))[((size_t)u.g * M + mq) * NH + h] = mx + __builtin_amdgcn_logf(lsum);
}
__device__ __forceinline__ void attn_loop(Frame& F, gu32* ctr) {
    volatile LAS int* slot = (volatile LAS int*)(F.lds + MISC_OFF + 64);
    if (F.tid == 0) *slot = (int)__hip_atomic_fetch_add(ctr, 1u, __ATOMIC_RELAXED, __HIP_MEMORY_SCOPE_AGENT);
    __syncthreads();
    int cur = *slot;
    AttnIn R;
    if (cur < ATT_UNITS) attn_fetch(F, attn_decode(cur), R);
    while (cur < ATT_UNITS) {
        const AttnUnit u = attn_decode(cur);
        __syncthreads();
        if (F.tid == 0) *slot = (int)__hip_atomic_fetch_add(ctr, 1u, __ATOMIC_RELAXED, __HIP_MEMORY_SCOPE_AGENT);
        attn_stage(F, R);
        const bf16x8 q0 = R.q0, q1 = R.q1;
        __syncthreads();
        const int nxt = *slot;
        if (nxt < ATT_UNITS) attn_fetch(F, attn_decode(nxt), R);
        attn_compute(F, u, q0, q1);
        cur = nxt;
    }
}

constexpr int CH = 64, NCHUNK = SEQ / CH, SCAN_UNITS = BATCH * NH * NCHUNK;
constexpr int MB = 64 * MP * 2;
constexpr int LP = 68;
constexpr int S1_KT = 0, S1_BT = MB, S1_KK = 2 * MB, S1_RT = 3 * MB, S1_KTT = 4 * MB, S1_BTT = 5 * MB, S1_KKT = 6 * MB, S1_VT = 7 * MB, S1_AAK = 8 * MB, S1_ARB = 9 * MB, S1_ARK = 10 * MB;
constexpr int S1_P = 11 * MB, S1_PT = 12 * MB, S1_TM = 13 * MB, S1_GC = 14 * MB, S1_WT = S1_P  , S1_END = S1_GC + 256;
constexpr int S1_AKVT = S1_KT, S1_WTT = S1_KK, S1_UT = S1_AAK;
static_assert(S1_END <= RING_BYTES, "S1 LDS");
constexpr size_t WS_XS = WS_H + 50 * MiB;
constexpr size_t WS_MC = WS_H, WS_RK = WS_H + 48 * MiB, WS_NCT = WS_Y, WS_YL = WS_END, WS_QE = WS_YL + 48 * MiB, WS_VV = WS_QE + 24 * MiB, WS_GG = WS_VV + 24 * MiB, WS_H0T = WS_GG + 24 * MiB, WS_END2 = WS_H0T + 24 * MiB;
static_assert((size_t)SCAN_UNITS * 64 * 64 * 4 <= 48 * MiB && (size_t)SCAN_UNITS * 64 * 64 * 2 <= 24 * MiB && WS_RK + (size_t)BATCH * NH * SEQ * 4 <= WS_HID, "scan scratch map");

__device__ __forceinline__ f32x4 mm_tile(const LAS bf16* X, const LAS bf16* Y, int tn, int tm, int fr, int fq, f32x4 acc) {
    const int o0 = swz(fr, 8 * fq), o1 = swz(fr, 32 + 8 * fq);
    const LAS bf16* ap = Y + 16 * tm * MP; const LAS bf16* bp = X + 16 * tn * MP;
    acc = __builtin_amdgcn_mfma_f32_16x16x32_bf16(*(const LAS bf16x8*)(ap + o0), *(const LAS bf16x8*)(bp + o0), acc, 0, 0, 0);
    acc = __builtin_amdgcn_mfma_f32_16x16x32_bf16(*(const LAS bf16x8*)(ap + o1), *(const LAS bf16x8*)(bp + o1), acc, 0, 0, 0);
    return acc;
}
__device__ __forceinline__ void st_tile_bf16(LAS bf16* Z, int tn, int tm, int fr, int fq, f32x4 v) {
    pg8::u32x2 w; w.x = pg8::cvt_pk_bf16(v[0], v[1]); w.y = pg8::cvt_pk_bf16(v[2], v[3]); *(LAS pg8::u32x2*)(Z + swz(16 * tn + fr, 16 * tm + 4 * fq)) = w;
}
constexpr f32x4 F4Z = {0.f, 0.f, 0.f, 0.f};

__device__ __forceinline__ void wave_sum8(float (&v)[8]) {
#pragma unroll
    for (int i = 0; i < 8; ++i) {
        v[i] += __builtin_bit_cast(float, __builtin_amdgcn_update_dpp(0, __builtin_bit_cast(int, v[i]), 0xB1, 0xF, 0xF, true));
        v[i] += __builtin_bit_cast(float, __builtin_amdgcn_update_dpp(0, __builtin_bit_cast(int, v[i]), 0x4E, 0xF, 0xF, true));
        v[i] += __builtin_bit_cast(float, __builtin_amdgcn_update_dpp(0, __builtin_bit_cast(int, v[i]), 0x141, 0xF, 0xF, true));
        v[i] += __builtin_bit_cast(float, __builtin_amdgcn_update_dpp(0, __builtin_bit_cast(int, v[i]), 0x140, 0xF, 0xF, true)); }
    float t[8];
#pragma unroll
    for (int i = 0; i < 8; ++i) t[i] = __shfl_xor(v[i], 16);
#pragma unroll
    for (int i = 0; i < 8; ++i) v[i] += t[i];
#pragma unroll
    for (int i = 0; i < 8; ++i) t[i] = __shfl_xor(v[i], 32);
#pragma unroll
    for (int i = 0; i < 8; ++i) v[i] += t[i];
}
struct S1Raw { unsigned zr[9], zk[9], zv[9], dw[8], da[8], gg[8]; float mu_r, mu_k, mu_v, w0, a0, k_k, k_a, r_k; };
__device__ __forceinline__ void s1_fetch(Frame& F, KArgs* A, int l, int unit, S1Raw& R) {
    const int hb = unit / NCHUNK, c = unit % NCHUNK, b = hb / NH, h = hb % NH, lane = F.tid & 63, hc = h * 64 + lane;
    const int s0 = c * CH + 8 * F.wave; const size_t m0 = (size_t)b * SEQ + s0;
    const GAS bf16* zr = (const GAS bf16*)(((const bf16*)(F.ws + WS_ZR)) + m0 * ZRP); const GAS bf16* Lr = (const GAS bf16*)(((const bf16*)(F.ws + WS_LB)) + m0 * LORA_N);
#pragma unroll
    for (int q = 0; q < 9; ++q) { if (q == 0 && s0 == 0) { R.zr[0] = 0u; R.zk[0] = 0u; R.zv[0] = 0u; } else { const GAS bf16* zp = zr + (q - 1) * ZRP; R.zr[q] = zp[hc]; R.zk[q] = zp[768 + hc]; R.zv[q] = zp[1536 + hc]; } }
#pragma unroll
    for (int q = 0; q < 8; ++q) { R.dw[q] = Lr[q * LORA_N + hc]; R.da[q] = Lr[q * LORA_N + 768 + hc]; R.gg[q] = Lr[q * LORA_N + 1536 + hc]; }
    const float* mu = INP(A, 10) + (size_t)l * DRWIN; const size_t lo = (size_t)l * DRW + hc;
    R.mu_r = mu[hc]; R.mu_k = mu[768 + hc]; R.mu_v = mu[1536 + hc];
    R.w0 = INP(A, 12)[lo]; R.a0 = INP(A, 14)[lo]; R.k_k = INP(A, 16)[lo]; R.k_a = INP(A, 17)[lo]; R.r_k = INP(A, 18)[lo];
}
__device__ __forceinline__ int tslot(int tn, int tm, int lane) { return (tn * 4 + tm) * 64 + lane; }

template <int PMODE  > __device__ __forceinline__ void scan_s1_phase(Frame& F, KArgs* A, int l) {
    const int lane = F.tid & 63, w = F.wave;
    const int fr = lane & 15, fq = lane >> 4, tn = w & 3, tm0 = 2 * (w >> 2);
    LAS bf16* KT = (LAS bf16*)(F.lds + S1_KT); LAS bf16* BT = (LAS bf16*)(F.lds + S1_BT); LAS bf16* KK = (LAS bf16*)(F.lds + S1_KK); LAS bf16* RT = (LAS bf16*)(F.lds + S1_RT);
    LAS bf16* KTT = (LAS bf16*)(F.lds + S1_KTT); LAS bf16* BTT = (LAS bf16*)(F.lds + S1_BTT); LAS bf16* KKT = (LAS bf16*)(F.lds + S1_KKT); LAS bf16* VT = (LAS bf16*)(F.lds + S1_VT);
    LAS bf16* AAK = (LAS bf16*)(F.lds + S1_AAK); LAS bf16* ARB = (LAS bf16*)(F.lds + S1_ARB); LAS bf16* ARK = (LAS bf16*)(F.lds + S1_ARK);
    LAS bf16* AKVT = (LAS bf16*)(F.lds + S1_AKVT); LAS bf16* TM = (LAS bf16*)(F.lds + S1_TM); LAS bf16* WTT = (LAS bf16*)(F.lds + S1_WTT); LAS bf16* UT = (LAS bf16*)(F.lds + S1_UT);
    LAS bf16* PM = (LAS bf16*)(F.lds + S1_P); LAS bf16* PT = (LAS bf16*)(F.lds + S1_PT);
    LAS float* GC = (LAS float*)(F.lds + S1_GC); LAS float* WTOT = (LAS float*)(F.lds + S1_WT);
    const int per = (SCAN_UNITS + F.G - 1) / F.G, u0 = (int)blockIdx.x * per, u1 = (u0 + per < SCAN_UNITS) ? u0 + per : SCAN_UNITS;
    if (u0 >= u1) return;
    S1Raw R; s1_fetch(F, A, l, u0, R);
    for (int unit = u0; unit < u1; ++unit) {
    const int hb = unit / NCHUNK, c = unit % NCHUNK;
    {
        const int s0 = c * CH + 8 * w;
        float rr[8], kap[8], kp[8], aa[8], vv[8], lw[8], cl[8], kk0[8], red[8];
#pragma unroll
        for (int q = 0; q < 8; ++q) {
            const float zr1 = __uint_as_float(R.zr[q + 1] << 16), zr0 = __uint_as_float(R.zr[q] << 16), zk1 = __uint_as_float(R.zk[q + 1] << 16), zk0 = __uint_as_float(R.zk[q] << 16), zv1 = __uint_as_float(R.zv[q + 1] << 16), zv0 = __uint_as_float(R.zv[q] << 16);
            rr[q] = zr1 + (zr0 - zr1) * R.mu_r; kk0[q] = zk1 + (zk0 - zk1) * R.mu_k; vv[q] = zv1 + (zv0 - zv1) * R.mu_v;
            lw[q] = -0.6065306597126334f * 1.4426950408889634f * sigmoid_f(R.w0 + __uint_as_float(R.dw[q] << 16));
            aa[q] = sigmoid_f(R.a0 + __uint_as_float(R.da[q] << 16));
            kp[q] = kk0[q] * (1.0f + (aa[q] - 1.0f) * R.k_a);
            const float kkn = kk0[q] * R.k_k; red[q] = kkn * kkn;
        }
        wave_sum8(red);
        float run = 0.f;
#pragma unroll
        for (int q = 0; q < 8; ++q) { kap[q] = kk0[q] * R.k_k * __builtin_amdgcn_rsqf(fmaxf(red[q], 1e-24f)); red[q] = rr[q] * kp[q] * R.r_k; run += lw[q]; cl[q] = run; }
        wave_sum8(red);
#pragma unroll
        for (int q = 0; q < 8; ++q) {
            const size_t tok = (size_t)hb * SEQ + s0 + q;
            ((bf16*)(F.ws + WS_VV))[tok * 64 + lane] = (bf16)(pg8::cvt_pk_bf16(vv[q], vv[q]) & 0xffffu); ((bf16*)(F.ws + WS_GG))[tok * 64 + lane] = (bf16)R.gg[q];
            if (lane == 0) ((float*)(F.ws + WS_RK))[tok] = red[q];
        }
        if (unit + 1 < u1) s1_fetch(F, A, l, unit + 1, R);
        WTOT[w * 64 + lane] = run;
        __syncthreads();
        float off = 0.f;
#pragma unroll
        for (int w2 = 0; w2 < 7; ++w2) off += (w2 < w) ? WTOT[w2 * 64 + lane] : 0.f;
        if (w == 7) GC[lane] = __builtin_amdgcn_exp2f(off + run);
        float fkt[8], fbt[8], fkk[8], frt[8];
#pragma unroll
        for (int q = 0; q < 8; ++q) {
            const float ct = off + cl[q], ctm1 = ct - lw[q];
            const float gp = __builtin_amdgcn_exp2f(ct), gm = __builtin_amdgcn_exp2f(ctm1), gi = __builtin_amdgcn_exp2f(-ct);
            fkt[q] = kap[q] * gm; fbt[q] = kap[q] * aa[q] * gi; fkk[q] = kp[q] * gi; frt[q] = rr[q] * gp;
        }
        v4u pkt, pbt, pkk, pvt, prt;
#pragma unroll
        for (int i = 0; i < 4; ++i) { pkt[i] = pg8::cvt_pk_bf16(fkt[2 * i], fkt[2 * i + 1]); pbt[i] = pg8::cvt_pk_bf16(fbt[2 * i], fbt[2 * i + 1]); pkk[i] = pg8::cvt_pk_bf16(fkk[2 * i], fkk[2 * i + 1]);
            prt[i] = pg8::cvt_pk_bf16(frt[2 * i], frt[2 * i + 1]); pvt[i] = pg8::cvt_pk_bf16(vv[2 * i], vv[2 * i + 1]); }
#pragma unroll
        for (int q = 0; q < 8; ++q) { const int o = swz(8 * w + q, lane), sh = 16 * (q & 1);
            KT[o] = (bf16)(pkt[q >> 1] >> sh); BT[o] = (bf16)(pbt[q >> 1] >> sh); KK[o] = (bf16)(pkk[q >> 1] >> sh); RT[o] = (bf16)(prt[q >> 1] >> sh); }
        { const int o = swz(lane, 8 * w); *(LAS v4u*)(KTT + o) = pkt; *(LAS v4u*)(BTT + o) = pbt; *(LAS v4u*)(KKT + o) = pkk; *(LAS v4u*)(VT + o) = pvt; }
    }
    __syncthreads();
    if (PMODE == 1) continue;
    f32x4 Treg[2];
#pragma unroll
    for (int d = 0; d < 2; ++d) { const int tm = tm0 + d; const int t = 16 * tn + fr, sb = 16 * tm + 4 * fq;
        const f32x4 aL = mm_tile(KT, BT, tn, tm, fr, fq, F4Z), aLt = mm_tile(BT, KT, tn, tm, fr, fq, F4Z);
        f32x4 aK = mm_tile(KT, KK, tn, tm, fr, fq, F4Z), aRB = mm_tile(RT, BT, tn, tm, fr, fq, F4Z), aRK = mm_tile(RT, KK, tn, tm, fr, fq, F4Z);
        f32x4 pl, plt;
#pragma unroll
        for (int e = 0; e < 4; ++e) { const bool st = (sb + e) < t, inc = (sb + e) <= t;
            pl[e] = st ? -aL[e] : 0.f; plt[e] = (t < sb + e) ? -aLt[e] : 0.f; Treg[d][e] = ((sb + e) == t ? 1.0f : 0.0f) + pl[e];
            aK[e] = st ? aK[e] : 0.f; aRB[e] = inc ? aRB[e] : 0.f; aRK[e] = inc ? aRK[e] : 0.f; }
        st_tile_bf16(PM, tn, tm, fr, fq, pl); st_tile_bf16(PT, tn, tm, fr, fq, plt); st_tile_bf16(TM, tn, tm, fr, fq, Treg[d]);
        st_tile_bf16(AAK, tn, tm, fr, fq, aK); st_tile_bf16(ARB, tn, tm, fr, fq, aRB); st_tile_bf16(ARK, tn, tm, fr, fq, aRK); }
    __syncthreads();
    {
        f32x4 p2[2], p2t[2];
#pragma unroll
        for (int d = 0; d < 2; ++d) { p2[d] = mm_tile(PM, PT, tn, tm0 + d, fr, fq, F4Z); p2t[d] = mm_tile(PT, PM, tn, tm0 + d, fr, fq, F4Z);
            st_tile_bf16(AKVT, tn, tm0 + d, fr, fq, mm_tile(VT, AAK, tn, tm0 + d, fr, fq, F4Z)); }
        __syncthreads();
#pragma unroll
        for (int d = 0; d < 2; ++d) { st_tile_bf16(PM, tn, tm0 + d, fr, fq, p2[d]); st_tile_bf16(PT, tn, tm0 + d, fr, fq, p2t[d]); }
        __syncthreads();
#pragma unroll
        for (int it = 1; it <= 5; ++it) {
#pragma unroll
            for (int d = 0; d < 2; ++d) { Treg[d] = mm_tile(TM, PT, tn, tm0 + d, fr, fq, Treg[d]);
                if (it < 5) { p2[d] = mm_tile(PM, PT, tn, tm0 + d, fr, fq, F4Z); p2t[d] = mm_tile(PT, PM, tn, tm0 + d, fr, fq, F4Z); } }
            __syncthreads();
#pragma unroll
            for (int d = 0; d < 2; ++d) { st_tile_bf16(TM, tn, tm0 + d, fr, fq, Treg[d]);
                if (it < 5) { st_tile_bf16(PM, tn, tm0 + d, fr, fq, p2[d]); st_tile_bf16(PT, tn, tm0 + d, fr, fq, p2t[d]); } }
            __syncthreads();
        }
    }
    if (PMODE == 2) { __syncthreads(); continue; }
    {
        f32x4 aw[2], au[2];
#pragma unroll
        for (int d = 0; d < 2; ++d) { aw[d] = mm_tile(KTT, TM, tn, tm0 + d, fr, fq, F4Z); au[d] = mm_tile(AKVT, TM, tn, tm0 + d, fr, fq, F4Z); }
#pragma unroll
        for (int d = 0; d < 2; ++d) { st_tile_bf16(WTT, tn, tm0 + d, fr, fq, aw[d]); st_tile_bf16(UT, tn, tm0 + d, fr, fq, au[d]); }
    }
    __syncthreads();
    {
        const size_t ub = (size_t)unit * 64 * 64;
        GAS f32x4* MC = (GAS f32x4*)((float*)(F.ws + WS_MC) + ub); GAS pg8::u32x2* NCT = (GAS pg8::u32x2*)((bf16*)(F.ws + WS_NCT) + ub);
        GAS pg8::u32x2* YL = (GAS pg8::u32x2*)((bf16*)(F.ws + WS_YL) + ub); GAS pg8::u32x2* QE = (GAS pg8::u32x2*)((bf16*)(F.ws + WS_QE) + ub);
#pragma unroll
        for (int d = 0; d < 2; ++d) { const int tm = tm0 + d, i = 16 * tn + fr, j = 16 * tm + 4 * fq, ts = tslot(tn, tm, lane);
            { const f32x4 a = mm_tile(ARB, WTT, tn, tm, fr, fq, F4Z); const pg8::u32x2 rv = *(const LAS pg8::u32x2*)(RT + swz(i, j));
              const float r0 = __uint_as_float(rv.x << 16), r1 = __uint_as_float(rv.x & 0xffff0000u), r2 = __uint_as_float(rv.y << 16), r3 = __uint_as_float(rv.y & 0xffff0000u);
              pg8::u32x2 o; o.x = pg8::cvt_pk_bf16(r0 - a[0], r1 - a[1]); o.y = pg8::cvt_pk_bf16(r2 - a[2], r3 - a[3]); if (PMODE != 3) QE[ts] = o; else asm volatile("" :: "v"(o.x), "v"(o.y)); }
            { const f32x4 a = mm_tile(ARK, VT, tn, tm, fr, fq, F4Z), a2 = mm_tile(ARB, UT, tn, tm, fr, fq, F4Z);
              pg8::u32x2 o; o.x = pg8::cvt_pk_bf16(a[0] - a2[0], a[1] - a2[1]); o.y = pg8::cvt_pk_bf16(a[2] - a2[2], a[3] - a2[3]); if (PMODE != 3) YL[ts] = o; else asm volatile("" :: "v"(o.x), "v"(o.y)); }
            { const f32x4 a = mm_tile(BTT, WTT, tn, tm, fr, fq, F4Z); const float gc = GC[i]; f32x4 o;
#pragma unroll
              for (int e = 0; e < 4; ++e) o[e] = gc * (((j + e) == i ? 1.0f : 0.0f) - a[e]);
              if (PMODE != 3) MC[ts] = o; else asm volatile("" :: "v"(o[0]), "v"(o[1]), "v"(o[2]), "v"(o[3])); }
            { const f32x4 a = mm_tile(VT, KKT, tn, tm, fr, fq, F4Z), a2 = mm_tile(UT, BTT, tn, tm, fr, fq, F4Z); const f32x4 gc = *(const LAS f32x4*)(GC + j);
              pg8::u32x2 o; o.x = pg8::cvt_pk_bf16((a[0] - a2[0]) * gc[0], (a[1] - a2[1]) * gc[1]); o.y = pg8::cvt_pk_bf16((a[2] - a2[2]) * gc[2], (a[3] - a2[3]) * gc[3]);
              if (PMODE != 3) NCT[ts] = o; else asm volatile("" :: "v"(o.x), "v"(o.y)); }
        }
    }
    __syncthreads();
    }
}

__device__ __forceinline__ void scan_s2_head(Frame& F, int hb) {
    if (F.wave >= 4) return;
    const int lane = F.tid & 63, fr = lane & 15, fq = lane >> 4, w = F.wave;
    f32x4 Hs[4];
#pragma unroll
    for (int t = 0; t < 4; ++t) Hs[t] = F4Z;
    for (int c = 0; c < NCHUNK; ++c) {
        const size_t ub = ((size_t)hb * NCHUNK + c) * 64 * 64;
        const float* MC = (const float*)(F.ws + WS_MC) + ub; const bf16* NCT = (const bf16*)(F.ws + WS_NCT) + ub; bf16* H0T = (bf16*)(F.ws + WS_H0T) + ub;
        f32x4 mc[4][4], nn[4];
#pragma unroll
        for (int to = 0; to < 4; ++to) { const pg8::u32x2 nv = ((const GAS pg8::u32x2*)NCT)[tslot(w, to, lane)];
            nn[to] = (f32x4){__uint_as_float(nv.x << 16), __uint_as_float(nv.x & 0xffff0000u), __uint_as_float(nv.y << 16), __uint_as_float(nv.y & 0xffff0000u)};
#pragma unroll
            for (int t = 0; t < 4; ++t) mc[to][t] = ((const GAS f32x4*)MC)[tslot(to, t, lane)]; }
#pragma unroll
        for (int t = 0; t < 4; ++t) { pg8::u32x2 o; o.x = pg8::cvt_pk_bf16(Hs[t][0], Hs[t][1]); o.y = pg8::cvt_pk_bf16(Hs[t][2], Hs[t][3]); ((GAS pg8::u32x2*)H0T)[tslot(w, t, lane)] = o; }
        if (c + 1 == NCHUNK) break;
#pragma unroll
        for (int to = 0; to < 4; ++to)
#pragma unroll
            for (int t = 0; t < 4; ++t)
#pragma unroll
                for (int i = 0; i < 4; ++i) nn[to] = __builtin_amdgcn_mfma_f32_16x16x4f32(mc[to][t][i], Hs[t][i], nn[to], 0, 0, 0);
#pragma unroll
        for (int t = 0; t < 4; ++t) Hs[t] = nn[t];
    }
}

__device__ __forceinline__ void scan_s3_pair(Frame& F, KArgs* A, int l, int pair) {
    const int lane = F.tid & 63, fr = lane & 15, fq = lane >> 4, w = F.wave, unit = 2 * pair + (w >> 2), tn = w & 3;
    const int hb = unit / NCHUNK, c = unit % NCHUNK, b = hb / NH, h = hb % NH;
    const size_t ub = (size_t)unit * 64 * 64;
    const GAS pg8::u32x2* QE = (const GAS pg8::u32x2*)((const bf16*)(F.ws + WS_QE) + ub); const GAS pg8::u32x2* H0T = (const GAS pg8::u32x2*)((const bf16*)(F.ws + WS_H0T) + ub);
    const GAS pg8::u32x2* YL = (const GAS pg8::u32x2*)((const bf16*)(F.ws + WS_YL) + ub);
    const int t = 16 * tn + fr; const size_t tok = (size_t)hb * SEQ + c * CH + t;
    const bf16* vp = (const bf16*)(F.ws + WS_VV) + tok * 64; const bf16* gp = (const bf16*)(F.ws + WS_GG) + tok * 64;
    const float* gnw = INP(A, 19) + (size_t)l * DRW + h * 64; const float* gnb = INP(A, 20) + (size_t)l * DRW + h * 64;
    pg8::u32x2 qv[4], hv[4][4], yv[4], vv[4], gg[4]; f32x4 gw[4], gb[4];
#pragma unroll
    for (int i = 0; i < 4; ++i) { qv[i] = QE[tslot(tn, i, lane)]; yv[i] = YL[tslot(tn, i, lane)]; const int v0 = 16 * i + 4 * fq;
        vv[i] = *(const GAS pg8::u32x2*)(vp + v0); gg[i] = *(const GAS pg8::u32x2*)(gp + v0); gw[i] = *(const GAS f32x4*)(gnw + v0); gb[i] = *(const GAS f32x4*)(gnb + v0);
#pragma unroll
        for (int k = 0; k < 4; ++k) hv[i][k] = H0T[tslot(i, k, lane)]; }
    const float rk = ((const float*)(F.ws + WS_RK))[tok];
    bf16x8 qb[2];
#pragma unroll
    for (int p = 0; p < 2; ++p) qb[p] = __builtin_bit_cast(bf16x8, (v4u){qv[2 * p].x, qv[2 * p].y, qv[2 * p + 1].x, qv[2 * p + 1].y});
    f32x4 y[4]; float s1 = 0.f;
#pragma unroll
    for (int tm = 0; tm < 4; ++tm) {
        f32x4 acc = (f32x4){__uint_as_float(yv[tm].x << 16), __uint_as_float(yv[tm].x & 0xffff0000u), __uint_as_float(yv[tm].y << 16), __uint_as_float(yv[tm].y & 0xffff0000u)};
#pragma unroll
        for (int p = 0; p < 2; ++p) acc = __builtin_amdgcn_mfma_f32_16x16x32_bf16(__builtin_bit_cast(bf16x8, (v4u){hv[tm][2 * p].x, hv[tm][2 * p].y, hv[tm][2 * p + 1].x, hv[tm][2 * p + 1].y}), qb[p], acc, 0, 0, 0);
        y[tm] = acc; s1 += (acc[0] + acc[1]) + (acc[2] + acc[3]); }
    s1 += __shfl_xor(s1, 16); s1 += __shfl_xor(s1, 32);
    const float mean = s1 * (1.f / 64.f); float s2 = 0.f;
#pragma unroll
    for (int tm = 0; tm < 4; ++tm)
#pragma unroll
        for (int e = 0; e < 4; ++e) { const float d = y[tm][e] - mean; s2 += d * d; }
    s2 += __shfl_xor(s2, 16); s2 += __shfl_xor(s2, 32);
    const float rstd = __builtin_amdgcn_rsqf(s2 * (1.f / 64.f) + GN_EPS);
    bf16* out = (bf16*)(F.ws + WS_CAT) + ((size_t)b * SEQ + c * CH + t) * D + DATT + h * 64;
#pragma unroll
    for (int tm = 0; tm < 4; ++tm) { const int v0 = 16 * tm + 4 * fq;
        const float vf[4] = {__uint_as_float(vv[tm].x << 16), __uint_as_float(vv[tm].x & 0xffff0000u), __uint_as_float(vv[tm].y << 16), __uint_as_float(vv[tm].y & 0xffff0000u)};
        const float gf[4] = {__uint_as_float(gg[tm].x << 16), __uint_as_float(gg[tm].x & 0xffff0000u), __uint_as_float(gg[tm].y << 16), __uint_as_float(gg[tm].y & 0xffff0000u)};
        float o[4];
#pragma unroll
        for (int e = 0; e < 4; ++e) o[e] = ((y[tm][e] - mean) * rstd * gw[tm][e] + gb[tm][e] + rk * vf[e]) * gf[e];
        pg8::u32x2 ow; ow.x = pg8::cvt_pk_bf16(o[0], o[1]); ow.y = pg8::cvt_pk_bf16(o[2], o[3]); *(GAS pg8::u32x2*)(out + v0) = ow; }
}

__global__ void __launch_bounds__(NWAVES * 64, 2) fwd_kernel(Args args) {
    extern __shared__ __attribute__((aligned(16))) unsigned char lds[];
    Frame F;
    F.lds = (LAS unsigned char*)lds;
    F.wave = __builtin_amdgcn_readfirstlane(threadIdx.x >> 6); F.tid = threadIdx.x;
    F.G = gridDim.x; { const int bx = blockIdx.x; F.vcu = (F.G % 8 == 0) ? (bx % 8) * (F.G / 8) + bx / 8 : bx; }
    unsigned char* ws = args.ws; F.ws = ws;
    F.X = args.out;
    for (int u = threadIdx.x; u < (LDS_BYTES - LDSCTL_OFF) / 4; u += NWAVES * 64) ((LAS unsigned*)(F.lds + LDSCTL_OFF))[u] = 0u;
    __syncthreads();
    XcdBarrier bar = xcd_barrier_post((unsigned*)(ws + WS_CTL) + CW_BAR, (volatile LAS unsigned*)(F.lds + MISC_OFF) + 8);
    const int lo = args.ph_lo, hi = args.ph_hi;
    int ph = 0;
    const Frame F0 = F; KArgs* const ka0 = (KArgs*)__builtin_amdgcn_kernarg_segment_ptr();
#define PH_BEGIN_R(NREP) if (ph >= lo && ph < hi) { Frame F = F0; KArgs* ka = ka0; F.tid = threadIdx.x; asm volatile("" : "+v"(F.tid)); GAS unsigned char* wsg_ = (GAS unsigned char*)F0.ws; GAS float* xg_ = (GAS float*)F0.X; asm volatile("" : "+s"(wsg_), "+s"(xg_), "+s"(F.wave), "+s"(F.vcu), "+s"(F.G), "+s"(ka)); F.ws = (unsigned char*)wsg_; F.X = (float*)xg_; unsigned char* const ws = F.ws; (void)ws; for (int rep_ = 0; rep_ < (NREP); ++rep_) { if (rep_) xcd_barrier(bar);
#define PH_BEGIN PH_BEGIN_R(1)
#define PH_END   } if (ph + 1 < hi) { xcd_barrier(bar); for (int xb_ = 0; xb_ < EXTRA_BAR; ++xb_) xcd_barrier(bar); } } ++ph;

    PH_BEGIN_R(REP_PRO) p0_prologue(F, ka); PH_END

    for (int j = 0; j < 2 * NL; ++j) {
        const int l = j >> 1; const bool second = (j & 1) != 0;
        PH_BEGIN_R(REP_GU) {
            pg8::Gemm g{((bf16*)(F.ws + WS_XB)), (const bf16*)(ws + WS_W + (size_t)l * LW + (second ? LW_GU2 : LW_GU1)), M, 2 * FF, D}; pg8::StaticOrder S; S.init(M, 2 * FF, F.G, (int)blockIdx.x);
            pg8::EpiSwiglu E{((bf16*)(F.ws + WS_HID)), FF, (const float*)(F.ws + WS_RS)};
            pg8::gemm_phase<pg8::EpiSwiglu, pg8::StaticOrder, true, true>(F.lds + RING_OFF, g, S, E);
        } PH_END
        PH_BEGIN {
            const int q = 3 * l + (second ? 2 : 0); const bool lastsub = second && (l + 1 == NL);
            pg8::Gemm g{((bf16*)(F.ws + WS_HID)), (const bf16*)(ws + WS_W + (size_t)l * LW + (second ? LW_D2 : LW_D1)), M, D, FF};
            pg8::EpiRes E{((bf16*)(F.ws + WS_XB)), lastsub ? F.X : nullptr, (second ? INP(ka, 24) : INP(ka, 2)) + (size_t)l * D, 0.5f, (float*)(F.ws + WS_RS),
                          (float*)(F.ws + WS_XS + (size_t)q * MiB), (unsigned*)(ws + WS_CTL) + CW_XC + q * XC_USE, (unsigned*)(ws + WS_CTL) + CW_TMO};
            for (int sl = 0; sl < 2; ++sl) { pg8::PanelOrder S{sl}; pg8::gemm_phase<pg8::EpiRes, pg8::PanelOrder, false, true>(F.lds + RING_OFF, g, S, E); __syncthreads(); }
        } PH_END
        if (!second) {
            PH_BEGIN_R(REP_WIN) {
                pg8::Gemm g{((bf16*)(F.ws + WS_XB)), (const bf16*)(ws + WS_W + (size_t)l * LW + LW_IN), M, DINP, D}; pg8::StaticOrder S; S.init(M, DINP, F.G, (int)blockIdx.x);
                pg8::EpiWin E{((bf16*)(F.ws + WS_QH)), ((bf16*)(F.ws + WS_KH)), ((bf16*)(F.ws + WS_VH)), ((bf16*)(F.ws + WS_ZR)), ((bf16*)(F.ws + WS_ZP)), ((float*)(F.ws + WS_COS)), ((float*)(F.ws + WS_SIN)), QSCALE, (const float*)(F.ws + WS_RS)};
                pg8::gemm_phase<pg8::EpiWin, pg8::StaticOrder, true, true>(F.lds + RING_OFF, g, S, E);
            } PH_END
            PH_BEGIN_R(REP_PREP) mix_prep(F, ka, l, (int)blockIdx.x, F.G); PH_END
            PH_BEGIN_R(REP_LORA) {
                { pg8::Gemm g{((bf16*)(F.ws + WS_LA)), (const bf16*)(ws + WS_W + (size_t)l * LW + LW_LORA), M, LORA_N, LORA_K}; pg8::StaticOrder S; S.init(M, LORA_N, F.G, (int)blockIdx.x);
                  pg8::EpiBf16Plain E{((bf16*)(F.ws + WS_LB)), LORA_N};
                  pg8::gemm_phase<pg8::EpiBf16Plain, pg8::StaticOrder, true, true>(F.lds + RING_OFF, g, S, E); }
                { pg8::Gemm g{((bf16*)(F.ws + WS_PP)), (const bf16*)(ws + WS_W + (size_t)l * LW + LW_POOL), M, DPOOL, 512}; pg8::StaticOrder S; S.init(M, DPOOL, F.G, (int)((blockIdx.x + F.G - (F.G >> 2)) % F.G));
                  pg8::EpiBf16Scale E{((bf16*)(F.ws + WS_CAT)) + DATT + DRW, D, INP(ka, 22) + (size_t)l * DPOOL};
                  pg8::gemm_phase<pg8::EpiBf16Scale, pg8::StaticOrder, true, true>(F.lds + RING_OFF, g, S, E); }
            } PH_END
            PH_BEGIN_R(REP_S1) scan_s1_phase<0>(F, ka, l); PH_END
            PH_BEGIN_R(REP_S2) {
                for (int hb = (int)blockIdx.x; hb < BATCH * NH; hb += F.G) scan_s2_head(F, hb);
                gu32* ctr = (gu32*)(ws + WS_CTL) + CW_ATTQ + 64 * (l + 4 * rep_);
                attn_loop(F, ctr);
            } PH_END
            PH_BEGIN_R(REP_S3) { for (int p = (int)blockIdx.x; p < SCAN_UNITS / 2; p += F.G) scan_s3_pair(F, ka, l, p); attn_combine(F); } PH_END
            PH_BEGIN {
                const int q = 3 * l + 1;
                pg8::Gemm g{((bf16*)(F.ws + WS_CAT)), (const bf16*)(ws + WS_W + (size_t)l * LW + LW_OUT), M, D, D};
                pg8::EpiRes E{((bf16*)(F.ws + WS_XB)), nullptr, INP(ka, 7) + (size_t)l * D, 1.0f, (float*)(F.ws + WS_RS),
                              (float*)(F.ws + WS_XS + (size_t)q * MiB), (unsigned*)(ws + WS_CTL) + CW_XC + q * XC_USE, (unsigned*)(ws + WS_CTL) + CW_TMO};
                for (int sl = 0; sl < 2; ++sl) { pg8::PanelOrder S{sl}; pg8::gemm_phase<pg8::EpiRes, pg8::PanelOrder, false, true>(F.lds + RING_OFF, g, S, E); __syncthreads(); }
            } PH_END
        }
    }
#undef PH_BEGIN
#undef PH_END
}


#ifndef PROBE_W
#define PROBE_W 0
#endif
#ifndef PROBE_N
#define PROBE_N 8
#endif
#if PROBE_W
__global__ void __launch_bounds__(NWAVES * 64, 2) probe_kernel(Args args) {
    extern __shared__ __attribute__((aligned(16))) unsigned char lds[];
    Frame F; F.lds = (LAS unsigned char*)lds; F.wave = __builtin_amdgcn_readfirstlane(threadIdx.x >> 6); F.tid = threadIdx.x;
    F.G = gridDim.x; { const int bx = blockIdx.x; F.vcu = (F.G % 8 == 0) ? (bx % 8) * (F.G / 8) + bx / 8 : bx; }
    F.ws = (unsigned char*)(GAS unsigned char*)args.ws; F.X = (float*)(GAS float*)args.out;
    KArgs* ka = (KArgs*)__builtin_amdgcn_kernarg_segment_ptr();
    const int l = NL - 1;
    if (PROBE_W == 1) scan_s1_phase<0>(F, ka, l);
    if (PROBE_W == 2) scan_s1_phase<1>(F, ka, l);
    if (PROBE_W == 3) scan_s1_phase<2>(F, ka, l);
    if (PROBE_W == 7) scan_s1_phase<3>(F, ka, l);
    if (PROBE_W == 4) for (int hb = (int)blockIdx.x; hb < BATCH * NH; hb += F.G) scan_s2_head(F, hb);
    if (PROBE_W == 5) attn_loop(F, (gu32*)(F.ws + WS_CTL) + CW_ATTQ + 64 * 8 + 64 * (int)(args.ph_hi & 0));
    if (PROBE_W == 6) mix_prep(F, ka, l, (int)blockIdx.x, F.G);
    if (PROBE_W == 8) row_pass(F, 0.0f, INP(ka, 7) + (size_t)l * D, false);
    if (PROBE_W == 9) { for (int p = (int)blockIdx.x; p < SCAN_UNITS / 2; p += F.G) scan_s3_pair(F, ka, l, p); attn_combine(F); }
    if (PROBE_W == 10) {
        { pg8::Gemm g{((bf16*)(F.ws + WS_LA)), (const bf16*)(F.ws + WS_W + (size_t)l * LW + LW_LORA), M, LORA_N, LORA_K}; pg8::StaticOrder S; S.init(M, LORA_N, F.G, (int)blockIdx.x);
          pg8::EpiBf16Plain E{((bf16*)(F.ws + WS_LB)), LORA_N}; pg8::gemm_phase<pg8::EpiBf16Plain, pg8::StaticOrder, true, true>(F.lds + RING_OFF, g, S, E); }
        { pg8::Gemm g{((bf16*)(F.ws + WS_PP)), (const bf16*)(F.ws + WS_W + (size_t)l * LW + LW_POOL), M, DPOOL, 512}; pg8::StaticOrder S; S.init(M, DPOOL, F.G, (int)((blockIdx.x + F.G - (F.G >> 2)) % F.G));
          pg8::EpiBf16Scale E{((bf16*)(F.ws + WS_CAT)) + DATT + DRW, D, INP(ka, 22) + (size_t)l * DPOOL}; pg8::gemm_phase<pg8::EpiBf16Scale, pg8::StaticOrder, true, true>(F.lds + RING_OFF, g, S, E); } }
    if (PROBE_W == 11) p0_prologue_w(F, ka);
    if (PROBE_W == 12) { pg8::Gemm g{((bf16*)(F.ws + WS_XB)), (const bf16*)(F.ws + WS_W + (size_t)l * LW + LW_GU2), M, 2 * FF, D}; pg8::StaticOrder S; S.init(M, 2 * FF, F.G, (int)blockIdx.x);
        pg8::EpiSwiglu E{((bf16*)(F.ws + WS_HID)), FF, (const float*)(F.ws + WS_RS)}; pg8::gemm_phase<pg8::EpiSwiglu, pg8::StaticOrder, true, true>(F.lds + RING_OFF, g, S, E); }
    if (PROBE_W == 16) { const int li = args.ph_lo & 3, sec = (args.ph_lo >> 2) & 1;
        pg8::Gemm g{((bf16*)(F.ws + WS_XB)), (const bf16*)(F.ws + WS_W + (size_t)li * LW + (sec ? LW_GU2 : LW_GU1)), M, 2 * FF, D}; pg8::StaticOrder S; S.init(M, 2 * FF, F.G, (int)blockIdx.x);
        pg8::EpiSwiglu E{((bf16*)(F.ws + WS_HID)), FF, (const float*)(F.ws + WS_RS)}; pg8::gemm_phase<pg8::EpiSwiglu, pg8::StaticOrder, true, true>(F.lds + RING_OFF, g, S, E); }
    if (PROBE_W == 17) { const int q = 12 + (args.ph_lo & 15);
        pg8::Gemm g{((bf16*)(F.ws + WS_HID)), (const bf16*)(F.ws + WS_W + (size_t)l * LW + LW_D2), M, D, FF};
        pg8::EpiRes E{((bf16*)(F.ws + WS_XB)), nullptr, INP(ka, 24) + (size_t)l * D, 0.5f, (float*)(F.ws + WS_RS), (float*)(F.ws + WS_XS + (size_t)(q % 12) * MiB), (unsigned*)(F.ws + WS_CTL) + CW_XC + q * XC_USE, (unsigned*)(F.ws + WS_CTL) + CW_TMO};
        for (int sl = 0; sl < 2; ++sl) { pg8::PanelOrder S{sl}; pg8::gemm_phase<pg8::EpiRes, pg8::PanelOrder, false, true>(F.lds + RING_OFF, g, S, E); __syncthreads(); } }
    if (PROBE_W == 18) { const int q = 12 + (args.ph_lo & 15);
        pg8::Gemm g{((bf16*)(F.ws + WS_CAT)), (const bf16*)(F.ws + WS_W + (size_t)l * LW + LW_OUT), M, D, D};
        pg8::EpiRes E{((bf16*)(F.ws + WS_XB)), nullptr, INP(ka, 7) + (size_t)l * D, 1.0f, (float*)(F.ws + WS_RS), (float*)(F.ws + WS_XS + (size_t)(q % 12) * MiB), (unsigned*)(F.ws + WS_CTL) + CW_XC + q * XC_USE, (unsigned*)(F.ws + WS_CTL) + CW_TMO};
        for (int sl = 0; sl < 2; ++sl) { pg8::PanelOrder S{sl}; pg8::gemm_phase<pg8::EpiRes, pg8::PanelOrder, false, true>(F.lds + RING_OFF, g, S, E); __syncthreads(); } }
    if (PROBE_W == 13) { pg8::Gemm g{((bf16*)(F.ws + WS_HID)), (const bf16*)(F.ws + WS_W + (size_t)l * LW + LW_D2), M, D, FF}; pg8::StaticOrder S; S.init(M, D, F.G, (int)blockIdx.x);
        pg8::EpiBf16Plain E{((bf16*)(F.ws + WS_Y)), D}; pg8::gemm_phase<pg8::EpiBf16Plain, pg8::StaticOrder, true, true>(F.lds + RING_OFF, g, S, E); }
    if (PROBE_W == 14) { pg8::Gemm g{((bf16*)(F.ws + WS_XB)), (const bf16*)(F.ws + WS_W + (size_t)l * LW + LW_IN), M, DINP, D}; pg8::StaticOrder S; S.init(M, DINP, F.G, (int)blockIdx.x);
        pg8::EpiWin E{((bf16*)(F.ws + WS_OG)), ((bf16*)(F.ws + WS_OG)) + 12 * MiB, ((bf16*)(F.ws + WS_OG)) + 24 * MiB, ((bf16*)(F.ws + WS_LA)), ((bf16*)(F.ws + WS_PP)), ((float*)(F.ws + WS_COS)), ((float*)(F.ws + WS_SIN)), QSCALE, (const float*)(F.ws + WS_RS)};
        (void)E; }
    if (PROBE_W == 15) { pg8::Gemm g{((bf16*)(F.ws + WS_CAT)), (const bf16*)(F.ws + WS_W + (size_t)l * LW + LW_OUT), M, D, D}; pg8::StaticOrder S; S.init(M, D, F.G, (int)blockIdx.x);
        pg8::EpiBf16Plain E{((bf16*)(F.ws + WS_Y)), D}; pg8::gemm_phase<pg8::EpiBf16Plain, pg8::StaticOrder, true, true>(F.lds + RING_OFF, g, S, E); }
}
#endif
extern "C" void kernel_launch(void* const* d_in, const int* in_sizes, int n_in, void* d_out, int out_size, void* d_ws, size_t ws_size, hipStream_t stream) {
    static int grid = 0;
    if (grid == 0) {
        if (n_in != 28 || in_sizes[0] != M * D || out_size != M * D || ws_size < WS_END2) { fprintf(stderr, "kernel_launch: unexpected problem (n_in %d, in0 %d, out %d, ws %zu < %zu); nothing launched\n", n_in, n_in > 0 ? in_sizes[0] : -1, out_size, ws_size, (size_t)WS_END2); grid = -1; return; }
        int dev = 0, cus = 0, per_cu = 0;
        if (hipGetDevice(&dev) != hipSuccess || hipDeviceGetAttribute(&cus, hipDeviceAttributeMultiprocessorCount, dev) != hipSuccess) { grid = -1; return; }
        if (hipFuncSetAttribute((const void*)fwd_kernel, hipFuncAttributeMaxDynamicSharedMemorySize, LDS_BYTES) != hipSuccess) { fprintf(stderr, "kernel_launch: hipFuncSetAttribute failed\n"); grid = -1; return; }
        if (hipOccupancyMaxActiveBlocksPerMultiprocessor(&per_cu, (const void*)fwd_kernel, NWAVES * 64, LDS_BYTES) != hipSuccess || per_cu < 1)
            fprintf(stderr, "kernel_launch: note: occupancy query reports %d workgroups per CU\n", per_cu);
        (void)hipGetLastError();
        grid = cus;
    }
    if (grid < 0) return;
    if (hipMemsetAsync((char*)d_ws + WS_CTL, 0, CTL_ZERO_BYTES, stream) != hipSuccess) return;
    Args a{};
    for (int i = 0; i < 28; ++i) a.in[i] = (const float*)d_in[i];
    a.out = (float*)d_out; a.ws = (unsigned char*)d_ws;
#if MK_MULTI
    for (int p = 0; p < NPH; ++p) { a.ph_lo = p; a.ph_hi = p + 1; hipLaunchKernelGGL(fwd_kernel, dim3(grid), dim3(NWAVES * 64), LDS_BYTES, stream, a); }
#else
    a.ph_lo = 0; a.ph_hi = NPH; hipLaunchKernelGGL(fwd_kernel, dim3(grid), dim3(NWAVES * 64), LDS_BYTES, stream, a);
#endif
#if PROBE_W
    { static bool once = false; if (!once) { once = true; (void)hipFuncSetAttribute((const void*)probe_kernel, hipFuncAttributeMaxDynamicSharedMemorySize, LDS_BYTES); }
      for (int i = 0; i < PROBE_N; ++i) { a.ph_lo = i; hipLaunchKernelGGL(probe_kernel, dim3(grid), dim3(NWAVES * 64), LDS_BYTES, stream, a); } }
#endif
}
```

```cpp
#include <hip/hip_runtime.h>
#include <cstdio>
#include <cstdint>
#include <cmath>
namespace pg8 {
#define PG8_LAS __attribute__((address_space(3)))
typedef unsigned short bf16_t;
typedef short bf16x8 __attribute__((ext_vector_type(8)));
typedef float f32x4 __attribute__((ext_vector_type(4)));
typedef unsigned u32x4 __attribute__((ext_vector_type(4)));
constexpr int BM = 256, BK = 64, HALF = 128, HTB = HALF * BK * 2  , STAGE_BYTES = 8 * HTB, NXCD = 8, WGM = 8;

__host__ __device__ __forceinline__ int lds_byte(int r, int c) { const int st = (r >> 4) * 2 + (c >> 5), rr = r & 15, cc = c & 31, ob = rr * 64 + cc * 2; return st * 1024 + (ob ^ (((ob >> 9) & 1) << 5)); }
__host__ __device__ __forceinline__ void stage_rc(int b, int& R, int& C) { const int st = b / 1024, sb = b % 1024, swz = sb ^ (((sb >> 9) & 1) << 5); R = (st >> 1) * 16 + swz / 64; C = (st & 1) * 32 + (swz % 64) / 2; }
__host__ __device__ __forceinline__ int perm32(int rho) { const int n = rho >> 4, i = rho & 15; return 8 * (i >> 2) + 4 * n + (i & 3); }

struct Unit { int pm, pn; };
struct Gemm { const bf16_t* A; const bf16_t* Bt; int M, N, K; };

struct StaticOrder {
    int nM, nN, nwg, G, c;
    __host__ __device__ void init(int M, int N, int G_, int c_) { nM = M / BM; nN = N / BM; nwg = nM * nN; G = G_; c = c_; }
    __host__ __device__ bool next(int i, Unit& u) const {
        const long L = (long)i * G + c; if (L >= nwg) return false;
        int wgid = (int)L; { const int q = nwg / NXCD, r = nwg % NXCD, xcd = wgid % NXCD, off = wgid / NXCD; wgid = (xcd < r ? xcd * (q + 1) : r * (q + 1) + (xcd - r) * q) + off; }
        const int nig = WGM * nN, gid = wgid / nig, fm = gid * WGM, gsz = (nM - fm) < WGM ? (nM - fm) : WGM;
        u.pm = fm + ((wgid % nig) % gsz); u.pn = (wgid % nig) / gsz; return true;
    }
    __device__ __forceinline__ void a_ready(const Unit&) const {}
    __device__ __forceinline__ void done(const Unit&) const {}
};

typedef float cvt_f32x2_t __attribute__((ext_vector_type(2))); typedef __bf16 cvt_bf16x2_t __attribute__((ext_vector_type(2)));
__device__ __forceinline__ unsigned cvt_pk_bf16(float lo, float hi) { const cvt_f32x2_t v = {lo, hi}; const cvt_bf16x2_t b = __builtin_convertvector(v, cvt_bf16x2_t); return __builtin_bit_cast(unsigned, b); }
typedef float f32x2 __attribute__((ext_vector_type(2)));
typedef unsigned u32x2 __attribute__((ext_vector_type(2)));
__device__ __forceinline__ float silu_f(float x) { return x * __builtin_amdgcn_rcpf(1.0f + __builtin_amdgcn_exp2f(-1.4426950408889634f * x)); }
__device__ __forceinline__ u32x4 pack8(const f32x4 v0, const f32x4 v1) { u32x4 w; w.x = cvt_pk_bf16(v0[0], v0[1]); w.y = cvt_pk_bf16(v0[2], v0[3]); w.z = cvt_pk_bf16(v1[0], v1[1]); w.w = cvt_pk_bf16(v1[2], v1[3]); return w; }

struct EpiF32 {
    static constexpr bool PERM = false, AFTER_DRAIN = false;
    float* C; int ldc;
    __device__ __forceinline__ void operator()(const f32x4 (&acc)[2][2][4][2], const Unit& u, int wr, int wc, int fr, int fq) const {
        asm volatile("" : "+v"(fr), "+v"(fq));
        const int row0 = u.pm * BM + wr * 64 + fr, col0 = u.pn * BM + wc * 32 + 4 * fq;
#pragma unroll
        for (int ai = 0; ai < 2; ++ai)
#pragma unroll
            for (int m = 0; m < 4; ++m) { float* rowp = C + (size_t)(row0 + ai * HALF + m * 16) * ldc + col0;
#pragma unroll
                for (int bj = 0; bj < 2; ++bj)
#pragma unroll
                    for (int n = 0; n < 2; ++n) *(f32x4*)(rowp + bj * HALF + n * 16) = acc[ai][bj][m][n]; }
    }
};
struct EpiBf16Plain {
    static constexpr bool PERM = true, AFTER_DRAIN = false;
    bf16_t* O; int ldc;
    __device__ __forceinline__ void operator()(const f32x4 (&acc)[2][2][4][2], const Unit& u, int wr, int wc, int fr, int fq) const {
        asm volatile("" : "+v"(fr), "+v"(fq));
        const int row0 = u.pm * BM + wr * 64 + fr, col0 = u.pn * BM + wc * 32 + 8 * fq;
#pragma unroll
        for (int ai = 0; ai < 2; ++ai)
#pragma unroll
            for (int m = 0; m < 4; ++m) { bf16_t* rowp = O + (size_t)(row0 + ai * HALF + m * 16) * ldc + col0;
#pragma unroll
                for (int bj = 0; bj < 2; ++bj) *(u32x4*)(rowp + bj * HALF) = pack8(acc[ai][bj][m][0], acc[ai][bj][m][1]); }
    }
};
struct EpiBf16Scale {
    static constexpr bool PERM = true, AFTER_DRAIN = false;
    bf16_t* O; int ldc; const float* scale;
    __device__ __forceinline__ void operator()(const f32x4 (&acc)[2][2][4][2], const Unit& u, int wr, int wc, int fr, int fq) const {
        asm volatile("" : "+v"(fr), "+v"(fq));
        const int row0 = u.pm * BM + wr * 64 + fr, col0 = u.pn * BM + wc * 32 + 8 * fq;
        f32x4 sv[2][2];
#pragma unroll
        for (int bj = 0; bj < 2; ++bj)
#pragma unroll
            for (int n = 0; n < 2; ++n) sv[bj][n] = *(const f32x4*)(scale + col0 + bj * HALF + 4 * n);
#pragma unroll
        for (int ai = 0; ai < 2; ++ai)
#pragma unroll
            for (int m = 0; m < 4; ++m) { bf16_t* rowp = O + (size_t)(row0 + ai * HALF + m * 16) * ldc + col0;
#pragma unroll
                for (int bj = 0; bj < 2; ++bj) *(u32x4*)(rowp + bj * HALF) = pack8(acc[ai][bj][m][0] * sv[bj][0], acc[ai][bj][m][1] * sv[bj][1]); }
    }
};
struct EpiSwiglu {
    static constexpr bool PERM = true, AFTER_DRAIN = false;
    bf16_t* O; int ldc; const float* rs;
    __device__ __forceinline__ void operator()(const f32x4 (&acc)[2][2][4][2], const Unit& u, int wr, int wc, int fr, int fq) const {
        asm volatile("" : "+v"(fr), "+v"(fq));
        const int row0 = u.pm * BM + wr * 64 + fr, col0 = u.pn * HALF + wc * 32 + 8 * fq;
#pragma unroll
        for (int ai = 0; ai < 2; ++ai)
#pragma unroll
            for (int m = 0; m < 4; ++m) { bf16_t* rowp = O + (size_t)(row0 + ai * HALF + m * 16) * ldc + col0; const float r = rs[row0 + ai * HALF + m * 16];
                f32x4 v0, v1;
#pragma unroll
                for (int e = 0; e < 4; ++e) { v0[e] = silu_f(acc[ai][0][m][0][e] * r) * (acc[ai][1][m][0][e] * r); v1[e] = silu_f(acc[ai][0][m][1][e] * r) * (acc[ai][1][m][1][e] * r); }
                *(u32x4*)rowp = pack8(v0, v1); }
    }
};
struct EpiWin {
    static constexpr bool PERM = true, AFTER_DRAIN = false;
    unsigned char* hid;
    static constexpr size_t SQS = 22u << 20, OQ = 0, OK_ = 3u << 20, OV = 6u << 20, OZR = 9u << 20, OZP = 20u << 20;
    const float *cs, *sn;
    float qscale; const float* rs;
    __device__ __forceinline__ void operator()(const f32x4 (&acc)[2][2][4][2], const Unit& u, int wr, int wc, int fr, int fq) const {
        asm volatile("" : "+v"(fr), "+v"(fq));
        const int row0 = u.pm * BM + wr * 64 + fr, pn = u.pn;
        if (pn < 6) {
            const size_t dsto = pn < 3 ? OQ : OK_; const int pt = pn < 3 ? pn : pn - 3; const float sc = pn < 3 ? qscale : 1.0f;
            const int d0 = 16 * (wc & 1) + 4 * fq;
#pragma unroll
            for (int ai = 0; ai < 2; ++ai)
#pragma unroll
                for (int m = 0; m < 4; ++m) { const int row = row0 + ai * HALF + m * 16, b = row >> 11, s = row & 2047; const float rsc = rs[row] * sc;
                    const f32x4 c4 = *(const f32x4*)(cs + s * 32 + d0), s4 = *(const f32x4*)(sn + s * 32 + d0);
#pragma unroll
                    for (int bj = 0; bj < 2; ++bj) { const int head = pt * 4 + bj * 2 + (wc >> 1);
                        const f32x4 x1 = acc[ai][bj][m][0], x2 = acc[ai][bj][m][1];
                        const f32x4 o1 = (x1 * c4 - x2 * s4) * rsc, o2 = (x2 * c4 + x1 * s4) * rsc;
                        bf16_t* p = (bf16_t*)(hid + (size_t)b * SQS + dsto) + ((size_t)head * 2048 + s) * 64 + d0;
                        u32x2 w1, w2; w1.x = cvt_pk_bf16(o1[0], o1[1]); w1.y = cvt_pk_bf16(o1[2], o1[3]); w2.x = cvt_pk_bf16(o2[0], o2[1]); w2.y = cvt_pk_bf16(o2[2], o2[3]);
                        *(u32x2*)p = w1; *(u32x2*)(p + 32) = w2; } }
        } else if (pn < 9) {
            const int d0 = 32 * (wc & 1) + 8 * fq;
#pragma unroll
            for (int ai = 0; ai < 2; ++ai)
#pragma unroll
                for (int m = 0; m < 4; ++m) { const int row = row0 + ai * HALF + m * 16, b = row >> 11, s = row & 2047; const float r = rs[row];
#pragma unroll
                    for (int bj = 0; bj < 2; ++bj) { const int head = (pn - 6) * 4 + bj * 2 + (wc >> 1);
                        *(u32x4*)((bf16_t*)(hid + (size_t)b * SQS + OV) + ((size_t)head * 2048 + s) * 64 + d0) = pack8(acc[ai][bj][m][0] * r, acc[ai][bj][m][1] * r); } }
        } else {
            size_t oo; int ldc, colt;
            if (pn < 20) { oo = OZR; ldc = 2816; colt = (pn - 9) * BM; } else { oo = OZP; ldc = 512; colt = (pn - 20) * BM; }
            const int col0 = colt + wc * 32 + 8 * fq;
#pragma unroll
            for (int ai = 0; ai < 2; ++ai)
#pragma unroll
                for (int m = 0; m < 4; ++m) { const int row = row0 + ai * HALF + m * 16; bf16_t* rowp = (bf16_t*)(hid + (size_t)(row >> 11) * SQS + oo) + (size_t)(row & 2047) * ldc + col0; const float r = rs[row];
#pragma unroll
                    for (int bj = 0; bj < 2; ++bj) *(u32x4*)(rowp + bj * HALF) = pack8(acc[ai][bj][m][0] * r, acc[ai][bj][m][1] * r); }
        }
    }
};

struct GroupOrder {
    int nN, nb, bi, pm0;
    __device__ __forceinline__ void init(int ntiles, int nb_, int bi_, int seq) { nN = ntiles; nb = nb_; bi = bi_; pm0 = 8 * seq; }
    __device__ __forceinline__ bool next(int i, Unit& u) const { const int L = i * nb + bi; if (L >= 8 * nN) return false; u.pm = pm0 + (L & 7); u.pn = L >> 3; return true; }
    __device__ __forceinline__ void a_ready(const Unit&) const {}
    __device__ __forceinline__ void done(const Unit&) const {}
};
struct PanelOrder {
    int slice, nb, bi, pm0;
    __device__ __forceinline__ bool next(int i, Unit& u) const { if (i) return false; const int P = nb >> 3, p = slice * P + (bi >> 3); if ((bi >> 3) >= P || p >= 8) return false; u.pm = pm0 + p; u.pn = bi & 7; return true; }
    __device__ __forceinline__ void a_ready(const Unit&) const {}
    __device__ __forceinline__ void done(const Unit&) const {}
};
struct EpiRes {
    static constexpr bool PERM = true, AFTER_DRAIN = true;
    bf16_t* X; float* OUT;
    const float* gpost; float coef; float* rs;
    float* slots;
    unsigned* cnt;
    unsigned* tmo;
    __device__ __forceinline__ float exchange(float part, int ex, const Unit& u, PG8_LAS float* P, PG8_LAS float* S, int wid, int lane, int wc, int rowl, bool writer) const {
        if (writer) P[rowl * 4 + wc] = part;
        asm volatile("s_waitcnt lgkmcnt(0)" ::: "memory"); __builtin_amdgcn_s_barrier(); asm volatile("" ::: "memory");
        const int tid = wid * 64 + lane;
        float* sl = slots + ((size_t)ex * 16384 * 8);
        if (tid < 256) { const float t4 = (P[tid * 4 + 0] + P[tid * 4 + 1]) + (P[tid * 4 + 2] + P[tid * 4 + 3]);
            __hip_atomic_store(sl + (size_t)(u.pm * BM + tid) * 8 + u.pn, t4, __ATOMIC_RELAXED, __HIP_MEMORY_SCOPE_AGENT);
            asm volatile("s_waitcnt vmcnt(0)" ::: "memory");
            if (lane == 0) __hip_atomic_fetch_add(cnt + 64 * (ex * 64 + u.pm), 1u, __ATOMIC_RELAXED, __HIP_MEMORY_SCOPE_AGENT); }
        if (wid == 0) { unsigned sp = 0;
            while ((unsigned)__builtin_amdgcn_readfirstlane(__hip_atomic_load(cnt + 64 * (ex * 64 + u.pm), __ATOMIC_RELAXED, __HIP_MEMORY_SCOPE_AGENT)) < 32u) {
                __builtin_amdgcn_s_sleep(1); if (++sp > (1u << 22)) { if (lane == 0) __hip_atomic_store(tmo, 1u, __ATOMIC_RELAXED, __HIP_MEMORY_SCOPE_AGENT); break; } } }
        asm volatile("s_waitcnt vmcnt(0) lgkmcnt(0)" ::: "memory"); __builtin_amdgcn_s_barrier(); asm volatile("" ::: "memory");
        if (tid < 256) { const float* q = sl + (size_t)(u.pm * BM + tid) * 8; float t = 0.f;
#pragma unroll
            for (int k = 0; k < 8; ++k) t += __hip_atomic_load(q + k, __ATOMIC_RELAXED, __HIP_MEMORY_SCOPE_AGENT);
            S[tid] = t; }
        asm volatile("s_waitcnt vmcnt(0) lgkmcnt(0)" ::: "memory"); __builtin_amdgcn_s_barrier(); asm volatile("" ::: "memory");
        return S[rowl];
    }
    __device__ __forceinline__ void fused(f32x4 (&acc)[2][2][4][2], const Unit& u, int wr, int wc, int fr, int fq, PG8_LAS unsigned char* lds, int wid, int lane) const {
        PG8_LAS float* P = (PG8_LAS float*)lds; PG8_LAS float* S = (PG8_LAS float*)(lds + 4096);
        const int col0 = u.pn * BM + wc * 32 + 8 * fq;
        f32x4 gv[2][2];
#pragma unroll
        for (int bj = 0; bj < 2; ++bj)
#pragma unroll
            for (int n = 0; n < 2; ++n) gv[bj][n] = *(const f32x4*)(gpost + col0 + bj * HALF + 4 * n);
        u32x4 xw_[2][4][2];
#pragma unroll
        for (int ai = 0; ai < 2; ++ai)
#pragma unroll
            for (int m = 0; m < 4; ++m)
#pragma unroll
                for (int bj = 0; bj < 2; ++bj) xw_[ai][m][bj] = *(const u32x4*)(X + ((size_t)u.pm * BM + ai * HALF + wr * 64 + m * 16 + fr) * 2048 + col0 + bj * HALF);
        float ssq[2][4];
#pragma unroll
        for (int ai = 0; ai < 2; ++ai)
#pragma unroll
            for (int m = 0; m < 4; ++m) { float s = 0.f;
#pragma unroll
                for (int bj = 0; bj < 2; ++bj)
#pragma unroll
                    for (int n = 0; n < 2; ++n) { const f32x4 v = acc[ai][bj][m][n]; s += (v[0] * v[0] + v[1] * v[1]) + (v[2] * v[2] + v[3] * v[3]); }
                s += __shfl_xor(s, 16); s += __shfl_xor(s, 32); ssq[ai][m] = s; }
#pragma unroll
        for (int ai = 0; ai < 2; ++ai)
#pragma unroll
            for (int m = 0; m < 4; ++m) if (fq == 0) P[(ai * HALF + wr * 64 + m * 16 + fr) * 4 + wc] = ssq[ai][m];
        const float dummy1 = exchange(0.f, 0, u, P, S, wid, lane, wc, 0, false); (void)dummy1;
        float ss2[2][4];
#pragma unroll
        for (int ai = 0; ai < 2; ++ai)
#pragma unroll
            for (int m = 0; m < 4; ++m) { const int rl = ai * HALF + wr * 64 + m * 16 + fr; const size_t row = (size_t)u.pm * BM + rl;
                const float cr = coef * __builtin_amdgcn_rsqf(S[rl] * (1.0f / 2048.0f) + 1e-6f); float s2 = 0.f;
#pragma unroll
                for (int bj = 0; bj < 2; ++bj) { bf16_t* xp = X + row * 2048 + col0 + bj * HALF; const u32x4 xw = xw_[ai][m][bj];
                    f32x4 x0 = {__uint_as_float(xw.x << 16), __uint_as_float(xw.x & 0xffff0000u), __uint_as_float(xw.y << 16), __uint_as_float(xw.y & 0xffff0000u)};
                    f32x4 x1 = {__uint_as_float(xw.z << 16), __uint_as_float(xw.z & 0xffff0000u), __uint_as_float(xw.w << 16), __uint_as_float(xw.w & 0xffff0000u)};
                    x0 = x0 + acc[ai][bj][m][0] * gv[bj][0] * cr; x1 = x1 + acc[ai][bj][m][1] * gv[bj][1] * cr;
                    if (OUT) { float* op = OUT + row * 2048 + col0 + bj * HALF; *(f32x4*)op = x0; *(f32x4*)(op + 4) = x1; }
                    else { const u32x4 w = pack8(x0, x1); *(u32x4*)xp = w;
                        const float a0 = __uint_as_float(w.x << 16), a1 = __uint_as_float(w.x & 0xffff0000u), a2 = __uint_as_float(w.y << 16), a3 = __uint_as_float(w.y & 0xffff0000u);
                        const float a4 = __uint_as_float(w.z << 16), a5 = __uint_as_float(w.z & 0xffff0000u), a6 = __uint_as_float(w.w << 16), a7 = __uint_as_float(w.w & 0xffff0000u);
                        s2 += ((a0 * a0 + a1 * a1) + (a2 * a2 + a3 * a3)) + ((a4 * a4 + a5 * a5) + (a6 * a6 + a7 * a7)); } }
                s2 += __shfl_xor(s2, 16); s2 += __shfl_xor(s2, 32); ss2[ai][m] = s2; }
        if (OUT) return;
        asm volatile("s_waitcnt lgkmcnt(0)" ::: "memory"); __builtin_amdgcn_s_barrier(); asm volatile("" ::: "memory");
#pragma unroll
        for (int ai = 0; ai < 2; ++ai)
#pragma unroll
            for (int m = 0; m < 4; ++m) if (fq == 0) P[(ai * HALF + wr * 64 + m * 16 + fr) * 4 + wc] = ss2[ai][m];
        const float dummy2 = exchange(0.f, 1, u, P, S, wid, lane, wc, 0, false); (void)dummy2;
        if (u.pn == 0) { const int tid = wid * 64 + lane; if (tid < 256) rs[(size_t)u.pm * BM + tid] = __builtin_amdgcn_rsqf(S[tid] * (1.0f / 2048.0f) + 1e-6f); }
    }
};

template <class Epi, class Sched, bool ALIGN_EPI = false, bool SP2 = false>
__device__ __forceinline__ void gemm_phase(PG8_LAS unsigned char* lds, const Gemm g, const Sched& S, const Epi& E) {
    int tid_ = threadIdx.x; asm volatile("" : "+v"(tid_));
    const int tid = tid_, wid = __builtin_amdgcn_readfirstlane(tid >> 6), lane = tid & 63, wr = wid >> 2, wc = wid & 3, fr = lane & 15, fq = lane >> 4;
    int K_ = g.K; asm volatile("" : "+s"(K_));
    const int K = K_, nt = K / BK;
    unsigned voffA[2], voffB[2];
#pragma unroll
    for (int i = 0; i < 2; ++i) { int R, C; stage_rc(tid * 16 + i * 8192, R, C); const int Rb = Epi::PERM ? ((R & ~31) + perm32(R & 31)) : R;
        voffA[i] = (unsigned)(R * K + C) * 2u; voffB[i] = (unsigned)(Rb * K + C) * 2u; }
    const size_t kstep = (size_t)(BK * 2);
    const size_t hstep = (size_t)HALF * K * 2;
    const size_t tstep = 2 * hstep;
    const unsigned ldsw = (unsigned)wid * 1024u;
    const int aoff = lds_byte(wr * 64 + fr, fq * 8), boff = lds_byte(wc * 32 + fr, fq * 8);
#define PG8_SA(b, h) (((b) * 2 + (h)) * HTB)
#define PG8_SB(b, h) ((4 + (b) * 2 + (h)) * HTB)
#define PG8_STAGE(bufoff, gbase, voff) do { _Pragma("unroll") for (int _i = 0; _i < 2; ++_i) \
        __builtin_amdgcn_global_load_lds((const unsigned*)((const char*)(gbase) + (voff)[_i]), (PG8_LAS unsigned*)(lds + (bufoff) + ldsw + _i * 8192), 16, 0, 0); } while (0)
#define PG8_LDA(dst, b, h) do { _Pragma("unroll") for (int m = 0; m < 4; ++m) _Pragma("unroll") for (int k = 0; k < 2; ++k) dst[m][k] = *(const PG8_LAS bf16x8*)(lds + PG8_SA(b, h) + aoff + m * 2048 + k * 1024); } while (0)
#define PG8_LDB(dst, b, h) do { _Pragma("unroll") for (int n = 0; n < 2; ++n) _Pragma("unroll") for (int k = 0; k < 2; ++k) dst[n][k] = *(const PG8_LAS bf16x8*)(lds + PG8_SB(b, h) + boff + n * 2048 + k * 1024); } while (0)
#define PG8_MMA(ai, bj, At, Bt) do { __builtin_amdgcn_s_setprio(1); _Pragma("unroll") for (int m = 0; m < 4; ++m) _Pragma("unroll") for (int n = 0; n < 2; ++n) _Pragma("unroll") for (int k = 0; k < 2; ++k) \
        acc[ai][bj][m][n] = __builtin_amdgcn_mfma_f32_16x16x32_bf16(Bt[n][k], At[m][k], acc[ai][bj][m][n], 0, 0, 0); __builtin_amdgcn_s_setprio(0); } while (0)
#define PG8_WAIT_V(n) asm volatile("s_waitcnt vmcnt(" #n ")" ::: "memory")
#define PG8_WAIT_L(n) asm volatile("s_waitcnt lgkmcnt(" #n ")" ::: "memory")
#define PG8_BAR __builtin_amdgcn_s_barrier()
#define PG8_SCHED __builtin_amdgcn_sched_barrier(0)
    Unit cur, nxt; int ui = 0;
    if (!S.next(0, cur)) return;
    f32x4 acc[2][2][4][2];
#pragma unroll
    for (int a = 0; a < 2; ++a)
#pragma unroll
        for (int b = 0; b < 2; ++b)
#pragma unroll
            for (int m = 0; m < 4; ++m)
#pragma unroll
                for (int n = 0; n < 2; ++n) acc[a][b][m][n] = (f32x4){0.f, 0.f, 0.f, 0.f};
    bf16x8 At[4][2], B0[2][2], B1[2][2];
    const char* cA = (const char*)g.A + (size_t)cur.pm * tstep; const char* cB = (const char*)g.Bt + (size_t)cur.pn * tstep;
    S.a_ready(cur);
    if constexpr (SP2) {
        PG8_STAGE(PG8_SB(0, 0), cB, voffB); PG8_STAGE(PG8_SB(0, 1), cB + hstep, voffB); PG8_STAGE(PG8_SA(0, 0), cA, voffA); PG8_STAGE(PG8_SA(0, 1), cA + hstep, voffA);
        if (wr == 1) PG8_BAR;
        PG8_WAIT_V(2); PG8_BAR;
        PG8_STAGE(PG8_SB(1, 0), cB + kstep, voffB); PG8_STAGE(PG8_SA(1, 0), cA + kstep, voffA); PG8_STAGE(PG8_SB(1, 1), cB + hstep + kstep, voffB);
        PG8_WAIT_V(6); PG8_BAR;
    } else {
        PG8_STAGE(PG8_SB(0, 0), cB, voffB); PG8_STAGE(PG8_SA(0, 0), cA, voffA); PG8_STAGE(PG8_SB(0, 1), cB + hstep, voffB); PG8_STAGE(PG8_SA(0, 1), cA + hstep, voffA);
        if (wr == 1) PG8_BAR;
        PG8_WAIT_V(4); PG8_BAR;
        PG8_STAGE(PG8_SB(1, 0), cB + kstep, voffB); PG8_STAGE(PG8_SA(1, 0), cA + kstep, voffA); PG8_STAGE(PG8_SB(1, 1), cB + hstep + kstep, voffB);
        PG8_WAIT_V(6); PG8_BAR;
    }
    for (;;) {
        const bool has_next = S.next(ui + 1, nxt);
        const char* nA = has_next ? (const char*)g.A + (size_t)nxt.pm * tstep : cA; const char* nB = has_next ? (const char*)g.Bt + (size_t)nxt.pn * tstep : cB;
        for (int t = 0; t < nt; t += 2) {
            const bool last = (t == nt - 2);
            const char* a1 = cA + (size_t)(t + 1) * kstep;
            const char* a2 = last ? nA : cA + (size_t)(t + 2) * kstep; const char* b2 = last ? nB : cB + (size_t)(t + 2) * kstep;
            const char* a3 = a2 + kstep; const char* b3 = b2 + kstep;
            if (last && has_next) S.a_ready(nxt);
            if constexpr (SP2) {
            PG8_LDB(B0, 0, 0); PG8_LDB(B1, 0, 1); PG8_SCHED; PG8_LDA(At, 0, 0); PG8_STAGE(PG8_SA(1, 1), a1 + hstep, voffA);
            PG8_WAIT_V(8); PG8_WAIT_L(0); PG8_BAR; PG8_MMA(0, 0, At, B0); PG8_MMA(0, 1, At, B1); PG8_BAR; PG8_SCHED;
            PG8_LDA(At, 0, 1); PG8_STAGE(PG8_SB(0, 0), b2, voffB); PG8_STAGE(PG8_SB(0, 1), b2 + hstep, voffB); PG8_STAGE(PG8_SA(0, 0), a2, voffA);
            PG8_WAIT_V(8); PG8_WAIT_L(0); PG8_BAR; PG8_MMA(1, 0, At, B0); PG8_MMA(1, 1, At, B1); PG8_BAR; PG8_SCHED;
            PG8_LDB(B0, 1, 0); PG8_LDB(B1, 1, 1); PG8_SCHED; PG8_LDA(At, 1, 0); PG8_STAGE(PG8_SA(0, 1), a2 + hstep, voffA);
            PG8_WAIT_V(8); PG8_WAIT_L(0); PG8_BAR; PG8_MMA(0, 0, At, B0); PG8_MMA(0, 1, At, B1); PG8_BAR; PG8_SCHED;
            PG8_LDA(At, 1, 1); PG8_STAGE(PG8_SB(1, 0), b3, voffB); PG8_STAGE(PG8_SB(1, 1), b3 + hstep, voffB); PG8_STAGE(PG8_SA(1, 0), a3, voffA);
            PG8_WAIT_V(8); PG8_WAIT_L(0); PG8_BAR; PG8_MMA(1, 0, At, B0); PG8_MMA(1, 1, At, B1); PG8_BAR; PG8_SCHED;
            } else {
            PG8_LDB(B0, 0, 0); PG8_SCHED; PG8_LDA(At, 0, 0); PG8_STAGE(PG8_SA(1, 1), a1 + hstep, voffA);
            PG8_WAIT_L(8); PG8_BAR; PG8_WAIT_L(0); PG8_MMA(0, 0, At, B0); PG8_BAR; PG8_SCHED;
            PG8_LDB(B1, 0, 1); PG8_STAGE(PG8_SB(0, 0), b2, voffB);
            PG8_BAR; PG8_WAIT_L(0); PG8_MMA(0, 1, At, B1); PG8_BAR;
            PG8_LDA(At, 0, 1); PG8_STAGE(PG8_SA(0, 0), a2, voffA);
            PG8_BAR; PG8_WAIT_L(0); PG8_MMA(1, 0, At, B0); PG8_BAR; PG8_SCHED;
            PG8_STAGE(PG8_SB(0, 1), b2 + hstep, voffB);
            PG8_WAIT_V(6); PG8_BAR; PG8_MMA(1, 1, At, B1); PG8_BAR;
            PG8_LDB(B0, 1, 0); PG8_SCHED; PG8_LDA(At, 1, 0); PG8_STAGE(PG8_SA(0, 1), a2 + hstep, voffA);
            PG8_WAIT_L(8); PG8_BAR; PG8_WAIT_L(0); PG8_MMA(0, 0, At, B0); PG8_BAR; PG8_SCHED;
            PG8_LDB(B1, 1, 1); PG8_STAGE(PG8_SB(1, 0), b3, voffB);
            PG8_BAR; PG8_WAIT_L(0); PG8_MMA(0, 1, At, B1); PG8_BAR;
            PG8_LDA(At, 1, 1); PG8_STAGE(PG8_SA(1, 0), a3, voffA);
            PG8_BAR; PG8_WAIT_L(0); PG8_MMA(1, 0, At, B0); PG8_BAR; PG8_SCHED;
            PG8_STAGE(PG8_SB(1, 1), b3 + hstep, voffB);
            PG8_WAIT_V(6); PG8_BAR; PG8_MMA(1, 1, At, B1); PG8_BAR;
            }
        }
        if constexpr (ALIGN_EPI) { if (wr == 0) PG8_BAR; }
        if constexpr (!Epi::AFTER_DRAIN) { E(acc, cur, wr, wc, fr, fq); S.done(cur); }
        if (!has_next) break;
#pragma unroll
        for (int a = 0; a < 2; ++a)
#pragma unroll
            for (int b = 0; b < 2; ++b)
#pragma unroll
                for (int m = 0; m < 4; ++m)
#pragma unroll
                    for (int n = 0; n < 2; ++n) acc[a][b][m][n] = (f32x4){0.f, 0.f, 0.f, 0.f};
        cur = nxt; cA = nA; cB = nB; ++ui;
        if constexpr (ALIGN_EPI) { if (wr == 1) PG8_BAR; }
    }
    PG8_WAIT_V(0);
    if constexpr (!ALIGN_EPI) { if (wr == 0) PG8_BAR; }
    PG8_BAR;
    if constexpr (Epi::AFTER_DRAIN) { E.fused(acc, cur, wr, wc, fr, fq, lds, wid, lane); S.done(cur); }
#undef PG8_SA
#undef PG8_SB
#undef PG8_STAGE
#undef PG8_LDA
#undef PG8_LDB
#undef PG8_MMA
#undef PG8_WAIT_V
#undef PG8_WAIT_L
#undef PG8_BAR
#undef PG8_SCHED
}
}
#define GAS __attribute__((address_space(1)))
#define LAS __attribute__((address_space(3)))
typedef unsigned short bf16;
typedef unsigned v4u __attribute__((ext_vector_type(4)));
typedef float f32x4 __attribute__((ext_vector_type(4)));
typedef short bf16x8 __attribute__((ext_vector_type(8)));
typedef GAS unsigned gu32;
typedef GAS unsigned long long gu64;
#define RLX_AGENT __ATOMIC_RELAXED, __HIP_MEMORY_SCOPE_AGENT
#define LDS_WAIT() asm volatile("s_waitcnt lgkmcnt(0)" ::: "memory")
#define VM_WAIT() asm volatile("s_waitcnt vmcnt(0)" ::: "memory")
__device__ __forceinline__ unsigned long long rt() { return __builtin_amdgcn_s_memrealtime(); }
__device__ __forceinline__ unsigned f2bf(float f) { unsigned u = __builtin_bit_cast(unsigned, f); return (u + 0x7fffu + ((u >> 16) & 1u)) >> 16; }
__device__ __forceinline__ unsigned pk2(float lo, float hi) { return f2bf(lo) | (f2bf(hi) << 16); }
#define XB_TMO      128
#define XB_XCNT(j)  (256  + 64 * (j))
#define XB_XSUB(j)  (1280 + 64 * (j))
#define XB_XGEN(j)  (2304 + 64 * (j))
#define XB_TOP      3328
#define XB_TOPGEN   3392
#define XCD_BAR_WORDS 3456
#define XB_SPIN_CAP (1u << 18)

__device__ __forceinline__ unsigned xb_ld(unsigned* p)              { return __hip_atomic_load(p, __ATOMIC_RELAXED, __HIP_MEMORY_SCOPE_AGENT); }
__device__ __forceinline__ unsigned xb_add(unsigned* p, unsigned v) { return __hip_atomic_fetch_add(p, v, __ATOMIC_RELAXED, __HIP_MEMORY_SCOPE_AGENT); }
__device__ __forceinline__ unsigned xb_xcc_id() { return (unsigned)__builtin_amdgcn_s_getreg((3 << 11) | 20) & 0xFu; }
#define XB_SPIN(cond, bar) do { unsigned _sp = 0; while (cond) { __builtin_amdgcn_s_sleep(1); \
    if ((++_sp & 255u) == 0u) { if (xb_ld(&(bar)[XB_TMO])) break; if (_sp > XB_SPIN_CAP) { atomicAdd(&(bar)[XB_TMO], 1u); break; } } } } while (0)

struct XcdBarrier {
    unsigned* bar; unsigned x;
    volatile LAS unsigned* st;
};

__device__ __forceinline__ XcdBarrier xcd_barrier_post(unsigned* bar, volatile LAS unsigned* st) {
    XcdBarrier b; b.bar = bar; b.x = xb_xcc_id(); b.st = st;
    if (threadIdx.x == 0) (void)xb_add(&bar[XB_XCNT(b.x)], 1u);
    return b;
}
__device__ __forceinline__ void xcd_barrier_complete(unsigned* bar, unsigned x, unsigned& nloc, unsigned& nx) {
    const unsigned G = gridDim.x * gridDim.y * gridDim.z;
    unsigned sum, cnt, mine, sp = 0u;
    for (;;) {
        sum = 0u; cnt = 0u; mine = 0u;
#pragma unroll
        for (unsigned j = 0; j < 16; ++j) { const unsigned c = xb_ld(&bar[XB_XCNT(j)]); sum += c; cnt += (c > 0u) ? 1u : 0u; mine = (j == x) ? c : mine; }
        if (sum == G) break;
        __builtin_amdgcn_s_sleep(1);
        if ((++sp & 255u) == 0u) { if (xb_ld(&bar[XB_TMO])) break; if (sp > XB_SPIN_CAP) { atomicAdd(&bar[XB_TMO], 1u); break; } }
    }
    nloc = mine > 0u ? mine : 1u; nx = cnt > 0u ? cnt : 1u;
}

__device__ __forceinline__ void xcd_barrier(const XcdBarrier& b) {
    asm volatile("s_waitcnt vmcnt(0)" ::: "memory");
    __syncthreads();
    if (threadIdx.x == 0) {
        unsigned* bar = b.bar;
        __builtin_amdgcn_s_waitcnt(0);
        unsigned nloc = b.st[0], nx = b.st[1];
        if (nloc == 0u) { xcd_barrier_complete(bar, b.x, nloc, nx); b.st[0] = nloc; b.st[1] = nx; }
        const unsigned old = xb_add(&bar[XB_XSUB(b.x)], 1u);
        const unsigned gen = old / nloc;
        if (old + 1u == (gen + 1u) * nloc) {
            __builtin_amdgcn_fence(__ATOMIC_RELEASE, "agent");
            asm volatile("s_waitcnt vmcnt(0)" ::: "memory");
            const unsigned og = xb_add(&bar[XB_TOP], 1u);
            const unsigned tg = og / nx;
            if (og + 1u == (tg + 1u) * nx) xb_add(&bar[XB_TOPGEN], 1u);
            else XB_SPIN(xb_ld(&bar[XB_TOPGEN]) == tg, bar);
            __builtin_amdgcn_fence(__ATOMIC_ACQUIRE, "agent");
            xb_add(&bar[XB_XGEN(b.x)], 1u);
            asm volatile("s_waitcnt vmcnt(0)" ::: "memory");
        } else {
            XB_SPIN(xb_ld(&bar[XB_XGEN(b.x)]) == gen, bar);
            __builtin_amdgcn_fence(__ATOMIC_ACQUIRE, "agent");
            asm volatile("s_waitcnt vmcnt(0)" ::: "memory");
        }
    }
    __syncthreads();
}

constexpr int NWAVES = 8;
#ifndef MK_MULTI
#define MK_MULTI 0
#endif
#ifndef SCAN_DPP
#define SCAN_DPP 1
#endif

#ifndef EXTRA_BAR
#define EXTRA_BAR 0
#endif
#ifndef REP_PRO
#define REP_PRO 1
#endif
#ifndef REP_GU
#define REP_GU 1
#endif
#ifndef REP_DN
#define REP_DN 1
#endif
#ifndef REP_ROW
#define REP_ROW 1
#endif
#ifndef REP_WIN
#define REP_WIN 1
#endif
#ifndef REP_PREP
#define REP_PREP 1
#endif
#ifndef REP_LORA
#define REP_LORA 1
#endif
#ifndef REP_MIX
#define REP_MIX 1
#endif
#ifndef REP_ATT
#define REP_ATT 1
#endif
#ifndef REP_S1
#define REP_S1 1
#endif
#ifndef REP_S2
#define REP_S2 1
#endif
#ifndef REP_S3
#define REP_S3 1
#endif
#ifndef REP_COMB
#define REP_COMB 1
#endif
#ifndef REP_WOUT
#define REP_WOUT 1
#endif

constexpr int BATCH = 8, SEQ = 2048, D = 2048, M = BATCH * SEQ, FF = 5632, NL = 4;
constexpr int NH = 12, HD = 64, DATT = 768, DRW = 768, DPOOL = 512;
constexpr int DRWIN = 2752, DIN = 5568, DINP = 5632, ZRP = 2816;
constexpr int LORA_K = 512, LORA_N = 2304;
constexpr float NORM_EPS = 1e-6f, GN_EPS = 64e-5f;
constexpr float QSCALE = 0.125f * 1.4426950408889634f;
constexpr int NPH = 1 + 8 * 2 + 4 * 7;

constexpr size_t MiB = 1u << 20;
constexpr size_t WS_CTL = 0, CTL_ZERO_BYTES = 1 * MiB;
constexpr size_t WS_COS = 1 * MiB, WS_SIN = 1 * MiB + 256 * 1024, WS_RS = 1 * MiB + 512 * 1024;
constexpr size_t WS_W = 2 * MiB, LW = 165 * MiB;
constexpr size_t LW_GU1 = 0, LW_D1 = 44 * MiB, LW_IN = 66 * MiB, LW_OUT = 88 * MiB, LW_GU2 = 96 * MiB, LW_D2 = 140 * MiB, LW_LORA = 162 * MiB, LW_POOL = 164 * MiB + 256 * 1024;
constexpr size_t WS_H = WS_W + NL * LW;
constexpr size_t WS_HID = WS_H + 64 * MiB;
constexpr size_t SQ_STRIDE = 22 * MiB, SQ_Q = 0, SQ_K = 3 * MiB, SQ_V = 6 * MiB, SQ_ZR = 9 * MiB, SQ_ZP = 20 * MiB;
static_assert((size_t)SEQ * FF * 2 == SQ_STRIDE && SQ_ZR + (size_t)SEQ * ZRP * 2 == SQ_ZP && SQ_ZP + (size_t)SEQ * 512 * 2 == SQ_STRIDE && (size_t)NH * SEQ * 64 * 2 == 3 * MiB, "per-sequence overlay");
constexpr size_t WS_Y = WS_HID + 176 * MiB;
constexpr size_t WS_CAT = WS_Y + 64 * MiB;
constexpr size_t WS_OG = WS_CAT + 64 * MiB;
constexpr size_t WS_LSE = WS_OG + 72 * MiB;
constexpr size_t WS_LA = WS_LSE + 3 * MiB;
constexpr size_t WS_PP = WS_LA + 16 * MiB;
constexpr size_t WS_L = WS_PP + 16 * MiB, WS_LB = WS_L, WS_XB = WS_L + 72 * MiB;
constexpr size_t WS_END = WS_L + 144 * MiB;
static_assert(WS_HID + BATCH * SQ_STRIDE <= WS_Y && LW_POOL + 512 * 512 * 2 <= LW && LW_LORA + (size_t)LORA_N * LORA_K * 2 <= LW_POOL, "d_ws map");
constexpr int CW_TMO = 0, CW_CODE = 1, CW_BAR = 4096, CW_ATTQ = 8192  , CW_RANK = 11264  , CW_GB = 12288  , CW_XC = 16384, XC_USE = 2 * 64 * 64;
static_assert((CW_XC + 12 * XC_USE) * 4 <= (int)CTL_ZERO_BYTES, "control words");

constexpr int RING_OFF = 0, RING_BYTES = 131072;
constexpr int LDSCTL_OFF = RING_BYTES, MISC_OFF = LDSCTL_OFF + 320;
constexpr int LDS_BYTES = 147456;

struct Args { const float* in[28]; float* out; unsigned char* ws; int ph_lo, ph_hi; };
struct ArgsD { const __attribute__((address_space(1))) float* in[28]; __attribute__((address_space(1))) float* out; __attribute__((address_space(1))) unsigned char* ws; int ph_lo, ph_hi; };
static_assert(sizeof(ArgsD) == sizeof(Args), "Args views");
typedef const __attribute__((address_space(4))) ArgsD KArgs;
#define INP(A, k) ((const float*)(A)->in[k])

typedef unsigned long long u64t;
typedef float f32x2g __attribute__((ext_vector_type(2)));
struct Frame {
    LAS unsigned char* lds;
    int wave, vcu, G, tid;
    int bi, nb, seq;
    float* X;
    unsigned char* ws;
};
__device__ __forceinline__ float bf2f(bf16 u) { return __uint_as_float((unsigned)u << 16); }
__device__ __forceinline__ float wave_sum(float v) {
#pragma unroll
    for (int o = 1; o < 64; o <<= 1) v += __shfl_xor(v, o);
    return v;
}
__device__ __forceinline__ float sigmoid_f(float x) { return __builtin_amdgcn_rcpf(1.0f + __builtin_amdgcn_exp2f(-1.4426950408889634f * x)); }

template <class SrcF>
__device__ __forceinline__ void transpose_item(const SrcF src, int ldw, int K, bf16* WT, LAS float* scr, int item, int nblk, int lane, const float* kgain = nullptr) {
    const int kb = item / nblk, nb = item % nblk, k0 = 64 * kb, n0 = 32 * nb;
    const float* colp = src(n0 + (lane & 31));
    float tv[32];
    const GAS float* cp = (const GAS float*)colp + (size_t)(k0 + (lane >> 5)) * ldw;
#pragma unroll
    for (int i = 0; i < 32; ++i) tv[i] = colp ? cp[(size_t)(2 * i) * ldw] : 0.f;
#pragma unroll
    for (int i = 0; i < 32; ++i) scr[(2 * i + (lane >> 5)) * 33 + (lane & 31)] = tv[i];
    LDS_WAIT(); asm volatile("" ::: "memory");
    const int c = lane & 7;
    f32x4 g0 = (f32x4){1.f, 1.f, 1.f, 1.f}, g1 = g0;
    if (kgain) { g0 = *(const GAS f32x4*)(kgain + k0 + 8 * c); g1 = *(const GAS f32x4*)(kgain + k0 + 8 * c + 4); }
#pragma unroll
    for (int j = 0; j < 4; ++j) { const int n = (lane >> 3) + 8 * j; const LAS float* s = scr + (8 * c) * 33 + n;
        v4u o; o.x = pk2(s[0 * 33] * g0[0], s[1 * 33] * g0[1]); o.y = pk2(s[2 * 33] * g0[2], s[3 * 33] * g0[3]); o.z = pk2(s[4 * 33] * g1[0], s[5 * 33] * g1[1]); o.w = pk2(s[6 * 33] * g1[2], s[7 * 33] * g1[3]);
        *(GAS v4u*)(WT + (size_t)(n0 + n) * K + k0 + 8 * c) = o; }
    LDS_WAIT(); asm volatile("" ::: "memory");
}
struct SrcGU { const float* g; long du;
    __device__ __forceinline__ const float* operator()(int n) const { const int col = 128 * (n >> 8) + (n & 127); const long off = ((n >> 7) & 1) ? du : 0l; return (const float*)((const char*)g + off) + col; } };
struct SrcPlain { const float* w; __device__ __forceinline__ const float* operator()(int n) const { return w + n; } };
struct SrcWin { const float* w;
    __device__ __forceinline__ const float* operator()(int n) const {
        if (n < 1536) { const int sec = n / 768, r = n % 768, h = r >> 6, j = r & 63, d = 4 * (j >> 3) + (j & 3) + 32 * ((j >> 2) & 1); return w + sec * 768 + h * 64 + d; }
        if (n < 2304 + DRWIN) return w + n;
        if (n < 2304 + ZRP) return nullptr;
        return w + (n - (ZRP - DRWIN));
    } };

__device__ __forceinline__ void x_row_init(Frame& F, const float* xrow, bf16* xb, float* rs) {
    const GAS f32x4* xr = (const GAS f32x4*)xrow + (F.tid & 63);
    f32x4 v[8]; float s = 0.f;
#pragma unroll
    for (int j = 0; j < 8; ++j) { v[j] = xr[64 * j]; s += (v[j].x * v[j].x + v[j].y * v[j].y) + (v[j].z * v[j].z + v[j].w * v[j].w); }
    const float rstd = 1.0f / sqrtf(wave_sum(s) * (1.f / D) + NORM_EPS);
    GAS u64t* o8 = (GAS u64t*)xb + (F.tid & 63);
#pragma unroll
    for (int j = 0; j < 8; ++j) o8[64 * j] = (u64t)pk2(v[j].x, v[j].y) | ((u64t)pk2(v[j].z, v[j].w) << 32);
    if ((F.tid & 63) == 0) *rs = rstd;
}

__device__ __forceinline__ void p0_prologue_w(Frame& F, KArgs* A);
__device__ __forceinline__ void p0_prologue(Frame& F, KArgs* A) {
    p0_prologue_w(F, A);
    const int gw = F.vcu * NWAVES + F.wave, NGW = F.G * NWAVES;
    for (int m = gw; m < M; m += NGW) x_row_init(F, INP(A, 0) + (size_t)m * D, ((bf16*)(F.ws + WS_XB)) + (size_t)m * D, ((float*)(F.ws + WS_RS)) + m);
}
__device__ __forceinline__ void p0_prologue_w(Frame& F, KArgs* A) {
    LAS float* scr = (LAS float*)(F.lds + RING_OFF + F.wave * 16384);
    const int gw = F.vcu * NWAVES + F.wave, NGW = F.G * NWAVES;
    constexpr int I_GU = (D / 64) * (2 * FF / 32), I_D = (FF / 64) * (D / 32), I_IN = (D / 64) * (DINP / 32), I_OUT = (D / 64) * (D / 32);
    constexpr int I_L = 2 * I_GU + 2 * I_D + I_IN + I_OUT;
    for (int it = gw; it < NL * I_L; it += NGW) {
        const int l = it / I_L; int r = it % I_L;
        unsigned char* wl = F.ws + WS_W + (size_t)l * LW;
        const size_t offF = (size_t)l * D * FF;
        if (r < I_GU) { transpose_item(SrcGU{INP(A, 3) + offF, (long)((const char*)INP(A, 4) - (const char*)INP(A, 3))}, FF, D, (bf16*)(wl + LW_GU1), scr, r, 2 * FF / 32, (F.tid & 63), INP(A, 1) + (size_t)l * D); continue; } r -= I_GU;
        if (r < I_D) { transpose_item(SrcPlain{INP(A, 5) + offF}, D, FF, (bf16*)(wl + LW_D1), scr, r, D / 32, (F.tid & 63)); continue; } r -= I_D;
        if (r < I_IN) { transpose_item(SrcWin{INP(A, 8) + (size_t)l * D * DIN}, DIN, D, (bf16*)(wl + LW_IN), scr, r, DINP / 32, (F.tid & 63), INP(A, 6) + (size_t)l * D); continue; } r -= I_IN;
        if (r < I_OUT) { transpose_item(SrcPlain{INP(A, 9) + (size_t)l * D * D}, D, D, (bf16*)(wl + LW_OUT), scr, r, D / 32, (F.tid & 63)); continue; } r -= I_OUT;
        if (r < I_GU) { transpose_item(SrcGU{INP(A, 25) + offF, (long)((const char*)INP(A, 26) - (const char*)INP(A, 25))}, FF, D, (bf16*)(wl + LW_GU2), scr, r, 2 * FF / 32, (F.tid & 63), INP(A, 23) + (size_t)l * D); continue; } r -= I_GU;
        transpose_item(SrcPlain{INP(A, 27) + offF}, D, FF, (bf16*)(wl + LW_D2), scr, r, D / 32, (F.tid & 63));
    }
    const int gt = F.vcu * (NWAVES * 64) + F.tid, NGT = F.G * NWAVES * 64;
    constexpr int E_LORA = LORA_N * LORA_K, E_POOL = 512 * 512, E_L = E_LORA + E_POOL;
    for (int e = gt; e < NL * E_L; e += NGT) {
        const int l = e / E_L; int r = e % E_L;
        unsigned char* wl = F.ws + WS_W + (size_t)l * LW;
        if (r < E_LORA) { const int n = r / LORA_K, k = r % LORA_K; float v = 0.f;
            if (n < 768) { if (k < 96) v = INP(A, 11)[(size_t)l * 96 * 768 + k * 768 + n]; }
            else if (n < 1536) { if (k >= 96 && k < 192) v = INP(A, 13)[(size_t)l * 96 * 768 + (k - 96) * 768 + (n - 768)]; }
            else { if (k >= 192 && k < 448) v = INP(A, 15)[(size_t)l * 256 * 768 + (k - 192) * 768 + (n - 1536)]; }
            ((bf16*)(wl + LW_LORA))[r] = (bf16)f2bf(v);
        } else { r -= E_LORA; const int n = r / 512, k = r % 512; float v = 0.f;
            if ((n >> 7) == (k >> 7)) v = INP(A, 21)[(size_t)l * 4 * 128 * 128 + (size_t)(n >> 7) * 128 * 128 + (k & 127) * 128 + (n & 127)];
            ((bf16*)(wl + LW_POOL))[r] = (bf16)f2bf(v);
        }
    }
    for (int e = gt; e < SEQ * 32; e += NGT) {
        const int pos = e >> 5, i = e & 31;
        const float invf = powf(10000.0f, -(float)i / 32.0f);
        const double rev = (double)pos * (double)invf * 0.15915494309189535;
        const float fr = (float)(rev - rint(rev));
        ((float*)(F.ws + WS_COS))[e] = __builtin_amdgcn_cosf(fr); ((float*)(F.ws + WS_SIN))[e] = __builtin_amdgcn_sinf(fr);
    }
}

__device__ __forceinline__ void row_pass(Frame& F, float coef, const float* gpost, bool last) {
    const int gw = F.vcu * NWAVES + F.wave, NGW = F.G * NWAVES, lane = F.tid & 63;
    for (int m = gw; m < M; m += NGW) {
        GAS u64t* xr = (GAS u64t*)(((bf16*)(F.ws + WS_XB)) + (size_t)m * D) + lane; const GAS u64t* yr = (const GAS u64t*)(((bf16*)(F.ws + WS_Y)) + (size_t)m * D) + lane;
        const GAS f32x4* gp = (const GAS f32x4*)gpost + lane;
        f32x4 xv[8], yv[8]; float s = 0.f;
#pragma unroll
        for (int j = 0; j < 8; ++j) { const u64t xw = xr[64 * j], w = yr[64 * j];
            xv[j].x = __uint_as_float((unsigned)(xw << 16)); xv[j].y = __uint_as_float((unsigned)xw & 0xffff0000u); xv[j].z = __uint_as_float((unsigned)(xw >> 32) << 16); xv[j].w = __uint_as_float((unsigned)(xw >> 32) & 0xffff0000u);
            yv[j].x = __uint_as_float((unsigned)(w << 16)); yv[j].y = __uint_as_float((unsigned)w & 0xffff0000u); yv[j].z = __uint_as_float((unsigned)(w >> 32) << 16); yv[j].w = __uint_as_float((unsigned)(w >> 32) & 0xffff0000u);
            s += (yv[j].x * yv[j].x + yv[j].y * yv[j].y) + (yv[j].z * yv[j].z + yv[j].w * yv[j].w); }
        const float cr = coef / sqrtf(wave_sum(s) * (1.f / D) + NORM_EPS); float s2 = 0.f;
        if (last) {
            GAS f32x4* xo = (GAS f32x4*)(F.X + (size_t)m * D) + lane;
#pragma unroll
            for (int j = 0; j < 8; ++j) { const f32x4 g = gp[64 * j]; xo[64 * j] = xv[j] + yv[j] * g * cr; }
        } else {
#pragma unroll
            for (int j = 0; j < 8; ++j) { const f32x4 g = gp[64 * j]; xv[j] = xv[j] + yv[j] * g * cr;
                const unsigned lo = pk2(xv[j].x, xv[j].y), hi = pk2(xv[j].z, xv[j].w); xr[64 * j] = (u64t)lo | ((u64t)hi << 32);
                const float a0 = __uint_as_float(lo << 16), a1 = __uint_as_float(lo & 0xffff0000u), a2 = __uint_as_float(hi << 16), a3 = __uint_as_float(hi & 0xffff0000u);
                s2 += (a0 * a0 + a1 * a1) + (a2 * a2 + a3 * a3); }
            const float rstd = 1.0f / sqrtf(wave_sum(s2) * (1.f / D) + NORM_EPS);
            if (lane == 0) ((float*)(F.ws + WS_RS))[m] = rstd;
        }
    }
}
__device__ __forceinline__ float tanh_f(float x) { return 1.0f - 2.0f * __builtin_amdgcn_rcpf(1.0f + __builtin_amdgcn_exp2f(2.8853900817779268f * x)); }
__device__ __forceinline__ void unpack8(const v4u z, float (&f)[8]) {
#pragma unroll
    for (int e = 0; e < 4; ++e) { f[2 * e] = __uint_as_float(z[e] << 16); f[2 * e + 1] = __uint_as_float(z[e] & 0xffff0000u); }
}
__device__ __forceinline__ void mix_prep(Frame& F, KArgs* A, int l) {
    const int gw = F.bi * NWAVES + F.wave, NGW = F.nb * NWAVES, lane = F.tid & 63;
    const float* mu = INP(A, 10) + (size_t)l * DRWIN + 2304;
    f32x4 mu0 = (f32x4){0.f, 0.f, 0.f, 0.f}, mu1 = mu0;
    if (lane < 56) { mu0 = *(const GAS f32x4*)(mu + 8 * lane); mu1 = *(const GAS f32x4*)(mu + 8 * lane + 4); }
    const int pw = 2 << (lane >> 4);
    const int per = (SEQ + NGW - 1) / NGW, r_lo = gw * per, r_hi = (r_lo + per < SEQ) ? r_lo + per : SEQ, m_lo = F.seq * SEQ + r_lo, m_hi = F.seq * SEQ + r_hi;
    for (int m = m_lo; m < m_hi; ++m) {
        const int s = m & (SEQ - 1);
        const unsigned char* sqb = F.ws + WS_HID + (size_t)(m >> 11) * SQ_STRIDE;
        const bf16* zr = ((const bf16*)(sqb + SQ_ZR)) + (size_t)s * ZRP + 2304 + 8 * (lane < 56 ? lane : 0);
        const bf16* zp = ((const bf16*)(sqb + SQ_ZP)) + (size_t)s * 512 + 8 * lane;
        const int cnt = (s + 1 < pw) ? s + 1 : pw;
        v4u zc = (v4u){0u, 0u, 0u, 0u}, zq = zc, zw[16];
        if (lane < 56) { zc = *(const GAS v4u*)zr; if (s > 0) zq = *(const GAS v4u*)(zr - ZRP); }
#pragma unroll
        for (int i = 0; i < 16; ++i) { zw[i] = (v4u){0u, 0u, 0u, 0u}; if (i < cnt) zw[i] = *(const GAS v4u*)(zp - (size_t)i * 512); }
        v4u outv = (v4u){0u, 0u, 0u, 0u};
        if (lane < 56) {
            float z[8], zpv[8], v[8]; unpack8(zc, z); unpack8(zq, zpv);
#pragma unroll
            for (int e = 0; e < 8; ++e) { const float mm = e < 4 ? mu0[e] : mu1[e - 4], zs = z[e] + (zpv[e] - z[e]) * mm; v[e] = lane < 12 ? tanh_f(zs) : (lane < 24 ? zs : sigmoid_f(zs)); }
            outv.x = pk2(v[0], v[1]); outv.y = pk2(v[2], v[3]); outv.z = pk2(v[4], v[5]); outv.w = pk2(v[6], v[7]);
        }
        *(GAS v4u*)(((bf16*)(F.ws + WS_LA)) + (size_t)m * LORA_K + 8 * lane) = outv;
        float acc[8], u[8]; unpack8(zw[0], u);
#pragma unroll
        for (int e = 0; e < 8; ++e) acc[e] = u[e];
#pragma unroll
        for (int i = 1; i < 16; ++i) { float t[8]; unpack8(zw[i], t);
#pragma unroll
            for (int e = 0; e < 8; ++e) acc[e] += t[e]; }
        const float ic = 1.0f / (float)cnt;
        v4u pv; pv.x = pk2(acc[0] * ic - u[0], acc[1] * ic - u[1]); pv.y = pk2(acc[2] * ic - u[2], acc[3] * ic - u[3]); pv.z = pk2(acc[4] * ic - u[4], acc[5] * ic - u[5]); pv.w = pk2(acc[6] * ic - u[6], acc[7] * ic - u[7]);
        *(GAS v4u*)(((bf16*)(F.ws + WS_PP)) + (size_t)m * 512 + 8 * lane) = pv;
    }
}
__device__ __forceinline__ void attn_combine(Frame& F) {
    const int gw = F.bi * NWAVES + F.wave, NGW = F.nb * NWAVES, lane = F.tid & 63;
    const float* LSE = (const float*)(F.ws + WS_LSE); const bf16* OG = (const bf16*)(F.ws + WS_OG); bf16* CAT = (bf16*)(F.ws + WS_CAT);
    const int per = (SEQ + NGW - 1) / NGW, r_lo = gw * per, r_hi = (r_lo + per < SEQ) ? r_lo + per : SEQ, m_lo = F.seq * SEQ + r_lo, m_hi = F.seq * SEQ + r_hi;
    constexpr int RB = 4;
    for (int m0 = m_lo; m0 < m_hi; m0 += RB) {
        u64t a[RB][3], b[RB][3], c[RB][3]; float l0[RB][3], l1[RB][3], l2[RB][3];
#pragma unroll
        for (int r = 0; r < RB; ++r) { const int m = (m0 + r < m_hi) ? m0 + r : m_hi - 1;
#pragma unroll
            for (int p = 0; p < 3; ++p) {
                const int h = 4 * p + (lane >> 4); const size_t o = (size_t)m * DATT + 256 * p + 4 * lane;
                l0[r][p] = LSE[(size_t)m * NH + h]; l1[r][p] = LSE[(size_t)(M + m) * NH + h]; l2[r][p] = LSE[(size_t)(2 * M + m) * NH + h];
                a[r][p] = *(const GAS u64t*)(OG + o); b[r][p] = *(const GAS u64t*)(OG + (size_t)M * DATT + o); c[r][p] = *(const GAS u64t*)(OG + (size_t)2 * M * DATT + o); } }
#pragma unroll
        for (int r = 0; r < RB; ++r) { if (m0 + r >= m_hi) break; const int m = m0 + r;
#pragma unroll
            for (int p = 0; p < 3; ++p) {
                const float mx = fmaxf(l0[r][p], fmaxf(l1[r][p], l2[r][p]));
                float e0 = __builtin_amdgcn_exp2f(l0[r][p] - mx), e1 = __builtin_amdgcn_exp2f(l1[r][p] - mx), e2 = __builtin_amdgcn_exp2f(l2[r][p] - mx); const float inv = __builtin_amdgcn_rcpf(e0 + e1 + e2);
                e0 *= inv; e1 *= inv; e2 *= inv;
                float rr[4];
#pragma unroll
                for (int e = 0; e < 4; ++e) rr[e] = e0 * bf2f((bf16)(a[r][p] >> (16 * e))) + e1 * bf2f((bf16)(b[r][p] >> (16 * e))) + e2 * bf2f((bf16)(c[r][p] >> (16 * e)));
                *(GAS u64t*)(CAT + (size_t)m * D + 256 * p + 4 * lane) = (u64t)pk2(rr[0], rr[1]) | ((u64t)pk2(rr[2], rr[3]) << 32); } }
    }
}
constexpr int MP = 64;
__device__ __forceinline__ int swz(int row, int col) { return row * MP + ((((col >> 3) ^ (row >> 1)) & 7) << 3) + (col & 7); }
constexpr int ATT_K_OFF = 0, ATT_V_OFF = 256 * 64 * 2;
constexpr int ATT_UNITS = 3 * BATCH * NH * 16;
static_assert(ATT_V_OFF + 256 * 64 * 2 <= RING_BYTES, "attention LDS");
typedef short s16x4v __attribute__((ext_vector_type(4)));
__device__ __forceinline__ int swzv(int key, int d) { return key * 64 + ((((d >> 3) ^ (2 * ((key >> 1) & 3))) & 7) << 3) + (d & 7); }
struct AttnIn { v4u kv[4], vv[4]; bf16x8 q0, q1; };
struct AttnUnit { int g, bh, dl, r, blk; };
constexpr int ATT_SEQ_UNITS = 3 * NH * 16;
__device__ __forceinline__ AttnUnit attn_decode(int lu, int seq) { AttnUnit u; u.g = lu / (NH * 16); const int rem = lu % (NH * 16), rb = rem & 15; u.bh = seq * NH + (rem >> 4);
    if (u.g == 0) { u.dl = 1; u.r = 0; u.blk = rb; } else if (u.g == 1) { u.dl = 4; u.r = rb & 3; u.blk = rb >> 2; } else { u.dl = 16; u.r = rb; u.blk = 0; } return u; }
__device__ __forceinline__ void attn_fetch(Frame& F, const AttnUnit& u, AttnIn& R) {
    const unsigned char* sqb = F.ws + WS_HID + (size_t)(u.bh / NH) * SQ_STRIDE; const size_t ho = (size_t)(u.bh % NH) * SEQ * 64;
    const bf16* Qh = ((const bf16*)(sqb + SQ_Q)) + ho; const bf16* Kh = ((const bf16*)(sqb + SQ_K)) + ho; const bf16* Vh = ((const bf16*)(sqb + SQ_V)) + ho;
#pragma unroll
    for (int it = 0; it < 4; ++it) { const int idx = F.tid + it * 512, j = idx >> 3, ch = idx & 7, lk = (u.blk - 1) * 128 + j;
        R.kv[it] = (v4u){0u, 0u, 0u, 0u}; R.vv[it] = (v4u){0u, 0u, 0u, 0u};
        if (lk >= 0) { const size_t off = (size_t)(lk * u.dl + u.r) * 64 + ch * 8; R.kv[it] = *(const GAS v4u*)(Kh + off); R.vv[it] = *(const GAS v4u*)(Vh + off); } }
    const int fr = (F.tid & 63) & 15, fq = (F.tid & 63) >> 4, tq = (u.blk * 128 + 16 * F.wave + fr) * u.dl + u.r;
    R.q0 = *(const GAS bf16x8*)(Qh + (size_t)tq * 64 + 8 * fq); R.q1 = *(const GAS bf16x8*)(Qh + (size_t)tq * 64 + 32 + 8 * fq);
}
__device__ __forceinline__ void attn_stage(Frame& F, const AttnIn& R) {
    LAS bf16* KS = (LAS bf16*)(F.lds + ATT_K_OFF); LAS bf16* VS = (LAS bf16*)(F.lds + ATT_V_OFF);
#pragma unroll
    for (int it = 0; it < 4; ++it) { const int idx = F.tid + it * 512, j = idx >> 3, ch = idx & 7;
        *(LAS v4u*)(KS + swz(j, 8 * ch)) = R.kv[it]; *(LAS v4u*)(VS + swzv(j, 8 * ch)) = R.vv[it]; }
}
__device__ __forceinline__ void attn_compute(Frame& F, const AttnUnit& u, const bf16x8 q0, const bf16x8 q1) {
    const LAS bf16* KS = (const LAS bf16*)(F.lds + ATT_K_OFF); const LAS bf16* VS = (const LAS bf16*)(F.lds + ATT_V_OFF);
    const int w = F.wave, lane = F.tid & 63, fr = lane & 15, fq = lane >> 4, blk = u.blk;
    const int tq = (blk * 128 + 16 * w + fr) * u.dl + u.r;
    const int ko0 = swz(fr, 8 * fq), ko1 = swz(fr, 32 + 8 * fq);
    f32x4 s[9];
#pragma unroll
    for (int t = 0; t < 9; ++t) { const LAS bf16* kp = KS + 16 * (w + t) * 64;
        f32x4 z = (f32x4){0.f, 0.f, 0.f, 0.f};
        z = __builtin_amdgcn_mfma_f32_16x16x32_bf16(*(const LAS bf16x8*)(kp + ko0), q0, z, 0, 0, 0);
        s[t] = __builtin_amdgcn_mfma_f32_16x16x32_bf16(*(const LAS bf16x8*)(kp + ko1), q1, z, 0, 0, 0); }
    float mx = -INFINITY;
#pragma unroll
    for (int t = 0; t < 9; ++t)
#pragma unroll
        for (int i = 0; i < 4; ++i) { const int kk = 16 * t + 4 * fq + i;
            const bool valid = (kk >= fr) && (kk <= 128 + fr) && (blk > 0 || 16 * (w + t) + 4 * fq + i >= 128);
            s[t][i] = valid ? s[t][i] : -INFINITY; mx = fmaxf(mx, s[t][i]); }
    mx = fmaxf(mx, __shfl_xor(mx, 16)); mx = fmaxf(mx, __shfl_xor(mx, 32));
    float lsum = 0.f;
#pragma unroll
    for (int t = 0; t < 9; ++t)
#pragma unroll
        for (int i = 0; i < 4; ++i) { s[t][i] = __builtin_amdgcn_exp2f(s[t][i] - mx); lsum += s[t][i]; }
    lsum += __shfl_xor(lsum, 16); lsum += __shfl_xor(lsum, 32);
    f32x4 o[4];
#pragma unroll
    for (int c = 0; c < 4; ++c) o[c] = (f32x4){0.f, 0.f, 0.f, 0.f};
    const int tq_ = (lane >> 2) & 3, tp = lane & 3;
#pragma unroll
    for (int pp = 0; pp < 5; ++pp) {
        v4u pw; pw.x = pg8::cvt_pk_bf16(s[2 * pp][0], s[2 * pp][1]); pw.y = pg8::cvt_pk_bf16(s[2 * pp][2], s[2 * pp][3]);
        if (pp < 4) { pw.z = pg8::cvt_pk_bf16(s[2 * pp + 1][0], s[2 * pp + 1][1]); pw.w = pg8::cvt_pk_bf16(s[2 * pp + 1][2], s[2 * pp + 1][3]); } else { pw.z = 0u; pw.w = 0u; }
        const bf16x8 pb = __builtin_bit_cast(bf16x8, pw);
        const int ka = 16 * (w + 2 * pp) + 4 * fq + tq_, kb = (pp < 4) ? ka + 16 : ka;
#pragma unroll
        for (int c = 0; c < 4; ++c) {
            const s16x4v lo = __builtin_bit_cast(s16x4v, __builtin_amdgcn_ds_read_tr16_b64_v4i16((LAS s16x4v*)(VS + swzv(ka, 16 * c + 4 * tp))));
            const s16x4v hi = __builtin_bit_cast(s16x4v, __builtin_amdgcn_ds_read_tr16_b64_v4i16((LAS s16x4v*)(VS + swzv(kb, 16 * c + 4 * tp))));
            const bf16x8 va = (bf16x8){lo[0], lo[1], lo[2], lo[3], hi[0], hi[1], hi[2], hi[3]};
            o[c] = __builtin_amdgcn_mfma_f32_16x16x32_bf16(va, pb, o[c], 0, 0, 0); }
    }
    const float inv = 1.0f / lsum;
    const int b = u.bh / NH, h = u.bh % NH; const size_t mq = (size_t)b * SEQ + tq;
    bf16* op = ((bf16*)(F.ws + WS_OG)) + (size_t)u.g * M * DATT + mq * DATT + h * 64 + 4 * fq;
#pragma unroll
    for (int c = 0; c < 4; ++c) { pg8::u32x2 wv; wv.x = pg8::cvt_pk_bf16(o[c][0] * inv, o[c][1] * inv); wv.y = pg8::cvt_pk_bf16(o[c][2] * inv, o[c][3] * inv); *(GAS pg8::u32x2*)(op + 16 * c) = wv; }
    if (fq == 0) ((float*)(F.ws + WS_LSE))[((size_t)u.g * M + mq) * NH + h] = mx + __builtin_amdgcn_logf(lsum);
}
__device__ __forceinline__ void attn_loop(Frame& F, gu32* ctr) {
    volatile LAS int* slot = (volatile LAS int*)(F.lds + MISC_OFF + 64);
    const int seq = F.seq;
    if (F.tid == 0) *slot = (int)__hip_atomic_fetch_add(ctr, 1u, __ATOMIC_RELAXED, __HIP_MEMORY_SCOPE_AGENT);
    __syncthreads();
    int cur = *slot;
    AttnIn R;
    if (cur < ATT_SEQ_UNITS) attn_fetch(F, attn_decode(cur, seq), R);
    while (cur < ATT_SEQ_UNITS) {
        const AttnUnit u = attn_decode(cur, seq);
        __syncthreads();
        if (F.tid == 0) *slot = (int)__hip_atomic_fetch_add(ctr, 1u, __ATOMIC_RELAXED, __HIP_MEMORY_SCOPE_AGENT);
        attn_stage(F, R);
        const bf16x8 q0 = R.q0, q1 = R.q1;
        __syncthreads();
        const int nxt = *slot;
        if (nxt < ATT_SEQ_UNITS) attn_fetch(F, attn_decode(nxt, seq), R);
        attn_compute(F, u, q0, q1);
        cur = nxt;
    }
}

constexpr int CH = 64, NCHUNK = SEQ / CH, SCAN_UNITS = BATCH * NH * NCHUNK;
constexpr int MB = 64 * MP * 2;
constexpr int LP = 68;
constexpr int S1_KT = 0, S1_BT = MB, S1_KK = 2 * MB, S1_RT = 3 * MB, S1_KTT = 4 * MB, S1_BTT = 5 * MB, S1_KKT = 6 * MB, S1_VT = 7 * MB, S1_AAK = 8 * MB, S1_ARB = 9 * MB, S1_ARK = 10 * MB;
constexpr int S1_P = 11 * MB, S1_PT = 12 * MB, S1_TM = 13 * MB, S1_GC = 14 * MB, S1_WT = S1_P  , S1_END = S1_GC + 256;
constexpr int S1_AKVT = S1_KT, S1_WTT = S1_KK, S1_UT = S1_AAK;
static_assert(S1_END <= RING_BYTES, "S1 LDS");
constexpr size_t WS_XS = WS_H + 50 * MiB;
constexpr size_t WS_MC = WS_H, WS_RK = WS_H + 48 * MiB, WS_NCT = WS_Y, WS_YL = WS_END, WS_QE = WS_YL + 48 * MiB, WS_VV = WS_QE + 24 * MiB, WS_GG = WS_VV + 24 * MiB, WS_H0T = WS_GG + 24 * MiB, WS_END2 = WS_H0T + 24 * MiB;
static_assert((size_t)SCAN_UNITS * 64 * 64 * 4 <= 48 * MiB && (size_t)SCAN_UNITS * 64 * 64 * 2 <= 24 * MiB && WS_RK + (size_t)BATCH * NH * SEQ * 4 <= WS_HID, "scan scratch map");

__device__ __forceinline__ f32x4 mm_tile(const LAS bf16* X, const LAS bf16* Y, int tn, int tm, int fr, int fq, f32x4 acc) {
    const int o0 = swz(fr, 8 * fq), o1 = swz(fr, 32 + 8 * fq);
    const LAS bf16* ap = Y + 16 * tm * MP; const LAS bf16* bp = X + 16 * tn * MP;
    acc = __builtin_amdgcn_mfma_f32_16x16x32_bf16(*(const LAS bf16x8*)(ap + o0), *(const LAS bf16x8*)(bp + o0), acc, 0, 0, 0);
    acc = __builtin_amdgcn_mfma_f32_16x16x32_bf16(*(const LAS bf16x8*)(ap + o1), *(const LAS bf16x8*)(bp + o1), acc, 0, 0, 0);
    return acc;
}
__device__ __forceinline__ void st_tile_bf16(LAS bf16* Z, int tn, int tm, int fr, int fq, f32x4 v) {
    pg8::u32x2 w; w.x = pg8::cvt_pk_bf16(v[0], v[1]); w.y = pg8::cvt_pk_bf16(v[2], v[3]); *(LAS pg8::u32x2*)(Z + swz(16 * tn + fr, 16 * tm + 4 * fq)) = w;
}
constexpr f32x4 F4Z = {0.f, 0.f, 0.f, 0.f};

__device__ __forceinline__ void wave_sum8(float (&v)[8]) {
#pragma unroll
    for (int i = 0; i < 8; ++i) {
        v[i] += __builtin_bit_cast(float, __builtin_amdgcn_update_dpp(0, __builtin_bit_cast(int, v[i]), 0xB1, 0xF, 0xF, true));
        v[i] += __builtin_bit_cast(float, __builtin_amdgcn_update_dpp(0, __builtin_bit_cast(int, v[i]), 0x4E, 0xF, 0xF, true));
        v[i] += __builtin_bit_cast(float, __builtin_amdgcn_update_dpp(0, __builtin_bit_cast(int, v[i]), 0x141, 0xF, 0xF, true));
        v[i] += __builtin_bit_cast(float, __builtin_amdgcn_update_dpp(0, __builtin_bit_cast(int, v[i]), 0x140, 0xF, 0xF, true)); }
    float t[8];
#pragma unroll
    for (int i = 0; i < 8; ++i) t[i] = __shfl_xor(v[i], 16);
#pragma unroll
    for (int i = 0; i < 8; ++i) v[i] += t[i];
#pragma unroll
    for (int i = 0; i < 8; ++i) t[i] = __shfl_xor(v[i], 32);
#pragma unroll
    for (int i = 0; i < 8; ++i) v[i] += t[i];
}
struct S1Raw { unsigned zr[9], zk[9], zv[9], dw[8], da[8], gg[8]; float mu_r, mu_k, mu_v, w0, a0, k_k, k_a, r_k; };
__device__ __forceinline__ void s1_fetch(Frame& F, KArgs* A, int l, int unit, S1Raw& R) {
    const int hb = unit / NCHUNK, c = unit % NCHUNK, b = hb / NH, h = hb % NH, lane = F.tid & 63, hc = h * 64 + lane;
    const int s0 = c * CH + 8 * F.wave; const size_t m0 = (size_t)b * SEQ + s0;
    const GAS bf16* zr = (const GAS bf16*)(((const bf16*)(F.ws + WS_HID + (size_t)b * SQ_STRIDE + SQ_ZR)) + (size_t)s0 * ZRP); const GAS bf16* Lr = (const GAS bf16*)(((const bf16*)(F.ws + WS_LB)) + m0 * LORA_N);
#pragma unroll
    for (int q = 0; q < 9; ++q) { if (q == 0 && s0 == 0) { R.zr[0] = 0u; R.zk[0] = 0u; R.zv[0] = 0u; } else { const GAS bf16* zp = zr + (q - 1) * ZRP; R.zr[q] = zp[hc]; R.zk[q] = zp[768 + hc]; R.zv[q] = zp[1536 + hc]; } }
#pragma unroll
    for (int q = 0; q < 8; ++q) { R.dw[q] = Lr[q * LORA_N + hc]; R.da[q] = Lr[q * LORA_N + 768 + hc]; R.gg[q] = Lr[q * LORA_N + 1536 + hc]; }
    const float* mu = INP(A, 10) + (size_t)l * DRWIN; const size_t lo = (size_t)l * DRW + hc;
    R.mu_r = mu[hc]; R.mu_k = mu[768 + hc]; R.mu_v = mu[1536 + hc];
    R.w0 = INP(A, 12)[lo]; R.a0 = INP(A, 14)[lo]; R.k_k = INP(A, 16)[lo]; R.k_a = INP(A, 17)[lo]; R.r_k = INP(A, 18)[lo];
}
__device__ __forceinline__ int tslot(int tn, int tm, int lane) { return (tn * 4 + tm) * 64 + lane; }

template <int PMODE  > __device__ __forceinline__ void scan_s1_phase(Frame& F, KArgs* A, int l) {
    const int lane = F.tid & 63, w = F.wave;
    const int fr = lane & 15, fq = lane >> 4, tn = w & 3, tm0 = 2 * (w >> 2);
    LAS bf16* KT = (LAS bf16*)(F.lds + S1_KT); LAS bf16* BT = (LAS bf16*)(F.lds + S1_BT); LAS bf16* KK = (LAS bf16*)(F.lds + S1_KK); LAS bf16* RT = (LAS bf16*)(F.lds + S1_RT);
    LAS bf16* KTT = (LAS bf16*)(F.lds + S1_KTT); LAS bf16* BTT = (LAS bf16*)(F.lds + S1_BTT); LAS bf16* KKT = (LAS bf16*)(F.lds + S1_KKT); LAS bf16* VT = (LAS bf16*)(F.lds + S1_VT);
    LAS bf16* AAK = (LAS bf16*)(F.lds + S1_AAK); LAS bf16* ARB = (LAS bf16*)(F.lds + S1_ARB); LAS bf16* ARK = (LAS bf16*)(F.lds + S1_ARK);
    LAS bf16* AKVT = (LAS bf16*)(F.lds + S1_AKVT); LAS bf16* TM = (LAS bf16*)(F.lds + S1_TM); LAS bf16* WTT = (LAS bf16*)(F.lds + S1_WTT); LAS bf16* UT = (LAS bf16*)(F.lds + S1_UT);
    LAS bf16* PM = (LAS bf16*)(F.lds + S1_P); LAS bf16* PT = (LAS bf16*)(F.lds + S1_PT);
    LAS float* GC = (LAS float*)(F.lds + S1_GC); LAS float* WTOT = (LAS float*)(F.lds + S1_WT);
    constexpr int SU = NH * NCHUNK;
    const int per = (SU + F.nb - 1) / F.nb, l0 = F.bi * per, l1 = (l0 + per < SU) ? l0 + per : SU, u0 = F.seq * SU + l0, u1 = F.seq * SU + l1;
    if (u0 >= u1) return;
    S1Raw R; s1_fetch(F, A, l, u0, R);
    for (int unit = u0; unit < u1; ++unit) {
    const int hb = unit / NCHUNK, c = unit % NCHUNK;
    {
        const int s0 = c * CH + 8 * w;
        float rr[8], kap[8], kp[8], aa[8], vv[8], lw[8], cl[8], kk0[8], red[8];
#pragma unroll
        for (int q = 0; q < 8; ++q) {
            const float zr1 = __uint_as_float(R.zr[q + 1] << 16), zr0 = __uint_as_float(R.zr[q] << 16), zk1 = __uint_as_float(R.zk[q + 1] << 16), zk0 = __uint_as_float(R.zk[q] << 16), zv1 = __uint_as_float(R.zv[q + 1] << 16), zv0 = __uint_as_float(R.zv[q] << 16);
            rr[q] = zr1 + (zr0 - zr1) * R.mu_r; kk0[q] = zk1 + (zk0 - zk1) * R.mu_k; vv[q] = zv1 + (zv0 - zv1) * R.mu_v;
            lw[q] = -0.6065306597126334f * 1.4426950408889634f * sigmoid_f(R.w0 + __uint_as_float(R.dw[q] << 16));
            aa[q] = sigmoid_f(R.a0 + __uint_as_float(R.da[q] << 16));
            kp[q] = kk0[q] * (1.0f + (aa[q] - 1.0f) * R.k_a);
            const float kkn = kk0[q] * R.k_k; red[q] = kkn * kkn;
        }
        wave_sum8(red);
        float run = 0.f;
#pragma unroll
        for (int q = 0; q < 8; ++q) { kap[q] = kk0[q] * R.k_k * __builtin_amdgcn_rsqf(fmaxf(red[q], 1e-24f)); red[q] = rr[q] * kp[q] * R.r_k; run += lw[q]; cl[q] = run; }
        wave_sum8(red);
#pragma unroll
        for (int q = 0; q < 8; ++q) {
            const size_t tok = (size_t)hb * SEQ + s0 + q;
            ((bf16*)(F.ws + WS_VV))[tok * 64 + lane] = (bf16)(pg8::cvt_pk_bf16(vv[q], vv[q]) & 0xffffu); ((bf16*)(F.ws + WS_GG))[tok * 64 + lane] = (bf16)R.gg[q];
            if (lane == 0) ((float*)(F.ws + WS_RK))[tok] = red[q];
        }
        if (unit + 1 < u1) s1_fetch(F, A, l, unit + 1, R);
        WTOT[w * 64 + lane] = run;
        __syncthreads();
        float off = 0.f;
#pragma unroll
        for (int w2 = 0; w2 < 7; ++w2) off += (w2 < w) ? WTOT[w2 * 64 + lane] : 0.f;
        if (w == 7) GC[lane] = __builtin_amdgcn_exp2f(off + run);
        float fkt[8], fbt[8], fkk[8], frt[8];
#pragma unroll
        for (int q = 0; q < 8; ++q) {
            const float ct = off + cl[q], ctm1 = ct - lw[q];
            const float gp = __builtin_amdgcn_exp2f(ct), gm = __builtin_amdgcn_exp2f(ctm1), gi = __builtin_amdgcn_exp2f(-ct);
            fkt[q] = kap[q] * gm; fbt[q] = kap[q] * aa[q] * gi; fkk[q] = kp[q] * gi; frt[q] = rr[q] * gp;
        }
        v4u pkt, pbt, pkk, pvt, prt;
#pragma unroll
        for (int i = 0; i < 4; ++i) { pkt[i] = pg8::cvt_pk_bf16(fkt[2 * i], fkt[2 * i + 1]); pbt[i] = pg8::cvt_pk_bf16(fbt[2 * i], fbt[2 * i + 1]); pkk[i] = pg8::cvt_pk_bf16(fkk[2 * i], fkk[2 * i + 1]);
            prt[i] = pg8::cvt_pk_bf16(frt[2 * i], frt[2 * i + 1]); pvt[i] = pg8::cvt_pk_bf16(vv[2 * i], vv[2 * i + 1]); }
#pragma unroll
        for (int q = 0; q < 8; ++q) { const int o = swz(8 * w + q, lane), sh = 16 * (q & 1);
            KT[o] = (bf16)(pkt[q >> 1] >> sh); BT[o] = (bf16)(pbt[q >> 1] >> sh); KK[o] = (bf16)(pkk[q >> 1] >> sh); RT[o] = (bf16)(prt[q >> 1] >> sh); }
        { const int o = swz(lane, 8 * w); *(LAS v4u*)(KTT + o) = pkt; *(LAS v4u*)(BTT + o) = pbt; *(LAS v4u*)(KKT + o) = pkk; *(LAS v4u*)(VT + o) = pvt; }
    }
    __syncthreads();
    if (PMODE == 1) continue;
    f32x4 Treg[2];
#pragma unroll
    for (int d = 0; d < 2; ++d) { const int tm = tm0 + d; const int t = 16 * tn + fr, sb = 16 * tm + 4 * fq;
        const f32x4 aL = mm_tile(KT, BT, tn, tm, fr, fq, F4Z), aLt = mm_tile(BT, KT, tn, tm, fr, fq, F4Z);
        f32x4 aK = mm_tile(KT, KK, tn, tm, fr, fq, F4Z), aRB = mm_tile(RT, BT, tn, tm, fr, fq, F4Z), aRK = mm_tile(RT, KK, tn, tm, fr, fq, F4Z);
        f32x4 pl, plt;
#pragma unroll
        for (int e = 0; e < 4; ++e) { const bool st = (sb + e) < t, inc = (sb + e) <= t;
            pl[e] = st ? -aL[e] : 0.f; plt[e] = (t < sb + e) ? -aLt[e] : 0.f; Treg[d][e] = ((sb + e) == t ? 1.0f : 0.0f) + pl[e];
            aK[e] = st ? aK[e] : 0.f; aRB[e] = inc ? aRB[e] : 0.f; aRK[e] = inc ? aRK[e] : 0.f; }
        st_tile_bf16(PM, tn, tm, fr, fq, pl); st_tile_bf16(PT, tn, tm, fr, fq, plt); st_tile_bf16(TM, tn, tm, fr, fq, Treg[d]);
        st_tile_bf16(AAK, tn, tm, fr, fq, aK); st_tile_bf16(ARB, tn, tm, fr, fq, aRB); st_tile_bf16(ARK, tn, tm, fr, fq, aRK); }
    __syncthreads();
    {
        f32x4 p2[2], p2t[2];
#pragma unroll
        for (int d = 0; d < 2; ++d) { p2[d] = mm_tile(PM, PT, tn, tm0 + d, fr, fq, F4Z); p2t[d] = mm_tile(PT, PM, tn, tm0 + d, fr, fq, F4Z);
            st_tile_bf16(AKVT, tn, tm0 + d, fr, fq, mm_tile(VT, AAK, tn, tm0 + d, fr, fq, F4Z)); }
        __syncthreads();
#pragma unroll
        for (int d = 0; d < 2; ++d) { st_tile_bf16(PM, tn, tm0 + d, fr, fq, p2[d]); st_tile_bf16(PT, tn, tm0 + d, fr, fq, p2t[d]); }
        __syncthreads();
#pragma unroll
        for (int it = 1; it <= 5; ++it) {
#pragma unroll
            for (int d = 0; d < 2; ++d) { Treg[d] = mm_tile(TM, PT, tn, tm0 + d, fr, fq, Treg[d]);
                if (it < 5) { p2[d] = mm_tile(PM, PT, tn, tm0 + d, fr, fq, F4Z); p2t[d] = mm_tile(PT, PM, tn, tm0 + d, fr, fq, F4Z); } }
            __syncthreads();
#pragma unroll
            for (int d = 0; d < 2; ++d) { st_tile_bf16(TM, tn, tm0 + d, fr, fq, Treg[d]);
                if (it < 5) { st_tile_bf16(PM, tn, tm0 + d, fr, fq, p2[d]); st_tile_bf16(PT, tn, tm0 + d, fr, fq, p2t[d]); } }
            __syncthreads();
        }
    }
    if (PMODE == 2) { __syncthreads(); continue; }
    {
        f32x4 aw[2], au[2];
#pragma unroll
        for (int d = 0; d < 2; ++d) { aw[d] = mm_tile(KTT, TM, tn, tm0 + d, fr, fq, F4Z); au[d] = mm_tile(AKVT, TM, tn, tm0 + d, fr, fq, F4Z); }
#pragma unroll
        for (int d = 0; d < 2; ++d) { st_tile_bf16(WTT, tn, tm0 + d, fr, fq, aw[d]); st_tile_bf16(UT, tn, tm0 + d, fr, fq, au[d]); }
    }
    __syncthreads();
    {
        const size_t ub = (size_t)unit * 64 * 64;
        GAS f32x4* MC = (GAS f32x4*)((float*)(F.ws + WS_MC) + ub); GAS pg8::u32x2* NCT = (GAS pg8::u32x2*)((bf16*)(F.ws + WS_NCT) + ub);
        GAS pg8::u32x2* YL = (GAS pg8::u32x2*)((bf16*)(F.ws + WS_YL) + ub); GAS pg8::u32x2* QE = (GAS pg8::u32x2*)((bf16*)(F.ws + WS_QE) + ub);
#pragma unroll
        for (int d = 0; d < 2; ++d) { const int tm = tm0 + d, i = 16 * tn + fr, j = 16 * tm + 4 * fq, ts = tslot(tn, tm, lane);
            { const f32x4 a = mm_tile(ARB, WTT, tn, tm, fr, fq, F4Z); const pg8::u32x2 rv = *(const LAS pg8::u32x2*)(RT + swz(i, j));
              const float r0 = __uint_as_float(rv.x << 16), r1 = __uint_as_float(rv.x & 0xffff0000u), r2 = __uint_as_float(rv.y << 16), r3 = __uint_as_float(rv.y & 0xffff0000u);
              pg8::u32x2 o; o.x = pg8::cvt_pk_bf16(r0 - a[0], r1 - a[1]); o.y = pg8::cvt_pk_bf16(r2 - a[2], r3 - a[3]); if (PMODE != 3) QE[ts] = o; else asm volatile("" :: "v"(o.x), "v"(o.y)); }
            { const f32x4 a = mm_tile(ARK, VT, tn, tm, fr, fq, F4Z), a2 = mm_tile(ARB, UT, tn, tm, fr, fq, F4Z);
              pg8::u32x2 o; o.x = pg8::cvt_pk_bf16(a[0] - a2[0], a[1] - a2[1]); o.y = pg8::cvt_pk_bf16(a[2] - a2[2], a[3] - a2[3]); if (PMODE != 3) YL[ts] = o; else asm volatile("" :: "v"(o.x), "v"(o.y)); }
            { const f32x4 a = mm_tile(BTT, WTT, tn, tm, fr, fq, F4Z); const float gc = GC[i]; f32x4 o;
#pragma unroll
              for (int e = 0; e < 4; ++e) o[e] = gc * (((j + e) == i ? 1.0f : 0.0f) - a[e]);
              if (PMODE != 3) MC[ts] = o; else asm volatile("" :: "v"(o[0]), "v"(o[1]), "v"(o[2]), "v"(o[3])); }
            { const f32x4 a = mm_tile(VT, KKT, tn, tm, fr, fq, F4Z), a2 = mm_tile(UT, BTT, tn, tm, fr, fq, F4Z); const f32x4 gc = *(const LAS f32x4*)(GC + j);
              pg8::u32x2 o; o.x = pg8::cvt_pk_bf16((a[0] - a2[0]) * gc[0], (a[1] - a2[1]) * gc[1]); o.y = pg8::cvt_pk_bf16((a[2] - a2[2]) * gc[2], (a[3] - a2[3]) * gc[3]);
              if (PMODE != 3) NCT[ts] = o; else asm volatile("" :: "v"(o.x), "v"(o.y)); }
        }
    }
    __syncthreads();
    }
}

__device__ __forceinline__ void scan_s2_head(Frame& F, int hb) {
    if (F.wave >= 4) return;
    const int lane = F.tid & 63, fr = lane & 15, fq = lane >> 4, w = F.wave;
    f32x4 Hs[4];
#pragma unroll
    for (int t = 0; t < 4; ++t) Hs[t] = F4Z;
    for (int c = 0; c < NCHUNK; ++c) {
        const size_t ub = ((size_t)hb * NCHUNK + c) * 64 * 64;
        const float* MC = (const float*)(F.ws + WS_MC) + ub; const bf16* NCT = (const bf16*)(F.ws + WS_NCT) + ub; bf16* H0T = (bf16*)(F.ws + WS_H0T) + ub;
        f32x4 mc[4][4], nn[4];
#pragma unroll
        for (int to = 0; to < 4; ++to) { const pg8::u32x2 nv = ((const GAS pg8::u32x2*)NCT)[tslot(w, to, lane)];
            nn[to] = (f32x4){__uint_as_float(nv.x << 16), __uint_as_float(nv.x & 0xffff0000u), __uint_as_float(nv.y << 16), __uint_as_float(nv.y & 0xffff0000u)};
#pragma unroll
            for (int t = 0; t < 4; ++t) mc[to][t] = ((const GAS f32x4*)MC)[tslot(to, t, lane)]; }
#pragma unroll
        for (int t = 0; t < 4; ++t) { pg8::u32x2 o; o.x = pg8::cvt_pk_bf16(Hs[t][0], Hs[t][1]); o.y = pg8::cvt_pk_bf16(Hs[t][2], Hs[t][3]); ((GAS pg8::u32x2*)H0T)[tslot(w, t, lane)] = o; }
        if (c + 1 == NCHUNK) break;
#pragma unroll
        for (int to = 0; to < 4; ++to)
#pragma unroll
            for (int t = 0; t < 4; ++t)
#pragma unroll
                for (int i = 0; i < 4; ++i) nn[to] = __builtin_amdgcn_mfma_f32_16x16x4f32(mc[to][t][i], Hs[t][i], nn[to], 0, 0, 0);
#pragma unroll
        for (int t = 0; t < 4; ++t) Hs[t] = nn[t];
    }
}

__device__ __forceinline__ void scan_s3_pair(Frame& F, KArgs* A, int l, int pair) {
    const int lane = F.tid & 63, fr = lane & 15, fq = lane >> 4, w = F.wave, unit = 2 * pair + (w >> 2), tn = w & 3;
    const int hb = unit / NCHUNK, c = unit % NCHUNK, b = hb / NH, h = hb % NH;
    const size_t ub = (size_t)unit * 64 * 64;
    const GAS pg8::u32x2* QE = (const GAS pg8::u32x2*)((const bf16*)(F.ws + WS_QE) + ub); const GAS pg8::u32x2* H0T = (const GAS pg8::u32x2*)((const bf16*)(F.ws + WS_H0T) + ub);
    const GAS pg8::u32x2* YL = (const GAS pg8::u32x2*)((const bf16*)(F.ws + WS_YL) + ub);
    const int t = 16 * tn + fr; const size_t tok = (size_t)hb * SEQ + c * CH + t;
    const bf16* vp = (const bf16*)(F.ws + WS_VV) + tok * 64; const bf16* gp = (const bf16*)(F.ws + WS_GG) + tok * 64;
    const float* gnw = INP(A, 19) + (size_t)l * DRW + h * 64; const float* gnb = INP(A, 20) + (size_t)l * DRW + h * 64;
    pg8::u32x2 qv[4], hv[4][4], yv[4], vv[4], gg[4]; f32x4 gw[4], gb[4];
#pragma unroll
    for (int i = 0; i < 4; ++i) { qv[i] = QE[tslot(tn, i, lane)]; yv[i] = YL[tslot(tn, i, lane)]; const int v0 = 16 * i + 4 * fq;
        vv[i] = *(const GAS pg8::u32x2*)(vp + v0); gg[i] = *(const GAS pg8::u32x2*)(gp + v0); gw[i] = *(const GAS f32x4*)(gnw + v0); gb[i] = *(const GAS f32x4*)(gnb + v0);
#pragma unroll
        for (int k = 0; k < 4; ++k) hv[i][k] = H0T[tslot(i, k, lane)]; }
    const float rk = ((const float*)(F.ws + WS_RK))[tok];
    bf16x8 qb[2];
#pragma unroll
    for (int p = 0; p < 2; ++p) qb[p] = __builtin_bit_cast(bf16x8, (v4u){qv[2 * p].x, qv[2 * p].y, qv[2 * p + 1].x, qv[2 * p + 1].y});
    f32x4 y[4]; float s1 = 0.f;
#pragma unroll
    for (int tm = 0; tm < 4; ++tm) {
        f32x4 acc = (f32x4){__uint_as_float(yv[tm].x << 16), __uint_as_float(yv[tm].x & 0xffff0000u), __uint_as_float(yv[tm].y << 16), __uint_as_float(yv[tm].y & 0xffff0000u)};
#pragma unroll
        for (int p = 0; p < 2; ++p) acc = __builtin_amdgcn_mfma_f32_16x16x32_bf16(__builtin_bit_cast(bf16x8, (v4u){hv[tm][2 * p].x, hv[tm][2 * p].y, hv[tm][2 * p + 1].x, hv[tm][2 * p + 1].y}), qb[p], acc, 0, 0, 0);
        y[tm] = acc; s1 += (acc[0] + acc[1]) + (acc[2] + acc[3]); }
    s1 += __shfl_xor(s1, 16); s1 += __shfl_xor(s1, 32);
    const float mean = s1 * (1.f / 64.f); float s2 = 0.f;
#pragma unroll
    for (int tm = 0; tm < 4; ++tm)
#pragma unroll
        for (int e = 0; e < 4; ++e) { const float d = y[tm][e] - mean; s2 += d * d; }
    s2 += __shfl_xor(s2, 16); s2 += __shfl_xor(s2, 32);
    const float rstd = __builtin_amdgcn_rsqf(s2 * (1.f / 64.f) + GN_EPS);
    bf16* out = (bf16*)(F.ws + WS_CAT) + ((size_t)b * SEQ + c * CH + t) * D + DATT + h * 64;
#pragma unroll
    for (int tm = 0; tm < 4; ++tm) { const int v0 = 16 * tm + 4 * fq;
        const float vf[4] = {__uint_as_float(vv[tm].x << 16), __uint_as_float(vv[tm].x & 0xffff0000u), __uint_as_float(vv[tm].y << 16), __uint_as_float(vv[tm].y & 0xffff0000u)};
        const float gf[4] = {__uint_as_float(gg[tm].x << 16), __uint_as_float(gg[tm].x & 0xffff0000u), __uint_as_float(gg[tm].y << 16), __uint_as_float(gg[tm].y & 0xffff0000u)};
        float o[4];
#pragma unroll
        for (int e = 0; e < 4; ++e) o[e] = ((y[tm][e] - mean) * rstd * gw[tm][e] + gb[tm][e] + rk * vf[e]) * gf[e];
        pg8::u32x2 ow; ow.x = pg8::cvt_pk_bf16(o[0], o[1]); ow.y = pg8::cvt_pk_bf16(o[2], o[3]); *(GAS pg8::u32x2*)(out + v0) = ow; }
}

__device__ __forceinline__ void grp_barrier(unsigned* cnt, unsigned nb, unsigned* tmo) {
    asm volatile("s_waitcnt vmcnt(0)" ::: "memory");
    __syncthreads();
    if (threadIdx.x == 0) {
        const unsigned old = __hip_atomic_fetch_add(cnt, 1u, __ATOMIC_RELAXED, __HIP_MEMORY_SCOPE_AGENT), target = (old / nb + 1u) * nb; unsigned sp = 0;
        while (__hip_atomic_load(cnt, __ATOMIC_RELAXED, __HIP_MEMORY_SCOPE_AGENT) < target) { __builtin_amdgcn_s_sleep(1); if (++sp > (1u << 22)) { __hip_atomic_store(tmo, 1u, __ATOMIC_RELAXED, __HIP_MEMORY_SCOPE_AGENT); break; } }
        __builtin_amdgcn_fence(__ATOMIC_ACQUIRE, "agent");
        asm volatile("s_waitcnt vmcnt(0)" ::: "memory");
    }
    __syncthreads();
}
__global__ void __launch_bounds__(NWAVES * 64, 2) fwd_kernel(Args args) {
    extern __shared__ __attribute__((aligned(16))) unsigned char lds[];
    Frame F;
    F.lds = (LAS unsigned char*)lds;
    F.wave = __builtin_amdgcn_readfirstlane(threadIdx.x >> 6); F.tid = threadIdx.x;
    F.G = gridDim.x; { const int bx = blockIdx.x; F.vcu = (F.G % 8 == 0) ? (bx % 8) * (F.G / 8) + bx / 8 : bx; }
    F.bi = 0; F.nb = 1; F.seq = 0;
    unsigned char* ws = args.ws; F.ws = ws;
    F.X = args.out;
    for (int u = threadIdx.x; u < (LDS_BYTES - LDSCTL_OFF) / 4; u += NWAVES * 64) ((LAS unsigned*)(F.lds + LDSCTL_OFF))[u] = 0u;
    __syncthreads();
    volatile LAS unsigned* MISC = (volatile LAS unsigned*)(F.lds + MISC_OFF);
    XcdBarrier bar = xcd_barrier_post((unsigned*)(ws + WS_CTL) + CW_BAR, MISC + 8);
    if (threadIdx.x == 0) MISC[20] = __hip_atomic_fetch_add((unsigned*)(ws + WS_CTL) + CW_RANK + 64 * bar.x, 1u, __ATOMIC_RELAXED, __HIP_MEMORY_SCOPE_AGENT);
    KArgs* const ka0 = (KArgs*)__builtin_amdgcn_kernarg_segment_ptr();
#define PH_BEGIN { Frame F = F0; KArgs* ka = ka0; F.tid = threadIdx.x; asm volatile("" : "+v"(F.tid)); GAS unsigned char* wsg_ = (GAS unsigned char*)F0.ws; GAS float* xg_ = (GAS float*)F0.X; asm volatile("" : "+s"(wsg_), "+s"(xg_), "+s"(F.wave), "+s"(F.bi), "+s"(F.nb), "+s"(F.seq), "+s"(ka)); F.ws = (unsigned char*)wsg_; F.X = (float*)xg_; unsigned char* const ws = F.ws; (void)ws;
#define PH_END   grp_barrier(gcnt, (unsigned)F0.nb, (unsigned*)(F0.ws + WS_CTL) + CW_TMO); }

    { const Frame F0 = F; { Frame F = F0; KArgs* ka = ka0; F.tid = threadIdx.x; asm volatile("" : "+v"(F.tid)); p0_prologue(F, ka); } }
    xcd_barrier(bar);
    if (threadIdx.x == 0) { unsigned g = 0, ng = 0, nbk = 1; unsigned* bw = (unsigned*)(ws + WS_CTL) + CW_BAR;
        for (unsigned j = 0; j < 16; ++j) { const unsigned c = xb_ld(&bw[XB_XCNT(j)]); if (c) { if (j < bar.x) ++g; ++ng; } if (j == bar.x) nbk = c ? c : 1u; }
        MISC[16] = g; MISC[17] = ng ? ng : 1u; MISC[18] = nbk; }
    __syncthreads();
    const int grp = __builtin_amdgcn_readfirstlane((int)MISC[16]), ngrp = __builtin_amdgcn_readfirstlane((int)MISC[17]);
    F.nb = __builtin_amdgcn_readfirstlane((int)MISC[18]); F.bi = __builtin_amdgcn_readfirstlane((int)MISC[20]);
    unsigned* const gcnt = (unsigned*)(ws + WS_CTL) + CW_GB + 64 * bar.x;

    for (int seq = grp; seq < BATCH; seq += ngrp) {
    F.seq = seq; const Frame F0 = F;
    for (int j = 0; j < 2 * NL; ++j) {
        const int l = j >> 1; const bool second = (j & 1) != 0;
        PH_BEGIN {
            pg8::Gemm g{((bf16*)(F.ws + WS_XB)), (const bf16*)(ws + WS_W + (size_t)l * LW + (second ? LW_GU2 : LW_GU1)), M, 2 * FF, D}; pg8::GroupOrder S; S.init(2 * FF / 256, F.nb, F.bi, F.seq);
            pg8::EpiSwiglu E{((bf16*)(F.ws + WS_HID)), FF, (const float*)(F.ws + WS_RS)};
            pg8::gemm_phase<pg8::EpiSwiglu, pg8::GroupOrder, true, true>(F.lds + RING_OFF, g, S, E);
        } PH_END
        PH_BEGIN {
            const int q = 3 * l + (second ? 2 : 0); const bool lastsub = second && (l + 1 == NL);
            pg8::Gemm g{((bf16*)(F.ws + WS_HID)), (const bf16*)(ws + WS_W + (size_t)l * LW + (second ? LW_D2 : LW_D1)), M, D, FF};
            pg8::EpiRes E{((bf16*)(F.ws + WS_XB)), lastsub ? F.X : nullptr, (second ? INP(ka, 24) : INP(ka, 2)) + (size_t)l * D, 0.5f, (float*)(F.ws + WS_RS),
                          (float*)(F.ws + WS_XS + (size_t)q * MiB), (unsigned*)(ws + WS_CTL) + CW_XC + q * XC_USE, (unsigned*)(ws + WS_CTL) + CW_TMO};
            const int P = F.nb >> 3, nsl = P > 0 ? (8 + P - 1) / P : 0;
            for (int sl = 0; sl < nsl; ++sl) { pg8::PanelOrder S{sl, F.nb, F.bi, 8 * F.seq}; pg8::gemm_phase<pg8::EpiRes, pg8::PanelOrder, false, true>(F.lds + RING_OFF, g, S, E); __syncthreads(); }
        } PH_END
        if (!second) {
            PH_BEGIN {
                pg8::Gemm g{((bf16*)(F.ws + WS_XB)), (const bf16*)(ws + WS_W + (size_t)l * LW + LW_IN), M, DINP, D}; pg8::GroupOrder S; S.init(DINP / 256, F.nb, F.bi, F.seq);
                pg8::EpiWin E{F.ws + WS_HID, ((float*)(F.ws + WS_COS)), ((float*)(F.ws + WS_SIN)), QSCALE, (const float*)(F.ws + WS_RS)};
                pg8::gemm_phase<pg8::EpiWin, pg8::GroupOrder, true, true>(F.lds + RING_OFF, g, S, E);
            } PH_END
            PH_BEGIN mix_prep(F, ka, l); PH_END
            PH_BEGIN {
                { pg8::Gemm g{((bf16*)(F.ws + WS_LA)), (const bf16*)(ws + WS_W + (size_t)l * LW + LW_LORA), M, LORA_N, LORA_K}; pg8::GroupOrder S; S.init(LORA_N / 256, F.nb, F.bi, F.seq);
                  pg8::EpiBf16Plain E{((bf16*)(F.ws + WS_LB)), LORA_N};
                  pg8::gemm_phase<pg8::EpiBf16Plain, pg8::GroupOrder, true, true>(F.lds + RING_OFF, g, S, E); }
                { pg8::Gemm g{((bf16*)(F.ws + WS_PP)), (const bf16*)(ws + WS_W + (size_t)l * LW + LW_POOL), M, DPOOL, 512}; pg8::GroupOrder S; S.init(DPOOL / 256, F.nb, (F.bi + F.nb - (F.nb >> 2)) % F.nb, F.seq);
                  pg8::EpiBf16Scale E{((bf16*)(F.ws + WS_CAT)) + DATT + DRW, D, INP(ka, 22) + (size_t)l * DPOOL};
                  pg8::gemm_phase<pg8::EpiBf16Scale, pg8::GroupOrder, true, true>(F.lds + RING_OFF, g, S, E); }
            } PH_END
            PH_BEGIN scan_s1_phase<0>(F, ka, l); PH_END
            PH_BEGIN {
                for (int h = F.bi; h < NH; h += F.nb) scan_s2_head(F, F.seq * NH + h);
                attn_loop(F, (gu32*)(ws + WS_CTL) + CW_ATTQ + 64 * (l * BATCH + F.seq));
            } PH_END
            PH_BEGIN { for (int p = F.bi; p < NH * NCHUNK / 2; p += F.nb) scan_s3_pair(F, ka, l, F.seq * (NH * NCHUNK / 2) + p); attn_combine(F); } PH_END
            PH_BEGIN {
                const int q = 3 * l + 1;
                pg8::Gemm g{((bf16*)(F.ws + WS_CAT)), (const bf16*)(ws + WS_W + (size_t)l * LW + LW_OUT), M, D, D};
                pg8::EpiRes E{((bf16*)(F.ws + WS_XB)), nullptr, INP(ka, 7) + (size_t)l * D, 1.0f, (float*)(F.ws + WS_RS),
                              (float*)(F.ws + WS_XS + (size_t)q * MiB), (unsigned*)(ws + WS_CTL) + CW_XC + q * XC_USE, (unsigned*)(ws + WS_CTL) + CW_TMO};
                const int P = F.nb >> 3, nsl = P > 0 ? (8 + P - 1) / P : 0;
                for (int sl = 0; sl < nsl; ++sl) { pg8::PanelOrder S{sl, F.nb, F.bi, 8 * F.seq}; pg8::gemm_phase<pg8::EpiRes, pg8::PanelOrder, false, true>(F.lds + RING_OFF, g, S, E); __syncthreads(); }
            } PH_END
        }
    }
    }
#undef PH_BEGIN
#undef PH_END
}

extern "C" void kernel_launch(void* const* d_in, const int* in_sizes, int n_in, void* d_out, int out_size, void* d_ws, size_t ws_size, hipStream_t stream) {
    static int grid = 0;
    if (grid == 0) {
        if (n_in != 28 || in_sizes[0] != M * D || out_size != M * D || ws_size < WS_END2) { fprintf(stderr, "kernel_launch: unexpected problem (n_in %d, in0 %d, out %d, ws %zu < %zu); nothing launched\n", n_in, n_in > 0 ? in_sizes[0] : -1, out_size, ws_size, (size_t)WS_END2); grid = -1; return; }
        int dev = 0, cus = 0, per_cu = 0;
        if (hipGetDevice(&dev) != hipSuccess || hipDeviceGetAttribute(&cus, hipDeviceAttributeMultiprocessorCount, dev) != hipSuccess) { grid = -1; return; }
        if (hipFuncSetAttribute((const void*)fwd_kernel, hipFuncAttributeMaxDynamicSharedMemorySize, LDS_BYTES) != hipSuccess) { fprintf(stderr, "kernel_launch: hipFuncSetAttribute failed\n"); grid = -1; return; }
        if (hipOccupancyMaxActiveBlocksPerMultiprocessor(&per_cu, (const void*)fwd_kernel, NWAVES * 64, LDS_BYTES) != hipSuccess || per_cu < 1)
            fprintf(stderr, "kernel_launch: note: occupancy query reports %d workgroups per CU\n", per_cu);
        (void)hipGetLastError();
        grid = cus;
    }
    if (grid < 0) return;
    if (hipMemsetAsync((char*)d_ws + WS_CTL, 0, CTL_ZERO_BYTES, stream) != hipSuccess) return;
    Args a{};
    for (int i = 0; i < 28; ++i) a.in[i] = (const float*)d_in[i];
    a.out = (float*)d_out; a.ws = (unsigned char*)d_ws; a.ph_lo = 0; a.ph_hi = 0;
    hipLaunchKernelGGL(fwd_kernel, dim3(grid), dim3(NWAVES * 64), LDS_BYTES, stream, a);
}
```

```cpp
#include <hip/hip_runtime.h>
#include <cstdio>
#include <cstdint>
#include <cmath>
namespace pg8 {
#define PG8_LAS __attribute__((address_space(3)))
typedef unsigned short bf16_t;
typedef short bf16x8 __attribute__((ext_vector_type(8)));
typedef float f32x4 __attribute__((ext_vector_type(4)));
typedef unsigned u32x4 __attribute__((ext_vector_type(4)));
constexpr int BM = 256, BK = 64, HALF = 128, HTB = HALF * BK * 2  , STAGE_BYTES = 8 * HTB, NXCD = 8, WGM = 8;

__host__ __device__ __forceinline__ int lds_byte(int r, int c) { const int st = (r >> 4) * 2 + (c >> 5), rr = r & 15, cc = c & 31, ob = rr * 64 + cc * 2; return st * 1024 + (ob ^ (((ob >> 9) & 1) << 5)); }
__host__ __device__ __forceinline__ void stage_rc(int b, int& R, int& C) { const int st = b / 1024, sb = b % 1024, swz = sb ^ (((sb >> 9) & 1) << 5); R = (st >> 1) * 16 + swz / 64; C = (st & 1) * 32 + (swz % 64) / 2; }
__host__ __device__ __forceinline__ int perm32(int rho) { const int n = rho >> 4, i = rho & 15; return 8 * (i >> 2) + 4 * n + (i & 3); }

struct Unit { int pm, pn; };
struct Gemm { const bf16_t* A; const bf16_t* Bt; int M, N, K; };

struct StaticOrder {
    int nM, nN, nwg, G, c;
    __host__ __device__ void init(int M, int N, int G_, int c_) { nM = M / BM; nN = N / BM; nwg = nM * nN; G = G_; c = c_; }
    __host__ __device__ bool next(int i, Unit& u) const {
        const long L = (long)i * G + c; if (L >= nwg) return false;
        int wgid = (int)L; { const int q = nwg / NXCD, r = nwg % NXCD, xcd = wgid % NXCD, off = wgid / NXCD; wgid = (xcd < r ? xcd * (q + 1) : r * (q + 1) + (xcd - r) * q) + off; }
        const int nig = WGM * nN, gid = wgid / nig, fm = gid * WGM, gsz = (nM - fm) < WGM ? (nM - fm) : WGM;
        u.pm = fm + ((wgid % nig) % gsz); u.pn = (wgid % nig) / gsz; return true;
    }
    __device__ __forceinline__ void a_ready(const Unit&) const {}
    __device__ __forceinline__ void done(const Unit&) const {}
};

typedef float cvt_f32x2_t __attribute__((ext_vector_type(2))); typedef __bf16 cvt_bf16x2_t __attribute__((ext_vector_type(2)));
__device__ __forceinline__ unsigned cvt_pk_bf16(float lo, float hi) { const cvt_f32x2_t v = {lo, hi}; const cvt_bf16x2_t b = __builtin_convertvector(v, cvt_bf16x2_t); return __builtin_bit_cast(unsigned, b); }
typedef float f32x2 __attribute__((ext_vector_type(2)));
typedef unsigned u32x2 __attribute__((ext_vector_type(2)));
__device__ __forceinline__ float silu_f(float x) { return x * __builtin_amdgcn_rcpf(1.0f + __builtin_amdgcn_exp2f(-1.4426950408889634f * x)); }
__device__ __forceinline__ u32x4 pack8(const f32x4 v0, const f32x4 v1) { u32x4 w; w.x = cvt_pk_bf16(v0[0], v0[1]); w.y = cvt_pk_bf16(v0[2], v0[3]); w.z = cvt_pk_bf16(v1[0], v1[1]); w.w = cvt_pk_bf16(v1[2], v1[3]); return w; }

struct EpiF32 {
    static constexpr bool PERM = false, AFTER_DRAIN = false;
    float* C; int ldc;
    __device__ __forceinline__ void operator()(const f32x4 (&acc)[2][2][4][2], const Unit& u, int wr, int wc, int fr, int fq) const {
        asm volatile("" : "+v"(fr), "+v"(fq));
        const int row0 = u.pm * BM + wr * 64 + fr, col0 = u.pn * BM + wc * 32 + 4 * fq;
#pragma unroll
        for (int ai = 0; ai < 2; ++ai)
#pragma unroll
            for (int m = 0; m < 4; ++m) { float* rowp = C + (size_t)(row0 + ai * HALF + m * 16) * ldc + col0;
#pragma unroll
                for (int bj = 0; bj < 2; ++bj)
#pragma unroll
                    for (int n = 0; n < 2; ++n) *(f32x4*)(rowp + bj * HALF + n * 16) = acc[ai][bj][m][n]; }
    }
};
struct EpiBf16Plain {
    static constexpr bool PERM = true, AFTER_DRAIN = false;
    bf16_t* O; int ldc;
    __device__ __forceinline__ void operator()(const f32x4 (&acc)[2][2][4][2], const Unit& u, int wr, int wc, int fr, int fq) const {
        asm volatile("" : "+v"(fr), "+v"(fq));
        const int row0 = u.pm * BM + wr * 64 + fr, col0 = u.pn * BM + wc * 32 + 8 * fq;
#pragma unroll
        for (int ai = 0; ai < 2; ++ai)
#pragma unroll
            for (int m = 0; m < 4; ++m) { bf16_t* rowp = O + (size_t)(row0 + ai * HALF + m * 16) * ldc + col0;
#pragma unroll
                for (int bj = 0; bj < 2; ++bj) *(u32x4*)(rowp + bj * HALF) = pack8(acc[ai][bj][m][0], acc[ai][bj][m][1]); }
    }
};
struct EpiBf16Scale {
    static constexpr bool PERM = true, AFTER_DRAIN = false;
    bf16_t* O; int ldc; const float* scale;
    __device__ __forceinline__ void operator()(const f32x4 (&acc)[2][2][4][2], const Unit& u, int wr, int wc, int fr, int fq) const {
        asm volatile("" : "+v"(fr), "+v"(fq));
        const int row0 = u.pm * BM + wr * 64 + fr, col0 = u.pn * BM + wc * 32 + 8 * fq;
        f32x4 sv[2][2];
#pragma unroll
        for (int bj = 0; bj < 2; ++bj)
#pragma unroll
            for (int n = 0; n < 2; ++n) sv[bj][n] = *(const f32x4*)(scale + col0 + bj * HALF + 4 * n);
#pragma unroll
        for (int ai = 0; ai < 2; ++ai)
#pragma unroll
            for (int m = 0; m < 4; ++m) { bf16_t* rowp = O + (size_t)(row0 + ai * HALF + m * 16) * ldc + col0;
#pragma unroll
                for (int bj = 0; bj < 2; ++bj) *(u32x4*)(rowp + bj * HALF) = pack8(acc[ai][bj][m][0] * sv[bj][0], acc[ai][bj][m][1] * sv[bj][1]); }
    }
};
struct EpiSwiglu {
    static constexpr bool PERM = true, AFTER_DRAIN = false;
    bf16_t* O; int ldc; const float* rs;
    __device__ __forceinline__ void operator()(const f32x4 (&acc)[2][2][4][2], const Unit& u, int wr, int wc, int fr, int fq) const {
        asm volatile("" : "+v"(fr), "+v"(fq));
        const int row0 = u.pm * BM + wr * 64 + fr, col0 = u.pn * HALF + wc * 32 + 8 * fq;
#pragma unroll
        for (int ai = 0; ai < 2; ++ai)
#pragma unroll
            for (int m = 0; m < 4; ++m) { bf16_t* rowp = O + (size_t)(row0 + ai * HALF + m * 16) * ldc + col0; const float r = rs[row0 + ai * HALF + m * 16];
                f32x4 v0, v1;
#pragma unroll
                for (int e = 0; e < 4; ++e) { v0[e] = silu_f(acc[ai][0][m][0][e] * r) * (acc[ai][1][m][0][e] * r); v1[e] = silu_f(acc[ai][0][m][1][e] * r) * (acc[ai][1][m][1][e] * r); }
                *(u32x4*)rowp = pack8(v0, v1); }
    }
};
struct EpiWin {
    static constexpr bool PERM = true, AFTER_DRAIN = false;
    unsigned char* hid;
    static constexpr size_t SQS = 22u << 20, OQ = 0, OK_ = 3u << 20, OV = 6u << 20, OZR = 9u << 20, OZP = 20u << 20;
    const float *cs, *sn;
    float qscale; const float* rs;
    __device__ __forceinline__ void operator()(const f32x4 (&acc)[2][2][4][2], const Unit& u, int wr, int wc, int fr, int fq) const {
        asm volatile("" : "+v"(fr), "+v"(fq));
        const int row0 = u.pm * BM + wr * 64 + fr, pn = u.pn;
        if (pn < 6) {
            const size_t dsto = pn < 3 ? OQ : OK_; const int pt = pn < 3 ? pn : pn - 3; const float sc = pn < 3 ? qscale : 1.0f;
            const int d0 = 16 * (wc & 1) + 4 * fq;
#pragma unroll
            for (int ai = 0; ai < 2; ++ai)
#pragma unroll
                for (int m = 0; m < 4; ++m) { const int row = row0 + ai * HALF + m * 16, b = row >> 11, s = row & 2047; const float rsc = rs[row] * sc;
                    const f32x4 c4 = *(const f32x4*)(cs + s * 32 + d0), s4 = *(const f32x4*)(sn + s * 32 + d0);
#pragma unroll
                    for (int bj = 0; bj < 2; ++bj) { const int head = pt * 4 + bj * 2 + (wc >> 1);
                        const f32x4 x1 = acc[ai][bj][m][0], x2 = acc[ai][bj][m][1];
                        const f32x4 o1 = (x1 * c4 - x2 * s4) * rsc, o2 = (x2 * c4 + x1 * s4) * rsc;
                        bf16_t* p = (bf16_t*)(hid + (size_t)b * SQS + dsto) + ((size_t)head * 2048 + s) * 64 + d0;
                        u32x2 w1, w2; w1.x = cvt_pk_bf16(o1[0], o1[1]); w1.y = cvt_pk_bf16(o1[2], o1[3]); w2.x = cvt_pk_bf16(o2[0], o2[1]); w2.y = cvt_pk_bf16(o2[2], o2[3]);
                        *(u32x2*)p = w1; *(u32x2*)(p + 32) = w2; } }
        } else if (pn < 9) {
            const int d0 = 32 * (wc & 1) + 8 * fq;
#pragma unroll
            for (int ai = 0; ai < 2; ++ai)
#pragma unroll
                for (int m = 0; m < 4; ++m) { const int row = row0 + ai * HALF + m * 16, b = row >> 11, s = row & 2047; const float r = rs[row];
#pragma unroll
                    for (int bj = 0; bj < 2; ++bj) { const int head = (pn - 6) * 4 + bj * 2 + (wc >> 1);
                        *(u32x4*)((bf16_t*)(hid + (size_t)b * SQS + OV) + ((size_t)head * 2048 + s) * 64 + d0) = pack8(acc[ai][bj][m][0] * r, acc[ai][bj][m][1] * r); } }
        } else {
            size_t oo; int ldc, colt;
            if (pn < 20) { oo = OZR; ldc = 2816; colt = (pn - 9) * BM; } else { oo = OZP; ldc = 512; colt = (pn - 20) * BM; }
            const int col0 = colt + wc * 32 + 8 * fq;
#pragma unroll
            for (int ai = 0; ai < 2; ++ai)
#pragma unroll
                for (int m = 0; m < 4; ++m) { const int row = row0 + ai * HALF + m * 16; bf16_t* rowp = (bf16_t*)(hid + (size_t)(row >> 11) * SQS + oo) + (size_t)(row & 2047) * ldc + col0; const float r = rs[row];
#pragma unroll
                    for (int bj = 0; bj < 2; ++bj) *(u32x4*)(rowp + bj * HALF) = pack8(acc[ai][bj][m][0] * r, acc[ai][bj][m][1] * r); }
        }
    }
};

struct GroupOrder {
    int nN, nb, bi, pm0;
    __device__ __forceinline__ void init(int ntiles, int nb_, int bi_, int seq) { nN = ntiles; nb = nb_; bi = bi_; pm0 = 8 * seq; }
    __device__ __forceinline__ bool next(int i, Unit& u) const { const int L = i * nb + bi; if (L >= 8 * nN) return false; u.pm = pm0 + (L & 7); u.pn = L >> 3; return true; }
    __device__ __forceinline__ void a_ready(const Unit&) const {}
    __device__ __forceinline__ void done(const Unit&) const {}
};
struct PanelOrder {
    int slice, nb, bi, pm0;
    __device__ __forceinline__ bool next(int i, Unit& u) const { if (i) return false; const int P = nb >> 3, p = slice * P + (bi >> 3); if ((bi >> 3) >= P || p >= 8) return false; u.pm = pm0 + p; u.pn = bi & 7; return true; }
    __device__ __forceinline__ void a_ready(const Unit&) const {}
    __device__ __forceinline__ void done(const Unit&) const {}
};
struct EpiRes {
    static constexpr bool PERM = true, AFTER_DRAIN = true;
    bf16_t* X; float* OUT;
    const float* gpost; float coef; float* rs;
    float* slots;
    unsigned* cnt;
    unsigned* tmo;
    __device__ __forceinline__ float exchange(float part, int ex, const Unit& u, PG8_LAS float* P, PG8_LAS float* S, int wid, int lane, int wc, int rowl, bool writer) const {
        if (writer) P[rowl * 4 + wc] = part;
        asm volatile("s_waitcnt lgkmcnt(0)" ::: "memory"); __builtin_amdgcn_s_barrier(); asm volatile("" ::: "memory");
        const int tid = wid * 64 + lane;
        float* sl = slots + ((size_t)ex * 16384 * 8);
        if (tid < 256) { const float t4 = (P[tid * 4 + 0] + P[tid * 4 + 1]) + (P[tid * 4 + 2] + P[tid * 4 + 3]);
            __hip_atomic_store(sl + (size_t)(u.pm * BM + tid) * 8 + u.pn, t4, __ATOMIC_RELAXED, __HIP_MEMORY_SCOPE_AGENT);
            asm volatile("s_waitcnt vmcnt(0)" ::: "memory");
            if (lane == 0) __hip_atomic_fetch_add(cnt + 64 * (ex * 64 + u.pm), 1u, __ATOMIC_RELAXED, __HIP_MEMORY_SCOPE_AGENT); }
        if (wid == 0) { unsigned sp = 0;
            while ((unsigned)__builtin_amdgcn_readfirstlane(__hip_atomic_load(cnt + 64 * (ex * 64 + u.pm), __ATOMIC_RELAXED, __HIP_MEMORY_SCOPE_AGENT)) < 32u) {
                __builtin_amdgcn_s_sleep(1); if (++sp > (1u << 22)) { if (lane == 0) __hip_atomic_store(tmo, 1u, __ATOMIC_RELAXED, __HIP_MEMORY_SCOPE_AGENT); break; } } }
        asm volatile("s_waitcnt vmcnt(0) lgkmcnt(0)" ::: "memory"); __builtin_amdgcn_s_barrier(); asm volatile("" ::: "memory");
        if (tid < 256) { const float* q = sl + (size_t)(u.pm * BM + tid) * 8; float t = 0.f;
#pragma unroll
            for (int k = 0; k < 8; ++k) t += __hip_atomic_load(q + k, __ATOMIC_RELAXED, __HIP_MEMORY_SCOPE_AGENT);
            S[tid] = t; }
        asm volatile("s_waitcnt vmcnt(0) lgkmcnt(0)" ::: "memory"); __builtin_amdgcn_s_barrier(); asm volatile("" ::: "memory");
        return S[rowl];
    }
    __device__ __forceinline__ void fused(f32x4 (&acc)[2][2][4][2], const Unit& u, int wr, int wc, int fr, int fq, PG8_LAS unsigned char* lds, int wid, int lane) const {
        PG8_LAS float* P = (PG8_LAS float*)lds; PG8_LAS float* S = (PG8_LAS float*)(lds + 4096);
        const int col0 = u.pn * BM + wc * 32 + 8 * fq;
        f32x4 gv[2][2];
#pragma unroll
        for (int bj = 0; bj < 2; ++bj)
#pragma unroll
            for (int n = 0; n < 2; ++n) gv[bj][n] = *(const f32x4*)(gpost + col0 + bj * HALF + 4 * n);
        u32x4 xw_[2][4][2];
#pragma unroll
        for (int ai = 0; ai < 2; ++ai)
#pragma unroll
            for (int m = 0; m < 4; ++m)
#pragma unroll
                for (int bj = 0; bj < 2; ++bj) xw_[ai][m][bj] = *(const u32x4*)(X + ((size_t)u.pm * BM + ai * HALF + wr * 64 + m * 16 + fr) * 2048 + col0 + bj * HALF);
        float ssq[2][4];
#pragma unroll
        for (int ai = 0; ai < 2; ++ai)
#pragma unroll
            for (int m = 0; m < 4; ++m) { float s = 0.f;
#pragma unroll
                for (int bj = 0; bj < 2; ++bj)
#pragma unroll
                    for (int n = 0; n < 2; ++n) { const f32x4 v = acc[ai][bj][m][n]; s += (v[0] * v[0] + v[1] * v[1]) + (v[2] * v[2] + v[3] * v[3]); }
                s += __shfl_xor(s, 16); s += __shfl_xor(s, 32); ssq[ai][m] = s; }
#pragma unroll
        for (int ai = 0; ai < 2; ++ai)
#pragma unroll
            for (int m = 0; m < 4; ++m) if (fq == 0) P[(ai * HALF + wr * 64 + m * 16 + fr) * 4 + wc] = ssq[ai][m];
        const float dummy1 = exchange(0.f, 0, u, P, S, wid, lane, wc, 0, false); (void)dummy1;
        float ss2[2][4];
#pragma unroll
        for (int ai = 0; ai < 2; ++ai)
#pragma unroll
            for (int m = 0; m < 4; ++m) { const int rl = ai * HALF + wr * 64 + m * 16 + fr; const size_t row = (size_t)u.pm * BM + rl;
                const float cr = coef * __builtin_amdgcn_rsqf(S[rl] * (1.0f / 2048.0f) + 1e-6f); float s2 = 0.f;
#pragma unroll
                for (int bj = 0; bj < 2; ++bj) { bf16_t* xp = X + row * 2048 + col0 + bj * HALF; const u32x4 xw = xw_[ai][m][bj];
                    f32x4 x0 = {__uint_as_float(xw.x << 16), __uint_as_float(xw.x & 0xffff0000u), __uint_as_float(xw.y << 16), __uint_as_float(xw.y & 0xffff0000u)};
                    f32x4 x1 = {__uint_as_float(xw.z << 16), __uint_as_float(xw.z & 0xffff0000u), __uint_as_float(xw.w << 16), __uint_as_float(xw.w & 0xffff0000u)};
                    x0 = x0 + acc[ai][bj][m][0] * gv[bj][0] * cr; x1 = x1 + acc[ai][bj][m][1] * gv[bj][1] * cr;
                    if (OUT) { float* op = OUT + row * 2048 + col0 + bj * HALF; *(f32x4*)op = x0; *(f32x4*)(op + 4) = x1; }
                    else { const u32x4 w = pack8(x0, x1); *(u32x4*)xp = w;
                        const float a0 = __uint_as_float(w.x << 16), a1 = __uint_as_float(w.x & 0xffff0000u), a2 = __uint_as_float(w.y << 16), a3 = __uint_as_float(w.y & 0xffff0000u);
                        const float a4 = __uint_as_float(w.z << 16), a5 = __uint_as_float(w.z & 0xffff0000u), a6 = __uint_as_float(w.w << 16), a7 = __uint_as_float(w.w & 0xffff0000u);
                        s2 += ((a0 * a0 + a1 * a1) + (a2 * a2 + a3 * a3)) + ((a4 * a4 + a5 * a5) + (a6 * a6 + a7 * a7)); } }
                s2 += __shfl_xor(s2, 16); s2 += __shfl_xor(s2, 32); ss2[ai][m] = s2; }
        if (OUT) return;
        asm volatile("s_waitcnt lgkmcnt(0)" ::: "memory"); __builtin_amdgcn_s_barrier(); asm volatile("" ::: "memory");
#pragma unroll
        for (int ai = 0; ai < 2; ++ai)
#pragma unroll
            for (int m = 0; m < 4; ++m) if (fq == 0) P[(ai * HALF + wr * 64 + m * 16 + fr) * 4 + wc] = ss2[ai][m];
        const float dummy2 = exchange(0.f, 1, u, P, S, wid, lane, wc, 0, false); (void)dummy2;
        if (u.pn == 0) { const int tid = wid * 64 + lane; if (tid < 256) rs[(size_t)u.pm * BM + tid] = __builtin_amdgcn_rsqf(S[tid] * (1.0f / 2048.0f) + 1e-6f); }
    }
};

template <class Epi, class Sched, bool ALIGN_EPI = false, bool SP2 = false>
__device__ __forceinline__ void gemm_phase(PG8_LAS unsigned char* lds, const Gemm g, const Sched& S, const Epi& E) {
    int tid_ = threadIdx.x; asm volatile("" : "+v"(tid_));
    const int tid = tid_, wid = __builtin_amdgcn_readfirstlane(tid >> 6), lane = tid & 63, wr = wid >> 2, wc = wid & 3, fr = lane & 15, fq = lane >> 4;
    int K_ = g.K; asm volatile("" : "+s"(K_));
    const int K = K_, nt = K / BK;
    unsigned voffA[2], voffB[2];
#pragma unroll
    for (int i = 0; i < 2; ++i) { int R, C; stage_rc(tid * 16 + i * 8192, R, C); const int Rb = Epi::PERM ? ((R & ~31) + perm32(R & 31)) : R;
        voffA[i] = (unsigned)(R * K + C) * 2u; voffB[i] = (unsigned)(Rb * K + C) * 2u; }
    const size_t kstep = (size_t)(BK * 2);
    const size_t hstep = (size_t)HALF * K * 2;
    const size_t tstep = 2 * hstep;
    const unsigned ldsw = (unsigned)wid * 1024u;
    const int aoff = lds_byte(wr * 64 + fr, fq * 8), boff = lds_byte(wc * 32 + fr, fq * 8);
#define PG8_SA(b, h) (((b) * 2 + (h)) * HTB)
#define PG8_SB(b, h) ((4 + (b) * 2 + (h)) * HTB)
#define PG8_STAGE(bufoff, gbase, voff) do { _Pragma("unroll") for (int _i = 0; _i < 2; ++_i) \
        __builtin_amdgcn_global_load_lds((const unsigned*)((const char*)(gbase) + (voff)[_i]), (PG8_LAS unsigned*)(lds + (bufoff) + ldsw + _i * 8192), 16, 0, 0); } while (0)
#define PG8_LDA(dst, b, h) do { _Pragma("unroll") for (int m = 0; m < 4; ++m) _Pragma("unroll") for (int k = 0; k < 2; ++k) dst[m][k] = *(const PG8_LAS bf16x8*)(lds + PG8_SA(b, h) + aoff + m * 2048 + k * 1024); } while (0)
#define PG8_LDB(dst, b, h) do { _Pragma("unroll") for (int n = 0; n < 2; ++n) _Pragma("unroll") for (int k = 0; k < 2; ++k) dst[n][k] = *(const PG8_LAS bf16x8*)(lds + PG8_SB(b, h) + boff + n * 2048 + k * 1024); } while (0)
#define PG8_MMA(ai, bj, At, Bt) do { __builtin_amdgcn_s_setprio(1); _Pragma("unroll") for (int m = 0; m < 4; ++m) _Pragma("unroll") for (int n = 0; n < 2; ++n) _Pragma("unroll") for (int k = 0; k < 2; ++k) \
        acc[ai][bj][m][n] = __builtin_amdgcn_mfma_f32_16x16x32_bf16(Bt[n][k], At[m][k], acc[ai][bj][m][n], 0, 0, 0); __builtin_amdgcn_s_setprio(0); } while (0)
#define PG8_WAIT_V(n) asm volatile("s_waitcnt vmcnt(" #n ")" ::: "memory")
#define PG8_WAIT_L(n) asm volatile("s_waitcnt lgkmcnt(" #n ")" ::: "memory")
#define PG8_BAR __builtin_amdgcn_s_barrier()
#define PG8_SCHED __builtin_amdgcn_sched_barrier(0)
    Unit cur, nxt; int ui = 0;
    if (!S.next(0, cur)) return;
    f32x4 acc[2][2][4][2];
#pragma unroll
    for (int a = 0; a < 2; ++a)
#pragma unroll
        for (int b = 0; b < 2; ++b)
#pragma unroll
            for (int m = 0; m < 4; ++m)
#pragma unroll
                for (int n = 0; n < 2; ++n) acc[a][b][m][n] = (f32x4){0.f, 0.f, 0.f, 0.f};
    bf16x8 At[4][2], B0[2][2], B1[2][2];
    const char* cA = (const char*)g.A + (size_t)cur.pm * tstep; const char* cB = (const char*)g.Bt + (size_t)cur.pn * tstep;
    S.a_ready(cur);
    if constexpr (SP2) {
        PG8_STAGE(PG8_SB(0, 0), cB, voffB); PG8_STAGE(PG8_SB(0, 1), cB + hstep, voffB); PG8_STAGE(PG8_SA(0, 0), cA, voffA); PG8_STAGE(PG8_SA(0, 1), cA + hstep, voffA);
        if (wr == 1) PG8_BAR;
        PG8_WAIT_V(2); PG8_BAR;
        PG8_STAGE(PG8_SB(1, 0), cB + kstep, voffB); PG8_STAGE(PG8_SA(1, 0), cA + kstep, voffA); PG8_STAGE(PG8_SB(1, 1), cB + hstep + kstep, voffB);
        PG8_WAIT_V(6); PG8_BAR;
    } else {
        PG8_STAGE(PG8_SB(0, 0), cB, voffB); PG8_STAGE(PG8_SA(0, 0), cA, voffA); PG8_STAGE(PG8_SB(0, 1), cB + hstep, voffB); PG8_STAGE(PG8_SA(0, 1), cA + hstep, voffA);
        if (wr == 1) PG8_BAR;
        PG8_WAIT_V(4); PG8_BAR;
        PG8_STAGE(PG8_SB(1, 0), cB + kstep, voffB); PG8_STAGE(PG8_SA(1, 0), cA + kstep, voffA); PG8_STAGE(PG8_SB(1, 1), cB + hstep + kstep, voffB);
        PG8_WAIT_V(6); PG8_BAR;
    }
    for (;;) {
        const bool has_next = S.next(ui + 1, nxt);
        const char* nA = has_next ? (const char*)g.A + (size_t)nxt.pm * tstep : cA; const char* nB = has_next ? (const char*)g.Bt + (size_t)nxt.pn * tstep : cB;
        for (int t = 0; t < nt; t += 2) {
            const bool last = (t == nt - 2);
            const char* a1 = cA + (size_t)(t + 1) * kstep;
            const char* a2 = last ? nA : cA + (size_t)(t + 2) * kstep; const char* b2 = last ? nB : cB + (size_t)(t + 2) * kstep;
            const char* a3 = a2 + kstep; const char* b3 = b2 + kstep;
            if (last && has_next) S.a_ready(nxt);
            if constexpr (SP2) {
            PG8_LDB(B0, 0, 0); PG8_LDB(B1, 0, 1); PG8_SCHED; PG8_LDA(At, 0, 0); PG8_STAGE(PG8_SA(1, 1), a1 + hstep, voffA);
            PG8_WAIT_V(8); PG8_WAIT_L(0); PG8_BAR; PG8_MMA(0, 0, At, B0); PG8_MMA(0, 1, At, B1); PG8_BAR; PG8_SCHED;
            PG8_LDA(At, 0, 1); PG8_STAGE(PG8_SB(0, 0), b2, voffB); PG8_STAGE(PG8_SB(0, 1), b2 + hstep, voffB); PG8_STAGE(PG8_SA(0, 0), a2, voffA);
            PG8_WAIT_V(8); PG8_WAIT_L(0); PG8_BAR; PG8_MMA(1, 0, At, B0); PG8_MMA(1, 1, At, B1); PG8_BAR; PG8_SCHED;
            PG8_LDB(B0, 1, 0); PG8_LDB(B1, 1, 1); PG8_SCHED; PG8_LDA(At, 1, 0); PG8_STAGE(PG8_SA(0, 1), a2 + hstep, voffA);
            PG8_WAIT_V(8); PG8_WAIT_L(0); PG8_BAR; PG8_MMA(0, 0, At, B0); PG8_MMA(0, 1, At, B1); PG8_BAR; PG8_SCHED;
            PG8_LDA(At, 1, 1); PG8_STAGE(PG8_SB(1, 0), b3, voffB); PG8_STAGE(PG8_SB(1, 1), b3 + hstep, voffB); PG8_STAGE(PG8_SA(1, 0), a3, voffA);
            PG8_WAIT_V(8); PG8_WAIT_L(0); PG8_BAR; PG8_MMA(1, 0, At, B0); PG8_MMA(1, 1, At, B1); PG8_BAR; PG8_SCHED;
            } else {
            PG8_LDB(B0, 0, 0); PG8_SCHED; PG8_LDA(At, 0, 0); PG8_STAGE(PG8_SA(1, 1), a1 + hstep, voffA);
            PG8_WAIT_L(8); PG8_BAR; PG8_WAIT_L(0); PG8_MMA(0, 0, At, B0); PG8_BAR; PG8_SCHED;
            PG8_LDB(B1, 0, 1); PG8_STAGE(PG8_SB(0, 0), b2, voffB);
            PG8_BAR; PG8_WAIT_L(0); PG8_MMA(0, 1, At, B1); PG8_BAR;
            PG8_LDA(At, 0, 1); PG8_STAGE(PG8_SA(0, 0), a2, voffA);
            PG8_BAR; PG8_WAIT_L(0); PG8_MMA(1, 0, At, B0); PG8_BAR; PG8_SCHED;
            PG8_STAGE(PG8_SB(0, 1), b2 + hstep, voffB);
            PG8_WAIT_V(6); PG8_BAR; PG8_MMA(1, 1, At, B1); PG8_BAR;
            PG8_LDB(B0, 1, 0); PG8_SCHED; PG8_LDA(At, 1, 0); PG8_STAGE(PG8_SA(0, 1), a2 + hstep, voffA);
            PG8_WAIT_L(8); PG8_BAR; PG8_WAIT_L(0); PG8_MMA(0, 0, At, B0); PG8_BAR; PG8_SCHED;
            PG8_LDB(B1, 1, 1); PG8_STAGE(PG8_SB(1, 0), b3, voffB);
            PG8_BAR; PG8_WAIT_L(0); PG8_MMA(0, 1, At, B1); PG8_BAR;
            PG8_LDA(At, 1, 1); PG8_STAGE(PG8_SA(1, 0), a3, voffA);
            PG8_BAR; PG8_WAIT_L(0); PG8_MMA(1, 0, At, B0); PG8_BAR; PG8_SCHED;
            PG8_STAGE(PG8_SB(1, 1), b3 + hstep, voffB);
            PG8_WAIT_V(6); PG8_BAR; PG8_MMA(1, 1, At, B1); PG8_BAR;
            }
        }
        if constexpr (ALIGN_EPI) { if (wr == 0) PG8_BAR; }
        if constexpr (!Epi::AFTER_DRAIN) { E(acc, cur, wr, wc, fr, fq); S.done(cur); }
        if (!has_next) break;
#pragma unroll
        for (int a = 0; a < 2; ++a)
#pragma unroll
            for (int b = 0; b < 2; ++b)
#pragma unroll
                for (int m = 0; m < 4; ++m)
#pragma unroll
                    for (int n = 0; n < 2; ++n) acc[a][b][m][n] = (f32x4){0.f, 0.f, 0.f, 0.f};
        cur = nxt; cA = nA; cB = nB; ++ui;
        if constexpr (ALIGN_EPI) { if (wr == 1) PG8_BAR; }
    }
    PG8_WAIT_V(0);
    if constexpr (!ALIGN_EPI) { if (wr == 0) PG8_BAR; }
    PG8_BAR;
    if constexpr (Epi::AFTER_DRAIN) { E.fused(acc, cur, wr, wc, fr, fq, lds, wid, lane); S.done(cur); }
#undef PG8_SA
#undef PG8_SB
#undef PG8_STAGE
#undef PG8_LDA
#undef PG8_LDB
#undef PG8_MMA
#undef PG8_WAIT_V
#undef PG8_WAIT_L
#undef PG8_BAR
#undef PG8_SCHED
}
}
#define GAS __attribute__((address_space(1)))
#define LAS __attribute__((address_space(3)))
typedef unsigned short bf16;
typedef unsigned v4u __attribute__((ext_vector_type(4)));
typedef float f32x4 __attribute__((ext_vector_type(4)));
typedef short bf16x8 __attribute__((ext_vector_type(8)));
typedef GAS unsigned gu32;
typedef GAS unsigned long long gu64;
#define RLX_AGENT __ATOMIC_RELAXED, __HIP_MEMORY_SCOPE_AGENT
#define LDS_WAIT() asm volatile("s_waitcnt lgkmcnt(0)" ::: "memory")
#define VM_WAIT() asm volatile("s_waitcnt vmcnt(0)" ::: "memory")
__device__ __forceinline__ unsigned long long rt() { return __builtin_amdgcn_s_memrealtime(); }
__device__ __forceinline__ unsigned f2bf(float f) { unsigned u = __builtin_bit_cast(unsigned, f); return (u + 0x7fffu + ((u >> 16) & 1u)) >> 16; }
__device__ __forceinline__ unsigned pk2(float lo, float hi) { return f2bf(lo) | (f2bf(hi) << 16); }
#define XB_TMO      128
#define XB_XCNT(j)  (256  + 64 * (j))
#define XB_XSUB(j)  (1280 + 64 * (j))
#define XB_XGEN(j)  (2304 + 64 * (j))
#define XB_TOP      3328
#define XB_TOPGEN   3392
#define XCD_BAR_WORDS 3456
#define XB_SPIN_CAP (1u << 18)

__device__ __forceinline__ unsigned xb_ld(unsigned* p)              { return __hip_atomic_load(p, __ATOMIC_RELAXED, __HIP_MEMORY_SCOPE_AGENT); }
__device__ __forceinline__ unsigned xb_add(unsigned* p, unsigned v) { return __hip_atomic_fetch_add(p, v, __ATOMIC_RELAXED, __HIP_MEMORY_SCOPE_AGENT); }
__device__ __forceinline__ unsigned xb_xcc_id() { return (unsigned)__builtin_amdgcn_s_getreg((3 << 11) | 20) & 0xFu; }
#define XB_SPIN(cond, bar) do { unsigned _sp = 0; while (cond) { __builtin_amdgcn_s_sleep(1); \
    if ((++_sp & 255u) == 0u) { if (xb_ld(&(bar)[XB_TMO])) break; if (_sp > XB_SPIN_CAP) { atomicAdd(&(bar)[XB_TMO], 1u); break; } } } } while (0)

struct XcdBarrier {
    unsigned* bar; unsigned x;
    volatile LAS unsigned* st;
};

__device__ __forceinline__ XcdBarrier xcd_barrier_post(unsigned* bar, volatile LAS unsigned* st) {
    XcdBarrier b; b.bar = bar; b.x = xb_xcc_id(); b.st = st;
    if (threadIdx.x == 0) (void)xb_add(&bar[XB_XCNT(b.x)], 1u);
    return b;
}
__device__ __forceinline__ void xcd_barrier_complete(unsigned* bar, unsigned x, unsigned& nloc, unsigned& nx) {
    const unsigned G = gridDim.x * gridDim.y * gridDim.z;
    unsigned sum, cnt, mine, sp = 0u;
    for (;;) {
        sum = 0u; cnt = 0u; mine = 0u;
#pragma unroll
        for (unsigned j = 0; j < 16; ++j) { const unsigned c = xb_ld(&bar[XB_XCNT(j)]); sum += c; cnt += (c > 0u) ? 1u : 0u; mine = (j == x) ? c : mine; }
        if (sum == G) break;
        __builtin_amdgcn_s_sleep(1);
        if ((++sp & 255u) == 0u) { if (xb_ld(&bar[XB_TMO])) break; if (sp > XB_SPIN_CAP) { atomicAdd(&bar[XB_TMO], 1u); break; } }
    }
    nloc = mine > 0u ? mine : 1u; nx = cnt > 0u ? cnt : 1u;
}

__device__ __forceinline__ void xcd_barrier(const XcdBarrier& b) {
    asm volatile("s_waitcnt vmcnt(0)" ::: "memory");
    __syncthreads();
    if (threadIdx.x == 0) {
        unsigned* bar = b.bar;
        __builtin_amdgcn_s_waitcnt(0);
        unsigned nloc = b.st[0], nx = b.st[1];
        if (nloc == 0u) { xcd_barrier_complete(bar, b.x, nloc, nx); b.st[0] = nloc; b.st[1] = nx; }
        const unsigned old = xb_add(&bar[XB_XSUB(b.x)], 1u);
        const unsigned gen = old / nloc;
        if (old + 1u == (gen + 1u) * nloc) {
            __builtin_amdgcn_fence(__ATOMIC_RELEASE, "agent");
            asm volatile("s_waitcnt vmcnt(0)" ::: "memory");
            const unsigned og = xb_add(&bar[XB_TOP], 1u);
            const unsigned tg = og / nx;
            if (og + 1u == (tg + 1u) * nx) xb_add(&bar[XB_TOPGEN], 1u);
            else XB_SPIN(xb_ld(&bar[XB_TOPGEN]) == tg, bar);
            __builtin_amdgcn_fence(__ATOMIC_ACQUIRE, "agent");
            xb_add(&bar[XB_XGEN(b.x)], 1u);
            asm volatile("s_waitcnt vmcnt(0)" ::: "memory");
        } else {
            XB_SPIN(xb_ld(&bar[XB_XGEN(b.x)]) == gen, bar);
            __builtin_amdgcn_fence(__ATOMIC_ACQUIRE, "agent");
            asm volatile("s_waitcnt vmcnt(0)" ::: "memory");
        }
    }
    __syncthreads();
}

constexpr int NWAVES = 8;
#ifndef MK_MULTI
#define MK_MULTI 0
#endif
#ifndef SCAN_DPP
#define SCAN_DPP 1
#endif

#ifndef EXTRA_BAR
#define EXTRA_BAR 0
#endif
#ifndef REP_PRO
#define REP_PRO 1
#endif
#ifndef REP_GU
#define REP_GU 1
#endif
#ifndef REP_DN
#define REP_DN 1
#endif
#ifndef REP_ROW
#define REP_ROW 1
#endif
#ifndef REP_WIN
#define REP_WIN 1
#endif
#ifndef REP_PREP
#define REP_PREP 1
#endif
#ifndef REP_LORA
#define REP_LORA 1
#endif
#ifndef REP_MIX
#define REP_MIX 1
#endif
#ifndef REP_ATT
#define REP_ATT 1
#endif
#ifndef REP_S1
#define REP_S1 1
#endif
#ifndef REP_S2
#define REP_S2 1
#endif
#ifndef REP_S3
#define REP_S3 1
#endif
#ifndef REP_COMB
#define REP_COMB 1
#endif
#ifndef REP_WOUT
#define REP_WOUT 1
#endif

constexpr int BATCH = 8, SEQ = 2048, D = 2048, M = BATCH * SEQ, FF = 5632, NL = 4;
constexpr int NH = 12, HD = 64, DATT = 768, DRW = 768, DPOOL = 512;
constexpr int DRWIN = 2752, DIN = 5568, DINP = 5632, ZRP = 2816;
constexpr int LORA_K = 512, LORA_N = 2304;
constexpr float NORM_EPS = 1e-6f, GN_EPS = 64e-5f;
constexpr float QSCALE = 0.125f * 1.4426950408889634f;
constexpr int NPH = 1 + 8 * 2 + 4 * 7;

constexpr size_t MiB = 1u << 20;
constexpr size_t WS_CTL = 0, CTL_ZERO_BYTES = 1 * MiB;
constexpr size_t WS_COS = 1 * MiB, WS_SIN = 1 * MiB + 256 * 1024, WS_RS = 1 * MiB + 512 * 1024;
constexpr size_t WS_W = 2 * MiB, LW = 165 * MiB;
constexpr size_t LW_GU1 = 0, LW_D1 = 44 * MiB, LW_IN = 66 * MiB, LW_OUT = 88 * MiB, LW_GU2 = 96 * MiB, LW_D2 = 140 * MiB, LW_LORA = 162 * MiB, LW_POOL = 164 * MiB + 256 * 1024;
constexpr size_t WS_H = WS_W + NL * LW;
constexpr size_t WS_HID = WS_H + 64 * MiB;
constexpr size_t SQ_STRIDE = 22 * MiB, SQ_Q = 0, SQ_K = 3 * MiB, SQ_V = 6 * MiB, SQ_ZR = 9 * MiB, SQ_ZP = 20 * MiB;
static_assert((size_t)SEQ * FF * 2 == SQ_STRIDE && SQ_ZR + (size_t)SEQ * ZRP * 2 == SQ_ZP && SQ_ZP + (size_t)SEQ * 512 * 2 == SQ_STRIDE && (size_t)NH * SEQ * 64 * 2 == 3 * MiB, "per-sequence overlay");
constexpr size_t WS_Y = WS_HID + 176 * MiB;
constexpr size_t WS_CAT = WS_Y + 64 * MiB;
constexpr size_t WS_OG = WS_CAT + 64 * MiB;
constexpr size_t WS_LSE = WS_OG + 72 * MiB;
constexpr size_t WS_LA = WS_LSE + 3 * MiB;
constexpr size_t WS_PP = WS_LA + 16 * MiB;
constexpr size_t WS_L = WS_PP + 16 * MiB, WS_LB = WS_L, WS_XB = WS_L + 72 * MiB;
constexpr size_t WS_END = WS_L + 144 * MiB;
static_assert(WS_HID + BATCH * SQ_STRIDE <= WS_Y && LW_POOL + 512 * 512 * 2 <= LW && LW_LORA + (size_t)LORA_N * LORA_K * 2 <= LW_POOL, "d_ws map");
constexpr int CW_TMO = 0, CW_CODE = 1, CW_BAR = 4096, CW_ATTQ = 8192  , CW_RANK = 11264  , CW_GB = 12288  , CW_XC = 16384, XC_USE = 2 * 64 * 64;
static_assert((CW_XC + 12 * XC_USE) * 4 <= (int)CTL_ZERO_BYTES, "control words");

constexpr int RING_OFF = 0, RING_BYTES = 131072;
constexpr int LDSCTL_OFF = RING_BYTES, MISC_OFF = LDSCTL_OFF + 320;
constexpr int LDS_BYTES = 147456;

struct Args { const float* in[28]; float* out; unsigned char* ws; int ph_lo, ph_hi; };
struct ArgsD { const __attribute__((address_space(1))) float* in[28]; __attribute__((address_space(1))) float* out; __attribute__((address_space(1))) unsigned char* ws; int ph_lo, ph_hi; };
static_assert(sizeof(ArgsD) == sizeof(Args), "Args views");
typedef const __attribute__((address_space(4))) ArgsD KArgs;
#define INP(A, k) ((const float*)(A)->in[k])

typedef unsigned long long u64t;
typedef float f32x2g __attribute__((ext_vector_type(2)));
struct Frame {
    LAS unsigned char* lds;
    int wave, vcu, G, tid;
    int bi, nb, seq;
    float* X;
    unsigned char* ws;
};
__device__ __forceinline__ float bf2f(bf16 u) { return __uint_as_float((unsigned)u << 16); }
__device__ __forceinline__ float wave_sum(float v) {
#pragma unroll
    for (int o = 1; o < 64; o <<= 1) v += __shfl_xor(v, o);
    return v;
}
__device__ __forceinline__ float sigmoid_f(float x) { return __builtin_amdgcn_rcpf(1.0f + __builtin_amdgcn_exp2f(-1.4426950408889634f * x)); }

template <class SrcF>
__device__ __forceinline__ void transpose_item(const SrcF src, int ldw, int K, bf16* WT, LAS float* scr, int item, int nblk, int lane, const float* kgain = nullptr) {
    const int kb = item / nblk, nb = item % nblk, k0 = 64 * kb, n0 = 32 * nb;
    const float* colp = src(n0 + (lane & 31));
    float tv[32];
    const GAS float* cp = (const GAS float*)colp + (size_t)(k0 + (lane >> 5)) * ldw;
#pragma unroll
    for (int i = 0; i < 32; ++i) tv[i] = colp ? cp[(size_t)(2 * i) * ldw] : 0.f;
#pragma unroll
    for (int i = 0; i < 32; ++i) scr[(2 * i + (lane >> 5)) * 33 + (lane & 31)] = tv[i];
    LDS_WAIT(); asm volatile("" ::: "memory");
    const int c = lane & 7;
    f32x4 g0 = (f32x4){1.f, 1.f, 1.f, 1.f}, g1 = g0;
    if (kgain) { g0 = *(const GAS f32x4*)(kgain + k0 + 8 * c); g1 = *(const GAS f32x4*)(kgain + k0 + 8 * c + 4); }
#pragma unroll
    for (int j = 0; j < 4; ++j) { const int n = (lane >> 3) + 8 * j; const LAS float* s = scr + (8 * c) * 33 + n;
        v4u o; o.x = pk2(s[0 * 33] * g0[0], s[1 * 33] * g0[1]); o.y = pk2(s[2 * 33] * g0[2], s[3 * 33] * g0[3]); o.z = pk2(s[4 * 33] * g1[0], s[5 * 33] * g1[1]); o.w = pk2(s[6 * 33] * g1[2], s[7 * 33] * g1[3]);
        *(GAS v4u*)(WT + (size_t)(n0 + n) * K + k0 + 8 * c) = o; }
    LDS_WAIT(); asm volatile("" ::: "memory");
}
struct SrcGU { const float* g; long du;
    __device__ __forceinline__ const float* operator()(int n) const { const int col = 128 * (n >> 8) + (n & 127); const long off = ((n >> 7) & 1) ? du : 0l; return (const float*)((const char*)g + off) + col; } };
struct SrcPlain { const float* w; __device__ __forceinline__ const float* operator()(int n) const { return w + n; } };
struct SrcWin { const float* w;
    __device__ __forceinline__ const float* operator()(int n) const {
        if (n < 1536) { const int sec = n / 768, r = n % 768, h = r >> 6, j = r & 63, d = 4 * (j >> 3) + (j & 3) + 32 * ((j >> 2) & 1); return w + sec * 768 + h * 64 + d; }
        if (n < 2304 + DRWIN) return w + n;
        if (n < 2304 + ZRP) return nullptr;
        return w + (n - (ZRP - DRWIN));
    } };

__device__ __forceinline__ void x_row_init(Frame& F, const float* xrow, bf16* xb, float* rs) {
    const GAS f32x4* xr = (const GAS f32x4*)xrow + (F.tid & 63);
    f32x4 v[8]; float s = 0.f;
#pragma unroll
    for (int j = 0; j < 8; ++j) { v[j] = xr[64 * j]; s += (v[j].x * v[j].x + v[j].y * v[j].y) + (v[j].z * v[j].z + v[j].w * v[j].w); }
    const float rstd = 1.0f / sqrtf(wave_sum(s) * (1.f / D) + NORM_EPS);
    GAS u64t* o8 = (GAS u64t*)xb + (F.tid & 63);
#pragma unroll
    for (int j = 0; j < 8; ++j) o8[64 * j] = (u64t)pk2(v[j].x, v[j].y) | ((u64t)pk2(v[j].z, v[j].w) << 32);
    if ((F.tid & 63) == 0) *rs = rstd;
}

__device__ __forceinline__ void p0_prologue_w(Frame& F, KArgs* A);
__device__ __forceinline__ void p0_prologue(Frame& F, KArgs* A) {
    p0_prologue_w(F, A);
    const int gw = F.vcu * NWAVES + F.wave, NGW = F.G * NWAVES;
    for (int m = gw; m < M; m += NGW) x_row_init(F, INP(A, 0) + (size_t)m * D, ((bf16*)(F.ws + WS_XB)) + (size_t)m * D, ((float*)(F.ws + WS_RS)) + m);
}
__device__ __forceinline__ void p0_prologue_w(Frame& F, KArgs* A) {
    LAS float* scr = (LAS float*)(F.lds + RING_OFF + F.wave * 16384);
    const int gw = F.vcu * NWAVES + F.wave, NGW = F.G * NWAVES;
    constexpr int I_GU = (D / 64) * (2 * FF / 32), I_D = (FF / 64) * (D / 32), I_IN = (D / 64) * (DINP / 32), I_OUT = (D / 64) * (D / 32);
    constexpr int I_L = 2 * I_GU + 2 * I_D + I_IN + I_OUT;
    for (int it = gw; it < NL * I_L; it += NGW) {
        const int l = it / I_L; int r = it % I_L;
        unsigned char* wl = F.ws + WS_W + (size_t)l * LW;
        const size_t offF = (size_t)l * D * FF;
        if (r < I_GU) { transpose_item(SrcGU{INP(A, 3) + offF, (long)((const char*)INP(A, 4) - (const char*)INP(A, 3))}, FF, D, (bf16*)(wl + LW_GU1), scr, r, 2 * FF / 32, (F.tid & 63), INP(A, 1) + (size_t)l * D); continue; } r -= I_GU;
        if (r < I_D) { transpose_item(SrcPlain{INP(A, 5) + offF}, D, FF, (bf16*)(wl + LW_D1), scr, r, D / 32, (F.tid & 63)); continue; } r -= I_D;
        if (r < I_IN) { transpose_item(SrcWin{INP(A, 8) + (size_t)l * D * DIN}, DIN, D, (bf16*)(wl + LW_IN), scr, r, DINP / 32, (F.tid & 63), INP(A, 6) + (size_t)l * D); continue; } r -= I_IN;
        if (r < I_OUT) { transpose_item(SrcPlain{INP(A, 9) + (size_t)l * D * D}, D, D, (bf16*)(wl + LW_OUT), scr, r, D / 32, (F.tid & 63)); continue; } r -= I_OUT;
        if (r < I_GU) { transpose_item(SrcGU{INP(A, 25) + offF, (long)((const char*)INP(A, 26) - (const char*)INP(A, 25))}, FF, D, (bf16*)(wl + LW_GU2), scr, r, 2 * FF / 32, (F.tid & 63), INP(A, 23) + (size_t)l * D); continue; } r -= I_GU;
        transpose_item(SrcPlain{INP(A, 27) + offF}, D, FF, (bf16*)(wl + LW_D2), scr, r, D / 32, (F.tid & 63));
    }
    const int gt = F.vcu * (NWAVES * 64) + F.tid, NGT = F.G * NWAVES * 64;
    constexpr int E_LORA = LORA_N * LORA_K, E_POOL = 512 * 512, E_L = E_LORA + E_POOL;
    for (int e = gt; e < NL * E_L; e += NGT) {
        const int l = e / E_L; int r = e % E_L;
        unsigned char* wl = F.ws + WS_W + (size_t)l * LW;
        if (r < E_LORA) { const int n = r / LORA_K, k = r % LORA_K; float v = 0.f;
            if (n < 768) { if (k < 96) v = INP(A, 11)[(size_t)l * 96 * 768 + k * 768 + n]; }
            else if (n < 1536) { if (k >= 96 && k < 192) v = INP(A, 13)[(size_t)l * 96 * 768 + (k - 96) * 768 + (n - 768)]; }
            else { if (k >= 192 && k < 448) v = INP(A, 15)[(size_t)l * 256 * 768 + (k - 192) * 768 + (n - 1536)]; }
            ((bf16*)(wl + LW_LORA))[r] = (bf16)f2bf(v);
        } else { r -= E_LORA; const int n = r / 512, k = r % 512; float v = 0.f;
            if ((n >> 7) == (k >> 7)) v = INP(A, 21)[(size_t)l * 4 * 128 * 128 + (size_t)(n >> 7) * 128 * 128 + (k & 127) * 128 + (n & 127)];
            ((bf16*)(wl + LW_POOL))[r] = (bf16)f2bf(v);
        }
    }
    for (int e = gt; e < SEQ * 32; e += NGT) {
        const int pos = e >> 5, i = e & 31;
        const float invf = powf(10000.0f, -(float)i / 32.0f);
        const double rev = (double)pos * (double)invf * 0.15915494309189535;
        const float fr = (float)(rev - rint(rev));
        ((float*)(F.ws + WS_COS))[e] = __builtin_amdgcn_cosf(fr); ((float*)(F.ws + WS_SIN))[e] = __builtin_amdgcn_sinf(fr);
    }
}

__device__ __forceinline__ void row_pass(Frame& F, float coef, const float* gpost, bool last) {
    const int gw = F.vcu * NWAVES + F.wave, NGW = F.G * NWAVES, lane = F.tid & 63;
    for (int m = gw; m < M; m += NGW) {
        GAS u64t* xr = (GAS u64t*)(((bf16*)(F.ws + WS_XB)) + (size_t)m * D) + lane; const GAS u64t* yr = (const GAS u64t*)(((bf16*)(F.ws + WS_Y)) + (size_t)m * D) + lane;
        const GAS f32x4* gp = (const GAS f32x4*)gpost + lane;
        f32x4 xv[8], yv[8]; float s = 0.f;
#pragma unroll
        for (int j = 0; j < 8; ++j) { const u64t xw = xr[64 * j], w = yr[64 * j];
            xv[j].x = __uint_as_float((unsigned)(xw << 16)); xv[j].y = __uint_as_float((unsigned)xw & 0xffff0000u); xv[j].z = __uint_as_float((unsigned)(xw >> 32) << 16); xv[j].w = __uint_as_float((unsigned)(xw >> 32) & 0xffff0000u);
            yv[j].x = __uint_as_float((unsigned)(w << 16)); yv[j].y = __uint_as_float((unsigned)w & 0xffff0000u); yv[j].z = __uint_as_float((unsigned)(w >> 32) << 16); yv[j].w = __uint_as_float((unsigned)(w >> 32) & 0xffff0000u);
            s += (yv[j].x * yv[j].x + yv[j].y * yv[j].y) + (yv[j].z * yv[j].z + yv[j].w * yv[j].w); }
        const float cr = coef / sqrtf(wave_sum(s) * (1.f / D) + NORM_EPS); float s2 = 0.f;
        if (last) {
            GAS f32x4* xo = (GAS f32x4*)(F.X + (size_t)m * D) + lane;
#pragma unroll
            for (int j = 0; j < 8; ++j) { const f32x4 g = gp[64 * j]; xo[64 * j] = xv[j] + yv[j] * g * cr; }
        } else {
#pragma unroll
            for (int j = 0; j < 8; ++j) { const f32x4 g = gp[64 * j]; xv[j] = xv[j] + yv[j] * g * cr;
                const unsigned lo = pk2(xv[j].x, xv[j].y), hi = pk2(xv[j].z, xv[j].w); xr[64 * j] = (u64t)lo | ((u64t)hi << 32);
                const float a0 = __uint_as_float(lo << 16), a1 = __uint_as_float(lo & 0xffff0000u), a2 = __uint_as_float(hi << 16), a3 = __uint_as_float(hi & 0xffff0000u);
                s2 += (a0 * a0 + a1 * a1) + (a2 * a2 + a3 * a3); }
            const float rstd = 1.0f / sqrtf(wave_sum(s2) * (1.f / D) + NORM_EPS);
            if (lane == 0) ((float*)(F.ws + WS_RS))[m] = rstd;
        }
    }
}
__device__ __forceinline__ float tanh_f(float x) { return 1.0f - 2.0f * __builtin_amdgcn_rcpf(1.0f + __builtin_amdgcn_exp2f(2.8853900817779268f * x)); }
__device__ __forceinline__ void unpack8(const v4u z, float (&f)[8]) {
#pragma unroll
    for (int e = 0; e < 4; ++e) { f[2 * e] = __uint_as_float(z[e] << 16); f[2 * e + 1] = __uint_as_float(z[e] & 0xffff0000u); }
}
__device__ __forceinline__ void mix_prep(Frame& F, KArgs* A, int l) {
    const int gw = F.bi * NWAVES + F.wave, NGW = F.nb * NWAVES, lane = F.tid & 63;
    const float* mu = INP(A, 10) + (size_t)l * DRWIN + 2304;
    f32x4 mu0 = (f32x4){0.f, 0.f, 0.f, 0.f}, mu1 = mu0;
    if (lane < 56) { mu0 = *(const GAS f32x4*)(mu + 8 * lane); mu1 = *(const GAS f32x4*)(mu + 8 * lane + 4); }
    const int pw = 2 << (lane >> 4);
    const int per = (SEQ + NGW - 1) / NGW, r_lo = gw * per, r_hi = (r_lo + per < SEQ) ? r_lo + per : SEQ, m_lo = F.seq * SEQ + r_lo, m_hi = F.seq * SEQ + r_hi;
    for (int m = m_lo; m < m_hi; ++m) {
        const int s = m & (SEQ - 1);
        const unsigned char* sqb = F.ws + WS_HID + (size_t)(m >> 11) * SQ_STRIDE;
        const bf16* zr = ((const bf16*)(sqb + SQ_ZR)) + (size_t)s * ZRP + 2304 + 8 * (lane < 56 ? lane : 0);
        const bf16* zp = ((const bf16*)(sqb + SQ_ZP)) + (size_t)s * 512 + 8 * lane;
        const int cnt = (s + 1 < pw) ? s + 1 : pw;
        v4u zc = (v4u){0u, 0u, 0u, 0u}, zq = zc, zw[16];
        if (lane < 56) { zc = *(const GAS v4u*)zr; if (s > 0) zq = *(const GAS v4u*)(zr - ZRP); }
#pragma unroll
        for (int i = 0; i < 16; ++i) { zw[i] = (v4u){0u, 0u, 0u, 0u}; if (i < cnt) zw[i] = *(const GAS v4u*)(zp - (size_t)i * 512); }
        v4u outv = (v4u){0u, 0u, 0u, 0u};
        if (lane < 56) {
            float z[8], zpv[8], v[8]; unpack8(zc, z); unpack8(zq, zpv);
#pragma unroll
            for (int e = 0; e < 8; ++e) { const float mm = e < 4 ? mu0[e] : mu1[e - 4], zs = z[e] + (zpv[e] - z[e]) * mm; v[e] = lane < 12 ? tanh_f(zs) : (lane < 24 ? zs : sigmoid_f(zs)); }
            outv.x = pk2(v[0], v[1]); outv.y = pk2(v[2], v[3]); outv.z = pk2(v[4], v[5]); outv.w = pk2(v[6], v[7]);
        }
        *(GAS v4u*)(((bf16*)(F.ws + WS_LA)) + (size_t)m * LORA_K + 8 * lane) = outv;
        float acc[8], u[8]; unpack8(zw[0], u);
#pragma unroll
        for (int e = 0; e < 8; ++e) acc[e] = u[e];
#pragma unroll
        for (int i = 1; i < 16; ++i) { float t[8]; unpack8(zw[i], t);
#pragma unroll
            for (int e = 0; e < 8; ++e) acc[e] += t[e]; }
        const float ic = 1.0f / (float)cnt;
        v4u pv; pv.x = pk2(acc[0] * ic - u[0], acc[1] * ic - u[1]); pv.y = pk2(acc[2] * ic - u[2], acc[3] * ic - u[3]); pv.z = pk2(acc[4] * ic - u[4], acc[5] * ic - u[5]); pv.w = pk2(acc[6] * ic - u[6], acc[7] * ic - u[7]);
        *(GAS v4u*)(((bf16*)(F.ws + WS_PP)) + (size_t)m * 512 + 8 * lane) = pv;
    }
}
__device__ __forceinline__ void attn_combine(Frame& F) {
    const int gw = F.bi * NWAVES + F.wave, NGW = F.nb * NWAVES, lane = F.tid & 63;
    const float* LSE = (const float*)(F.ws + WS_LSE); const bf16* OG = (const bf16*)(F.ws + WS_OG); bf16* CAT = (bf16*)(F.ws + WS_CAT);
    const int per = (SEQ + NGW - 1) / NGW, r_lo = gw * per, r_hi = (r_lo + per < SEQ) ? r_lo + per : SEQ, m_lo = F.seq * SEQ + r_lo, m_hi = F.seq * SEQ + r_hi;
    constexpr int RB = 4;
    for (int m0 = m_lo; m0 < m_hi; m0 += RB) {
        u64t a[RB][3], b[RB][3], c[RB][3]; float l0[RB][3], l1[RB][3], l2[RB][3];
#pragma unroll
        for (int r = 0; r < RB; ++r) { const int m = (m0 + r < m_hi) ? m0 + r : m_hi - 1;
#pragma unroll
            for (int p = 0; p < 3; ++p) {
                const int h = 4 * p + (lane >> 4); const size_t o = (size_t)m * DATT + 256 * p + 4 * lane;
                l0[r][p] = LSE[(size_t)m * NH + h]; l1[r][p] = LSE[(size_t)(M + m) * NH + h]; l2[r][p] = LSE[(size_t)(2 * M + m) * NH + h];
                a[r][p] = *(const GAS u64t*)(OG + o); b[r][p] = *(const GAS u64t*)(OG + (size_t)M * DATT + o); c[r][p] = *(const GAS u64t*)(OG + (size_t)2 * M * DATT + o); } }
#pragma unroll
        for (int r = 0; r < RB; ++r) { if (m0 + r >= m_hi) break; const int m = m0 + r;
#pragma unroll
            for (int p = 0; p < 3; ++p) {
                const float mx = fmaxf(l0[r][p], fmaxf(l1[r][p], l2[r][p]));
                float e0 = __builtin_amdgcn_exp2f(l0[r][p] - mx), e1 = __builtin_amdgcn_exp2f(l1[r][p] - mx), e2 = __builtin_amdgcn_exp2f(l2[r][p] - mx); const float inv = __builtin_amdgcn_rcpf(e0 + e1 + e2);
                e0 *= inv; e1 *= inv; e2 *= inv;
                float rr[4];
#pragma unroll
                for (int e = 0; e < 4; ++e) rr[e] = e0 * bf2f((bf16)(a[r][p] >> (16 * e))) + e1 * bf2f((bf16)(b[r][p] >> (16 * e))) + e2 * bf2f((bf16)(c[r][p] >> (16 * e)));
                *(GAS u64t*)(CAT + (size_t)m * D + 256 * p + 4 * lane) = (u64t)pk2(rr[0], rr[1]) | ((u64t)pk2(rr[2], rr[3]) << 32); } }
    }
}
constexpr int MP = 64;
__device__ __forceinline__ int swz(int row, int col) { return row * MP + ((((col >> 3) ^ (row >> 1)) & 7) << 3) + (col & 7); }
constexpr int ATT_K_OFF = 0, ATT_V_OFF = 256 * 64 * 2;
constexpr int ATT_UNITS = 3 * BATCH * NH * 16;
static_assert(ATT_V_OFF + 256 * 64 * 2 <= RING_BYTES, "attention LDS");
typedef short s16x4v __attribute__((ext_vector_type(4)));
__device__ __forceinline__ int swzv(int key, int d) { return key * 64 + ((((d >> 3) ^ (2 * ((key >> 1) & 3))) & 7) << 3) + (d & 7); }
struct AttnIn { v4u kv[4], vv[4]; bf16x8 q0, q1; };
struct AttnUnit { int g, bh, dl, r, blk; };
constexpr int ATT_SEQ_UNITS = 3 * NH * 16;
__device__ __forceinline__ AttnUnit attn_decode(int lu, int seq) { AttnUnit u; u.g = lu / (NH * 16); const int rem = lu % (NH * 16), rb = rem & 15; u.bh = seq * NH + (rem >> 4);
    if (u.g == 0) { u.dl = 1; u.r = 0; u.blk = rb; } else if (u.g == 1) { u.dl = 4; u.r = rb & 3; u.blk = rb >> 2; } else { u.dl = 16; u.r = rb; u.blk = 0; } return u; }
__device__ __forceinline__ void attn_fetch(Frame& F, const AttnUnit& u, AttnIn& R) {
    const unsigned char* sqb = F.ws + WS_HID + (size_t)(u.bh / NH) * SQ_STRIDE; const size_t ho = (size_t)(u.bh % NH) * SEQ * 64;
    const bf16* Qh = ((const bf16*)(sqb + SQ_Q)) + ho; const bf16* Kh = ((const bf16*)(sqb + SQ_K)) + ho; const bf16* Vh = ((const bf16*)(sqb + SQ_V)) + ho;
#pragma unroll
    for (int it = 0; it < 4; ++it) { const int idx = F.tid + it * 512, j = idx >> 3, ch = idx & 7, lk = (u.blk - 1) * 128 + j;
        R.kv[it] = (v4u){0u, 0u, 0u, 0u}; R.vv[it] = (v4u){0u, 0u, 0u, 0u};
        if (lk >= 0) { const size_t off = (size_t)(lk * u.dl + u.r) * 64 + ch * 8; R.kv[it] = *(const GAS v4u*)(Kh + off); R.vv[it] = *(const GAS v4u*)(Vh + off); } }
    const int fr = (F.tid & 63) & 15, fq = (F.tid & 63) >> 4, tq = (u.blk * 128 + 16 * F.wave + fr) * u.dl + u.r;
    R.q0 = *(const GAS bf16x8*)(Qh + (size_t)tq * 64 + 8 * fq); R.q1 = *(const GAS bf16x8*)(Qh + (size_t)tq * 64 + 32 + 8 * fq);
}
__device__ __forceinline__ void attn_stage(Frame& F, const AttnIn& R) {
    LAS bf16* KS = (LAS bf16*)(F.lds + ATT_K_OFF); LAS bf16* VS = (LAS bf16*)(F.lds + ATT_V_OFF);
#pragma unroll
    for (int it = 0; it < 4; ++it) { const int idx = F.tid + it * 512, j = idx >> 3, ch = idx & 7;
        *(LAS v4u*)(KS + swz(j, 8 * ch)) = R.kv[it]; *(LAS v4u*)(VS + swzv(j, 8 * ch)) = R.vv[it]; }
}
__device__ __forceinline__ void attn_compute(Frame& F, const AttnUnit& u, const bf16x8 q0, const bf16x8 q1) {
    const LAS bf16* KS = (const LAS bf16*)(F.lds + ATT_K_OFF); const LAS bf16* VS = (const LAS bf16*)(F.lds + ATT_V_OFF);
    const int w = F.wave, lane = F.tid & 63, fr = lane & 15, fq = lane >> 4, blk = u.blk;
    const int tq = (blk * 128 + 16 * w + fr) * u.dl + u.r;
    const int ko0 = swz(fr, 8 * fq), ko1 = swz(fr, 32 + 8 * fq);
    f32x4 s[9];
#pragma unroll
    for (int t = 0; t < 9; ++t) { const LAS bf16* kp = KS + 16 * (w + t) * 64;
        f32x4 z = (f32x4){0.f, 0.f, 0.f, 0.f};
        z = __builtin_amdgcn_mfma_f32_16x16x32_bf16(*(const LAS bf16x8*)(kp + ko0), q0, z, 0, 0, 0);
        s[t] = __builtin_amdgcn_mfma_f32_16x16x32_bf16(*(const LAS bf16x8*)(kp + ko1), q1, z, 0, 0, 0); }
    float mx = -INFINITY;
#pragma unroll
    for (int t = 0; t < 9; ++t)
#pragma unroll
        for (int i = 0; i < 4; ++i) { const int kk = 16 * t + 4 * fq + i;
            const bool valid = (kk >= fr) && (kk <= 128 + fr) && (blk > 0 || 16 * (w + t) + 4 * fq + i >= 128);
            s[t][i] = valid ? s[t][i] : -INFINITY; mx = fmaxf(mx, s[t][i]); }
    mx = fmaxf(mx, __shfl_xor(mx, 16)); mx = fmaxf(mx, __shfl_xor(mx, 32));
    float lsum = 0.f;
#pragma unroll
    for (int t = 0; t < 9; ++t)
#pragma unroll
        for (int i = 0; i < 4; ++i) { s[t][i] = __builtin_amdgcn_exp2f(s[t][i] - mx); lsum += s[t][i]; }
    lsum += __shfl_xor(lsum, 16); lsum += __shfl_xor(lsum, 32);
    f32x4 o[4];
#pragma unroll
    for (int c = 0; c < 4; ++c) o[c] = (f32x4){0.f, 0.f, 0.f, 0.f};
    const int tq_ = (lane >> 2) & 3, tp = lane & 3;
#pragma unroll
    for (int pp = 0; pp < 5; ++pp) {
        v4u pw; pw.x = pg8::cvt_pk_bf16(s[2 * pp][0], s[2 * pp][1]); pw.y = pg8::cvt_pk_bf16(s[2 * pp][2], s[2 * pp][3]);
        if (pp < 4) { pw.z = pg8::cvt_pk_bf16(s[2 * pp + 1][0], s[2 * pp + 1][1]); pw.w = pg8::cvt_pk_bf16(s[2 * pp + 1][2], s[2 * pp + 1][3]); } else { pw.z = 0u; pw.w = 0u; }
        const bf16x8 pb = __builtin_bit_cast(bf16x8, pw);
        const int ka = 16 * (w + 2 * pp) + 4 * fq + tq_, kb = (pp < 4) ? ka + 16 : ka;
#pragma unroll
        for (int c = 0; c < 4; ++c) {
            const s16x4v lo = __builtin_bit_cast(s16x4v, __builtin_amdgcn_ds_read_tr16_b64_v4i16((LAS s16x4v*)(VS + swzv(ka, 16 * c + 4 * tp))));
            const s16x4v hi = __builtin_bit_cast(s16x4v, __builtin_amdgcn_ds_read_tr16_b64_v4i16((LAS s16x4v*)(VS + swzv(kb, 16 * c + 4 * tp))));
            const bf16x8 va = (bf16x8){lo[0], lo[1], lo[2], lo[3], hi[0], hi[1], hi[2], hi[3]};
            o[c] = __builtin_amdgcn_mfma_f32_16x16x32_bf16(va, pb, o[c], 0, 0, 0); }
    }
    const float inv = 1.0f / lsum;
    const int b = u.bh / NH, h = u.bh % NH; const size_t mq = (size_t)b * SEQ + tq;
    bf16* op = ((bf16*)(F.ws + WS_OG)) + (size_t)u.g * M * DATT + mq * DATT + h * 64 + 4 * fq;
#pragma unroll
    for (int c = 0; c < 4; ++c) { pg8::u32x2 wv; wv.x = pg8::cvt_pk_bf16(o[c][0] * inv, o[c][1] * inv); wv.y = pg8::cvt_pk_bf16(o[c][2] * inv, o[c][3] * inv); *(GAS pg8::u32x2*)(op + 16 * c) = wv; }
    if (fq == 0) ((float*)(F.ws + WS_LSE))[((size_t)u.g * M + mq) * NH + h] = mx + __builtin_amdgcn_logf(lsum);
}
__device__ __forceinline__ void attn_loop(Frame& F, gu32* ctr) {
    volatile LAS int* slot = (volatile LAS int*)(F.lds + MISC_OFF + 64);
    const int seq = F.seq;
    if (F.tid == 0) *slot = (int)__hip_atomic_fetch_add(ctr, 1u, __ATOMIC_RELAXED, __HIP_MEMORY_SCOPE_AGENT);
    __syncthreads();
    int cur = *slot;
    AttnIn R;
    if (cur < ATT_SEQ_UNITS) attn_fetch(F, attn_decode(cur, seq), R);
    while (cur < ATT_SEQ_UNITS) {
        const AttnUnit u = attn_decode(cur, seq);
        __syncthreads();
        if (F.tid == 0) *slot = (int)__hip_atomic_fetch_add(ctr, 1u, __ATOMIC_RELAXED, __HIP_MEMORY_SCOPE_AGENT);
        attn_stage(F, R);
        const bf16x8 q0 = R.q0, q1 = R.q1;
        __syncthreads();
        const int nxt = *slot;
        if (nxt < ATT_SEQ_UNITS) attn_fetch(F, attn_decode(nxt, seq), R);
        attn_compute(F, u, q0, q1);
        cur = nxt;
    }
}

constexpr int CH = 64, NCHUNK = SEQ / CH, SCAN_UNITS = BATCH * NH * NCHUNK;
constexpr int MB = 64 * MP * 2;
constexpr int LP = 68;
constexpr int S1_KT = 0, S1_BT = MB, S1_KK = 2 * MB, S1_RT = 3 * MB, S1_KTT = 4 * MB, S1_BTT = 5 * MB, S1_KKT = 6 * MB, S1_VT = 7 * MB, S1_AAK = 8 * MB, S1_ARB = 9 * MB, S1_ARK = 10 * MB;
constexpr int S1_P = 11 * MB, S1_PT = 12 * MB, S1_TM = 13 * MB, S1_GC = 14 * MB, S1_WT = S1_P  , S1_END = S1_GC + 256;
constexpr int S1_AKVT = S1_KT, S1_WTT = S1_KK, S1_UT = S1_AAK;
static_assert(S1_END <= RING_BYTES, "S1 LDS");
constexpr size_t WS_XS = WS_H + 50 * MiB;
constexpr size_t WS_MC = WS_H, WS_RK = WS_H + 48 * MiB, WS_NCT = WS_Y, WS_YL = WS_END, WS_QE = WS_YL + 48 * MiB, WS_VV = WS_QE + 24 * MiB, WS_GG = WS_VV + 24 * MiB, WS_H0T = WS_GG + 24 * MiB, WS_END2 = WS_H0T + 24 * MiB;
static_assert((size_t)SCAN_UNITS * 64 * 64 * 4 <= 48 * MiB && (size_t)SCAN_UNITS * 64 * 64 * 2 <= 24 * MiB && WS_RK + (size_t)BATCH * NH * SEQ * 4 <= WS_HID, "scan scratch map");

__device__ __forceinline__ f32x4 mm_tile(const LAS bf16* X, const LAS bf16* Y, int tn, int tm, int fr, int fq, f32x4 acc) {
    const int o0 = swz(fr, 8 * fq), o1 = swz(fr, 32 + 8 * fq);
    const LAS bf16* ap = Y + 16 * tm * MP; const LAS bf16* bp = X + 16 * tn * MP;
    acc = __builtin_amdgcn_mfma_f32_16x16x32_bf16(*(const LAS bf16x8*)(ap + o0), *(const LAS bf16x8*)(bp + o0), acc, 0, 0, 0);
    acc = __builtin_amdgcn_mfma_f32_16x16x32_bf16(*(const LAS bf16x8*)(ap + o1), *(const LAS bf16x8*)(bp + o1), acc, 0, 0, 0);
    return acc;
}
__device__ __forceinline__ void st_tile_bf16(LAS bf16* Z, int tn, int tm, int fr, int fq, f32x4 v) {
    pg8::u32x2 w; w.x = pg8::cvt_pk_bf16(v[0], v[1]); w.y = pg8::cvt_pk_bf16(v[2], v[3]); *(LAS pg8::u32x2*)(Z + swz(16 * tn + fr, 16 * tm + 4 * fq)) = w;
}
constexpr f32x4 F4Z = {0.f, 0.f, 0.f, 0.f};

__device__ __forceinline__ void wave_sum8(float (&v)[8]) {
#pragma unroll
    for (int i = 0; i < 8; ++i) {
        v[i] += __builtin_bit_cast(float, __builtin_amdgcn_update_dpp(0, __builtin_bit_cast(int, v[i]), 0xB1, 0xF, 0xF, true));
        v[i] += __builtin_bit_cast(float, __builtin_amdgcn_update_dpp(0, __builtin_bit_cast(int, v[i]), 0x4E, 0xF, 0xF, true));
        v[i] += __builtin_bit_cast(float, __builtin_amdgcn_update_dpp(0, __builtin_bit_cast(int, v[i]), 0x141, 0xF, 0xF, true));
        v[i] += __builtin_bit_cast(float, __builtin_amdgcn_update_dpp(0, __builtin_bit_cast(int, v[i]), 0x140, 0xF, 0xF, true)); }
    float t[8];
#pragma unroll
    for (int i = 0; i < 8; ++i) t[i] = __shfl_xor(v[i], 16);
#pragma unroll
    for (int i = 0; i < 8; ++i) v[i] += t[i];
#pragma unroll
    for (int i = 0; i < 8; ++i) t[i] = __shfl_xor(v[i], 32);
#pragma unroll
    for (int i = 0; i < 8; ++i) v[i] += t[i];
}
constexpr int LAP = 456, PPP = 520;
constexpr int MF_STG = 64 * PPP * 2;
static_assert(MF_STG + 8 * 4096 <= RING_BYTES && 64 * LAP * 2 <= MF_STG, "mixer-front LDS");
__device__ __forceinline__ void mf_store_rows(int lane, LAS bf16* stg, bf16* dst, size_t pitch) {
    asm volatile("s_waitcnt lgkmcnt(0)" ::: "memory");
#pragma unroll
    for (int i = 0; i < 4; ++i) { const int row = 8 * i + (lane >> 3), ch = lane & 7; const v4u v = *(const LAS v4u*)(stg + row * 64 + ch * 8); *(GAS v4u*)(dst + (size_t)row * pitch + ch * 8) = v; }
    asm volatile("s_waitcnt lgkmcnt(0)" ::: "memory");
}
__device__ __forceinline__ void mix_front(Frame& F, KArgs* A, int l, int seq, int c) {
    int tid_ = F.tid; asm volatile("" : "+v"(tid_));
    const int tid = tid_, lane = tid & 63, w = F.wave, fr = lane & 15, fq = lane >> 4;
    LAS bf16* TL = (LAS bf16*)F.lds; LAS bf16* stg = (LAS bf16*)(F.lds + MF_STG + w * 4096);
    const int s00 = c * CH; const size_t m0 = (size_t)seq * SEQ + s00;
    const unsigned char* sqb = F.ws + WS_HID + (size_t)seq * SQ_STRIDE;
    const int row = tid >> 3, sub = tid & 7;
    { const float* mu = INP(A, 10) + (size_t)l * DRWIN + 2304; const int s = s00 + row;
      const bf16* zr = ((const bf16*)(sqb + SQ_ZR)) + (size_t)s * ZRP + 2304;
#pragma unroll
      for (int i = 0; i < 7; ++i) { const int j = sub + 8 * i;
          const v4u zc = *(const GAS v4u*)(zr + 8 * j); v4u zq = (v4u){0u, 0u, 0u, 0u}; if (s > 0) zq = *(const GAS v4u*)(zr + 8 * j - ZRP);
          const f32x4 mu0 = *(const GAS f32x4*)(mu + 8 * j), mu1 = *(const GAS f32x4*)(mu + 8 * j + 4);
          float z[8], zp[8], v[8]; unpack8(zc, z); unpack8(zq, zp);
#pragma unroll
          for (int e = 0; e < 8; ++e) { const float mm = e < 4 ? mu0[e] : mu1[e - 4], zs = z[e] + (zp[e] - z[e]) * mm; v[e] = j < 12 ? tanh_f(zs) : (j < 24 ? zs : sigmoid_f(zs)); }
          v4u o; o.x = pk2(v[0], v[1]); o.y = pk2(v[2], v[3]); o.z = pk2(v[4], v[5]); o.w = pk2(v[6], v[7]);
          *(LAS v4u*)(TL + row * LAP + 8 * j) = o; } }
    __syncthreads();
    { const bf16* WL = (const bf16*)(F.ws + WS_W + (size_t)l * LW + LW_LORA);
#define MF_WL_LOAD(STEP, DST) do { const int it_ = w + NWAVES * ((STEP) >> 2), cb_ = it_ >> 1, g_ = cb_ / 12, kb_ = g_ == 0 ? 0 : (g_ == 1 ? 96 : 192), nk_ = g_ == 2 ? 8 : 3; \
        const bf16* p_ = WL + (size_t)(cb_ * 64 + ((STEP) & 3) * 16 + fr) * LORA_K + kb_ + 8 * fq; \
        _Pragma("unroll") for (int ks_ = 0; ks_ < 8; ++ks_) if (ks_ < nk_) DST[ks_] = *(const GAS bf16x8*)(p_ + 32 * ks_); } while (0)
#define MF_WL_STEP(STEP, CUR) do { const int it_ = w + NWAVES * ((STEP) >> 2), cb_ = it_ >> 1, th_ = it_ & 1, ct_ = (STEP) & 3, g_ = cb_ / 12, kb_ = g_ == 0 ? 0 : (g_ == 1 ? 96 : 192), nk_ = g_ == 2 ? 8 : 3; \
        f32x4 acc_[2] = {F4Z, F4Z}; \
        _Pragma("unroll") for (int ks_ = 0; ks_ < 8; ++ks_) if (ks_ < nk_) { _Pragma("unroll") for (int tt_ = 0; tt_ < 2; ++tt_) \
            acc_[tt_] = __builtin_amdgcn_mfma_f32_16x16x32_bf16(CUR[ks_], *(const LAS bf16x8*)(TL + (32 * th_ + 16 * tt_ + fr) * LAP + kb_ + 32 * ks_ + 8 * fq), acc_[tt_], 0, 0, 0); } \
        _Pragma("unroll") for (int tt_ = 0; tt_ < 2; ++tt_) { pg8::u32x2 o_; o_.x = pg8::cvt_pk_bf16(acc_[tt_][0], acc_[tt_][1]); o_.y = pg8::cvt_pk_bf16(acc_[tt_][2], acc_[tt_][3]); *(LAS pg8::u32x2*)(stg + (16 * tt_ + fr) * 64 + ct_ * 16 + 4 * fq) = o_; } \
        if (ct_ == 3) mf_store_rows(lane, stg, ((bf16*)(F.ws + WS_LB)) + (m0 + 32 * th_) * LORA_N + cb_ * 64, LORA_N); } while (0)
      bf16x8 wa[8], wb[8];
      MF_WL_LOAD(0, wa);
      for (int st = 0; st < 36; st += 2) { MF_WL_LOAD(st + 1, wb); MF_WL_STEP(st, wa); if (st + 2 < 36) MF_WL_LOAD(st + 2, wa); MF_WL_STEP(st + 1, wb); }
#undef MF_WL_LOAD
#undef MF_WL_STEP
    }
    __syncthreads();
    { const int s = s00 + row; const bf16* zpb = ((const bf16*)(sqb + SQ_ZP)) + (size_t)s * 512;
#define MF_PW_LOAD(I, DST) do { constexpr int pw_ = 2 << ((I) >> 1); const int j_ = sub + 8 * (I); \
        _Pragma("unroll") for (int r_ = 0; r_ < pw_; ++r_) { DST[r_] = (v4u){0u, 0u, 0u, 0u}; if (r_ <= s) DST[r_] = *(const GAS v4u*)(zpb + 8 * j_ - (size_t)r_ * 512); } } while (0)
#define MF_PW_STEP(I, CUR) do { constexpr int pw_ = 2 << ((I) >> 1); const int j_ = sub + 8 * (I), cnt_ = (s + 1 < pw_) ? s + 1 : pw_; \
        float acc_[8], u_[8]; unpack8(CUR[0], u_); \
        _Pragma("unroll") for (int e_ = 0; e_ < 8; ++e_) acc_[e_] = u_[e_]; \
        _Pragma("unroll") for (int r_ = 1; r_ < pw_; ++r_) { float t_[8]; unpack8(CUR[r_], t_); _Pragma("unroll") for (int e_ = 0; e_ < 8; ++e_) acc_[e_] += t_[e_]; } \
        const float ic_ = 1.0f / (float)cnt_; v4u pv_; \
        pv_.x = pk2(acc_[0] * ic_ - u_[0], acc_[1] * ic_ - u_[1]); pv_.y = pk2(acc_[2] * ic_ - u_[2], acc_[3] * ic_ - u_[3]); pv_.z = pk2(acc_[4] * ic_ - u_[4], acc_[5] * ic_ - u_[5]); pv_.w = pk2(acc_[6] * ic_ - u_[6], acc_[7] * ic_ - u_[7]); \
        *(LAS v4u*)(TL + row * PPP + 8 * j_) = pv_; } while (0)
      { v4u z0[2], z1[2], z2[4], z3[4], z4[8], z5[8];
        MF_PW_LOAD(0, z0); MF_PW_LOAD(1, z1); MF_PW_LOAD(2, z2); MF_PW_LOAD(3, z3); MF_PW_LOAD(4, z4); MF_PW_LOAD(5, z5);
        MF_PW_STEP(0, z0); MF_PW_STEP(1, z1); MF_PW_STEP(2, z2); MF_PW_STEP(3, z3); MF_PW_STEP(4, z4); MF_PW_STEP(5, z5); }
      { v4u z6[16]; MF_PW_LOAD(6, z6); MF_PW_STEP(6, z6); }
      { v4u z7[16]; MF_PW_LOAD(7, z7); MF_PW_STEP(7, z7); }
#undef MF_PW_LOAD
#undef MF_PW_STEP
    }
    __syncthreads();
    { const bf16* WP = (const bf16*)(F.ws + WS_W + (size_t)l * LW + LW_POOL); const float* psc = INP(A, 22) + (size_t)l * DPOOL;
      for (int it = w; it < 16; it += NWAVES) { const int cb = it >> 1, th = it & 1, kbeg = 128 * (cb >> 1);
          bf16x8 wa[4][4]; f32x4 sc[4];
#pragma unroll
          for (int ct = 0; ct < 4; ++ct) { sc[ct] = *(const GAS f32x4*)(psc + cb * 64 + ct * 16 + 4 * fq);
#pragma unroll
              for (int ks = 0; ks < 4; ++ks) wa[ct][ks] = *(const GAS bf16x8*)(WP + (size_t)(cb * 64 + ct * 16 + fr) * 512 + kbeg + 32 * ks + 8 * fq); }
#pragma unroll
          for (int ct = 0; ct < 4; ++ct) { f32x4 acc[2] = {F4Z, F4Z};
#pragma unroll
              for (int ks = 0; ks < 4; ++ks)
#pragma unroll
                  for (int tt = 0; tt < 2; ++tt) acc[tt] = __builtin_amdgcn_mfma_f32_16x16x32_bf16(wa[ct][ks], *(const LAS bf16x8*)(TL + (32 * th + 16 * tt + fr) * PPP + kbeg + 32 * ks + 8 * fq), acc[tt], 0, 0, 0);
#pragma unroll
              for (int tt = 0; tt < 2; ++tt) { pg8::u32x2 o; o.x = pg8::cvt_pk_bf16(acc[tt][0] * sc[ct][0], acc[tt][1] * sc[ct][1]); o.y = pg8::cvt_pk_bf16(acc[tt][2] * sc[ct][2], acc[tt][3] * sc[ct][3]); *(LAS pg8::u32x2*)(stg + (16 * tt + fr) * 64 + ct * 16 + 4 * fq) = o; } }
          mf_store_rows(lane, stg, ((bf16*)(F.ws + WS_CAT)) + (m0 + 32 * th) * D + DATT + DRW + cb * 64, D); } }
    asm volatile("s_waitcnt vmcnt(0)" ::: "memory");
    __syncthreads();
}

struct S1Raw { unsigned zr[9], zk[9], zv[9], dw[8], da[8], gg[8]; float mu_r, mu_k, mu_v, w0, a0, k_k, k_a, r_k; };
__device__ __forceinline__ void s1_fetch(Frame& F, KArgs* A, int l, int unit, S1Raw& R) {
    const int hb = unit / NCHUNK, c = unit % NCHUNK, b = hb / NH, h = hb % NH, lane = F.tid & 63, hc = h * 64 + lane;
    const int s0 = c * CH + 8 * F.wave; const size_t m0 = (size_t)b * SEQ + s0;
    const GAS bf16* zr = (const GAS bf16*)(((const bf16*)(F.ws + WS_HID + (size_t)b * SQ_STRIDE + SQ_ZR)) + (size_t)s0 * ZRP); const GAS bf16* Lr = (const GAS bf16*)(((const bf16*)(F.ws + WS_LB)) + m0 * LORA_N);
#pragma unroll
    for (int q = 0; q < 9; ++q) { if (q == 0 && s0 == 0) { R.zr[0] = 0u; R.zk[0] = 0u; R.zv[0] = 0u; } else { const GAS bf16* zp = zr + (q - 1) * ZRP; R.zr[q] = zp[hc]; R.zk[q] = zp[768 + hc]; R.zv[q] = zp[1536 + hc]; } }
#pragma unroll
    for (int q = 0; q < 8; ++q) { R.dw[q] = Lr[q * LORA_N + hc]; R.da[q] = Lr[q * LORA_N + 768 + hc]; R.gg[q] = Lr[q * LORA_N + 1536 + hc]; }
    const float* mu = INP(A, 10) + (size_t)l * DRWIN; const size_t lo = (size_t)l * DRW + hc;
    R.mu_r = mu[hc]; R.mu_k = mu[768 + hc]; R.mu_v = mu[1536 + hc];
    R.w0 = INP(A, 12)[lo]; R.a0 = INP(A, 14)[lo]; R.k_k = INP(A, 16)[lo]; R.k_a = INP(A, 17)[lo]; R.r_k = INP(A, 18)[lo];
}
__device__ __forceinline__ int tslot(int tn, int tm, int lane) { return (tn * 4 + tm) * 64 + lane; }

template <int PMODE  > __device__ __forceinline__ void scan_s1_phase(Frame& F, KArgs* A, int l) {
    const int lane = F.tid & 63, w = F.wave;
    const int fr = lane & 15, fq = lane >> 4, tn = w & 3, tm0 = 2 * (w >> 2);
    LAS bf16* KT = (LAS bf16*)(F.lds + S1_KT); LAS bf16* BT = (LAS bf16*)(F.lds + S1_BT); LAS bf16* KK = (LAS bf16*)(F.lds + S1_KK); LAS bf16* RT = (LAS bf16*)(F.lds + S1_RT);
    LAS bf16* KTT = (LAS bf16*)(F.lds + S1_KTT); LAS bf16* BTT = (LAS bf16*)(F.lds + S1_BTT); LAS bf16* KKT = (LAS bf16*)(F.lds + S1_KKT); LAS bf16* VT = (LAS bf16*)(F.lds + S1_VT);
    LAS bf16* AAK = (LAS bf16*)(F.lds + S1_AAK); LAS bf16* ARB = (LAS bf16*)(F.lds + S1_ARB); LAS bf16* ARK = (LAS bf16*)(F.lds + S1_ARK);
    LAS bf16* AKVT = (LAS bf16*)(F.lds + S1_AKVT); LAS bf16* TM = (LAS bf16*)(F.lds + S1_TM); LAS bf16* WTT = (LAS bf16*)(F.lds + S1_WTT); LAS bf16* UT = (LAS bf16*)(F.lds + S1_UT);
    LAS bf16* PM = (LAS bf16*)(F.lds + S1_P); LAS bf16* PT = (LAS bf16*)(F.lds + S1_PT);
    LAS float* GC = (LAS float*)(F.lds + S1_GC); LAS float* WTOT = (LAS float*)(F.lds + S1_WT);
    for (int cc = F.bi; cc < NCHUNK; cc += F.nb) {
    mix_front(F, A, l, F.seq, cc);
    S1Raw R; s1_fetch(F, A, l, (F.seq * NH) * NCHUNK + cc, R);
    for (int hh = 0; hh < NH; ++hh) {
    const int unit = (F.seq * NH + hh) * NCHUNK + cc;
    const int hb = unit / NCHUNK, c = unit % NCHUNK;
    {
        const int s0 = c * CH + 8 * w;
        float rr[8], kap[8], kp[8], aa[8], vv[8], lw[8], cl[8], kk0[8], red[8];
#pragma unroll
        for (int q = 0; q < 8; ++q) {
            const float zr1 = __uint_as_float(R.zr[q + 1] << 16), zr0 = __uint_as_float(R.zr[q] << 16), zk1 = __uint_as_float(R.zk[q + 1] << 16), zk0 = __uint_as_float(R.zk[q] << 16), zv1 = __uint_as_float(R.zv[q + 1] << 16), zv0 = __uint_as_float(R.zv[q] << 16);
            rr[q] = zr1 + (zr0 - zr1) * R.mu_r; kk0[q] = zk1 + (zk0 - zk1) * R.mu_k; vv[q] = zv1 + (zv0 - zv1) * R.mu_v;
            lw[q] = -0.6065306597126334f * 1.4426950408889634f * sigmoid_f(R.w0 + __uint_as_float(R.dw[q] << 16));
            aa[q] = sigmoid_f(R.a0 + __uint_as_float(R.da[q] << 16));
            kp[q] = kk0[q] * (1.0f + (aa[q] - 1.0f) * R.k_a);
            const float kkn = kk0[q] * R.k_k; red[q] = kkn * kkn;
        }
        wave_sum8(red);
        float run = 0.f;
#pragma unroll
        for (int q = 0; q < 8; ++q) { kap[q] = kk0[q] * R.k_k * __builtin_amdgcn_rsqf(fmaxf(red[q], 1e-24f)); red[q] = rr[q] * kp[q] * R.r_k; run += lw[q]; cl[q] = run; }
        wave_sum8(red);
#pragma unroll
        for (int q = 0; q < 8; ++q) {
            const size_t tok = (size_t)hb * SEQ + s0 + q;
            ((bf16*)(F.ws + WS_VV))[tok * 64 + lane] = (bf16)(pg8::cvt_pk_bf16(vv[q], vv[q]) & 0xffffu); ((bf16*)(F.ws + WS_GG))[tok * 64 + lane] = (bf16)R.gg[q];
            if (lane == 0) ((float*)(F.ws + WS_RK))[tok] = red[q];
        }
        if (hh + 1 < NH) s1_fetch(F, A, l, unit + NCHUNK, R);
        WTOT[w * 64 + lane] = run;
        __syncthreads();
        float off = 0.f;
#pragma unroll
        for (int w2 = 0; w2 < 7; ++w2) off += (w2 < w) ? WTOT[w2 * 64 + lane] : 0.f;
        if (w == 7) GC[lane] = __builtin_amdgcn_exp2f(off + run);
        float fkt[8], fbt[8], fkk[8], frt[8];
#pragma unroll
        for (int q = 0; q < 8; ++q) {
            const float ct = off + cl[q], ctm1 = ct - lw[q];
            const float gp = __builtin_amdgcn_exp2f(ct), gm = __builtin_amdgcn_exp2f(ctm1), gi = __builtin_amdgcn_exp2f(-ct);
            fkt[q] = kap[q] * gm; fbt[q] = kap[q] * aa[q] * gi; fkk[q] = kp[q] * gi; frt[q] = rr[q] * gp;
        }
        v4u pkt, pbt, pkk, pvt, prt;
#pragma unroll
        for (int i = 0; i < 4; ++i) { pkt[i] = pg8::cvt_pk_bf16(fkt[2 * i], fkt[2 * i + 1]); pbt[i] = pg8::cvt_pk_bf16(fbt[2 * i], fbt[2 * i + 1]); pkk[i] = pg8::cvt_pk_bf16(fkk[2 * i], fkk[2 * i + 1]);
            prt[i] = pg8::cvt_pk_bf16(frt[2 * i], frt[2 * i + 1]); pvt[i] = pg8::cvt_pk_bf16(vv[2 * i], vv[2 * i + 1]); }
#pragma unroll
        for (int q = 0; q < 8; ++q) { const int o = swz(8 * w + q, lane), sh = 16 * (q & 1);
            KT[o] = (bf16)(pkt[q >> 1] >> sh); BT[o] = (bf16)(pbt[q >> 1] >> sh); KK[o] = (bf16)(pkk[q >> 1] >> sh); RT[o] = (bf16)(prt[q >> 1] >> sh); }
        { const int o = swz(lane, 8 * w); *(LAS v4u*)(KTT + o) = pkt; *(LAS v4u*)(BTT + o) = pbt; *(LAS v4u*)(KKT + o) = pkk; *(LAS v4u*)(VT + o) = pvt; }
    }
    __syncthreads();
    if (PMODE == 1) continue;
    f32x4 Treg[2];
#pragma unroll
    for (int d = 0; d < 2; ++d) { const int tm = tm0 + d; const int t = 16 * tn + fr, sb = 16 * tm + 4 * fq;
        const f32x4 aL = mm_tile(KT, BT, tn, tm, fr, fq, F4Z), aLt = mm_tile(BT, KT, tn, tm, fr, fq, F4Z);
        f32x4 aK = mm_tile(KT, KK, tn, tm, fr, fq, F4Z), aRB = mm_tile(RT, BT, tn, tm, fr, fq, F4Z), aRK = mm_tile(RT, KK, tn, tm, fr, fq, F4Z);
        f32x4 pl, plt;
#pragma unroll
        for (int e = 0; e < 4; ++e) { const bool st = (sb + e) < t, inc = (sb + e) <= t;
            pl[e] = st ? -aL[e] : 0.f; plt[e] = (t < sb + e) ? -aLt[e] : 0.f; Treg[d][e] = ((sb + e) == t ? 1.0f : 0.0f) + pl[e];
            aK[e] = st ? aK[e] : 0.f; aRB[e] = inc ? aRB[e] : 0.f; aRK[e] = inc ? aRK[e] : 0.f; }
        st_tile_bf16(PM, tn, tm, fr, fq, pl); st_tile_bf16(PT, tn, tm, fr, fq, plt); st_tile_bf16(TM, tn, tm, fr, fq, Treg[d]);
        st_tile_bf16(AAK, tn, tm, fr, fq, aK); st_tile_bf16(ARB, tn, tm, fr, fq, aRB); st_tile_bf16(ARK, tn, tm, fr, fq, aRK); }
    __syncthreads();
    {
        f32x4 p2[2], p2t[2];
#pragma unroll
        for (int d = 0; d < 2; ++d) { p2[d] = mm_tile(PM, PT, tn, tm0 + d, fr, fq, F4Z); p2t[d] = mm_tile(PT, PM, tn, tm0 + d, fr, fq, F4Z);
            st_tile_bf16(AKVT, tn, tm0 + d, fr, fq, mm_tile(VT, AAK, tn, tm0 + d, fr, fq, F4Z)); }
        __syncthreads();
#pragma unroll
        for (int d = 0; d < 2; ++d) { st_tile_bf16(PM, tn, tm0 + d, fr, fq, p2[d]); st_tile_bf16(PT, tn, tm0 + d, fr, fq, p2t[d]); }
        __syncthreads();
#pragma unroll
        for (int it = 1; it <= 5; ++it) {
#pragma unroll
            for (int d = 0; d < 2; ++d) { Treg[d] = mm_tile(TM, PT, tn, tm0 + d, fr, fq, Treg[d]);
                if (it < 5) { p2[d] = mm_tile(PM, PT, tn, tm0 + d, fr, fq, F4Z); p2t[d] = mm_tile(PT, PM, tn, tm0 + d, fr, fq, F4Z); } }
            __syncthreads();
#pragma unroll
            for (int d = 0; d < 2; ++d) { st_tile_bf16(TM, tn, tm0 + d, fr, fq, Treg[d]);
                if (it < 5) { st_tile_bf16(PM, tn, tm0 + d, fr, fq, p2[d]); st_tile_bf16(PT, tn, tm0 + d, fr, fq, p2t[d]); } }
            __syncthreads();
        }
    }
    if (PMODE == 2) { __syncthreads(); continue; }
    {
        f32x4 aw[2], au[2];
#pragma unroll
        for (int d = 0; d < 2; ++d) { aw[d] = mm_tile(KTT, TM, tn, tm0 + d, fr, fq, F4Z); au[d] = mm_tile(AKVT, TM, tn, tm0 + d, fr, fq, F4Z); }
#pragma unroll
        for (int d = 0; d < 2; ++d) { st_tile_bf16(WTT, tn, tm0 + d, fr, fq, aw[d]); st_tile_bf16(UT, tn, tm0 + d, fr, fq, au[d]); }
    }
    __syncthreads();
    {
        const size_t ub = (size_t)unit * 64 * 64;
        GAS f32x4* MC = (GAS f32x4*)((float*)(F.ws + WS_MC) + ub); GAS pg8::u32x2* NCT = (GAS pg8::u32x2*)((bf16*)(F.ws + WS_NCT) + ub);
        GAS pg8::u32x2* YL = (GAS pg8::u32x2*)((bf16*)(F.ws + WS_YL) + ub); GAS pg8::u32x2* QE = (GAS pg8::u32x2*)((bf16*)(F.ws + WS_QE) + ub);
#pragma unroll
        for (int d = 0; d < 2; ++d) { const int tm = tm0 + d, i = 16 * tn + fr, j = 16 * tm + 4 * fq, ts = tslot(tn, tm, lane);
            { const f32x4 a = mm_tile(ARB, WTT, tn, tm, fr, fq, F4Z); const pg8::u32x2 rv = *(const LAS pg8::u32x2*)(RT + swz(i, j));
              const float r0 = __uint_as_float(rv.x << 16), r1 = __uint_as_float(rv.x & 0xffff0000u), r2 = __uint_as_float(rv.y << 16), r3 = __uint_as_float(rv.y & 0xffff0000u);
              pg8::u32x2 o; o.x = pg8::cvt_pk_bf16(r0 - a[0], r1 - a[1]); o.y = pg8::cvt_pk_bf16(r2 - a[2], r3 - a[3]); if (PMODE != 3) QE[ts] = o; else asm volatile("" :: "v"(o.x), "v"(o.y)); }
            { const f32x4 a = mm_tile(ARK, VT, tn, tm, fr, fq, F4Z), a2 = mm_tile(ARB, UT, tn, tm, fr, fq, F4Z);
              pg8::u32x2 o; o.x = pg8::cvt_pk_bf16(a[0] - a2[0], a[1] - a2[1]); o.y = pg8::cvt_pk_bf16(a[2] - a2[2], a[3] - a2[3]); if (PMODE != 3) YL[ts] = o; else asm volatile("" :: "v"(o.x), "v"(o.y)); }
            { const f32x4 a = mm_tile(BTT, WTT, tn, tm, fr, fq, F4Z); const float gc = GC[i]; f32x4 o;
#pragma unroll
              for (int e = 0; e < 4; ++e) o[e] = gc * (((j + e) == i ? 1.0f : 0.0f) - a[e]);
              if (PMODE != 3) MC[ts] = o; else asm volatile("" :: "v"(o[0]), "v"(o[1]), "v"(o[2]), "v"(o[3])); }
            { const f32x4 a = mm_tile(VT, KKT, tn, tm, fr, fq, F4Z), a2 = mm_tile(UT, BTT, tn, tm, fr, fq, F4Z); const f32x4 gc = *(const LAS f32x4*)(GC + j);
              pg8::u32x2 o; o.x = pg8::cvt_pk_bf16((a[0] - a2[0]) * gc[0], (a[1] - a2[1]) * gc[1]); o.y = pg8::cvt_pk_bf16((a[2] - a2[2]) * gc[2], (a[3] - a2[3]) * gc[3]);
              if (PMODE != 3) NCT[ts] = o; else asm volatile("" :: "v"(o.x), "v"(o.y)); }
        }
    }
    __syncthreads();
    }
    }
}

__device__ __forceinline__ void scan_s2_head(Frame& F, int hb) {
    if (F.wave >= 4) return;
    const int lane = F.tid & 63, fr = lane & 15, fq = lane >> 4, w = F.wave;
    f32x4 Hs[4];
#pragma unroll
    for (int t = 0; t < 4; ++t) Hs[t] = F4Z;
    for (int c = 0; c < NCHUNK; ++c) {
        const size_t ub = ((size_t)hb * NCHUNK + c) * 64 * 64;
        const float* MC = (const float*)(F.ws + WS_MC) + ub; const bf16* NCT = (const bf16*)(F.ws + WS_NCT) + ub; bf16* H0T = (bf16*)(F.ws + WS_H0T) + ub;
        f32x4 mc[4][4], nn[4];
#pragma unroll
        for (int to = 0; to < 4; ++to) { const pg8::u32x2 nv = ((const GAS pg8::u32x2*)NCT)[tslot(w, to, lane)];
            nn[to] = (f32x4){__uint_as_float(nv.x << 16), __uint_as_float(nv.x & 0xffff0000u), __uint_as_float(nv.y << 16), __uint_as_float(nv.y & 0xffff0000u)};
#pragma unroll
            for (int t = 0; t < 4; ++t) mc[to][t] = ((const GAS f32x4*)MC)[tslot(to, t, lane)]; }
#pragma unroll
        for (int t = 0; t < 4; ++t) { pg8::u32x2 o; o.x = pg8::cvt_pk_bf16(Hs[t][0], Hs[t][1]); o.y = pg8::cvt_pk_bf16(Hs[t][2], Hs[t][3]); ((GAS pg8::u32x2*)H0T)[tslot(w, t, lane)] = o; }
        if (c + 1 == NCHUNK) break;
#pragma unroll
        for (int to = 0; to < 4; ++to)
#pragma unroll
            for (int t = 0; t < 4; ++t)
#pragma unroll
                for (int i = 0; i < 4; ++i) nn[to] = __builtin_amdgcn_mfma_f32_16x16x4f32(mc[to][t][i], Hs[t][i], nn[to], 0, 0, 0);
#pragma unroll
        for (int t = 0; t < 4; ++t) Hs[t] = nn[t];
    }
}

__device__ __forceinline__ void scan_s3_pair(Frame& F, KArgs* A, int l, int pair) {
    const int lane = F.tid & 63, fr = lane & 15, fq = lane >> 4, w = F.wave, unit = 2 * pair + (w >> 2), tn = w & 3;
    const int hb = unit / NCHUNK, c = unit % NCHUNK, b = hb / NH, h = hb % NH;
    const size_t ub = (size_t)unit * 64 * 64;
    const GAS pg8::u32x2* QE = (const GAS pg8::u32x2*)((const bf16*)(F.ws + WS_QE) + ub); const GAS pg8::u32x2* H0T = (const GAS pg8::u32x2*)((const bf16*)(F.ws + WS_H0T) + ub);
    const GAS pg8::u32x2* YL = (const GAS pg8::u32x2*)((const bf16*)(F.ws + WS_YL) + ub);
    const int t = 16 * tn + fr; const size_t tok = (size_t)hb * SEQ + c * CH + t;
    const bf16* vp = (const bf16*)(F.ws + WS_VV) + tok * 64; const bf16* gp = (const bf16*)(F.ws + WS_GG) + tok * 64;
    const float* gnw = INP(A, 19) + (size_t)l * DRW + h * 64; const float* gnb = INP(A, 20) + (size_t)l * DRW + h * 64;
    pg8::u32x2 qv[4], hv[4][4], yv[4], vv[4], gg[4]; f32x4 gw[4], gb[4];
#pragma unroll
    for (int i = 0; i < 4; ++i) { qv[i] = QE[tslot(tn, i, lane)]; yv[i] = YL[tslot(tn, i, lane)]; const int v0 = 16 * i + 4 * fq;
        vv[i] = *(const GAS pg8::u32x2*)(vp + v0); gg[i] = *(const GAS pg8::u32x2*)(gp + v0); gw[i] = *(const GAS f32x4*)(gnw + v0); gb[i] = *(const GAS f32x4*)(gnb + v0);
#pragma unroll
        for (int k = 0; k < 4; ++k) hv[i][k] = H0T[tslot(i, k, lane)]; }
    const float rk = ((const float*)(F.ws + WS_RK))[tok];
    bf16x8 qb[2];
#pragma unroll
    for (int p = 0; p < 2; ++p) qb[p] = __builtin_bit_cast(bf16x8, (v4u){qv[2 * p].x, qv[2 * p].y, qv[2 * p + 1].x, qv[2 * p + 1].y});
    f32x4 y[4]; float s1 = 0.f;
#pragma unroll
    for (int tm = 0; tm < 4; ++tm) {
        f32x4 acc = (f32x4){__uint_as_float(yv[tm].x << 16), __uint_as_float(yv[tm].x & 0xffff0000u), __uint_as_float(yv[tm].y << 16), __uint_as_float(yv[tm].y & 0xffff0000u)};
#pragma unroll
        for (int p = 0; p < 2; ++p) acc = __builtin_amdgcn_mfma_f32_16x16x32_bf16(__builtin_bit_cast(bf16x8, (v4u){hv[tm][2 * p].x, hv[tm][2 * p].y, hv[tm][2 * p + 1].x, hv[tm][2 * p + 1].y}), qb[p], acc, 0, 0, 0);
        y[tm] = acc; s1 += (acc[0] + acc[1]) + (acc[2] + acc[3]); }
    s1 += __shfl_xor(s1, 16); s1 += __shfl_xor(s1, 32);
    const float mean = s1 * (1.f / 64.f); float s2 = 0.f;
#pragma unroll
    for (int tm = 0; tm < 4; ++tm)
#pragma unroll
        for (int e = 0; e < 4; ++e) { const float d = y[tm][e] - mean; s2 += d * d; }
    s2 += __shfl_xor(s2, 16); s2 += __shfl_xor(s2, 32);
    const float rstd = __builtin_amdgcn_rsqf(s2 * (1.f / 64.f) + GN_EPS);
    bf16* out = (bf16*)(F.ws + WS_CAT) + ((size_t)b * SEQ + c * CH + t) * D + DATT + h * 64;
#pragma unroll
    for (int tm = 0; tm < 4; ++tm) { const int v0 = 16 * tm + 4 * fq;
        const float vf[4] = {__uint_as_float(vv[tm].x << 16), __uint_as_float(vv[tm].x & 0xffff0000u), __uint_as_float(vv[tm].y << 16), __uint_as_float(vv[tm].y & 0xffff0000u)};
        const float gf[4] = {__uint_as_float(gg[tm].x << 16), __uint_as_float(gg[tm].x & 0xffff0000u), __uint_as_float(gg[tm].y << 16), __uint_as_float(gg[tm].y & 0xffff0000u)};
        float o[4];
#pragma unroll
        for (int e = 0; e < 4; ++e) o[e] = ((y[tm][e] - mean) * rstd * gw[tm][e] + gb[tm][e] + rk * vf[e]) * gf[e];
        pg8::u32x2 ow; ow.x = pg8::cvt_pk_bf16(o[0], o[1]); ow.y = pg8::cvt_pk_bf16(o[2], o[3]); *(GAS pg8::u32x2*)(out + v0) = ow; }
}

__device__ __forceinline__ void grp_barrier(unsigned* cnt, unsigned nb, unsigned* tmo) {
    asm volatile("s_waitcnt vmcnt(0)" ::: "memory");
    __syncthreads();
    if (threadIdx.x == 0) {
        const unsigned old = __hip_atomic_fetch_add(cnt, 1u, __ATOMIC_RELAXED, __HIP_MEMORY_SCOPE_AGENT), target = (old / nb + 1u) * nb; unsigned sp = 0;
        while (__hip_atomic_load(cnt, __ATOMIC_RELAXED, __HIP_MEMORY_SCOPE_AGENT) < target) { __builtin_amdgcn_s_sleep(1); if (++sp > (1u << 22)) { __hip_atomic_store(tmo, 1u, __ATOMIC_RELAXED, __HIP_MEMORY_SCOPE_AGENT); break; } }
        __builtin_amdgcn_fence(__ATOMIC_ACQUIRE, "agent");
        asm volatile("s_waitcnt vmcnt(0)" ::: "memory");
    }
    __syncthreads();
}
__global__ void __launch_bounds__(NWAVES * 64, 2) fwd_kernel(Args args) {
    extern __shared__ __attribute__((aligned(16))) unsigned char lds[];
    Frame F;
    F.lds = (LAS unsigned char*)lds;
    F.wave = __builtin_amdgcn_readfirstlane(threadIdx.x >> 6); F.tid = threadIdx.x;
    F.G = gridDim.x; { const int bx = blockIdx.x; F.vcu = (F.G % 8 == 0) ? (bx % 8) * (F.G / 8) + bx / 8 : bx; }
    F.bi = 0; F.nb = 1; F.seq = 0;
    unsigned char* ws = args.ws; F.ws = ws;
    F.X = args.out;
    for (int u = threadIdx.x; u < (LDS_BYTES - LDSCTL_OFF) / 4; u += NWAVES * 64) ((LAS unsigned*)(F.lds + LDSCTL_OFF))[u] = 0u;
    __syncthreads();
    volatile LAS unsigned* MISC = (volatile LAS unsigned*)(F.lds + MISC_OFF);
    XcdBarrier bar = xcd_barrier_post((unsigned*)(ws + WS_CTL) + CW_BAR, MISC + 8);
    if (threadIdx.x == 0) MISC[20] = __hip_atomic_fetch_add((unsigned*)(ws + WS_CTL) + CW_RANK + 64 * bar.x, 1u, __ATOMIC_RELAXED, __HIP_MEMORY_SCOPE_AGENT);
    KArgs* const ka0 = (KArgs*)__builtin_amdgcn_kernarg_segment_ptr();
#define PH_BEGIN { Frame F = F0; KArgs* ka = ka0; F.tid = threadIdx.x; asm volatile("" : "+v"(F.tid)); GAS unsigned char* wsg_ = (GAS unsigned char*)F0.ws; GAS float* xg_ = (GAS float*)F0.X; asm volatile("" : "+s"(wsg_), "+s"(xg_), "+s"(F.wave), "+s"(F.bi), "+s"(F.nb), "+s"(F.seq), "+s"(ka)); F.ws = (unsigned char*)wsg_; F.X = (float*)xg_; unsigned char* const ws = F.ws; (void)ws;
#define PH_END   grp_barrier(gcnt, (unsigned)F0.nb, (unsigned*)(F0.ws + WS_CTL) + CW_TMO); }

    { const Frame F0 = F; { Frame F = F0; KArgs* ka = ka0; F.tid = threadIdx.x; asm volatile("" : "+v"(F.tid)); p0_prologue(F, ka); } }
    xcd_barrier(bar);
    if (threadIdx.x == 0) { unsigned g = 0, ng = 0, nbk = 1; unsigned* bw = (unsigned*)(ws + WS_CTL) + CW_BAR;
        for (unsigned j = 0; j < 16; ++j) { const unsigned c = xb_ld(&bw[XB_XCNT(j)]); if (c) { if (j < bar.x) ++g; ++ng; } if (j == bar.x) nbk = c ? c : 1u; }
        MISC[16] = g; MISC[17] = ng ? ng : 1u; MISC[18] = nbk; }
    __syncthreads();
    const int grp = __builtin_amdgcn_readfirstlane((int)MISC[16]), ngrp = __builtin_amdgcn_readfirstlane((int)MISC[17]);
    F.nb = __builtin_amdgcn_readfirstlane((int)MISC[18]); F.bi = __builtin_amdgcn_readfirstlane((int)MISC[20]);
    unsigned* const gcnt = (unsigned*)(ws + WS_CTL) + CW_GB + 64 * bar.x;

    for (int seq = grp; seq < BATCH; seq += ngrp) {
    F.seq = seq; const Frame F0 = F;
    for (int j = 0; j < 2 * NL; ++j) {
        const int l = j >> 1; const bool second = (j & 1) != 0;
        PH_BEGIN {
            pg8::Gemm g{((bf16*)(F.ws + WS_XB)), (const bf16*)(ws + WS_W + (size_t)l * LW + (second ? LW_GU2 : LW_GU1)), M, 2 * FF, D}; pg8::GroupOrder S; S.init(2 * FF / 256, F.nb, F.bi, F.seq);
            pg8::EpiSwiglu E{((bf16*)(F.ws + WS_HID)), FF, (const float*)(F.ws + WS_RS)};
            pg8::gemm_phase<pg8::EpiSwiglu, pg8::GroupOrder, true, true>(F.lds + RING_OFF, g, S, E);
        } PH_END
        PH_BEGIN {
            const int q = 3 * l + (second ? 2 : 0); const bool lastsub = second && (l + 1 == NL);
            pg8::Gemm g{((bf16*)(F.ws + WS_HID)), (const bf16*)(ws + WS_W + (size_t)l * LW + (second ? LW_D2 : LW_D1)), M, D, FF};
            pg8::EpiRes E{((bf16*)(F.ws + WS_XB)), lastsub ? F.X : nullptr, (second ? INP(ka, 24) : INP(ka, 2)) + (size_t)l * D, 0.5f, (float*)(F.ws + WS_RS),
                          (float*)(F.ws + WS_XS + (size_t)q * MiB), (unsigned*)(ws + WS_CTL) + CW_XC + q * XC_USE, (unsigned*)(ws + WS_CTL) + CW_TMO};
            const int P = F.nb >> 3, nsl = P > 0 ? (8 + P - 1) / P : 0;
            for (int sl = 0; sl < nsl; ++sl) { pg8::PanelOrder S{sl, F.nb, F.bi, 8 * F.seq}; pg8::gemm_phase<pg8::EpiRes, pg8::PanelOrder, false, true>(F.lds + RING_OFF, g, S, E); __syncthreads(); }
        } PH_END
        if (!second) {
            PH_BEGIN {
                pg8::Gemm g{((bf16*)(F.ws + WS_XB)), (const bf16*)(ws + WS_W + (size_t)l * LW + LW_IN), M, DINP, D}; pg8::GroupOrder S; S.init(DINP / 256, F.nb, F.bi, F.seq);
                pg8::EpiWin E{F.ws + WS_HID, ((float*)(F.ws + WS_COS)), ((float*)(F.ws + WS_SIN)), QSCALE, (const float*)(F.ws + WS_RS)};
                pg8::gemm_phase<pg8::EpiWin, pg8::GroupOrder, true, true>(F.lds + RING_OFF, g, S, E);
            } PH_END
            PH_BEGIN scan_s1_phase<0>(F, ka, l); PH_END
            PH_BEGIN {
                for (int h = F.bi; h < NH; h += F.nb) scan_s2_head(F, F.seq * NH + h);
                attn_loop(F, (gu32*)(ws + WS_CTL) + CW_ATTQ + 64 * (l * BATCH + F.seq));
            } PH_END
            PH_BEGIN { for (int p = F.bi; p < NH * NCHUNK / 2; p += F.nb) scan_s3_pair(F, ka, l, F.seq * (NH * NCHUNK / 2) + p); attn_combine(F); } PH_END
            PH_BEGIN {
                const int q = 3 * l + 1;
                pg8::Gemm g{((bf16*)(F.ws + WS_CAT)), (const bf16*)(ws + WS_W + (size_t)l * LW + LW_OUT), M, D, D};
                pg8::EpiRes E{((bf16*)(F.ws + WS_XB)), nullptr, INP(ka, 7) + (size_t)l * D, 1.0f, (float*)(F.ws + WS_RS),
                              (float*)(F.ws + WS_XS + (size_t)q * MiB), (unsigned*)(ws + WS_CTL) + CW_XC + q * XC_USE, (unsigned*)(ws + WS_CTL) + CW_TMO};
                const int P = F.nb >> 3, nsl = P > 0 ? (8 + P - 1) / P : 0;
                for (int sl = 0; sl < nsl; ++sl) { pg8::PanelOrder S{sl, F.nb, F.bi, 8 * F.seq}; pg8::gemm_phase<pg8::EpiRes, pg8::PanelOrder, false, true>(F.lds + RING_OFF, g, S, E); __syncthreads(); }
            } PH_END
        }
    }
    }
#undef PH_BEGIN
#undef PH_END
}

extern "C" void kernel_launch(void* const* d_in, const int* in_sizes, int n_in, void* d_out, int out_size, void* d_ws, size_t ws_size, hipStream_t stream) {
    static int grid = 0;
    if (grid == 0) {
        if (n_in != 28 || in_sizes[0] != M * D || out_size != M * D || ws_size < WS_END2) { fprintf(stderr, "kernel_launch: unexpected problem (n_in %d, in0 %d, out %d, ws %zu < %zu); nothing launched\n", n_in, n_in > 0 ? in_sizes[0] : -1, out_size, ws_size, (size_t)WS_END2); grid = -1; return; }
        int dev = 0, cus = 0, per_cu = 0;
        if (hipGetDevice(&dev) != hipSuccess || hipDeviceGetAttribute(&cus, hipDeviceAttributeMultiprocessorCount, dev) != hipSuccess) { grid = -1; return; }
        if (hipFuncSetAttribute((const void*)fwd_kernel, hipFuncAttributeMaxDynamicSharedMemorySize, LDS_BYTES) != hipSuccess) { fprintf(stderr, "kernel_launch: hipFuncSetAttribute failed\n"); grid = -1; return; }
        if (hipOccupancyMaxActiveBlocksPerMultiprocessor(&per_cu, (const void*)fwd_kernel, NWAVES * 64, LDS_BYTES) != hipSuccess || per_cu < 1)
            fprintf(stderr, "kernel_launch: note: occupancy query reports %d workgroups per CU\n", per_cu);
        (void)hipGetLastError();
        grid = cus;
    }
    if (grid < 0) return;
    if (hipMemsetAsync((char*)d_ws + WS_CTL, 0, CTL_ZERO_BYTES, stream) != hipSuccess) return;
    Args a{};
    for (int i = 0; i < 28; ++i) a.in[i] = (const float*)d_in[i];
    a.out = (float*)d_out; a.ws = (unsigned char*)d_ws; a.ph_lo = 0; a.ph_hi = 0;
    hipLaunchKernelGGL(fwd_kernel, dim3(grid), dim3(NWAVES * 64), LDS_BYTES, stream, a);
}
```

```cpp
#include <hip/hip_runtime.h>
#include <cstdio>
#include <cstdint>
#include <cmath>
namespace pg8 {
#define PG8_LAS __attribute__((address_space(3)))
typedef unsigned short bf16_t;
typedef short bf16x8 __attribute__((ext_vector_type(8)));
typedef float f32x4 __attribute__((ext_vector_type(4)));
typedef unsigned u32x4 __attribute__((ext_vector_type(4)));
constexpr int BM = 256, BK = 64, HALF = 128, HTB = HALF * BK * 2  , STAGE_BYTES = 8 * HTB, NXCD = 8, WGM = 8;

__host__ __device__ __forceinline__ int lds_byte(int r, int c) { const int st = (r >> 4) * 2 + (c >> 5), rr = r & 15, cc = c & 31, ob = rr * 64 + cc * 2; return st * 1024 + (ob ^ (((ob >> 9) & 1) << 5)); }
__host__ __device__ __forceinline__ void stage_rc(int b, int& R, int& C) { const int st = b / 1024, sb = b % 1024, swz = sb ^ (((sb >> 9) & 1) << 5); R = (st >> 1) * 16 + swz / 64; C = (st & 1) * 32 + (swz % 64) / 2; }
__host__ __device__ __forceinline__ int perm32(int rho) { const int n = rho >> 4, i = rho & 15; return 8 * (i >> 2) + 4 * n + (i & 3); }

struct Unit { int pm, pn; };
struct Gemm { const bf16_t* A; const bf16_t* Bt; int M, N, K; };

struct StaticOrder {
    int nM, nN, nwg, G, c;
    __host__ __device__ void init(int M, int N, int G_, int c_) { nM = M / BM; nN = N / BM; nwg = nM * nN; G = G_; c = c_; }
    __host__ __device__ bool next(int i, Unit& u) const {
        const long L = (long)i * G + c; if (L >= nwg) return false;
        int wgid = (int)L; { const int q = nwg / NXCD, r = nwg % NXCD, xcd = wgid % NXCD, off = wgid / NXCD; wgid = (xcd < r ? xcd * (q + 1) : r * (q + 1) + (xcd - r) * q) + off; }
        const int nig = WGM * nN, gid = wgid / nig, fm = gid * WGM, gsz = (nM - fm) < WGM ? (nM - fm) : WGM;
        u.pm = fm + ((wgid % nig) % gsz); u.pn = (wgid % nig) / gsz; return true;
    }
    __device__ __forceinline__ void a_ready(const Unit&) const {}
    __device__ __forceinline__ void done(const Unit&) const {}
};

typedef float cvt_f32x2_t __attribute__((ext_vector_type(2))); typedef __bf16 cvt_bf16x2_t __attribute__((ext_vector_type(2)));
__device__ __forceinline__ unsigned cvt_pk_bf16(float lo, float hi) { const cvt_f32x2_t v = {lo, hi}; const cvt_bf16x2_t b = __builtin_convertvector(v, cvt_bf16x2_t); return __builtin_bit_cast(unsigned, b); }
typedef float f32x2 __attribute__((ext_vector_type(2)));
typedef unsigned u32x2 __attribute__((ext_vector_type(2)));
__device__ __forceinline__ float silu_f(float x) { return x * __builtin_amdgcn_rcpf(1.0f + __builtin_amdgcn_exp2f(-1.4426950408889634f * x)); }
__device__ __forceinline__ u32x4 pack8(const f32x4 v0, const f32x4 v1) { u32x4 w; w.x = cvt_pk_bf16(v0[0], v0[1]); w.y = cvt_pk_bf16(v0[2], v0[3]); w.z = cvt_pk_bf16(v1[0], v1[1]); w.w = cvt_pk_bf16(v1[2], v1[3]); return w; }

struct EpiF32 {
    static constexpr bool PERM = false, AFTER_DRAIN = false;
    float* C; int ldc;
    __device__ __forceinline__ void operator()(const f32x4 (&acc)[2][2][4][2], const Unit& u, int wr, int wc, int fr, int fq) const {
        asm volatile("" : "+v"(fr), "+v"(fq));
        const int row0 = u.pm * BM + wr * 64 + fr, col0 = u.pn * BM + wc * 32 + 4 * fq;
#pragma unroll
        for (int ai = 0; ai < 2; ++ai)
#pragma unroll
            for (int m = 0; m < 4; ++m) { float* rowp = C + (size_t)(row0 + ai * HALF + m * 16) * ldc + col0;
#pragma unroll
                for (int bj = 0; bj < 2; ++bj)
#pragma unroll
                    for (int n = 0; n < 2; ++n) *(f32x4*)(rowp + bj * HALF + n * 16) = acc[ai][bj][m][n]; }
    }
};
struct EpiBf16Plain {
    static constexpr bool PERM = true, AFTER_DRAIN = false;
    bf16_t* O; int ldc;
    __device__ __forceinline__ void operator()(const f32x4 (&acc)[2][2][4][2], const Unit& u, int wr, int wc, int fr, int fq) const {
        asm volatile("" : "+v"(fr), "+v"(fq));
        const int row0 = u.pm * BM + wr * 64 + fr, col0 = u.pn * BM + wc * 32 + 8 * fq;
#pragma unroll
        for (int ai = 0; ai < 2; ++ai)
#pragma unroll
            for (int m = 0; m < 4; ++m) { bf16_t* rowp = O + (size_t)(row0 + ai * HALF + m * 16) * ldc + col0;
#pragma unroll
                for (int bj = 0; bj < 2; ++bj) *(u32x4*)(rowp + bj * HALF) = pack8(acc[ai][bj][m][0], acc[ai][bj][m][1]); }
    }
};
struct EpiBf16Scale {
    static constexpr bool PERM = true, AFTER_DRAIN = false;
    bf16_t* O; int ldc; const float* scale;
    __device__ __forceinline__ void operator()(const f32x4 (&acc)[2][2][4][2], const Unit& u, int wr, int wc, int fr, int fq) const {
        asm volatile("" : "+v"(fr), "+v"(fq));
        const int row0 = u.pm * BM + wr * 64 + fr, col0 = u.pn * BM + wc * 32 + 8 * fq;
        f32x4 sv[2][2];
#pragma unroll
        for (int bj = 0; bj < 2; ++bj)
#pragma unroll
            for (int n = 0; n < 2; ++n) sv[bj][n] = *(const f32x4*)(scale + col0 + bj * HALF + 4 * n);
#pragma unroll
        for (int ai = 0; ai < 2; ++ai)
#pragma unroll
            for (int m = 0; m < 4; ++m) { bf16_t* rowp = O + (size_t)(row0 + ai * HALF + m * 16) * ldc + col0;
#pragma unroll
                for (int bj = 0; bj < 2; ++bj) *(u32x4*)(rowp + bj * HALF) = pack8(acc[ai][bj][m][0] * sv[bj][0], acc[ai][bj][m][1] * sv[bj][1]); }
    }
};
struct EpiSwiglu {
    static constexpr bool PERM = true, AFTER_DRAIN = false;
    bf16_t* O; int ldc; const float* rs;
    __device__ __forceinline__ void operator()(const f32x4 (&acc)[2][2][4][2], const Unit& u, int wr, int wc, int fr, int fq) const {
        asm volatile("" : "+v"(fr), "+v"(fq));
        const int row0 = u.pm * BM + wr * 64 + fr, col0 = u.pn * HALF + wc * 32 + 8 * fq;
#pragma unroll
        for (int ai = 0; ai < 2; ++ai)
#pragma unroll
            for (int m = 0; m < 4; ++m) { bf16_t* rowp = O + (size_t)(row0 + ai * HALF + m * 16) * ldc + col0; const float r = rs[row0 + ai * HALF + m * 16];
                f32x4 v0, v1;
#pragma unroll
                for (int e = 0; e < 4; ++e) { v0[e] = silu_f(acc[ai][0][m][0][e] * r) * (acc[ai][1][m][0][e] * r); v1[e] = silu_f(acc[ai][0][m][1][e] * r) * (acc[ai][1][m][1][e] * r); }
                *(u32x4*)rowp = pack8(v0, v1); }
    }
};
struct EpiWin {
    static constexpr bool PERM = true, AFTER_DRAIN = false;
    unsigned char* hid;
    static constexpr size_t SQS = 22u << 20, OQ = 0, OK_ = 3u << 20, OV = 6u << 20, OZR = 9u << 20, OZP = 20u << 20;
    const float *cs, *sn;
    float qscale; const float* rs;
    __device__ __forceinline__ void operator()(const f32x4 (&acc)[2][2][4][2], const Unit& u, int wr, int wc, int fr, int fq) const {
        asm volatile("" : "+v"(fr), "+v"(fq));
        const int row0 = u.pm * BM + wr * 64 + fr, pn = u.pn;
        if (pn < 6) {
            const size_t dsto = pn < 3 ? OQ : OK_; const int pt = pn < 3 ? pn : pn - 3; const float sc = pn < 3 ? qscale : 1.0f;
            const int d0 = 16 * (wc & 1) + 4 * fq;
#pragma unroll
            for (int ai = 0; ai < 2; ++ai)
#pragma unroll
                for (int m = 0; m < 4; ++m) { const int row = row0 + ai * HALF + m * 16, b = row >> 11, s = row & 2047; const float rsc = rs[row] * sc;
                    const f32x4 c4 = *(const f32x4*)(cs + s * 32 + d0), s4 = *(const f32x4*)(sn + s * 32 + d0);
#pragma unroll
                    for (int bj = 0; bj < 2; ++bj) { const int head = pt * 4 + bj * 2 + (wc >> 1);
                        const f32x4 x1 = acc[ai][bj][m][0], x2 = acc[ai][bj][m][1];
                        const f32x4 o1 = (x1 * c4 - x2 * s4) * rsc, o2 = (x2 * c4 + x1 * s4) * rsc;
                        bf16_t* p = (bf16_t*)(hid + (size_t)b * SQS + dsto) + ((size_t)head * 2048 + s) * 64 + d0;
                        u32x2 w1, w2; w1.x = cvt_pk_bf16(o1[0], o1[1]); w1.y = cvt_pk_bf16(o1[2], o1[3]); w2.x = cvt_pk_bf16(o2[0], o2[1]); w2.y = cvt_pk_bf16(o2[2], o2[3]);
                        *(u32x2*)p = w1; *(u32x2*)(p + 32) = w2; } }
        } else if (pn < 9) {
            const int d0 = 32 * (wc & 1) + 8 * fq;
#pragma unroll
            for (int ai = 0; ai < 2; ++ai)
#pragma unroll
                for (int m = 0; m < 4; ++m) { const int row = row0 + ai * HALF + m * 16, b = row >> 11, s = row & 2047; const float r = rs[row];
#pragma unroll
                    for (int bj = 0; bj < 2; ++bj) { const int head = (pn - 6) * 4 + bj * 2 + (wc >> 1);
                        *(u32x4*)((bf16_t*)(hid + (size_t)b * SQS + OV) + ((size_t)head * 2048 + s) * 64 + d0) = pack8(acc[ai][bj][m][0] * r, acc[ai][bj][m][1] * r); } }
        } else {
            size_t oo; int ldc, colt;
            if (pn < 20) { oo = OZR; ldc = 2816; colt = (pn - 9) * BM; } else { oo = OZP; ldc = 512; colt = (pn - 20) * BM; }
            const int col0 = colt + wc * 32 + 8 * fq;
#pragma unroll
            for (int ai = 0; ai < 2; ++ai)
#pragma unroll
                for (int m = 0; m < 4; ++m) { const int row = row0 + ai * HALF + m * 16; bf16_t* rowp = (bf16_t*)(hid + (size_t)(row >> 11) * SQS + oo) + (size_t)(row & 2047) * ldc + col0; const float r = rs[row];
#pragma unroll
                    for (int bj = 0; bj < 2; ++bj) *(u32x4*)(rowp + bj * HALF) = pack8(acc[ai][bj][m][0] * r, acc[ai][bj][m][1] * r); }
        }
    }
};

struct GroupOrder {
    int nN, nb, bi, pm0;
    __device__ __forceinline__ void init(int ntiles, int nb_, int bi_, int seq) { nN = ntiles; nb = nb_; bi = bi_; pm0 = 8 * seq; }
    __device__ __forceinline__ bool next(int i, Unit& u) const { const int L = i * nb + bi; if (L >= 8 * nN) return false; u.pm = pm0 + (L & 7); u.pn = L >> 3; return true; }
    __device__ __forceinline__ void a_ready(const Unit&) const {}
    __device__ __forceinline__ void done(const Unit&) const {}
};
struct PanelOrder {
    int slice, nb, bi, pm0;
    __device__ __forceinline__ bool next(int i, Unit& u) const { if (i) return false; const int P = nb >> 3, p = slice * P + (bi >> 3); if ((bi >> 3) >= P || p >= 8) return false; u.pm = pm0 + p; u.pn = bi & 7; return true; }
    __device__ __forceinline__ void a_ready(const Unit&) const {}
    __device__ __forceinline__ void done(const Unit&) const {}
};
struct EpiRes {
    static constexpr bool PERM = true, AFTER_DRAIN = true;
    bf16_t* X; float* OUT;
    const float* gpost; float coef; float* rs;
    float* slots;
    unsigned* cnt;
    unsigned* tmo;
    __device__ __forceinline__ float exchange(float part, int ex, const Unit& u, PG8_LAS float* P, PG8_LAS float* S, int wid, int lane, int wc, int rowl, bool writer) const {
        if (writer) P[rowl * 4 + wc] = part;
        asm volatile("s_waitcnt lgkmcnt(0)" ::: "memory"); __builtin_amdgcn_s_barrier(); asm volatile("" ::: "memory");
        const int tid = wid * 64 + lane;
        float* sl = slots + ((size_t)ex * 16384 * 8);
        if (tid < 256) { const float t4 = (P[tid * 4 + 0] + P[tid * 4 + 1]) + (P[tid * 4 + 2] + P[tid * 4 + 3]);
            __hip_atomic_store(sl + (size_t)(u.pm * BM + tid) * 8 + u.pn, t4, __ATOMIC_RELAXED, __HIP_MEMORY_SCOPE_AGENT);
            asm volatile("s_waitcnt vmcnt(0)" ::: "memory");
            if (lane == 0) __hip_atomic_fetch_add(cnt + 64 * (ex * 64 + u.pm), 1u, __ATOMIC_RELAXED, __HIP_MEMORY_SCOPE_AGENT); }
        if (wid == 0) { unsigned sp = 0;
            while ((unsigned)__builtin_amdgcn_readfirstlane(__hip_atomic_load(cnt + 64 * (ex * 64 + u.pm), __ATOMIC_RELAXED, __HIP_MEMORY_SCOPE_AGENT)) < 32u) {
                __builtin_amdgcn_s_sleep(1); if (++sp > (1u << 22)) { if (lane == 0) __hip_atomic_store(tmo, 1u, __ATOMIC_RELAXED, __HIP_MEMORY_SCOPE_AGENT); break; } } }
        asm volatile("s_waitcnt vmcnt(0) lgkmcnt(0)" ::: "memory"); __builtin_amdgcn_s_barrier(); asm volatile("" ::: "memory");
        if (tid < 256) { const float* q = sl + (size_t)(u.pm * BM + tid) * 8; float t = 0.f;
#pragma unroll
            for (int k = 0; k < 8; ++k) t += __hip_atomic_load(q + k, __ATOMIC_RELAXED, __HIP_MEMORY_SCOPE_AGENT);
            S[tid] = t; }
        asm volatile("s_waitcnt vmcnt(0) lgkmcnt(0)" ::: "memory"); __builtin_amdgcn_s_barrier(); asm volatile("" ::: "memory");
        return S[rowl];
    }
    __device__ __forceinline__ void fused(f32x4 (&acc)[2][2][4][2], const Unit& u, int wr, int wc, int fr, int fq, PG8_LAS unsigned char* lds, int wid, int lane) const {
        PG8_LAS float* P = (PG8_LAS float*)lds; PG8_LAS float* S = (PG8_LAS float*)(lds + 4096);
        const int col0 = u.pn * BM + wc * 32 + 8 * fq;
        f32x4 gv[2][2];
#pragma unroll
        for (int bj = 0; bj < 2; ++bj)
#pragma unroll
            for (int n = 0; n < 2; ++n) gv[bj][n] = *(const f32x4*)(gpost + col0 + bj * HALF + 4 * n);
        u32x4 xw_[2][4][2];
#pragma unroll
        for (int ai = 0; ai < 2; ++ai)
#pragma unroll
            for (int m = 0; m < 4; ++m)
#pragma unroll
                for (int bj = 0; bj < 2; ++bj) xw_[ai][m][bj] = *(const u32x4*)(X + ((size_t)u.pm * BM + ai * HALF + wr * 64 + m * 16 + fr) * 2048 + col0 + bj * HALF);
        float ssq[2][4];
#pragma unroll
        for (int ai = 0; ai < 2; ++ai)
#pragma unroll
            for (int m = 0; m < 4; ++m) { float s = 0.f;
#pragma unroll
                for (int bj = 0; bj < 2; ++bj)
#pragma unroll
                    for (int n = 0; n < 2; ++n) { const f32x4 v = acc[ai][bj][m][n]; s += (v[0] * v[0] + v[1] * v[1]) + (v[2] * v[2] + v[3] * v[3]); }
                s += __shfl_xor(s, 16); s += __shfl_xor(s, 32); ssq[ai][m] = s; }
#pragma unroll
        for (int ai = 0; ai < 2; ++ai)
#pragma unroll
            for (int m = 0; m < 4; ++m) if (fq == 0) P[(ai * HALF + wr * 64 + m * 16 + fr) * 4 + wc] = ssq[ai][m];
        const float dummy1 = exchange(0.f, 0, u, P, S, wid, lane, wc, 0, false); (void)dummy1;
        float ss2[2][4];
#pragma unroll
        for (int ai = 0; ai < 2; ++ai)
#pragma unroll
            for (int m = 0; m < 4; ++m) { const int rl = ai * HALF + wr * 64 + m * 16 + fr; const size_t row = (size_t)u.pm * BM + rl;
                const float cr = coef * __builtin_amdgcn_rsqf(S[rl] * (1.0f / 2048.0f) + 1e-6f); float s2 = 0.f;
#pragma unroll
                for (int bj = 0; bj < 2; ++bj) { bf16_t* xp = X + row * 2048 + col0 + bj * HALF; const u32x4 xw = xw_[ai][m][bj];
                    f32x4 x0 = {__uint_as_float(xw.x << 16), __uint_as_float(xw.x & 0xffff0000u), __uint_as_float(xw.y << 16), __uint_as_float(xw.y & 0xffff0000u)};
                    f32x4 x1 = {__uint_as_float(xw.z << 16), __uint_as_float(xw.z & 0xffff0000u), __uint_as_float(xw.w << 16), __uint_as_float(xw.w & 0xffff0000u)};
                    x0 = x0 + acc[ai][bj][m][0] * gv[bj][0] * cr; x1 = x1 + acc[ai][bj][m][1] * gv[bj][1] * cr;
                    if (OUT) { float* op = OUT + row * 2048 + col0 + bj * HALF; *(f32x4*)op = x0; *(f32x4*)(op + 4) = x1; }
                    else { const u32x4 w = pack8(x0, x1); *(u32x4*)xp = w;
                        const float a0 = __uint_as_float(w.x << 16), a1 = __uint_as_float(w.x & 0xffff0000u), a2 = __uint_as_float(w.y << 16), a3 = __uint_as_float(w.y & 0xffff0000u);
                        const float a4 = __uint_as_float(w.z << 16), a5 = __uint_as_float(w.z & 0xffff0000u), a6 = __uint_as_float(w.w << 16), a7 = __uint_as_float(w.w & 0xffff0000u);
                        s2 += ((a0 * a0 + a1 * a1) + (a2 * a2 + a3 * a3)) + ((a4 * a4 + a5 * a5) + (a6 * a6 + a7 * a7)); } }
                s2 += __shfl_xor(s2, 16); s2 += __shfl_xor(s2, 32); ss2[ai][m] = s2; }
        if (OUT) return;
        asm volatile("s_waitcnt lgkmcnt(0)" ::: "memory"); __builtin_amdgcn_s_barrier(); asm volatile("" ::: "memory");
#pragma unroll
        for (int ai = 0; ai < 2; ++ai)
#pragma unroll
            for (int m = 0; m < 4; ++m) if (fq == 0) P[(ai * HALF + wr * 64 + m * 16 + fr) * 4 + wc] = ss2[ai][m];
        const float dummy2 = exchange(0.f, 1, u, P, S, wid, lane, wc, 0, false); (void)dummy2;
        if (u.pn == 0) { const int tid = wid * 64 + lane; if (tid < 256) rs[(size_t)u.pm * BM + tid] = __builtin_amdgcn_rsqf(S[tid] * (1.0f / 2048.0f) + 1e-6f); }
    }
};

template <class Epi, class Sched, bool ALIGN_EPI = false, bool SP2 = false>
__device__ __forceinline__ void gemm_phase(PG8_LAS unsigned char* lds, const Gemm g, const Sched& S, const Epi& E) {
    int tid_ = threadIdx.x; asm volatile("" : "+v"(tid_));
    const int tid = tid_, wid = __builtin_amdgcn_readfirstlane(tid >> 6), lane = tid & 63, wr = wid >> 2, wc = wid & 3, fr = lane & 15, fq = lane >> 4;
    int K_ = g.K; asm volatile("" : "+s"(K_));
    const int K = K_, nt = K / BK;
    unsigned voffA[2], voffB[2];
#pragma unroll
    for (int i = 0; i < 2; ++i) { int R, C; stage_rc(tid * 16 + i * 8192, R, C); const int Rb = Epi::PERM ? ((R & ~31) + perm32(R & 31)) : R;
        voffA[i] = (unsigned)(R * K + C) * 2u; voffB[i] = (unsigned)(Rb * K + C) * 2u; }
    const size_t kstep = (size_t)(BK * 2);
    const size_t hstep = (size_t)HALF * K * 2;
    const size_t tstep = 2 * hstep;
    const unsigned ldsw = (unsigned)wid * 1024u;
    const int aoff = lds_byte(wr * 64 + fr, fq * 8), boff = lds_byte(wc * 32 + fr, fq * 8);
#define PG8_SA(b, h) (((b) * 2 + (h)) * HTB)
#define PG8_SB(b, h) ((4 + (b) * 2 + (h)) * HTB)
#define PG8_STAGE(bufoff, gbase, voff) do { _Pragma("unroll") for (int _i = 0; _i < 2; ++_i) \
        __builtin_amdgcn_global_load_lds((const unsigned*)((const char*)(gbase) + (voff)[_i]), (PG8_LAS unsigned*)(lds + (bufoff) + ldsw + _i * 8192), 16, 0, 0); } while (0)
#define PG8_LDA(dst, b, h) do { _Pragma("unroll") for (int m = 0; m < 4; ++m) _Pragma("unroll") for (int k = 0; k < 2; ++k) dst[m][k] = *(const PG8_LAS bf16x8*)(lds + PG8_SA(b, h) + aoff + m * 2048 + k * 1024); } while (0)
#define PG8_LDB(dst, b, h) do { _Pragma("unroll") for (int n = 0; n < 2; ++n) _Pragma("unroll") for (int k = 0; k < 2; ++k) dst[n][k] = *(const PG8_LAS bf16x8*)(lds + PG8_SB(b, h) + boff + n * 2048 + k * 1024); } while (0)
#define PG8_MMA(ai, bj, At, Bt) do { __builtin_amdgcn_s_setprio(1); _Pragma("unroll") for (int m = 0; m < 4; ++m) _Pragma("unroll") for (int n = 0; n < 2; ++n) _Pragma("unroll") for (int k = 0; k < 2; ++k) \
        acc[ai][bj][m][n] = __builtin_amdgcn_mfma_f32_16x16x32_bf16(Bt[n][k], At[m][k], acc[ai][bj][m][n], 0, 0, 0); __builtin_amdgcn_s_setprio(0); } while (0)
#define PG8_WAIT_V(n) asm volatile("s_waitcnt vmcnt(" #n ")" ::: "memory")
#define PG8_WAIT_L(n) asm volatile("s_waitcnt lgkmcnt(" #n ")" ::: "memory")
#define PG8_BAR __builtin_amdgcn_s_barrier()
#define PG8_SCHED __builtin_amdgcn_sched_barrier(0)
    Unit cur, nxt; int ui = 0;
    if (!S.next(0, cur)) return;
    f32x4 acc[2][2][4][2];
#pragma unroll
    for (int a = 0; a < 2; ++a)
#pragma unroll
        for (int b = 0; b < 2; ++b)
#pragma unroll
            for (int m = 0; m < 4; ++m)
#pragma unroll
                for (int n = 0; n < 2; ++n) acc[a][b][m][n] = (f32x4){0.f, 0.f, 0.f, 0.f};
    bf16x8 At[4][2], B0[2][2], B1[2][2];
    const char* cA = (const char*)g.A + (size_t)cur.pm * tstep; const char* cB = (const char*)g.Bt + (size_t)cur.pn * tstep;
    S.a_ready(cur);
    if constexpr (SP2) {
        PG8_STAGE(PG8_SB(0, 0), cB, voffB); PG8_STAGE(PG8_SB(0, 1), cB + hstep, voffB); PG8_STAGE(PG8_SA(0, 0), cA, voffA); PG8_STAGE(PG8_SA(0, 1), cA + hstep, voffA);
        if (wr == 1) PG8_BAR;
        PG8_WAIT_V(2); PG8_BAR;
        PG8_STAGE(PG8_SB(1, 0), cB + kstep, voffB); PG8_STAGE(PG8_SA(1, 0), cA + kstep, voffA); PG8_STAGE(PG8_SB(1, 1), cB + hstep + kstep, voffB);
        PG8_WAIT_V(6); PG8_BAR;
    } else {
        PG8_STAGE(PG8_SB(0, 0), cB, voffB); PG8_STAGE(PG8_SA(0, 0), cA, voffA); PG8_STAGE(PG8_SB(0, 1), cB + hstep, voffB); PG8_STAGE(PG8_SA(0, 1), cA + hstep, voffA);
        if (wr == 1) PG8_BAR;
        PG8_WAIT_V(4); PG8_BAR;
        PG8_STAGE(PG8_SB(1, 0), cB + kstep, voffB); PG8_STAGE(PG8_SA(1, 0), cA + kstep, voffA); PG8_STAGE(PG8_SB(1, 1), cB + hstep + kstep, voffB);
        PG8_WAIT_V(6); PG8_BAR;
    }
    for (;;) {
        const bool has_next = S.next(ui + 1, nxt);
        const char* nA = has_next ? (const char*)g.A + (size_t)nxt.pm * tstep : cA; const char* nB = has_next ? (const char*)g.Bt + (size_t)nxt.pn * tstep : cB;
        for (int t = 0; t < nt; t += 2) {
            const bool last = (t == nt - 2);
            const char* a1 = cA + (size_t)(t + 1) * kstep;
            const char* a2 = last ? nA : cA + (size_t)(t + 2) * kstep; const char* b2 = last ? nB : cB + (size_t)(t + 2) * kstep;
            const char* a3 = a2 + kstep; const char* b3 = b2 + kstep;
            if (last && has_next) S.a_ready(nxt);
            if constexpr (SP2) {
            PG8_LDB(B0, 0, 0); PG8_LDB(B1, 0, 1); PG8_SCHED; PG8_LDA(At, 0, 0); PG8_STAGE(PG8_SA(1, 1), a1 + hstep, voffA);
            PG8_WAIT_V(8); PG8_WAIT_L(0); PG8_BAR; PG8_MMA(0, 0, At, B0); PG8_MMA(0, 1, At, B1); PG8_BAR; PG8_SCHED;
            PG8_LDA(At, 0, 1); PG8_STAGE(PG8_SB(0, 0), b2, voffB); PG8_STAGE(PG8_SB(0, 1), b2 + hstep, voffB); PG8_STAGE(PG8_SA(0, 0), a2, voffA);
            PG8_WAIT_V(8); PG8_WAIT_L(0); PG8_BAR; PG8_MMA(1, 0, At, B0); PG8_MMA(1, 1, At, B1); PG8_BAR; PG8_SCHED;
            PG8_LDB(B0, 1, 0); PG8_LDB(B1, 1, 1); PG8_SCHED; PG8_LDA(At, 1, 0); PG8_STAGE(PG8_SA(0, 1), a2 + hstep, voffA);
            PG8_WAIT_V(8); PG8_WAIT_L(0); PG8_BAR; PG8_MMA(0, 0, At, B0); PG8_MMA(0, 1, At, B1); PG8_BAR; PG8_SCHED;
            PG8_LDA(At, 1, 1); PG8_STAGE(PG8_SB(1, 0), b3, voffB); PG8_STAGE(PG8_SB(1, 1), b3 + hstep, voffB); PG8_STAGE(PG8_SA(1, 0), a3, voffA);
            PG8_WAIT_V(8); PG8_WAIT_L(0); PG8_BAR; PG8_MMA(1, 0, At, B0); PG8_MMA(1, 1, At, B1); PG8_BAR; PG8_SCHED;
            } else {
            PG8_LDB(B0, 0, 0); PG8_SCHED; PG8_LDA(At, 0, 0); PG8_STAGE(PG8_SA(1, 1), a1 + hstep, voffA);
            PG8_WAIT_L(8); PG8_BAR; PG8_WAIT_L(0); PG8_MMA(0, 0, At, B0); PG8_BAR; PG8_SCHED;
            PG8_LDB(B1, 0, 1); PG8_STAGE(PG8_SB(0, 0), b2, voffB);
            PG8_BAR; PG8_WAIT_L(0); PG8_MMA(0, 1, At, B1); PG8_BAR;
            PG8_LDA(At, 0, 1); PG8_STAGE(PG8_SA(0, 0), a2, voffA);
            PG8_BAR; PG8_WAIT_L(0); PG8_MMA(1, 0, At, B0); PG8_BAR; PG8_SCHED;
            PG8_STAGE(PG8_SB(0, 1), b2 + hstep, voffB);
            PG8_WAIT_V(6); PG8_BAR; PG8_MMA(1, 1, At, B1); PG8_BAR;
            PG8_LDB(B0, 1, 0); PG8_SCHED; PG8_LDA(At, 1, 0); PG8_STAGE(PG8_SA(0, 1), a2 + hstep, voffA);
            PG8_WAIT_L(8); PG8_BAR; PG8_WAIT_L(0); PG8_MMA(0, 0, At, B0); PG8_BAR; PG8_SCHED;
            PG8_LDB(B1, 1, 1); PG8_STAGE(PG8_SB(1, 0), b3, voffB);
            PG8_BAR; PG8_WAIT_L(0); PG8_MMA(0, 1, At, B1); PG8_BAR;
            PG8_LDA(At, 1, 1); PG8_STAGE(PG8_SA(1, 0), a3, voffA);
            PG8_BAR; PG8_WAIT_L(0); PG8_MMA(1, 0, At, B0); PG8_BAR; PG8_SCHED;
            PG8_STAGE(PG8_SB(1, 1), b3 + hstep, voffB);
            PG8_WAIT_V(6); PG8_BAR; PG8_MMA(1, 1, At, B1); PG8_BAR;
            }
        }
        if constexpr (ALIGN_EPI) { if (wr == 0) PG8_BAR; }
        if constexpr (!Epi::AFTER_DRAIN) { E(acc, cur, wr, wc, fr, fq); S.done(cur); }
        if (!has_next) break;
#pragma unroll
        for (int a = 0; a < 2; ++a)
#pragma unroll
            for (int b = 0; b < 2; ++b)
#pragma unroll
                for (int m = 0; m < 4; ++m)
#pragma unroll
                    for (int n = 0; n < 2; ++n) acc[a][b][m][n] = (f32x4){0.f, 0.f, 0.f, 0.f};
        cur = nxt; cA = nA; cB = nB; ++ui;
        if constexpr (ALIGN_EPI) { if (wr == 1) PG8_BAR; }
    }
    PG8_WAIT_V(0);
    if constexpr (!ALIGN_EPI) { if (wr == 0) PG8_BAR; }
    PG8_BAR;
    if constexpr (Epi::AFTER_DRAIN) { E.fused(acc, cur, wr, wc, fr, fq, lds, wid, lane); S.done(cur); }
#undef PG8_SA
#undef PG8_SB
#undef PG8_STAGE
#undef PG8_LDA
#undef PG8_LDB
#undef PG8_MMA
#undef PG8_WAIT_V
#undef PG8_WAIT_L
#undef PG8_BAR
#undef PG8_SCHED
}
}
#define GAS __attribute__((address_space(1)))
#define LAS __attribute__((address_space(3)))
typedef unsigned short bf16;
typedef unsigned v4u __attribute__((ext_vector_type(4)));
typedef float f32x4 __attribute__((ext_vector_type(4)));
typedef short bf16x8 __attribute__((ext_vector_type(8)));
typedef GAS unsigned gu32;
typedef GAS unsigned long long gu64;
#define RLX_AGENT __ATOMIC_RELAXED, __HIP_MEMORY_SCOPE_AGENT
#define LDS_WAIT() asm volatile("s_waitcnt lgkmcnt(0)" ::: "memory")
#define VM_WAIT() asm volatile("s_waitcnt vmcnt(0)" ::: "memory")
__device__ __forceinline__ unsigned long long rt() { return __builtin_amdgcn_s_memrealtime(); }
__device__ __forceinline__ unsigned f2bf(float f) { unsigned u = __builtin_bit_cast(unsigned, f); return (u + 0x7fffu + ((u >> 16) & 1u)) >> 16; }
__device__ __forceinline__ unsigned pk2(float lo, float hi) { return f2bf(lo) | (f2bf(hi) << 16); }
#define XB_TMO      128
#define XB_XCNT(j)  (256  + 64 * (j))
#define XB_XSUB(j)  (1280 + 64 * (j))
#define XB_XGEN(j)  (2304 + 64 * (j))
#define XB_TOP      3328
#define XB_TOPGEN   3392
#define XCD_BAR_WORDS 3456
#define XB_SPIN_CAP (1u << 18)

__device__ __forceinline__ unsigned xb_ld(unsigned* p)              { return __hip_atomic_load(p, __ATOMIC_RELAXED, __HIP_MEMORY_SCOPE_AGENT); }
__device__ __forceinline__ unsigned xb_add(unsigned* p, unsigned v) { return __hip_atomic_fetch_add(p, v, __ATOMIC_RELAXED, __HIP_MEMORY_SCOPE_AGENT); }
__device__ __forceinline__ unsigned xb_xcc_id() { return (unsigned)__builtin_amdgcn_s_getreg((3 << 11) | 20) & 0xFu; }
#define XB_SPIN(cond, bar) do { unsigned _sp = 0; while (cond) { __builtin_amdgcn_s_sleep(1); \
    if ((++_sp & 255u) == 0u) { if (xb_ld(&(bar)[XB_TMO])) break; if (_sp > XB_SPIN_CAP) { atomicAdd(&(bar)[XB_TMO], 1u); break; } } } } while (0)

struct XcdBarrier {
    unsigned* bar; unsigned x;
    volatile LAS unsigned* st;
};

__device__ __forceinline__ XcdBarrier xcd_barrier_post(unsigned* bar, volatile LAS unsigned* st) {
    XcdBarrier b; b.bar = bar; b.x = xb_xcc_id(); b.st = st;
    if (threadIdx.x == 0) (void)xb_add(&bar[XB_XCNT(b.x)], 1u);
    return b;
}
__device__ __forceinline__ void xcd_barrier_complete(unsigned* bar, unsigned x, unsigned& nloc, unsigned& nx) {
    const unsigned G = gridDim.x * gridDim.y * gridDim.z;
    unsigned sum, cnt, mine, sp = 0u;
    for (;;) {
        sum = 0u; cnt = 0u; mine = 0u;
#pragma unroll
        for (unsigned j = 0; j < 16; ++j) { const unsigned c = xb_ld(&bar[XB_XCNT(j)]); sum += c; cnt += (c > 0u) ? 1u : 0u; mine = (j == x) ? c : mine; }
        if (sum == G) break;
        __builtin_amdgcn_s_sleep(1);
        if ((++sp & 255u) == 0u) { if (xb_ld(&bar[XB_TMO])) break; if (sp > XB_SPIN_CAP) { atomicAdd(&bar[XB_TMO], 1u); break; } }
    }
    nloc = mine > 0u ? mine : 1u; nx = cnt > 0u ? cnt : 1u;
}

__device__ __forceinline__ void xcd_barrier(const XcdBarrier& b) {
    asm volatile("s_waitcnt vmcnt(0)" ::: "memory");
    __syncthreads();
    if (threadIdx.x == 0) {
        unsigned* bar = b.bar;
        __builtin_amdgcn_s_waitcnt(0);
        unsigned nloc = b.st[0], nx = b.st[1];
        if (nloc == 0u) { xcd_barrier_complete(bar, b.x, nloc, nx); b.st[0] = nloc; b.st[1] = nx; }
        const unsigned old = xb_add(&bar[XB_XSUB(b.x)], 1u);
        const unsigned gen = old / nloc;
        if (old + 1u == (gen + 1u) * nloc) {
            __builtin_amdgcn_fence(__ATOMIC_RELEASE, "agent");
            asm volatile("s_waitcnt vmcnt(0)" ::: "memory");
            const unsigned og = xb_add(&bar[XB_TOP], 1u);
            const unsigned tg = og / nx;
            if (og + 1u == (tg + 1u) * nx) xb_add(&bar[XB_TOPGEN], 1u);
            else XB_SPIN(xb_ld(&bar[XB_TOPGEN]) == tg, bar);
            __builtin_amdgcn_fence(__ATOMIC_ACQUIRE, "agent");
            xb_add(&bar[XB_XGEN(b.x)], 1u);
            asm volatile("s_waitcnt vmcnt(0)" ::: "memory");
        } else {
            XB_SPIN(xb_ld(&bar[XB_XGEN(b.x)]) == gen, bar);
            __builtin_amdgcn_fence(__ATOMIC_ACQUIRE, "agent");
            asm volatile("s_waitcnt vmcnt(0)" ::: "memory");
        }
    }
    __syncthreads();
}

constexpr int NWAVES = 8;
#ifndef MK_MULTI
#define MK_MULTI 0
#endif
#ifndef SCAN_DPP
#define SCAN_DPP 1
#endif

#ifndef EXTRA_BAR
#define EXTRA_BAR 0
#endif
#ifndef REP_PRO
#define REP_PRO 1
#endif
#ifndef REP_GU
#define REP_GU 1
#endif
#ifndef REP_DN
#define REP_DN 1
#endif
#ifndef REP_ROW
#define REP_ROW 1
#endif
#ifndef REP_WIN
#define REP_WIN 1
#endif
#ifndef REP_PREP
#define REP_PREP 1
#endif
#ifndef REP_LORA
#define REP_LORA 1
#endif
#ifndef REP_MIX
#define REP_MIX 1
#endif
#ifndef REP_ATT
#define REP_ATT 1
#endif
#ifndef REP_S1
#define REP_S1 1
#endif
#ifndef REP_S2
#define REP_S2 1
#endif
#ifndef REP_S3
#define REP_S3 1
#endif
#ifndef REP_COMB
#define REP_COMB 1
#endif
#ifndef REP_WOUT
#define REP_WOUT 1
#endif

constexpr int BATCH = 8, SEQ = 2048, D = 2048, M = BATCH * SEQ, FF = 5632, NL = 4;
constexpr int NH = 12, HD = 64, DATT = 768, DRW = 768, DPOOL = 512;
constexpr int DRWIN = 2752, DIN = 5568, DINP = 5632, ZRP = 2816;
constexpr int LORA_K = 512, LORA_N = 2304;
constexpr float NORM_EPS = 1e-6f, GN_EPS = 64e-5f;
constexpr float QSCALE = 0.125f * 1.4426950408889634f;
constexpr int NPH = 1 + 8 * 2 + 4 * 7;

constexpr size_t MiB = 1u << 20;
constexpr size_t WS_CTL = 0, CTL_ZERO_BYTES = 1 * MiB;
constexpr size_t WS_COS = 1 * MiB, WS_SIN = 1 * MiB + 256 * 1024, WS_RS = 1 * MiB + 512 * 1024;
constexpr size_t WS_W = 2 * MiB, LW = 165 * MiB;
constexpr size_t LW_GU1 = 0, LW_D1 = 44 * MiB, LW_IN = 66 * MiB, LW_OUT = 88 * MiB, LW_GU2 = 96 * MiB, LW_D2 = 140 * MiB, LW_LORA = 162 * MiB, LW_POOL = 164 * MiB + 256 * 1024;
constexpr size_t WS_H = WS_W + NL * LW;
constexpr size_t WS_HID = WS_H + 64 * MiB;
constexpr size_t SQ_STRIDE = 22 * MiB, SQ_Q = 0, SQ_K = 3 * MiB, SQ_V = 6 * MiB, SQ_ZR = 9 * MiB, SQ_ZP = 20 * MiB;
static_assert((size_t)SEQ * FF * 2 == SQ_STRIDE && SQ_ZR + (size_t)SEQ * ZRP * 2 == SQ_ZP && SQ_ZP + (size_t)SEQ * 512 * 2 == SQ_STRIDE && (size_t)NH * SEQ * 64 * 2 == 3 * MiB, "per-sequence overlay");
constexpr size_t WS_Y = WS_HID + 176 * MiB;
constexpr size_t WS_CAT = WS_Y + 64 * MiB;
constexpr size_t WS_OG = WS_CAT + 64 * MiB;
constexpr size_t WS_LSE = WS_OG + 72 * MiB;
constexpr size_t WS_LA = WS_LSE + 3 * MiB;
constexpr size_t WS_PP = WS_LA + 16 * MiB;
constexpr size_t WS_L = WS_PP + 16 * MiB, WS_LB = WS_L, WS_XB = WS_L + 72 * MiB;
constexpr size_t WS_END = WS_L + 144 * MiB;
static_assert(WS_HID + BATCH * SQ_STRIDE <= WS_Y && LW_POOL + 512 * 512 * 2 <= LW && LW_LORA + (size_t)LORA_N * LORA_K * 2 <= LW_POOL, "d_ws map");
constexpr int CW_TMO = 0, CW_CODE = 1, CW_BAR = 4096, CW_ATTQ = 8192  , CW_RANK = 11264  , CW_GB = 12288  , CW_XC = 16384, XC_USE = 2 * 64 * 64;
static_assert((CW_XC + 12 * XC_USE) * 4 <= (int)CTL_ZERO_BYTES, "control words");

constexpr int RING_OFF = 0, RING_BYTES = 131072;
constexpr int LDSCTL_OFF = RING_BYTES, MISC_OFF = LDSCTL_OFF + 320;
constexpr int LDS_BYTES = 147456;

struct Args { const float* in[28]; float* out; unsigned char* ws; int ph_lo, ph_hi; };
struct ArgsD { const __attribute__((address_space(1))) float* in[28]; __attribute__((address_space(1))) float* out; __attribute__((address_space(1))) unsigned char* ws; int ph_lo, ph_hi; };
static_assert(sizeof(ArgsD) == sizeof(Args), "Args views");
typedef const __attribute__((address_space(4))) ArgsD KArgs;
#define INP(A, k) ((const float*)(A)->in[k])

typedef unsigned long long u64t;
typedef float f32x2g __attribute__((ext_vector_type(2)));
struct Frame {
    LAS unsigned char* lds;
    int wave, vcu, G, tid;
    int bi, nb, seq;
    float* X;
    unsigned char* ws;
};
__device__ __forceinline__ float bf2f(bf16 u) { return __uint_as_float((unsigned)u << 16); }
__device__ __forceinline__ float wave_sum(float v) {
#pragma unroll
    for (int o = 1; o < 64; o <<= 1) v += __shfl_xor(v, o);
    return v;
}
__device__ __forceinline__ float sigmoid_f(float x) { return __builtin_amdgcn_rcpf(1.0f + __builtin_amdgcn_exp2f(-1.4426950408889634f * x)); }

template <class SrcF>
__device__ __forceinline__ void transpose_item(const SrcF src, int ldw, int K, bf16* WT, LAS float* scr, int item, int nblk, int lane, const float* kgain = nullptr) {
    const int kb = item / nblk, nb = item % nblk, k0 = 64 * kb, n0 = 32 * nb;
    const float* colp = src(n0 + (lane & 31));
    float tv[32];
    const GAS float* cp = (const GAS float*)colp + (size_t)(k0 + (lane >> 5)) * ldw;
#pragma unroll
    for (int i = 0; i < 32; ++i) tv[i] = colp ? cp[(size_t)(2 * i) * ldw] : 0.f;
#pragma unroll
    for (int i = 0; i < 32; ++i) scr[(2 * i + (lane >> 5)) * 33 + (lane & 31)] = tv[i];
    LDS_WAIT(); asm volatile("" ::: "memory");
    const int c = lane & 7;
    f32x4 g0 = (f32x4){1.f, 1.f, 1.f, 1.f}, g1 = g0;
    if (kgain) { g0 = *(const GAS f32x4*)(kgain + k0 + 8 * c); g1 = *(const GAS f32x4*)(kgain + k0 + 8 * c + 4); }
#pragma unroll
    for (int j = 0; j < 4; ++j) { const int n = (lane >> 3) + 8 * j; const LAS float* s = scr + (8 * c) * 33 + n;
        v4u o; o.x = pk2(s[0 * 33] * g0[0], s[1 * 33] * g0[1]); o.y = pk2(s[2 * 33] * g0[2], s[3 * 33] * g0[3]); o.z = pk2(s[4 * 33] * g1[0], s[5 * 33] * g1[1]); o.w = pk2(s[6 * 33] * g1[2], s[7 * 33] * g1[3]);
        *(GAS v4u*)(WT + (size_t)(n0 + n) * K + k0 + 8 * c) = o; }
    LDS_WAIT(); asm volatile("" ::: "memory");
}
struct SrcGU { const float* g; long du;
    __device__ __forceinline__ const float* operator()(int n) const { const int col = 128 * (n >> 8) + (n & 127); const long off = ((n >> 7) & 1) ? du : 0l; return (const float*)((const char*)g + off) + col; } };
struct SrcPlain { const float* w; __device__ __forceinline__ const float* operator()(int n) const { return w + n; } };
struct SrcWin { const float* w;
    __device__ __forceinline__ const float* operator()(int n) const {
        if (n < 1536) { const int sec = n / 768, r = n % 768, h = r >> 6, j = r & 63, d = 4 * (j >> 3) + (j & 3) + 32 * ((j >> 2) & 1); return w + sec * 768 + h * 64 + d; }
        if (n < 2304 + DRWIN) return w + n;
        if (n < 2304 + ZRP) return nullptr;
        return w + (n - (ZRP - DRWIN));
    } };

__device__ __forceinline__ void x_row_init(Frame& F, const float* xrow, bf16* xb, float* rs) {
    const GAS f32x4* xr = (const GAS f32x4*)xrow + (F.tid & 63);
    f32x4 v[8]; float s = 0.f;
#pragma unroll
    for (int j = 0; j < 8; ++j) { v[j] = xr[64 * j]; s += (v[j].x * v[j].x + v[j].y * v[j].y) + (v[j].z * v[j].z + v[j].w * v[j].w); }
    const float rstd = 1.0f / sqrtf(wave_sum(s) * (1.f / D) + NORM_EPS);
    GAS u64t* o8 = (GAS u64t*)xb + (F.tid & 63);
#pragma unroll
    for (int j = 0; j < 8; ++j) o8[64 * j] = (u64t)pk2(v[j].x, v[j].y) | ((u64t)pk2(v[j].z, v[j].w) << 32);
    if ((F.tid & 63) == 0) *rs = rstd;
}

__device__ __forceinline__ void p0_prologue_w(Frame& F, KArgs* A);
__device__ __forceinline__ void p0_prologue(Frame& F, KArgs* A) {
    p0_prologue_w(F, A);
    const int gw = F.vcu * NWAVES + F.wave, NGW = F.G * NWAVES;
    for (int m = gw; m < M; m += NGW) x_row_init(F, INP(A, 0) + (size_t)m * D, ((bf16*)(F.ws + WS_XB)) + (size_t)m * D, ((float*)(F.ws + WS_RS)) + m);
}
__device__ __forceinline__ void p0_prologue_w(Frame& F, KArgs* A) {
    LAS float* scr = (LAS float*)(F.lds + RING_OFF + F.wave * 16384);
    const int gw = F.vcu * NWAVES + F.wave, NGW = F.G * NWAVES;
    constexpr int I_GU = (D / 64) * (2 * FF / 32), I_D = (FF / 64) * (D / 32), I_IN = (D / 64) * (DINP / 32), I_OUT = (D / 64) * (D / 32);
    constexpr int I_L = 2 * I_GU + 2 * I_D + I_IN + I_OUT;
    for (int it = gw; it < NL * I_L; it += NGW) {
        const int l = it / I_L; int r = it % I_L;
        unsigned char* wl = F.ws + WS_W + (size_t)l * LW;
        const size_t offF = (size_t)l * D * FF;
        if (r < I_GU) { transpose_item(SrcGU{INP(A, 3) + offF, (long)((const char*)INP(A, 4) - (const char*)INP(A, 3))}, FF, D, (bf16*)(wl + LW_GU1), scr, r, 2 * FF / 32, (F.tid & 63), INP(A, 1) + (size_t)l * D); continue; } r -= I_GU;
        if (r < I_D) { transpose_item(SrcPlain{INP(A, 5) + offF}, D, FF, (bf16*)(wl + LW_D1), scr, r, D / 32, (F.tid & 63)); continue; } r -= I_D;
        if (r < I_IN) { transpose_item(SrcWin{INP(A, 8) + (size_t)l * D * DIN}, DIN, D, (bf16*)(wl + LW_IN), scr, r, DINP / 32, (F.tid & 63), INP(A, 6) + (size_t)l * D); continue; } r -= I_IN;
        if (r < I_OUT) { transpose_item(SrcPlain{INP(A, 9) + (size_t)l * D * D}, D, D, (bf16*)(wl + LW_OUT), scr, r, D / 32, (F.tid & 63)); continue; } r -= I_OUT;
        if (r < I_GU) { transpose_item(SrcGU{INP(A, 25) + offF, (long)((const char*)INP(A, 26) - (const char*)INP(A, 25))}, FF, D, (bf16*)(wl + LW_GU2), scr, r, 2 * FF / 32, (F.tid & 63), INP(A, 23) + (size_t)l * D); continue; } r -= I_GU;
        transpose_item(SrcPlain{INP(A, 27) + offF}, D, FF, (bf16*)(wl + LW_D2), scr, r, D / 32, (F.tid & 63));
    }
    const int gt = F.vcu * (NWAVES * 64) + F.tid, NGT = F.G * NWAVES * 64;
    constexpr int E_LORA = LORA_N * LORA_K, E_POOL = 512 * 512, E_L = E_LORA + E_POOL;
    for (int e = gt; e < NL * E_L; e += NGT) {
        const int l = e / E_L; int r = e % E_L;
        unsigned char* wl = F.ws + WS_W + (size_t)l * LW;
        if (r < E_LORA) { const int n = r / LORA_K, k = r % LORA_K; float v = 0.f;
            if (n < 768) { if (k < 96) v = INP(A, 11)[(size_t)l * 96 * 768 + k * 768 + n]; }
            else if (n < 1536) { if (k >= 96 && k < 192) v = INP(A, 13)[(size_t)l * 96 * 768 + (k - 96) * 768 + (n - 768)]; }
            else { if (k >= 192 && k < 448) v = INP(A, 15)[(size_t)l * 256 * 768 + (k - 192) * 768 + (n - 1536)]; }
            ((bf16*)(wl + LW_LORA))[r] = (bf16)f2bf(v);
        } else { r -= E_LORA; const int n = r / 512, k = r % 512; float v = 0.f;
            if ((n >> 7) == (k >> 7)) v = INP(A, 21)[(size_t)l * 4 * 128 * 128 + (size_t)(n >> 7) * 128 * 128 + (k & 127) * 128 + (n & 127)];
            ((bf16*)(wl + LW_POOL))[r] = (bf16)f2bf(v);
        }
    }
    for (int e = gt; e < SEQ * 32; e += NGT) {
        const int pos = e >> 5, i = e & 31;
        const float invf = powf(10000.0f, -(float)i / 32.0f);
        const double rev = (double)pos * (double)invf * 0.15915494309189535;
        const float fr = (float)(rev - rint(rev));
        ((float*)(F.ws + WS_COS))[e] = __builtin_amdgcn_cosf(fr); ((float*)(F.ws + WS_SIN))[e] = __builtin_amdgcn_sinf(fr);
    }
}

__device__ __forceinline__ void row_pass(Frame& F, float coef, const float* gpost, bool last) {
    const int gw = F.vcu * NWAVES + F.wave, NGW = F.G * NWAVES, lane = F.tid & 63;
    for (int m = gw; m < M; m += NGW) {
        GAS u64t* xr = (GAS u64t*)(((bf16*)(F.ws + WS_XB)) + (size_t)m * D) + lane; const GAS u64t* yr = (const GAS u64t*)(((bf16*)(F.ws + WS_Y)) + (size_t)m * D) + lane;
        const GAS f32x4* gp = (const GAS f32x4*)gpost + lane;
        f32x4 xv[8], yv[8]; float s = 0.f;
#pragma unroll
        for (int j = 0; j < 8; ++j) { const u64t xw = xr[64 * j], w = yr[64 * j];
            xv[j].x = __uint_as_float((unsigned)(xw << 16)); xv[j].y = __uint_as_float((unsigned)xw & 0xffff0000u); xv[j].z = __uint_as_float((unsigned)(xw >> 32) << 16); xv[j].w = __uint_as_float((unsigned)(xw >> 32) & 0xffff0000u);
            yv[j].x = __uint_as_float((unsigned)(w << 16)); yv[j].y = __uint_as_float((unsigned)w & 0xffff0000u); yv[j].z = __uint_as_float((unsigned)(w >> 32) << 16); yv[j].w = __uint_as_float((unsigned)(w >> 32) & 0xffff0000u);
            s += (yv[j].x * yv[j].x + yv[j].y * yv[j].y) + (yv[j].z * yv[j].z + yv[j].w * yv[j].w); }
        const float cr = coef / sqrtf(wave_sum(s) * (1.f / D) + NORM_EPS); float s2 = 0.f;
        if (last) {
            GAS f32x4* xo = (GAS f32x4*)(F.X + (size_t)m * D) + lane;
#pragma unroll
            for (int j = 0; j < 8; ++j) { const f32x4 g = gp[64 * j]; xo[64 * j] = xv[j] + yv[j] * g * cr; }
        } else {
#pragma unroll
            for (int j = 0; j < 8; ++j) { const f32x4 g = gp[64 * j]; xv[j] = xv[j] + yv[j] * g * cr;
                const unsigned lo = pk2(xv[j].x, xv[j].y), hi = pk2(xv[j].z, xv[j].w); xr[64 * j] = (u64t)lo | ((u64t)hi << 32);
                const float a0 = __uint_as_float(lo << 16), a1 = __uint_as_float(lo & 0xffff0000u), a2 = __uint_as_float(hi << 16), a3 = __uint_as_float(hi & 0xffff0000u);
                s2 += (a0 * a0 + a1 * a1) + (a2 * a2 + a3 * a3); }
            const float rstd = 1.0f / sqrtf(wave_sum(s2) * (1.f / D) + NORM_EPS);
            if (lane == 0) ((float*)(F.ws + WS_RS))[m] = rstd;
        }
    }
}
__device__ __forceinline__ float tanh_f(float x) { return 1.0f - 2.0f * __builtin_amdgcn_rcpf(1.0f + __builtin_amdgcn_exp2f(2.8853900817779268f * x)); }
__device__ __forceinline__ void unpack8(const v4u z, float (&f)[8]) {
#pragma unroll
    for (int e = 0; e < 4; ++e) { f[2 * e] = __uint_as_float(z[e] << 16); f[2 * e + 1] = __uint_as_float(z[e] & 0xffff0000u); }
}
__device__ __forceinline__ void mix_prep(Frame& F, KArgs* A, int l) {
    const int gw = F.bi * NWAVES + F.wave, NGW = F.nb * NWAVES, lane = F.tid & 63;
    const float* mu = INP(A, 10) + (size_t)l * DRWIN + 2304;
    f32x4 mu0 = (f32x4){0.f, 0.f, 0.f, 0.f}, mu1 = mu0;
    if (lane < 56) { mu0 = *(const GAS f32x4*)(mu + 8 * lane); mu1 = *(const GAS f32x4*)(mu + 8 * lane + 4); }
    const int pw = 2 << (lane >> 4);
    const int per = (SEQ + NGW - 1) / NGW, r_lo = gw * per, r_hi = (r_lo + per < SEQ) ? r_lo + per : SEQ, m_lo = F.seq * SEQ + r_lo, m_hi = F.seq * SEQ + r_hi;
    for (int m = m_lo; m < m_hi; ++m) {
        const int s = m & (SEQ - 1);
        const unsigned char* sqb = F.ws + WS_HID + (size_t)(m >> 11) * SQ_STRIDE;
        const bf16* zr = ((const bf16*)(sqb + SQ_ZR)) + (size_t)s * ZRP + 2304 + 8 * (lane < 56 ? lane : 0);
        const bf16* zp = ((const bf16*)(sqb + SQ_ZP)) + (size_t)s * 512 + 8 * lane;
        const int cnt = (s + 1 < pw) ? s + 1 : pw;
        v4u zc = (v4u){0u, 0u, 0u, 0u}, zq = zc, zw[16];
        if (lane < 56) { zc = *(const GAS v4u*)zr; if (s > 0) zq = *(const GAS v4u*)(zr - ZRP); }
#pragma unroll
        for (int i = 0; i < 16; ++i) { zw[i] = (v4u){0u, 0u, 0u, 0u}; if (i < cnt) zw[i] = *(const GAS v4u*)(zp - (size_t)i * 512); }
        v4u outv = (v4u){0u, 0u, 0u, 0u};
        if (lane < 56) {
            float z[8], zpv[8], v[8]; unpack8(zc, z); unpack8(zq, zpv);
#pragma unroll
            for (int e = 0; e < 8; ++e) { const float mm = e < 4 ? mu0[e] : mu1[e - 4], zs = z[e] + (zpv[e] - z[e]) * mm; v[e] = lane < 12 ? tanh_f(zs) : (lane < 24 ? zs : sigmoid_f(zs)); }
            outv.x = pk2(v[0], v[1]); outv.y = pk2(v[2], v[3]); outv.z = pk2(v[4], v[5]); outv.w = pk2(v[6], v[7]);
        }
        *(GAS v4u*)(((bf16*)(F.ws + WS_LA)) + (size_t)m * LORA_K + 8 * lane) = outv;
        float acc[8], u[8]; unpack8(zw[0], u);
#pragma unroll
        for (int e = 0; e < 8; ++e) acc[e] = u[e];
#pragma unroll
        for (int i = 1; i < 16; ++i) { float t[8]; unpack8(zw[i], t);
#pragma unroll
            for (int e = 0; e < 8; ++e) acc[e] += t[e]; }
        const float ic = 1.0f / (float)cnt;
        v4u pv; pv.x = pk2(acc[0] * ic - u[0], acc[1] * ic - u[1]); pv.y = pk2(acc[2] * ic - u[2], acc[3] * ic - u[3]); pv.z = pk2(acc[4] * ic - u[4], acc[5] * ic - u[5]); pv.w = pk2(acc[6] * ic - u[6], acc[7] * ic - u[7]);
        *(GAS v4u*)(((bf16*)(F.ws + WS_PP)) + (size_t)m * 512 + 8 * lane) = pv;
    }
}
__device__ __forceinline__ void attn_combine(Frame& F) {
    const int gw = F.bi * NWAVES + F.wave, NGW = F.nb * NWAVES, lane = F.tid & 63;
    const float* LSE = (const float*)(F.ws + WS_LSE); const bf16* OG = (const bf16*)(F.ws + WS_OG); bf16* CAT = (bf16*)(F.ws + WS_CAT);
    const int per = (SEQ + NGW - 1) / NGW, r_lo = gw * per, r_hi = (r_lo + per < SEQ) ? r_lo + per : SEQ, m_lo = F.seq * SEQ + r_lo, m_hi = F.seq * SEQ + r_hi;
    constexpr int RB = 4;
    for (int m0 = m_lo; m0 < m_hi; m0 += RB) {
        u64t a[RB][3], b[RB][3], c[RB][3]; float l0[RB][3], l1[RB][3], l2[RB][3];
#pragma unroll
        for (int r = 0; r < RB; ++r) { const int m = (m0 + r < m_hi) ? m0 + r : m_hi - 1;
#pragma unroll
            for (int p = 0; p < 3; ++p) {
                const int h = 4 * p + (lane >> 4); const size_t o = (size_t)m * DATT + 256 * p + 4 * lane;
                l0[r][p] = LSE[(size_t)m * NH + h]; l1[r][p] = LSE[(size_t)(M + m) * NH + h]; l2[r][p] = LSE[(size_t)(2 * M + m) * NH + h];
                a[r][p] = *(const GAS u64t*)(OG + o); b[r][p] = *(const GAS u64t*)(OG + (size_t)M * DATT + o); c[r][p] = *(const GAS u64t*)(OG + (size_t)2 * M * DATT + o); } }
#pragma unroll
        for (int r = 0; r < RB; ++r) { if (m0 + r >= m_hi) break; const int m = m0 + r;
#pragma unroll
            for (int p = 0; p < 3; ++p) {
                const float mx = fmaxf(l0[r][p], fmaxf(l1[r][p], l2[r][p]));
                float e0 = __builtin_amdgcn_exp2f(l0[r][p] - mx), e1 = __builtin_amdgcn_exp2f(l1[r][p] - mx), e2 = __builtin_amdgcn_exp2f(l2[r][p] - mx); const float inv = __builtin_amdgcn_rcpf(e0 + e1 + e2);
                e0 *= inv; e1 *= inv; e2 *= inv;
                float rr[4];
#pragma unroll
                for (int e = 0; e < 4; ++e) rr[e] = e0 * bf2f((bf16)(a[r][p] >> (16 * e))) + e1 * bf2f((bf16)(b[r][p] >> (16 * e))) + e2 * bf2f((bf16)(c[r][p] >> (16 * e)));
                *(GAS u64t*)(CAT + (size_t)m * D + 256 * p + 4 * lane) = (u64t)pk2(rr[0], rr[1]) | ((u64t)pk2(rr[2], rr[3]) << 32); } }
    }
}
constexpr int MP = 64;
__device__ __forceinline__ int swz(int row, int col) { return row * MP + ((((col >> 3) ^ (row >> 1)) & 7) << 3) + (col & 7); }
constexpr int ATT_K_OFF = 0, ATT_V_OFF = 256 * 64 * 2;
constexpr int ATT_UNITS = 3 * BATCH * NH * 16;
static_assert(ATT_V_OFF + 256 * 64 * 2 <= RING_BYTES, "attention LDS");
typedef short s16x4v __attribute__((ext_vector_type(4)));
__device__ __forceinline__ int swzv(int key, int d) { return key * 64 + ((((d >> 3) ^ (2 * ((key >> 1) & 3))) & 7) << 3) + (d & 7); }
struct AttnIn { v4u kv[4], vv[4]; bf16x8 q0, q1; };
struct AttnUnit { int g, bh, dl, r, blk; };
constexpr int ATT_SEQ_UNITS = 3 * NH * 16;
__device__ __forceinline__ AttnUnit attn_decode(int lu, int seq) { AttnUnit u; u.g = lu / (NH * 16); const int rem = lu % (NH * 16), rb = rem & 15; u.bh = seq * NH + (rem >> 4);
    if (u.g == 0) { u.dl = 1; u.r = 0; u.blk = rb; } else if (u.g == 1) { u.dl = 4; u.r = rb & 3; u.blk = rb >> 2; } else { u.dl = 16; u.r = rb; u.blk = 0; } return u; }
__device__ __forceinline__ void attn_fetch(Frame& F, const AttnUnit& u, AttnIn& R) {
    const unsigned char* sqb = F.ws + WS_HID + (size_t)(u.bh / NH) * SQ_STRIDE; const size_t ho = (size_t)(u.bh % NH) * SEQ * 64;
    const bf16* Qh = ((const bf16*)(sqb + SQ_Q)) + ho; const bf16* Kh = ((const bf16*)(sqb + SQ_K)) + ho; const bf16* Vh = ((const bf16*)(sqb + SQ_V)) + ho;
#pragma unroll
    for (int it = 0; it < 4; ++it) { const int idx = F.tid + it * 512, j = idx >> 3, ch = idx & 7, lk = (u.blk - 1) * 128 + j;
        R.kv[it] = (v4u){0u, 0u, 0u, 0u}; R.vv[it] = (v4u){0u, 0u, 0u, 0u};
        if (lk >= 0) { const size_t off = (size_t)(lk * u.dl + u.r) * 64 + ch * 8; R.kv[it] = *(const GAS v4u*)(Kh + off); R.vv[it] = *(const GAS v4u*)(Vh + off); } }
    const int fr = (F.tid & 63) & 15, fq = (F.tid & 63) >> 4, tq = (u.blk * 128 + 16 * F.wave + fr) * u.dl + u.r;
    R.q0 = *(const GAS bf16x8*)(Qh + (size_t)tq * 64 + 8 * fq); R.q1 = *(const GAS bf16x8*)(Qh + (size_t)tq * 64 + 32 + 8 * fq);
}
__device__ __forceinline__ void attn_stage(Frame& F, const AttnIn& R) {
    LAS bf16* KS = (LAS bf16*)(F.lds + ATT_K_OFF); LAS bf16* VS = (LAS bf16*)(F.lds + ATT_V_OFF);
#pragma unroll
    for (int it = 0; it < 4; ++it) { const int idx = F.tid + it * 512, j = idx >> 3, ch = idx & 7;
        *(LAS v4u*)(KS + swz(j, 8 * ch)) = R.kv[it]; *(LAS v4u*)(VS + swzv(j, 8 * ch)) = R.vv[it]; }
}
__device__ __forceinline__ void attn_compute(Frame& F, const AttnUnit& u, const bf16x8 q0, const bf16x8 q1) {
    const LAS bf16* KS = (const LAS bf16*)(F.lds + ATT_K_OFF); const LAS bf16* VS = (const LAS bf16*)(F.lds + ATT_V_OFF);
    const int w = F.wave, lane = F.tid & 63, fr = lane & 15, fq = lane >> 4, blk = u.blk;
    const int tq = (blk * 128 + 16 * w + fr) * u.dl + u.r;
    const int ko0 = swz(fr, 8 * fq), ko1 = swz(fr, 32 + 8 * fq);
    f32x4 s[9];
#pragma unroll
    for (int t = 0; t < 9; ++t) { const LAS bf16* kp = KS + 16 * (w + t) * 64;
        f32x4 z = (f32x4){0.f, 0.f, 0.f, 0.f};
        z = __builtin_amdgcn_mfma_f32_16x16x32_bf16(*(const LAS bf16x8*)(kp + ko0), q0, z, 0, 0, 0);
        s[t] = __builtin_amdgcn_mfma_f32_16x16x32_bf16(*(const LAS bf16x8*)(kp + ko1), q1, z, 0, 0, 0); }
    float mx = -INFINITY;
#pragma unroll
    for (int t = 0; t < 9; ++t)
#pragma unroll
        for (int i = 0; i < 4; ++i) { const int kk = 16 * t + 4 * fq + i;
            const bool valid = (kk >= fr) && (kk <= 128 + fr) && (blk > 0 || 16 * (w + t) + 4 * fq + i >= 128);
            s[t][i] = valid ? s[t][i] : -INFINITY; mx = fmaxf(mx, s[t][i]); }
    mx = fmaxf(mx, __shfl_xor(mx, 16)); mx = fmaxf(mx, __shfl_xor(mx, 32));
    float lsum = 0.f;
#pragma unroll
    for (int t = 0; t < 9; ++t)
#pragma unroll
        for (int i = 0; i < 4; ++i) { s[t][i] = __builtin_amdgcn_exp2f(s[t][i] - mx); lsum += s[t][i]; }
    lsum += __shfl_xor(lsum, 16); lsum += __shfl_xor(lsum, 32);
    f32x4 o[4];
#pragma unroll
    for (int c = 0; c < 4; ++c) o[c] = (f32x4){0.f, 0.f, 0.f, 0.f};
    const int tq_ = (lane >> 2) & 3, tp = lane & 3;
#pragma unroll
    for (int pp = 0; pp < 5; ++pp) {
        v4u pw; pw.x = pg8::cvt_pk_bf16(s[2 * pp][0], s[2 * pp][1]); pw.y = pg8::cvt_pk_bf16(s[2 * pp][2], s[2 * pp][3]);
        if (pp < 4) { pw.z = pg8::cvt_pk_bf16(s[2 * pp + 1][0], s[2 * pp + 1][1]); pw.w = pg8::cvt_pk_bf16(s[2 * pp + 1][2], s[2 * pp + 1][3]); } else { pw.z = 0u; pw.w = 0u; }
        const bf16x8 pb = __builtin_bit_cast(bf16x8, pw);
        const int ka = 16 * (w + 2 * pp) + 4 * fq + tq_, kb = (pp < 4) ? ka + 16 : ka;
#pragma unroll
        for (int c = 0; c < 4; ++c) {
            const s16x4v lo = __builtin_bit_cast(s16x4v, __builtin_amdgcn_ds_read_tr16_b64_v4i16((LAS s16x4v*)(VS + swzv(ka, 16 * c + 4 * tp))));
            const s16x4v hi = __builtin_bit_cast(s16x4v, __builtin_amdgcn_ds_read_tr16_b64_v4i16((LAS s16x4v*)(VS + swzv(kb, 16 * c + 4 * tp))));
            const bf16x8 va = (bf16x8){lo[0], lo[1], lo[2], lo[3], hi[0], hi[1], hi[2], hi[3]};
            o[c] = __builtin_amdgcn_mfma_f32_16x16x32_bf16(va, pb, o[c], 0, 0, 0); }
    }
    const float inv = 1.0f / lsum;
    const int b = u.bh / NH, h = u.bh % NH; const size_t mq = (size_t)b * SEQ + tq;
    bf16* op = ((bf16*)(F.ws + WS_OG)) + (size_t)u.g * M * DATT + mq * DATT + h * 64 + 4 * fq;
#pragma unroll
    for (int c = 0; c < 4; ++c) { pg8::u32x2 wv; wv.x = pg8::cvt_pk_bf16(o[c][0] * inv, o[c][1] * inv); wv.y = pg8::cvt_pk_bf16(o[c][2] * inv, o[c][3] * inv); *(GAS pg8::u32x2*)(op + 16 * c) = wv; }
    if (fq == 0) ((float*)(F.ws + WS_LSE))[((size_t)u.g * M + mq) * NH + h] = mx + __builtin_amdgcn_logf(lsum);
}
__device__ __forceinline__ void attn_loop(Frame& F, gu32* ctr) {
    volatile LAS int* slot = (volatile LAS int*)(F.lds + MISC_OFF + 64);
    const int seq = F.seq;
    if (F.tid == 0) *slot = (int)__hip_atomic_fetch_add(ctr, 1u, __ATOMIC_RELAXED, __HIP_MEMORY_SCOPE_AGENT);
    __syncthreads();
    int cur = *slot;
    AttnIn R;
    if (cur < ATT_SEQ_UNITS) attn_fetch(F, attn_decode(cur, seq), R);
    while (cur < ATT_SEQ_UNITS) {
        const AttnUnit u = attn_decode(cur, seq);
        __syncthreads();
        if (F.tid == 0) *slot = (int)__hip_atomic_fetch_add(ctr, 1u, __ATOMIC_RELAXED, __HIP_MEMORY_SCOPE_AGENT);
        attn_stage(F, R);
        const bf16x8 q0 = R.q0, q1 = R.q1;
        __syncthreads();
        const int nxt = *slot;
        if (nxt < ATT_SEQ_UNITS) attn_fetch(F, attn_decode(nxt, seq), R);
        attn_compute(F, u, q0, q1);
        cur = nxt;
    }
}

constexpr int CH = 64, NCHUNK = SEQ / CH, SCAN_UNITS = BATCH * NH * NCHUNK;
constexpr int MB = 64 * MP * 2;
constexpr int LP = 68;
constexpr int S1_KT = 0, S1_BT = MB, S1_KK = 2 * MB, S1_RT = 3 * MB, S1_KTT = 4 * MB, S1_BTT = 5 * MB, S1_KKT = 6 * MB, S1_VT = 7 * MB, S1_AAK = 8 * MB, S1_ARB = 9 * MB, S1_ARK = 10 * MB;
constexpr int S1_P = 11 * MB, S1_PT = 12 * MB, S1_TM = 13 * MB, S1_GC = 14 * MB, S1_WT = S1_P  , S1_END = S1_GC + 256;
constexpr int S1_AKVT = S1_KT, S1_WTT = S1_KK, S1_UT = S1_AAK;
static_assert(S1_END <= RING_BYTES, "S1 LDS");
constexpr size_t WS_XS = WS_H + 50 * MiB;
constexpr size_t WS_MC = WS_H, WS_RK = WS_H + 48 * MiB, WS_NCT = WS_Y, WS_YL = WS_END, WS_QE = WS_YL + 48 * MiB, WS_VV = WS_QE + 24 * MiB, WS_GG = WS_VV + 24 * MiB, WS_H0T = WS_GG + 24 * MiB, WS_END2 = WS_H0T + 24 * MiB;
static_assert((size_t)SCAN_UNITS * 64 * 64 * 4 <= 48 * MiB && (size_t)SCAN_UNITS * 64 * 64 * 2 <= 24 * MiB && WS_RK + (size_t)BATCH * NH * SEQ * 4 <= WS_HID, "scan scratch map");

__device__ __forceinline__ f32x4 mm_tile(const LAS bf16* X, const LAS bf16* Y, int tn, int tm, int fr, int fq, f32x4 acc) {
    const int o0 = swz(fr, 8 * fq), o1 = swz(fr, 32 + 8 * fq);
    const LAS bf16* ap = Y + 16 * tm * MP; const LAS bf16* bp = X + 16 * tn * MP;
    acc = __builtin_amdgcn_mfma_f32_16x16x32_bf16(*(const LAS bf16x8*)(ap + o0), *(const LAS bf16x8*)(bp + o0), acc, 0, 0, 0);
    acc = __builtin_amdgcn_mfma_f32_16x16x32_bf16(*(const LAS bf16x8*)(ap + o1), *(const LAS bf16x8*)(bp + o1), acc, 0, 0, 0);
    return acc;
}
__device__ __forceinline__ void st_tile_bf16(LAS bf16* Z, int tn, int tm, int fr, int fq, f32x4 v) {
    pg8::u32x2 w; w.x = pg8::cvt_pk_bf16(v[0], v[1]); w.y = pg8::cvt_pk_bf16(v[2], v[3]); *(LAS pg8::u32x2*)(Z + swz(16 * tn + fr, 16 * tm + 4 * fq)) = w;
}
constexpr f32x4 F4Z = {0.f, 0.f, 0.f, 0.f};

__device__ __forceinline__ void wave_sum8(float (&v)[8]) {
#pragma unroll
    for (int i = 0; i < 8; ++i) {
        v[i] += __builtin_bit_cast(float, __builtin_amdgcn_update_dpp(0, __builtin_bit_cast(int, v[i]), 0xB1, 0xF, 0xF, true));
        v[i] += __builtin_bit_cast(float, __builtin_amdgcn_update_dpp(0, __builtin_bit_cast(int, v[i]), 0x4E, 0xF, 0xF, true));
        v[i] += __builtin_bit_cast(float, __builtin_amdgcn_update_dpp(0, __builtin_bit_cast(int, v[i]), 0x141, 0xF, 0xF, true));
        v[i] += __builtin_bit_cast(float, __builtin_amdgcn_update_dpp(0, __builtin_bit_cast(int, v[i]), 0x140, 0xF, 0xF, true)); }
    float t[8];
#pragma unroll
    for (int i = 0; i < 8; ++i) t[i] = __shfl_xor(v[i], 16);
#pragma unroll
    for (int i = 0; i < 8; ++i) v[i] += t[i];
#pragma unroll
    for (int i = 0; i < 8; ++i) t[i] = __shfl_xor(v[i], 32);
#pragma unroll
    for (int i = 0; i < 8; ++i) v[i] += t[i];
}
constexpr int LAP = 456, PPP = 520;
constexpr int MF_STG = 64 * PPP * 2;
static_assert(MF_STG + 8 * 4096 <= RING_BYTES && 64 * LAP * 2 <= MF_STG, "mixer-front LDS");
__device__ __forceinline__ void mf_store_rows(int lane, LAS bf16* stg, bf16* dst, size_t pitch) {
    asm volatile("s_waitcnt lgkmcnt(0)" ::: "memory");
#pragma unroll
    for (int i = 0; i < 4; ++i) { const int row = 8 * i + (lane >> 3), ch = lane & 7; const v4u v = *(const LAS v4u*)(stg + row * 64 + ch * 8); *(GAS v4u*)(dst + (size_t)row * pitch + ch * 8) = v; }
    asm volatile("s_waitcnt lgkmcnt(0)" ::: "memory");
}
__device__ __forceinline__ void mix_front(Frame& F, KArgs* A, int l, int seq, int c) {
    int tid_ = F.tid; asm volatile("" : "+v"(tid_));
    const int tid = tid_, lane = tid & 63, w = F.wave, fr = lane & 15, fq = lane >> 4;
    LAS bf16* TL = (LAS bf16*)F.lds; LAS bf16* stg = (LAS bf16*)(F.lds + MF_STG + w * 4096);
    const int s00 = c * CH; const size_t m0 = (size_t)seq * SEQ + s00;
    const unsigned char* sqb = F.ws + WS_HID + (size_t)seq * SQ_STRIDE;
    const int row = tid >> 3, sub = tid & 7;
    { const float* mu = INP(A, 10) + (size_t)l * DRWIN + 2304; const int s = s00 + row;
      const bf16* zr = ((const bf16*)(sqb + SQ_ZR)) + (size_t)s * ZRP + 2304;
      v4u zc[7], zq[7]; f32x4 mu0[7], mu1[7];
#pragma unroll
      for (int i = 0; i < 7; ++i) { const int j = sub + 8 * i;
          zc[i] = *(const GAS v4u*)(zr + 8 * j); zq[i] = (v4u){0u, 0u, 0u, 0u}; if (s > 0) zq[i] = *(const GAS v4u*)(zr + 8 * j - ZRP);
          mu0[i] = *(const GAS f32x4*)(mu + 8 * j); mu1[i] = *(const GAS f32x4*)(mu + 8 * j + 4); }
#pragma unroll
      for (int i = 0; i < 7; ++i) { const int j = sub + 8 * i;
          float z[8], zp[8], v[8]; unpack8(zc[i], z); unpack8(zq[i], zp);
#pragma unroll
          for (int e = 0; e < 8; ++e) { const float mm = e < 4 ? mu0[i][e] : mu1[i][e - 4], zs = z[e] + (zp[e] - z[e]) * mm; v[e] = j < 12 ? tanh_f(zs) : (j < 24 ? zs : sigmoid_f(zs)); }
          v4u o; o.x = pk2(v[0], v[1]); o.y = pk2(v[2], v[3]); o.z = pk2(v[4], v[5]); o.w = pk2(v[6], v[7]);
          *(LAS v4u*)(TL + row * LAP + 8 * j) = o; } }
    __syncthreads();
    { const bf16* WL = (const bf16*)(F.ws + WS_W + (size_t)l * LW + LW_LORA);
#define MF_WL_LOAD(STEP, DST) do { const int it_ = w + NWAVES * ((STEP) >> 2), cb_ = it_ >> 1, g_ = cb_ / 12, kb_ = g_ == 0 ? 0 : (g_ == 1 ? 96 : 192), nk_ = g_ == 2 ? 8 : 3; \
        const bf16* p_ = WL + (size_t)(cb_ * 64 + ((STEP) & 3) * 16 + fr) * LORA_K + kb_ + 8 * fq; \
        _Pragma("unroll") for (int ks_ = 0; ks_ < 8; ++ks_) if (ks_ < nk_) DST[ks_] = *(const GAS bf16x8*)(p_ + 32 * ks_); } while (0)
#define MF_WL_STEP(STEP, CUR) do { const int it_ = w + NWAVES * ((STEP) >> 2), cb_ = it_ >> 1, th_ = it_ & 1, ct_ = (STEP) & 3, g_ = cb_ / 12, kb_ = g_ == 0 ? 0 : (g_ == 1 ? 96 : 192), nk_ = g_ == 2 ? 8 : 3; \
        f32x4 acc_[2] = {F4Z, F4Z}; \
        _Pragma("unroll") for (int ks_ = 0; ks_ < 8; ++ks_) if (ks_ < nk_) { _Pragma("unroll") for (int tt_ = 0; tt_ < 2; ++tt_) \
            acc_[tt_] = __builtin_amdgcn_mfma_f32_16x16x32_bf16(CUR[ks_], *(const LAS bf16x8*)(TL + (32 * th_ + 16 * tt_ + fr) * LAP + kb_ + 32 * ks_ + 8 * fq), acc_[tt_], 0, 0, 0); } \
        _Pragma("unroll") for (int tt_ = 0; tt_ < 2; ++tt_) { pg8::u32x2 o_; o_.x = pg8::cvt_pk_bf16(acc_[tt_][0], acc_[tt_][1]); o_.y = pg8::cvt_pk_bf16(acc_[tt_][2], acc_[tt_][3]); *(LAS pg8::u32x2*)(stg + (16 * tt_ + fr) * 64 + ct_ * 16 + 4 * fq) = o_; } \
        if (ct_ == 3) mf_store_rows(lane, stg, ((bf16*)(F.ws + WS_LB)) + (m0 + 32 * th_) * LORA_N + cb_ * 64, LORA_N); } while (0)
      bf16x8 wa[8], wb[8];
      MF_WL_LOAD(0, wa);
      for (int st = 0; st < 36; st += 2) { MF_WL_LOAD(st + 1, wb); MF_WL_STEP(st, wa); if (st + 2 < 36) MF_WL_LOAD(st + 2, wa); MF_WL_STEP(st + 1, wb); }
#undef MF_WL_LOAD
#undef MF_WL_STEP
    }
    __syncthreads();
    { const int s = s00 + row; const bf16* zpb = ((const bf16*)(sqb + SQ_ZP)) + (size_t)s * 512;
#define MF_PW_LOAD(I, DST) do { constexpr int pw_ = 2 << ((I) >> 1); const int j_ = sub + 8 * (I); \
        _Pragma("unroll") for (int r_ = 0; r_ < pw_; ++r_) { DST[r_] = (v4u){0u, 0u, 0u, 0u}; if (r_ <= s) DST[r_] = *(const GAS v4u*)(zpb + 8 * j_ - (size_t)r_ * 512); } } while (0)
#define MF_PW_STEP(I, CUR) do { constexpr int pw_ = 2 << ((I) >> 1); const int j_ = sub + 8 * (I), cnt_ = (s + 1 < pw_) ? s + 1 : pw_; \
        float acc_[8], u_[8]; unpack8(CUR[0], u_); \
        _Pragma("unroll") for (int e_ = 0; e_ < 8; ++e_) acc_[e_] = u_[e_]; \
        _Pragma("unroll") for (int r_ = 1; r_ < pw_; ++r_) { float t_[8]; unpack8(CUR[r_], t_); _Pragma("unroll") for (int e_ = 0; e_ < 8; ++e_) acc_[e_] += t_[e_]; } \
        const float ic_ = 1.0f / (float)cnt_; v4u pv_; \
        pv_.x = pk2(acc_[0] * ic_ - u_[0], acc_[1] * ic_ - u_[1]); pv_.y = pk2(acc_[2] * ic_ - u_[2], acc_[3] * ic_ - u_[3]); pv_.z = pk2(acc_[4] * ic_ - u_[4], acc_[5] * ic_ - u_[5]); pv_.w = pk2(acc_[6] * ic_ - u_[6], acc_[7] * ic_ - u_[7]); \
        *(LAS v4u*)(TL + row * PPP + 8 * j_) = pv_; } while (0)
      { v4u z0[2], z1[2], z2[4], z3[4], z4[8], z5[8];
        MF_PW_LOAD(0, z0); MF_PW_LOAD(1, z1); MF_PW_LOAD(2, z2); MF_PW_LOAD(3, z3); MF_PW_LOAD(4, z4); MF_PW_LOAD(5, z5);
        MF_PW_STEP(0, z0); MF_PW_STEP(1, z1); MF_PW_STEP(2, z2); MF_PW_STEP(3, z3); MF_PW_STEP(4, z4); MF_PW_STEP(5, z5); }
      { v4u z6[16]; MF_PW_LOAD(6, z6); MF_PW_STEP(6, z6); }
      { v4u z7[16]; MF_PW_LOAD(7, z7); MF_PW_STEP(7, z7); }
#undef MF_PW_LOAD
#undef MF_PW_STEP
    }
    __syncthreads();
    { const bf16* WP = (const bf16*)(F.ws + WS_W + (size_t)l * LW + LW_POOL); const float* psc = INP(A, 22) + (size_t)l * DPOOL;
      for (int it = w; it < 16; it += NWAVES) { const int cb = it >> 1, th = it & 1, kbeg = 128 * (cb >> 1);
          bf16x8 wa[4][4]; f32x4 sc[4];
#pragma unroll
          for (int ct = 0; ct < 4; ++ct) { sc[ct] = *(const GAS f32x4*)(psc + cb * 64 + ct * 16 + 4 * fq);
#pragma unroll
              for (int ks = 0; ks < 4; ++ks) wa[ct][ks] = *(const GAS bf16x8*)(WP + (size_t)(cb * 64 + ct * 16 + fr) * 512 + kbeg + 32 * ks + 8 * fq); }
#pragma unroll
          for (int ct = 0; ct < 4; ++ct) { f32x4 acc[2] = {F4Z, F4Z};
#pragma unroll
              for (int ks = 0; ks < 4; ++ks)
#pragma unroll
                  for (int tt = 0; tt < 2; ++tt) acc[tt] = __builtin_amdgcn_mfma_f32_16x16x32_bf16(wa[ct][ks], *(const LAS bf16x8*)(TL + (32 * th + 16 * tt + fr) * PPP + kbeg + 32 * ks + 8 * fq), acc[tt], 0, 0, 0);
#pragma unroll
              for (int tt = 0; tt < 2; ++tt) { pg8::u32x2 o; o.x = pg8::cvt_pk_bf16(acc[tt][0] * sc[ct][0], acc[tt][1] * sc[ct][1]); o.y = pg8::cvt_pk_bf16(acc[tt][2] * sc[ct][2], acc[tt][3] * sc[ct][3]); *(LAS pg8::u32x2*)(stg + (16 * tt + fr) * 64 + ct * 16 + 4 * fq) = o; } }
          mf_store_rows(lane, stg, ((bf16*)(F.ws + WS_CAT)) + (m0 + 32 * th) * D + DATT + DRW + cb * 64, D); } }
    asm volatile("s_waitcnt vmcnt(0)" ::: "memory");
    __syncthreads();
}

struct S1Raw { unsigned zr[9], zk[9], zv[9], dw[8], da[8], gg[8]; float mu_r, mu_k, mu_v, w0, a0, k_k, k_a, r_k; };
__device__ __forceinline__ void s1_fetch(Frame& F, KArgs* A, int l, int unit, S1Raw& R) {
    const int hb = unit / NCHUNK, c = unit % NCHUNK, b = hb / NH, h = hb % NH, lane = F.tid & 63, hc = h * 64 + lane;
    const int s0 = c * CH + 8 * F.wave; const size_t m0 = (size_t)b * SEQ + s0;
    const GAS bf16* zr = (const GAS bf16*)(((const bf16*)(F.ws + WS_HID + (size_t)b * SQ_STRIDE + SQ_ZR)) + (size_t)s0 * ZRP); const GAS bf16* Lr = (const GAS bf16*)(((const bf16*)(F.ws + WS_LB)) + m0 * LORA_N);
#pragma unroll
    for (int q = 0; q < 9; ++q) { if (q == 0 && s0 == 0) { R.zr[0] = 0u; R.zk[0] = 0u; R.zv[0] = 0u; } else { const GAS bf16* zp = zr + (q - 1) * ZRP; R.zr[q] = zp[hc]; R.zk[q] = zp[768 + hc]; R.zv[q] = zp[1536 + hc]; } }
#pragma unroll
    for (int q = 0; q < 8; ++q) { R.dw[q] = Lr[q * LORA_N + hc]; R.da[q] = Lr[q * LORA_N + 768 + hc]; R.gg[q] = Lr[q * LORA_N + 1536 + hc]; }
    const float* mu = INP(A, 10) + (size_t)l * DRWIN; const size_t lo = (size_t)l * DRW + hc;
    R.mu_r = mu[hc]; R.mu_k = mu[768 + hc]; R.mu_v = mu[1536 + hc];
    R.w0 = INP(A, 12)[lo]; R.a0 = INP(A, 14)[lo]; R.k_k = INP(A, 16)[lo]; R.k_a = INP(A, 17)[lo]; R.r_k = INP(A, 18)[lo];
}
__device__ __forceinline__ int tslot(int tn, int tm, int lane) { return (tn * 4 + tm) * 64 + lane; }

template <int PMODE  > __device__ __forceinline__ void scan_s1_phase(Frame& F, KArgs* A, int l) {
    const int lane = F.tid & 63, w = F.wave;
    const int fr = lane & 15, fq = lane >> 4, tn = w & 3, tm0 = 2 * (w >> 2);
    LAS bf16* KT = (LAS bf16*)(F.lds + S1_KT); LAS bf16* BT = (LAS bf16*)(F.lds + S1_BT); LAS bf16* KK = (LAS bf16*)(F.lds + S1_KK); LAS bf16* RT = (LAS bf16*)(F.lds + S1_RT);
    LAS bf16* KTT = (LAS bf16*)(F.lds + S1_KTT); LAS bf16* BTT = (LAS bf16*)(F.lds + S1_BTT); LAS bf16* KKT = (LAS bf16*)(F.lds + S1_KKT); LAS bf16* VT = (LAS bf16*)(F.lds + S1_VT);
    LAS bf16* AAK = (LAS bf16*)(F.lds + S1_AAK); LAS bf16* ARB = (LAS bf16*)(F.lds + S1_ARB); LAS bf16* ARK = (LAS bf16*)(F.lds + S1_ARK);
    LAS bf16* AKVT = (LAS bf16*)(F.lds + S1_AKVT); LAS bf16* TM = (LAS bf16*)(F.lds + S1_TM); LAS bf16* WTT = (LAS bf16*)(F.lds + S1_WTT); LAS bf16* UT = (LAS bf16*)(F.lds + S1_UT);
    LAS bf16* PM = (LAS bf16*)(F.lds + S1_P); LAS bf16* PT = (LAS bf16*)(F.lds + S1_PT);
    LAS float* GC = (LAS float*)(F.lds + S1_GC); LAS float* WTOT = (LAS float*)(F.lds + S1_WT);
    for (int cc = F.bi; cc < NCHUNK; cc += F.nb) {
    mix_front(F, A, l, F.seq, cc);
    S1Raw R; s1_fetch(F, A, l, (F.seq * NH) * NCHUNK + cc, R);
    for (int hh = 0; hh < NH; ++hh) {
    const int unit = (F.seq * NH + hh) * NCHUNK + cc;
    const int hb = unit / NCHUNK, c = unit % NCHUNK;
    {
        const int s0 = c * CH + 8 * w;
        float rr[8], kap[8], kp[8], aa[8], vv[8], lw[8], cl[8], kk0[8], red[8];
#pragma unroll
        for (int q = 0; q < 8; ++q) {
            const float zr1 = __uint_as_float(R.zr[q + 1] << 16), zr0 = __uint_as_float(R.zr[q] << 16), zk1 = __uint_as_float(R.zk[q + 1] << 16), zk0 = __uint_as_float(R.zk[q] << 16), zv1 = __uint_as_float(R.zv[q + 1] << 16), zv0 = __uint_as_float(R.zv[q] << 16);
            rr[q] = zr1 + (zr0 - zr1) * R.mu_r; kk0[q] = zk1 + (zk0 - zk1) * R.mu_k; vv[q] = zv1 + (zv0 - zv1) * R.mu_v;
            lw[q] = -0.6065306597126334f * 1.4426950408889634f * sigmoid_f(R.w0 + __uint_as_float(R.dw[q] << 16));
            aa[q] = sigmoid_f(R.a0 + __uint_as_float(R.da[q] << 16));
            kp[q] = kk0[q] * (1.0f + (aa[q] - 1.0f) * R.k_a);
            const float kkn = kk0[q] * R.k_k; red[q] = kkn * kkn;
        }
        wave_sum8(red);
        float run = 0.f;
#pragma unroll
        for (int q = 0; q < 8; ++q) { kap[q] = kk0[q] * R.k_k * __builtin_amdgcn_rsqf(fmaxf(red[q], 1e-24f)); red[q] = rr[q] * kp[q] * R.r_k; run += lw[q]; cl[q] = run; }
        wave_sum8(red);
#pragma unroll
        for (int q = 0; q < 8; ++q) {
            const size_t tok = (size_t)hb * SEQ + s0 + q;
            ((bf16*)(F.ws + WS_VV))[tok * 64 + lane] = (bf16)(pg8::cvt_pk_bf16(vv[q], vv[q]) & 0xffffu); ((bf16*)(F.ws + WS_GG))[tok * 64 + lane] = (bf16)R.gg[q];
            if (lane == 0) ((float*)(F.ws + WS_RK))[tok] = red[q];
        }
        if (hh + 1 < NH) s1_fetch(F, A, l, unit + NCHUNK, R);
        WTOT[w * 64 + lane] = run;
        __syncthreads();
        float off = 0.f;
#pragma unroll
        for (int w2 = 0; w2 < 7; ++w2) off += (w2 < w) ? WTOT[w2 * 64 + lane] : 0.f;
        if (w == 7) GC[lane] = __builtin_amdgcn_exp2f(off + run);
        float fkt[8], fbt[8], fkk[8], frt[8];
#pragma unroll
        for (int q = 0; q < 8; ++q) {
            const float ct = off + cl[q], ctm1 = ct - lw[q];
            const float gp = __builtin_amdgcn_exp2f(ct), gm = __builtin_amdgcn_exp2f(ctm1), gi = __builtin_amdgcn_exp2f(-ct);
            fkt[q] = kap[q] * gm; fbt[q] = kap[q] * aa[q] * gi; fkk[q] = kp[q] * gi; frt[q] = rr[q] * gp;
        }
        v4u pkt, pbt, pkk, pvt, prt;
#pragma unroll
        for (int i = 0; i < 4; ++i) { pkt[i] = pg8::cvt_pk_bf16(fkt[2 * i], fkt[2 * i + 1]); pbt[i] = pg8::cvt_pk_bf16(fbt[2 * i], fbt[2 * i + 1]); pkk[i] = pg8::cvt_pk_bf16(fkk[2 * i], fkk[2 * i + 1]);
            prt[i] = pg8::cvt_pk_bf16(frt[2 * i], frt[2 * i + 1]); pvt[i] = pg8::cvt_pk_bf16(vv[2 * i], vv[2 * i + 1]); }
#pragma unroll
        for (int q = 0; q < 8; ++q) { const int o = swz(8 * w + q, lane), sh = 16 * (q & 1);
            KT[o] = (bf16)(pkt[q >> 1] >> sh); BT[o] = (bf16)(pbt[q >> 1] >> sh); KK[o] = (bf16)(pkk[q >> 1] >> sh); RT[o] = (bf16)(prt[q >> 1] >> sh); }
        { const int o = swz(lane, 8 * w); *(LAS v4u*)(KTT + o) = pkt; *(LAS v4u*)(BTT + o) = pbt; *(LAS v4u*)(KKT + o) = pkk; *(LAS v4u*)(VT + o) = pvt; }
    }
    __syncthreads();
    if (PMODE == 1) continue;
    f32x4 Treg[2];
#pragma unroll
    for (int d = 0; d < 2; ++d) { const int tm = tm0 + d; const int t = 16 * tn + fr, sb = 16 * tm + 4 * fq;
        const f32x4 aL = mm_tile(KT, BT, tn, tm, fr, fq, F4Z), aLt = mm_tile(BT, KT, tn, tm, fr, fq, F4Z);
        f32x4 aK = mm_tile(KT, KK, tn, tm, fr, fq, F4Z), aRB = mm_tile(RT, BT, tn, tm, fr, fq, F4Z), aRK = mm_tile(RT, KK, tn, tm, fr, fq, F4Z);
        f32x4 pl, plt;
#pragma unroll
        for (int e = 0; e < 4; ++e) { const bool st = (sb + e) < t, inc = (sb + e) <= t;
            pl[e] = st ? -aL[e] : 0.f; plt[e] = (t < sb + e) ? -aLt[e] : 0.f; Treg[d][e] = ((sb + e) == t ? 1.0f : 0.0f) + pl[e];
            aK[e] = st ? aK[e] : 0.f; aRB[e] = inc ? aRB[e] : 0.f; aRK[e] = inc ? aRK[e] : 0.f; }
        st_tile_bf16(PM, tn, tm, fr, fq, pl); st_tile_bf16(PT, tn, tm, fr, fq, plt); st_tile_bf16(TM, tn, tm, fr, fq, Treg[d]);
        st_tile_bf16(AAK, tn, tm, fr, fq, aK); st_tile_bf16(ARB, tn, tm, fr, fq, aRB); st_tile_bf16(ARK, tn, tm, fr, fq, aRK); }
    __syncthreads();
    {
        f32x4 p2[2], p2t[2];
#pragma unroll
        for (int d = 0; d < 2; ++d) { p2[d] = mm_tile(PM, PT, tn, tm0 + d, fr, fq, F4Z); p2t[d] = mm_tile(PT, PM, tn, tm0 + d, fr, fq, F4Z);
            st_tile_bf16(AKVT, tn, tm0 + d, fr, fq, mm_tile(VT, AAK, tn, tm0 + d, fr, fq, F4Z)); }
        __syncthreads();
#pragma unroll
        for (int d = 0; d < 2; ++d) { st_tile_bf16(PM, tn, tm0 + d, fr, fq, p2[d]); st_tile_bf16(PT, tn, tm0 + d, fr, fq, p2t[d]); }
        __syncthreads();
#pragma unroll
        for (int it = 1; it <= 5; ++it) {
#pragma unroll
            for (int d = 0; d < 2; ++d) { Treg[d] = mm_tile(TM, PT, tn, tm0 + d, fr, fq, Treg[d]);
                if (it < 5) { p2[d] = mm_tile(PM, PT, tn, tm0 + d, fr, fq, F4Z); p2t[d] = mm_tile(PT, PM, tn, tm0 + d, fr, fq, F4Z); } }
            __syncthreads();
#pragma unroll
            for (int d = 0; d < 2; ++d) { st_tile_bf16(TM, tn, tm0 + d, fr, fq, Treg[d]);
                if (it < 5) { st_tile_bf16(PM, tn, tm0 + d, fr, fq, p2[d]); st_tile_bf16(PT, tn, tm0 + d, fr, fq, p2t[d]); } }
            __syncthreads();
        }
    }
    if (PMODE == 2) { __syncthreads(); continue; }
    {
        f32x4 aw[2], au[2];
#pragma unroll
        for (int d = 0; d < 2; ++d) { aw[d] = mm_tile(KTT, TM, tn, tm0 + d, fr, fq, F4Z); au[d] = mm_tile(AKVT, TM, tn, tm0 + d, fr, fq, F4Z); }
#pragma unroll
        for (int d = 0; d < 2; ++d) { st_tile_bf16(WTT, tn, tm0 + d, fr, fq, aw[d]); st_tile_bf16(UT, tn, tm0 + d, fr, fq, au[d]); }
    }
    __syncthreads();
    {
        const size_t ub = (size_t)unit * 64 * 64;
        GAS f32x4* MC = (GAS f32x4*)((float*)(F.ws + WS_MC) + ub); GAS pg8::u32x2* NCT = (GAS pg8::u32x2*)((bf16*)(F.ws + WS_NCT) + ub);
        GAS pg8::u32x2* YL = (GAS pg8::u32x2*)((bf16*)(F.ws + WS_YL) + ub); GAS pg8::u32x2* QE = (GAS pg8::u32x2*)((bf16*)(F.ws + WS_QE) + ub);
#pragma unroll
        for (int d = 0; d < 2; ++d) { const int tm = tm0 + d, i = 16 * tn + fr, j = 16 * tm + 4 * fq, ts = tslot(tn, tm, lane);
            { const f32x4 a = mm_tile(ARB, WTT, tn, tm, fr, fq, F4Z); const pg8::u32x2 rv = *(const LAS pg8::u32x2*)(RT + swz(i, j));
              const float r0 = __uint_as_float(rv.x << 16), r1 = __uint_as_float(rv.x & 0xffff0000u), r2 = __uint_as_float(rv.y << 16), r3 = __uint_as_float(rv.y & 0xffff0000u);
              pg8::u32x2 o; o.x = pg8::cvt_pk_bf16(r0 - a[0], r1 - a[1]); o.y = pg8::cvt_pk_bf16(r2 - a[2], r3 - a[3]); if (PMODE != 3) QE[ts] = o; else asm volatile("" :: "v"(o.x), "v"(o.y)); }
            { const f32x4 a = mm_tile(ARK, VT, tn, tm, fr, fq, F4Z), a2 = mm_tile(ARB, UT, tn, tm, fr, fq, F4Z);
              pg8::u32x2 o; o.x = pg8::cvt_pk_bf16(a[0] - a2[0], a[1] - a2[1]); o.y = pg8::cvt_pk_bf16(a[2] - a2[2], a[3] - a2[3]); if (PMODE != 3) YL[ts] = o; else asm volatile("" :: "v"(o.x), "v"(o.y)); }
            { const f32x4 a = mm_tile(BTT, WTT, tn, tm, fr, fq, F4Z); const float gc = GC[i]; f32x4 o;
#pragma unroll
              for (int e = 0; e < 4; ++e) o[e] = gc * (((j + e) == i ? 1.0f : 0.0f) - a[e]);
              if (PMODE != 3) MC[ts] = o; else asm volatile("" :: "v"(o[0]), "v"(o[1]), "v"(o[2]), "v"(o[3])); }
            { const f32x4 a = mm_tile(VT, KKT, tn, tm, fr, fq, F4Z), a2 = mm_tile(UT, BTT, tn, tm, fr, fq, F4Z); const f32x4 gc = *(const LAS f32x4*)(GC + j);
              pg8::u32x2 o; o.x = pg8::cvt_pk_bf16((a[0] - a2[0]) * gc[0], (a[1] - a2[1]) * gc[1]); o.y = pg8::cvt_pk_bf16((a[2] - a2[2]) * gc[2], (a[3] - a2[3]) * gc[3]);
              if (PMODE != 3) NCT[ts] = o; else asm volatile("" :: "v"(o.x), "v"(o.y)); }
        }
    }
    __syncthreads();
    }
    }
}

__device__ __forceinline__ void scan_s2_head(Frame& F, int hb) {
    if (F.wave >= 4) return;
    const int lane = F.tid & 63, fr = lane & 15, fq = lane >> 4, w = F.wave;
    f32x4 Hs[4];
#pragma unroll
    for (int t = 0; t < 4; ++t) Hs[t] = F4Z;
    for (int c = 0; c < NCHUNK; ++c) {
        const size_t ub = ((size_t)hb * NCHUNK + c) * 64 * 64;
        const float* MC = (const float*)(F.ws + WS_MC) + ub; const bf16* NCT = (const bf16*)(F.ws + WS_NCT) + ub; bf16* H0T = (bf16*)(F.ws + WS_H0T) + ub;
        f32x4 mc[4][4], nn[4];
#pragma unroll
        for (int to = 0; to < 4; ++to) { const pg8::u32x2 nv = ((const GAS pg8::u32x2*)NCT)[tslot(w, to, lane)];
            nn[to] = (f32x4){__uint_as_float(nv.x << 16), __uint_as_float(nv.x & 0xffff0000u), __uint_as_float(nv.y << 16), __uint_as_float(nv.y & 0xffff0000u)};
#pragma unroll
            for (int t = 0; t < 4; ++t) mc[to][t] = ((const GAS f32x4*)MC)[tslot(to, t, lane)]; }
#pragma unroll
        for (int t = 0; t < 4; ++t) { pg8::u32x2 o; o.x = pg8::cvt_pk_bf16(Hs[t][0], Hs[t][1]); o.y = pg8::cvt_pk_bf16(Hs[t][2], Hs[t][3]); ((GAS pg8::u32x2*)H0T)[tslot(w, t, lane)] = o; }
        if (c + 1 == NCHUNK) break;
#pragma unroll
        for (int to = 0; to < 4; ++to)
#pragma unroll
            for (int t = 0; t < 4; ++t)
#pragma unroll
                for (int i = 0; i < 4; ++i) nn[to] = __builtin_amdgcn_mfma_f32_16x16x4f32(mc[to][t][i], Hs[t][i], nn[to], 0, 0, 0);
#pragma unroll
        for (int t = 0; t < 4; ++t) Hs[t] = nn[t];
    }
}

__device__ __forceinline__ void scan_s3_pair(Frame& F, KArgs* A, int l, int pair) {
    const int lane = F.tid & 63, fr = lane & 15, fq = lane >> 4, w = F.wave, unit = 2 * pair + (w >> 2), tn = w & 3;
    const int hb = unit / NCHUNK, c = unit % NCHUNK, b = hb / NH, h = hb % NH;
    const size_t ub = (size_t)unit * 64 * 64;
    const GAS pg8::u32x2* QE = (const GAS pg8::u32x2*)((const bf16*)(F.ws + WS_QE) + ub); const GAS pg8::u32x2* H0T = (const GAS pg8::u32x2*)((const bf16*)(F.ws + WS_H0T) + ub);
    const GAS pg8::u32x2* YL = (const GAS pg8::u32x2*)((const bf16*)(F.ws + WS_YL) + ub);
    const int t = 16 * tn + fr; const size_t tok = (size_t)hb * SEQ + c * CH + t;
    const bf16* vp = (const bf16*)(F.ws + WS_VV) + tok * 64; const bf16* gp = (const bf16*)(F.ws + WS_GG) + tok * 64;
    const float* gnw = INP(A, 19) + (size_t)l * DRW + h * 64; const float* gnb = INP(A, 20) + (size_t)l * DRW + h * 64;
    pg8::u32x2 qv[4], hv[4][4], yv[4], vv[4], gg[4]; f32x4 gw[4], gb[4];
#pragma unroll
    for (int i = 0; i < 4; ++i) { qv[i] = QE[tslot(tn, i, lane)]; yv[i] = YL[tslot(tn, i, lane)]; const int v0 = 16 * i + 4 * fq;
        vv[i] = *(const GAS pg8::u32x2*)(vp + v0); gg[i] = *(const GAS pg8::u32x2*)(gp + v0); gw[i] = *(const GAS f32x4*)(gnw + v0); gb[i] = *(const GAS f32x4*)(gnb + v0);
#pragma unroll
        for (int k = 0; k < 4; ++k) hv[i][k] = H0T[tslot(i, k, lane)]; }
    const float rk = ((const float*)(F.ws + WS_RK))[tok];
    bf16x8 qb[2];
#pragma unroll
    for (int p = 0; p < 2; ++p) qb[p] = __builtin_bit_cast(bf16x8, (v4u){qv[2 * p].x, qv[2 * p].y, qv[2 * p + 1].x, qv[2 * p + 1].y});
    f32x4 y[4]; float s1 = 0.f;
#pragma unroll
    for (int tm = 0; tm < 4; ++tm) {
        f32x4 acc = (f32x4){__uint_as_float(yv[tm].x << 16), __uint_as_float(yv[tm].x & 0xffff0000u), __uint_as_float(yv[tm].y << 16), __uint_as_float(yv[tm].y & 0xffff0000u)};
#pragma unroll
        for (int p = 0; p < 2; ++p) acc = __builtin_amdgcn_mfma_f32_16x16x32_bf16(__builtin_bit_cast(bf16x8, (v4u){hv[tm][2 * p].x, hv[tm][2 * p].y, hv[tm][2 * p + 1].x, hv[tm][2 * p + 1].y}), qb[p], acc, 0, 0, 0);
        y[tm] = acc; s1 += (acc[0] + acc[1]) + (acc[2] + acc[3]); }
    s1 += __shfl_xor(s1, 16); s1 += __shfl_xor(s1, 32);
    const float mean = s1 * (1.f / 64.f); float s2 = 0.f;
#pragma unroll
    for (int tm = 0; tm < 4; ++tm)
#pragma unroll
        for (int e = 0; e < 4; ++e) { const float d = y[tm][e] - mean; s2 += d * d; }
    s2 += __shfl_xor(s2, 16); s2 += __shfl_xor(s2, 32);
    const float rstd = __builtin_amdgcn_rsqf(s2 * (1.f / 64.f) + GN_EPS);
    bf16* out = (bf16*)(F.ws + WS_CAT) + ((size_t)b * SEQ + c * CH + t) * D + DATT + h * 64;
#pragma unroll
    for (int tm = 0; tm < 4; ++tm) { const int v0 = 16 * tm + 4 * fq;
        const float vf[4] = {__uint_as_float(vv[tm].x << 16), __uint_as_float(vv[tm].x & 0xffff0000u), __uint_as_float(vv[tm].y << 16), __uint_as_float(vv[tm].y & 0xffff0000u)};
        const float gf[4] = {__uint_as_float(gg[tm].x << 16), __uint_as_float(gg[tm].x & 0xffff0000u), __uint_as_float(gg[tm].y << 16), __uint_as_float(gg[tm].y & 0xffff0000u)};
        float o[4];
#pragma unroll
        for (int e = 0; e < 4; ++e) o[e] = ((y[tm][e] - mean) * rstd * gw[tm][e] + gb[tm][e] + rk * vf[e]) * gf[e];
        pg8::u32x2 ow; ow.x = pg8::cvt_pk_bf16(o[0], o[1]); ow.y = pg8::cvt_pk_bf16(o[2], o[3]); *(GAS pg8::u32x2*)(out + v0) = ow; }
}

__device__ __forceinline__ void grp_barrier(unsigned* cnt, unsigned nb, unsigned* tmo) {
    asm volatile("s_waitcnt vmcnt(0)" ::: "memory");
    __syncthreads();
    if (threadIdx.x == 0) {
        const unsigned old = __hip_atomic_fetch_add(cnt, 1u, __ATOMIC_RELAXED, __HIP_MEMORY_SCOPE_AGENT), target = (old / nb + 1u) * nb; unsigned sp = 0;
        while (__hip_atomic_load(cnt, __ATOMIC_RELAXED, __HIP_MEMORY_SCOPE_AGENT) < target) { __builtin_amdgcn_s_sleep(1); if (++sp > (1u << 22)) { __hip_atomic_store(tmo, 1u, __ATOMIC_RELAXED, __HIP_MEMORY_SCOPE_AGENT); break; } }
        __builtin_amdgcn_fence(__ATOMIC_ACQUIRE, "agent");
        asm volatile("s_waitcnt vmcnt(0)" ::: "memory");
    }
    __syncthreads();
}
__global__ void __launch_bounds__(NWAVES * 64, 2) fwd_kernel(Args args) {
    extern __shared__ __attribute__((aligned(16))) unsigned char lds[];
    Frame F;
    F.lds = (LAS unsigned char*)lds;
    F.wave = __builtin_amdgcn_readfirstlane(threadIdx.x >> 6); F.tid = threadIdx.x;
    F.G = gridDim.x; { const int bx = blockIdx.x; F.vcu = (F.G % 8 == 0) ? (bx % 8) * (F.G / 8) + bx / 8 : bx; }
    F.bi = 0; F.nb = 1; F.seq = 0;
    unsigned char* ws = args.ws; F.ws = ws;
    F.X = args.out;
    for (int u = threadIdx.x; u < (LDS_BYTES - LDSCTL_OFF) / 4; u += NWAVES * 64) ((LAS unsigned*)(F.lds + LDSCTL_OFF))[u] = 0u;
    __syncthreads();
    volatile LAS unsigned* MISC = (volatile LAS unsigned*)(F.lds + MISC_OFF);
    XcdBarrier bar = xcd_barrier_post((unsigned*)(ws + WS_CTL) + CW_BAR, MISC + 8);
    if (threadIdx.x == 0) MISC[20] = __hip_atomic_fetch_add((unsigned*)(ws + WS_CTL) + CW_RANK + 64 * bar.x, 1u, __ATOMIC_RELAXED, __HIP_MEMORY_SCOPE_AGENT);
    KArgs* const ka0 = (KArgs*)__builtin_amdgcn_kernarg_segment_ptr();
#define PH_BEGIN { Frame F = F0; KArgs* ka = ka0; F.tid = threadIdx.x; asm volatile("" : "+v"(F.tid)); GAS unsigned char* wsg_ = (GAS unsigned char*)F0.ws; GAS float* xg_ = (GAS float*)F0.X; asm volatile("" : "+s"(wsg_), "+s"(xg_), "+s"(F.wave), "+s"(F.bi), "+s"(F.nb), "+s"(F.seq), "+s"(ka)); F.ws = (unsigned char*)wsg_; F.X = (float*)xg_; unsigned char* const ws = F.ws; (void)ws;
#define PH_END   grp_barrier(gcnt, (unsigned)F0.nb, (unsigned*)(F0.ws + WS_CTL) + CW_TMO); }

    { const Frame F0 = F; { Frame F = F0; KArgs* ka = ka0; F.tid = threadIdx.x; asm volatile("" : "+v"(F.tid)); p0_prologue(F, ka); } }
    xcd_barrier(bar);
    if (threadIdx.x == 0) { unsigned g = 0, ng = 0, nbk = 1; unsigned* bw = (unsigned*)(ws + WS_CTL) + CW_BAR;
        for (unsigned j = 0; j < 16; ++j) { const unsigned c = xb_ld(&bw[XB_XCNT(j)]); if (c) { if (j < bar.x) ++g; ++ng; } if (j == bar.x) nbk = c ? c : 1u; }
        MISC[16] = g; MISC[17] = ng ? ng : 1u; MISC[18] = nbk; }
    __syncthreads();
    const int grp = __builtin_amdgcn_readfirstlane((int)MISC[16]), ngrp = __builtin_amdgcn_readfirstlane((int)MISC[17]);
    F.nb = __builtin_amdgcn_readfirstlane((int)MISC[18]); F.bi = __builtin_amdgcn_readfirstlane((int)MISC[20]);
    unsigned* const gcnt = (unsigned*)(ws + WS_CTL) + CW_GB + 64 * bar.x;

    for (int seq = grp; seq < BATCH; seq += ngrp) {
    F.seq = seq; const Frame F0 = F;
    for (int j = 0; j < 2 * NL; ++j) {
        const int l = j >> 1; const bool second = (j & 1) != 0;
        PH_BEGIN {
            pg8::Gemm g{((bf16*)(F.ws + WS_XB)), (const bf16*)(ws + WS_W + (size_t)l * LW + (second ? LW_GU2 : LW_GU1)), M, 2 * FF, D}; pg8::GroupOrder S; S.init(2 * FF / 256, F.nb, F.bi, F.seq);
            pg8::EpiSwiglu E{((bf16*)(F.ws + WS_HID)), FF, (const float*)(F.ws + WS_RS)};
            pg8::gemm_phase<pg8::EpiSwiglu, pg8::GroupOrder, true, true>(F.lds + RING_OFF, g, S, E);
        } PH_END
        PH_BEGIN {
            const int q = 3 * l + (second ? 2 : 0); const bool lastsub = second && (l + 1 == NL);
            pg8::Gemm g{((bf16*)(F.ws + WS_HID)), (const bf16*)(ws + WS_W + (size_t)l * LW + (second ? LW_D2 : LW_D1)), M, D, FF};
            pg8::EpiRes E{((bf16*)(F.ws + WS_XB)), lastsub ? F.X : nullptr, (second ? INP(ka, 24) : INP(ka, 2)) + (size_t)l * D, 0.5f, (float*)(F.ws + WS_RS),
                          (float*)(F.ws + WS_XS + (size_t)q * MiB), (unsigned*)(ws + WS_CTL) + CW_XC + q * XC_USE, (unsigned*)(ws + WS_CTL) + CW_TMO};
            const int P = F.nb >> 3, nsl = P > 0 ? (8 + P - 1) / P : 0;
            for (int sl = 0; sl < nsl; ++sl) { pg8::PanelOrder S{sl, F.nb, F.bi, 8 * F.seq}; pg8::gemm_phase<pg8::EpiRes, pg8::PanelOrder, false, true>(F.lds + RING_OFF, g, S, E); __syncthreads(); }
        } PH_END
        if (!second) {
            PH_BEGIN {
                pg8::Gemm g{((bf16*)(F.ws + WS_XB)), (const bf16*)(ws + WS_W + (size_t)l * LW + LW_IN), M, DINP, D}; pg8::GroupOrder S; S.init(DINP / 256, F.nb, F.bi, F.seq);
                pg8::EpiWin E{F.ws + WS_HID, ((float*)(F.ws + WS_COS)), ((float*)(F.ws + WS_SIN)), QSCALE, (const float*)(F.ws + WS_RS)};
                pg8::gemm_phase<pg8::EpiWin, pg8::GroupOrder, true, true>(F.lds + RING_OFF, g, S, E);
            } PH_END
            PH_BEGIN scan_s1_phase<0>(F, ka, l); PH_END
            PH_BEGIN {
                for (int h = F.bi; h < NH; h += F.nb) scan_s2_head(F, F.seq * NH + h);
                attn_loop(F, (gu32*)(ws + WS_CTL) + CW_ATTQ + 64 * (l * BATCH + F.seq));
            } PH_END
            PH_BEGIN { for (int p = F.bi; p < NH * NCHUNK / 2; p += F.nb) scan_s3_pair(F, ka, l, F.seq * (NH * NCHUNK / 2) + p); attn_combine(F); } PH_END
            PH_BEGIN {
                const int q = 3 * l + 1;
                pg8::Gemm g{((bf16*)(F.ws + WS_CAT)), (const bf16*)(ws + WS_W + (size_t)l * LW + LW_OUT), M, D, D};
                pg8::EpiRes E{((bf16*)(F.ws + WS_XB)), nullptr, INP(ka, 7) + (size_t)l * D, 1.0f, (float*)(F.ws + WS_RS),
                              (float*)(F.ws + WS_XS + (size_t)q * MiB), (unsigned*)(ws + WS_CTL) + CW_XC + q * XC_USE, (unsigned*)(ws + WS_CTL) + CW_TMO};
                const int P = F.nb >> 3, nsl = P > 0 ? (8 + P - 1) / P : 0;
                for (int sl = 0; sl < nsl; ++sl) { pg8::PanelOrder S{sl, F.nb, F.bi, 8 * F.seq}; pg8::gemm_phase<pg8::EpiRes, pg8::PanelOrder, false, true>(F.lds + RING_OFF, g, S, E); __syncthreads(); }
            } PH_END
        }
    }
    }
#undef PH_BEGIN
#undef PH_END
}

extern "C" void kernel_launch(void* const* d_in, const int* in_sizes, int n_in, void* d_out, int out_size, void* d_ws, size_t ws_size, hipStream_t stream) {
    static int grid = 0;
    if (grid == 0) {
        if (n_in != 28 || in_sizes[0] != M * D || out_size != M * D || ws_size < WS_END2) { fprintf(stderr, "kernel_launch: unexpected problem (n_in %d, in0 %d, out %d, ws %zu < %zu); nothing launched\n", n_in, n_in > 0 ? in_sizes[0] : -1, out_size, ws_size, (size_t)WS_END2); grid = -1; return; }
        int dev = 0, cus = 0, per_cu = 0;
        if (hipGetDevice(&dev) != hipSuccess || hipDeviceGetAttribute(&cus, hipDeviceAttributeMultiprocessorCount, dev) != hipSuccess) { grid = -1; return; }
        if (hipFuncSetAttribute((const void*)fwd_kernel, hipFuncAttributeMaxDynamicSharedMemorySize, LDS_BYTES) != hipSuccess) { fprintf(stderr, "kernel_launch: hipFuncSetAttribute failed\n"); grid = -1; return; }
        if (hipOccupancyMaxActiveBlocksPerMultiprocessor(&per_cu, (const void*)fwd_kernel, NWAVES * 64, LDS_BYTES) != hipSuccess || per_cu < 1)
            fprintf(stderr, "kernel_launch: note: occupancy query reports %d workgroups per CU\n", per_cu);
        (void)hipGetLastError();
        grid = cus;
    }
    if (grid < 0) return;
    if (hipMemsetAsync((char*)d_ws + WS_CTL, 0, CTL_ZERO_BYTES, stream) != hipSuccess) return;
    Args a{};
    for (int i = 0; i < 28; ++i) a.in[i] = (const float*)d_in[i];
    a.out = (float*)d_out; a.ws = (unsigned char*)d_ws; a.ph_lo = 0; a.ph_hi = 0;
    hipLaunchKernelGGL(fwd_kernel, dim3(grid), dim3(NWAVES * 64), LDS_BYTES, stream, a);
}
```

```cpp
#include <hip/hip_runtime.h>
#include <cstdio>
#include <cstdint>
#include <cmath>
namespace pg8 {
#define PG8_LAS __attribute__((address_space(3)))
typedef unsigned short bf16_t;
typedef short bf16x8 __attribute__((ext_vector_type(8)));
typedef float f32x4 __attribute__((ext_vector_type(4)));
typedef unsigned u32x4 __attribute__((ext_vector_type(4)));
constexpr int BM = 256, BK = 64, HALF = 128, HTB = HALF * BK * 2  , STAGE_BYTES = 8 * HTB, NXCD = 8, WGM = 8;

__host__ __device__ __forceinline__ int lds_byte(int r, int c) { const int st = (r >> 4) * 2 + (c >> 5), rr = r & 15, cc = c & 31, ob = rr * 64 + cc * 2; return st * 1024 + (ob ^ (((ob >> 9) & 1) << 5)); }
__host__ __device__ __forceinline__ void stage_rc(int b, int& R, int& C) { const int st = b / 1024, sb = b % 1024, swz = sb ^ (((sb >> 9) & 1) << 5); R = (st >> 1) * 16 + swz / 64; C = (st & 1) * 32 + (swz % 64) / 2; }
__host__ __device__ __forceinline__ int perm32(int rho) { const int n = rho >> 4, i = rho & 15; return 8 * (i >> 2) + 4 * n + (i & 3); }

struct Unit { int pm, pn; };
struct Gemm { const bf16_t* A; const bf16_t* Bt; int M, N, K; };

struct StaticOrder {
    int nM, nN, nwg, G, c;
    __host__ __device__ void init(int M, int N, int G_, int c_) { nM = M / BM; nN = N / BM; nwg = nM * nN; G = G_; c = c_; }
    __host__ __device__ bool next(int i, Unit& u) const {
        const long L = (long)i * G + c; if (L >= nwg) return false;
        int wgid = (int)L; { const int q = nwg / NXCD, r = nwg % NXCD, xcd = wgid % NXCD, off = wgid / NXCD; wgid = (xcd < r ? xcd * (q + 1) : r * (q + 1) + (xcd - r) * q) + off; }
        const int nig = WGM * nN, gid = wgid / nig, fm = gid * WGM, gsz = (nM - fm) < WGM ? (nM - fm) : WGM;
        u.pm = fm + ((wgid % nig) % gsz); u.pn = (wgid % nig) / gsz; return true;
    }
    __device__ __forceinline__ void a_ready(const Unit&) const {}
    __device__ __forceinline__ void done(const Unit&) const {}
};

typedef float cvt_f32x2_t __attribute__((ext_vector_type(2))); typedef __bf16 cvt_bf16x2_t __attribute__((ext_vector_type(2)));
__device__ __forceinline__ unsigned cvt_pk_bf16(float lo, float hi) { const cvt_f32x2_t v = {lo, hi}; const cvt_bf16x2_t b = __builtin_convertvector(v, cvt_bf16x2_t); return __builtin_bit_cast(unsigned, b); }
typedef float f32x2 __attribute__((ext_vector_type(2)));
typedef unsigned u32x2 __attribute__((ext_vector_type(2)));
__device__ __forceinline__ float silu_f(float x) { return x * __builtin_amdgcn_rcpf(1.0f + __builtin_amdgcn_exp2f(-1.4426950408889634f * x)); }
__device__ __forceinline__ u32x4 pack8(const f32x4 v0, const f32x4 v1) { u32x4 w; w.x = cvt_pk_bf16(v0[0], v0[1]); w.y = cvt_pk_bf16(v0[2], v0[3]); w.z = cvt_pk_bf16(v1[0], v1[1]); w.w = cvt_pk_bf16(v1[2], v1[3]); return w; }

struct EpiF32 {
    static constexpr bool PERM = false, AFTER_DRAIN = false;
    float* C; int ldc;
    __device__ __forceinline__ void operator()(const f32x4 (&acc)[2][2][4][2], const Unit& u, int wr, int wc, int fr, int fq) const {
        asm volatile("" : "+v"(fr), "+v"(fq));
        const int row0 = u.pm * BM + wr * 64 + fr, col0 = u.pn * BM + wc * 32 + 4 * fq;
#pragma unroll
        for (int ai = 0; ai < 2; ++ai)
#pragma unroll
            for (int m = 0; m < 4; ++m) { float* rowp = C + (size_t)(row0 + ai * HALF + m * 16) * ldc + col0;
#pragma unroll
                for (int bj = 0; bj < 2; ++bj)
#pragma unroll
                    for (int n = 0; n < 2; ++n) *(f32x4*)(rowp + bj * HALF + n * 16) = acc[ai][bj][m][n]; }
    }
};
struct EpiBf16Plain {
    static constexpr bool PERM = true, AFTER_DRAIN = false;
    bf16_t* O; int ldc;
    __device__ __forceinline__ void operator()(const f32x4 (&acc)[2][2][4][2], const Unit& u, int wr, int wc, int fr, int fq) const {
        asm volatile("" : "+v"(fr), "+v"(fq));
        const int row0 = u.pm * BM + wr * 64 + fr, col0 = u.pn * BM + wc * 32 + 8 * fq;
#pragma unroll
        for (int ai = 0; ai < 2; ++ai)
#pragma unroll
            for (int m = 0; m < 4; ++m) { bf16_t* rowp = O + (size_t)(row0 + ai * HALF + m * 16) * ldc + col0;
#pragma unroll
                for (int bj = 0; bj < 2; ++bj) *(u32x4*)(rowp + bj * HALF) = pack8(acc[ai][bj][m][0], acc[ai][bj][m][1]); }
    }
};
struct EpiBf16Scale {
    static constexpr bool PERM = true, AFTER_DRAIN = false;
    bf16_t* O; int ldc; const float* scale;
    __device__ __forceinline__ void operator()(const f32x4 (&acc)[2][2][4][2], const Unit& u, int wr, int wc, int fr, int fq) const {
        asm volatile("" : "+v"(fr), "+v"(fq));
        const int row0 = u.pm * BM + wr * 64 + fr, col0 = u.pn * BM + wc * 32 + 8 * fq;
        f32x4 sv[2][2];
#pragma unroll
        for (int bj = 0; bj < 2; ++bj)
#pragma unroll
            for (int n = 0; n < 2; ++n) sv[bj][n] = *(const f32x4*)(scale + col0 + bj * HALF + 4 * n);
#pragma unroll
        for (int ai = 0; ai < 2; ++ai)
#pragma unroll
            for (int m = 0; m < 4; ++m) { bf16_t* rowp = O + (size_t)(row0 + ai * HALF + m * 16) * ldc + col0;
#pragma unroll
                for (int bj = 0; bj < 2; ++bj) *(u32x4*)(rowp + bj * HALF) = pack8(acc[ai][bj][m][0] * sv[bj][0], acc[ai][bj][m][1] * sv[bj][1]); }
    }
};
struct EpiSwiglu {
    static constexpr bool PERM = true, AFTER_DRAIN = false;
    bf16_t* O; int ldc; const float* rs;
    __device__ __forceinline__ void operator()(const f32x4 (&acc)[2][2][4][2], const Unit& u, int wr, int wc, int fr, int fq) const {
        asm volatile("" : "+v"(fr), "+v"(fq));
        const int row0 = u.pm * BM + wr * 64 + fr, col0 = u.pn * HALF + wc * 32 + 8 * fq;
#pragma unroll
        for (int ai = 0; ai < 2; ++ai)
#pragma unroll
            for (int m = 0; m < 4; ++m) { bf16_t* rowp = O + (size_t)(row0 + ai * HALF + m * 16) * ldc + col0; const float r = rs[row0 + ai * HALF + m * 16];
                f32x4 v0, v1;
#pragma unroll
                for (int e = 0; e < 4; ++e) { v0[e] = silu_f(acc[ai][0][m][0][e] * r) * (acc[ai][1][m][0][e] * r); v1[e] = silu_f(acc[ai][0][m][1][e] * r) * (acc[ai][1][m][1][e] * r); }
                *(u32x4*)rowp = pack8(v0, v1); }
    }
};
struct EpiWin {
    static constexpr bool PERM = true, AFTER_DRAIN = false;
    unsigned char* hid;
    static constexpr size_t SQS = 22u << 20, OQ = 0, OK_ = 3u << 20, OV = 6u << 20, OZR = 9u << 20, OZP = 20u << 20;
    const float *cs, *sn;
    float qscale; const float* rs;
    __device__ __forceinline__ void operator()(const f32x4 (&acc)[2][2][4][2], const Unit& u, int wr, int wc, int fr, int fq) const {
        asm volatile("" : "+v"(fr), "+v"(fq));
        const int row0 = u.pm * BM + wr * 64 + fr, pn = u.pn;
        if (pn < 6) {
            const size_t dsto = pn < 3 ? OQ : OK_; const int pt = pn < 3 ? pn : pn - 3; const float sc = pn < 3 ? qscale : 1.0f;
            const int d0 = 16 * (wc & 1) + 4 * fq;
#pragma unroll
            for (int ai = 0; ai < 2; ++ai)
#pragma unroll
                for (int m = 0; m < 4; ++m) { const int row = row0 + ai * HALF + m * 16, b = row >> 11, s = row & 2047; const float rsc = rs[row] * sc;
                    const f32x4 c4 = *(const f32x4*)(cs + s * 32 + d0), s4 = *(const f32x4*)(sn + s * 32 + d0);
#pragma unroll
                    for (int bj = 0; bj < 2; ++bj) { const int head = pt * 4 + bj * 2 + (wc >> 1);
                        const f32x4 x1 = acc[ai][bj][m][0], x2 = acc[ai][bj][m][1];
                        const f32x4 o1 = (x1 * c4 - x2 * s4) * rsc, o2 = (x2 * c4 + x1 * s4) * rsc;
                        bf16_t* p = (bf16_t*)(hid + (size_t)b * SQS + dsto) + ((size_t)head * 2048 + s) * 64 + d0;
                        u32x2 w1, w2; w1.x = cvt_pk_bf16(o1[0], o1[1]); w1.y = cvt_pk_bf16(o1[2], o1[3]); w2.x = cvt_pk_bf16(o2[0], o2[1]); w2.y = cvt_pk_bf16(o2[2], o2[3]);
                        *(u32x2*)p = w1; *(u32x2*)(p + 32) = w2; } }
        } else if (pn < 9) {
            const int d0 = 32 * (wc & 1) + 8 * fq;
#pragma unroll
            for (int ai = 0; ai < 2; ++ai)
#pragma unroll
                for (int m = 0; m < 4; ++m) { const int row = row0 + ai * HALF + m * 16, b = row >> 11, s = row & 2047; const float r = rs[row];
#pragma unroll
                    for (int bj = 0; bj < 2; ++bj) { const int head = (pn - 6) * 4 + bj * 2 + (wc >> 1);
                        *(u32x4*)((bf16_t*)(hid + (size_t)b * SQS + OV) + ((size_t)head * 2048 + s) * 64 + d0) = pack8(acc[ai][bj][m][0] * r, acc[ai][bj][m][1] * r); } }
        } else {
            size_t oo; int ldc, colt;
            if (pn < 20) { oo = OZR; ldc = 2816; colt = (pn - 9) * BM; } else { oo = OZP; ldc = 512; colt = (pn - 20) * BM; }
            const int col0 = colt + wc * 32 + 8 * fq;
#pragma unroll
            for (int ai = 0; ai < 2; ++ai)
#pragma unroll
                for (int m = 0; m < 4; ++m) { const int row = row0 + ai * HALF + m * 16; bf16_t* rowp = (bf16_t*)(hid + (size_t)(row >> 11) * SQS + oo) + (size_t)(row & 2047) * ldc + col0; const float r = rs[row];
#pragma unroll
                    for (int bj = 0; bj < 2; ++bj) *(u32x4*)(rowp + bj * HALF) = pack8(acc[ai][bj][m][0] * r, acc[ai][bj][m][1] * r); }
        }
    }
};

struct GroupOrder {
    int nN, nb, bi, pm0;
    __device__ __forceinline__ void init(int ntiles, int nb_, int bi_, int seq) { nN = ntiles; nb = nb_; bi = bi_; pm0 = 8 * seq; }
    __device__ __forceinline__ bool next(int i, Unit& u) const { const int L = i * nb + bi; if (L >= 8 * nN) return false; u.pm = pm0 + (L & 7); u.pn = L >> 3; return true; }
    __device__ __forceinline__ void a_ready(const Unit&) const {}
    __device__ __forceinline__ void done(const Unit&) const {}
};
struct PanelOrder {
    int slice, nb, bi, pm0;
    __device__ __forceinline__ bool next(int i, Unit& u) const { if (i) return false; const int P = nb >> 3, p = slice * P + (bi >> 3); if ((bi >> 3) >= P || p >= 8) return false; u.pm = pm0 + p; u.pn = bi & 7; return true; }
    __device__ __forceinline__ void a_ready(const Unit&) const {}
    __device__ __forceinline__ void done(const Unit&) const {}
};
struct EpiRes {
    static constexpr bool PERM = true, AFTER_DRAIN = true;
    bf16_t* X; float* OUT;
    const float* gpost; float coef; float* rs;
    float* slots;
    unsigned* cnt;
    unsigned* tmo;
    __device__ __forceinline__ float exchange(float part, int ex, const Unit& u, PG8_LAS float* P, PG8_LAS float* S, int wid, int lane, int wc, int rowl, bool writer) const {
        if (writer) P[rowl * 4 + wc] = part;
        asm volatile("s_waitcnt lgkmcnt(0)" ::: "memory"); __builtin_amdgcn_s_barrier(); asm volatile("" ::: "memory");
        const int tid = wid * 64 + lane;
        float* sl = slots + ((size_t)ex * 16384 * 8);
        if (tid < 256) { const float t4 = (P[tid * 4 + 0] + P[tid * 4 + 1]) + (P[tid * 4 + 2] + P[tid * 4 + 3]);
            __hip_atomic_store(sl + (size_t)(u.pm * BM + tid) * 8 + u.pn, t4, __ATOMIC_RELAXED, __HIP_MEMORY_SCOPE_AGENT);
            asm volatile("s_waitcnt vmcnt(0)" ::: "memory");
            if (lane == 0) __hip_atomic_fetch_add(cnt + 64 * (ex * 64 + u.pm), 1u, __ATOMIC_RELAXED, __HIP_MEMORY_SCOPE_AGENT); }
        if (wid == 0) { unsigned sp = 0;
            while ((unsigned)__builtin_amdgcn_readfirstlane(__hip_atomic_load(cnt + 64 * (ex * 64 + u.pm), __ATOMIC_RELAXED, __HIP_MEMORY_SCOPE_AGENT)) < 32u) {
                __builtin_amdgcn_s_sleep(1); if (++sp > (1u << 22)) { if (lane == 0) __hip_atomic_store(tmo, 1u, __ATOMIC_RELAXED, __HIP_MEMORY_SCOPE_AGENT); break; } } }
        asm volatile("s_waitcnt vmcnt(0) lgkmcnt(0)" ::: "memory"); __builtin_amdgcn_s_barrier(); asm volatile("" ::: "memory");
        if (tid < 256) { const float* q = sl + (size_t)(u.pm * BM + tid) * 8; float t = 0.f;
#pragma unroll
            for (int k = 0; k < 8; ++k) t += __hip_atomic_load(q + k, __ATOMIC_RELAXED, __HIP_MEMORY_SCOPE_AGENT);
            S[tid] = t; }
        asm volatile("s_waitcnt vmcnt(0) lgkmcnt(0)" ::: "memory"); __builtin_amdgcn_s_barrier(); asm volatile("" ::: "memory");
        return S[rowl];
    }
    __device__ __forceinline__ void fused(f32x4 (&acc)[2][2][4][2], const Unit& u, int wr, int wc, int fr, int fq, PG8_LAS unsigned char* lds, int wid, int lane) const {
        PG8_LAS float* P = (PG8_LAS float*)lds; PG8_LAS float* S = (PG8_LAS float*)(lds + 4096);
        const int col0 = u.pn * BM + wc * 32 + 8 * fq;
        f32x4 gv[2][2];
#pragma unroll
        for (int bj = 0; bj < 2; ++bj)
#pragma unroll
            for (int n = 0; n < 2; ++n) gv[bj][n] = *(const f32x4*)(gpost + col0 + bj * HALF + 4 * n);
        u32x4 xw_[2][4][2];
#pragma unroll
        for (int ai = 0; ai < 2; ++ai)
#pragma unroll
            for (int m = 0; m < 4; ++m)
#pragma unroll
                for (int bj = 0; bj < 2; ++bj) xw_[ai][m][bj] = *(const u32x4*)(X + ((size_t)u.pm * BM + ai * HALF + wr * 64 + m * 16 + fr) * 2048 + col0 + bj * HALF);
        float ssq[2][4];
#pragma unroll
        for (int ai = 0; ai < 2; ++ai)
#pragma unroll
            for (int m = 0; m < 4; ++m) { float s = 0.f;
#pragma unroll
                for (int bj = 0; bj < 2; ++bj)
#pragma unroll
                    for (int n = 0; n < 2; ++n) { const f32x4 v = acc[ai][bj][m][n]; s += (v[0] * v[0] + v[1] * v[1]) + (v[2] * v[2] + v[3] * v[3]); }
                s += __shfl_xor(s, 16); s += __shfl_xor(s, 32); ssq[ai][m] = s; }
#pragma unroll
        for (int ai = 0; ai < 2; ++ai)
#pragma unroll
            for (int m = 0; m < 4; ++m) if (fq == 0) P[(ai * HALF + wr * 64 + m * 16 + fr) * 4 + wc] = ssq[ai][m];
        const float dummy1 = exchange(0.f, 0, u, P, S, wid, lane, wc, 0, false); (void)dummy1;
        float ss2[2][4];
#pragma unroll
        for (int ai = 0; ai < 2; ++ai)
#pragma unroll
            for (int m = 0; m < 4; ++m) { const int rl = ai * HALF + wr * 64 + m * 16 + fr; const size_t row = (size_t)u.pm * BM + rl;
                const float cr = coef * __builtin_amdgcn_rsqf(S[rl] * (1.0f / 2048.0f) + 1e-6f); float s2 = 0.f;
#pragma unroll
                for (int bj = 0; bj < 2; ++bj) { bf16_t* xp = X + row * 2048 + col0 + bj * HALF; const u32x4 xw = xw_[ai][m][bj];
                    f32x4 x0 = {__uint_as_float(xw.x << 16), __uint_as_float(xw.x & 0xffff0000u), __uint_as_float(xw.y << 16), __uint_as_float(xw.y & 0xffff0000u)};
                    f32x4 x1 = {__uint_as_float(xw.z << 16), __uint_as_float(xw.z & 0xffff0000u), __uint_as_float(xw.w << 16), __uint_as_float(xw.w & 0xffff0000u)};
                    x0 = x0 + acc[ai][bj][m][0] * gv[bj][0] * cr; x1 = x1 + acc[ai][bj][m][1] * gv[bj][1] * cr;
                    if (OUT) { float* op = OUT + row * 2048 + col0 + bj * HALF; *(f32x4*)op = x0; *(f32x4*)(op + 4) = x1; }
                    else { const u32x4 w = pack8(x0, x1); *(u32x4*)xp = w;
                        const float a0 = __uint_as_float(w.x << 16), a1 = __uint_as_float(w.x & 0xffff0000u), a2 = __uint_as_float(w.y << 16), a3 = __uint_as_float(w.y & 0xffff0000u);
                        const float a4 = __uint_as_float(w.z << 16), a5 = __uint_as_float(w.z & 0xffff0000u), a6 = __uint_as_float(w.w << 16), a7 = __uint_as_float(w.w & 0xffff0000u);
                        s2 += ((a0 * a0 + a1 * a1) + (a2 * a2 + a3 * a3)) + ((a4 * a4 + a5 * a5) + (a6 * a6 + a7 * a7)); } }
                s2 += __shfl_xor(s2, 16); s2 += __shfl_xor(s2, 32); ss2[ai][m] = s2; }
        if (OUT) return;
        asm volatile("s_waitcnt lgkmcnt(0)" ::: "memory"); __builtin_amdgcn_s_barrier(); asm volatile("" ::: "memory");
#pragma unroll
        for (int ai = 0; ai < 2; ++ai)
#pragma unroll
            for (int m = 0; m < 4; ++m) if (fq == 0) P[(ai * HALF + wr * 64 + m * 16 + fr) * 4 + wc] = ss2[ai][m];
        const float dummy2 = exchange(0.f, 1, u, P, S, wid, lane, wc, 0, false); (void)dummy2;
        if (u.pn == 0) { const int tid = wid * 64 + lane; if (tid < 256) rs[(size_t)u.pm * BM + tid] = __builtin_amdgcn_rsqf(S[tid] * (1.0f / 2048.0f) + 1e-6f); }
    }
};

template <class Epi, class Sched, bool ALIGN_EPI = false, bool SP2 = false>
__device__ __forceinline__ void gemm_phase(PG8_LAS unsigned char* lds, const Gemm g, const Sched& S, const Epi& E) {
    int tid_ = threadIdx.x; asm volatile("" : "+v"(tid_));
    const int tid = tid_, wid = __builtin_amdgcn_readfirstlane(tid >> 6), lane = tid & 63, wr = wid >> 2, wc = wid & 3, fr = lane & 15, fq = lane >> 4;
    int K_ = g.K; asm volatile("" : "+s"(K_));
    const int K = K_, nt = K / BK;
    unsigned voffA[2], voffB[2];
#pragma unroll
    for (int i = 0; i < 2; ++i) { int R, C; stage_rc(tid * 16 + i * 8192, R, C); const int Rb = Epi::PERM ? ((R & ~31) + perm32(R & 31)) : R;
        voffA[i] = (unsigned)(R * K + C) * 2u; voffB[i] = (unsigned)(Rb * K + C) * 2u; }
    const size_t kstep = (size_t)(BK * 2);
    const size_t hstep = (size_t)HALF * K * 2;
    const size_t tstep = 2 * hstep;
    const unsigned ldsw = (unsigned)wid * 1024u;
    const int aoff = lds_byte(wr * 64 + fr, fq * 8), boff = lds_byte(wc * 32 + fr, fq * 8);
#define PG8_SA(b, h) (((b) * 2 + (h)) * HTB)
#define PG8_SB(b, h) ((4 + (b) * 2 + (h)) * HTB)
#define PG8_STAGE(bufoff, gbase, voff) do { _Pragma("unroll") for (int _i = 0; _i < 2; ++_i) \
        __builtin_amdgcn_global_load_lds((const unsigned*)((const char*)(gbase) + (voff)[_i]), (PG8_LAS unsigned*)(lds + (bufoff) + ldsw + _i * 8192), 16, 0, 0); } while (0)
#define PG8_LDA(dst, b, h) do { _Pragma("unroll") for (int m = 0; m < 4; ++m) _Pragma("unroll") for (int k = 0; k < 2; ++k) dst[m][k] = *(const PG8_LAS bf16x8*)(lds + PG8_SA(b, h) + aoff + m * 2048 + k * 1024); } while (0)
#define PG8_LDB(dst, b, h) do { _Pragma("unroll") for (int n = 0; n < 2; ++n) _Pragma("unroll") for (int k = 0; k < 2; ++k) dst[n][k] = *(const PG8_LAS bf16x8*)(lds + PG8_SB(b, h) + boff + n * 2048 + k * 1024); } while (0)
#define PG8_MMA(ai, bj, At, Bt) do { __builtin_amdgcn_s_setprio(1); _Pragma("unroll") for (int m = 0; m < 4; ++m) _Pragma("unroll") for (int n = 0; n < 2; ++n) _Pragma("unroll") for (int k = 0; k < 2; ++k) \
        acc[ai][bj][m][n] = __builtin_amdgcn_mfma_f32_16x16x32_bf16(Bt[n][k], At[m][k], acc[ai][bj][m][n], 0, 0, 0); __builtin_amdgcn_s_setprio(0); } while (0)
#define PG8_WAIT_V(n) asm volatile("s_waitcnt vmcnt(" #n ")" ::: "memory")
#define PG8_WAIT_L(n) asm volatile("s_waitcnt lgkmcnt(" #n ")" ::: "memory")
#define PG8_BAR __builtin_amdgcn_s_barrier()
#define PG8_SCHED __builtin_amdgcn_sched_barrier(0)
    Unit cur, nxt; int ui = 0;
    if (!S.next(0, cur)) return;
    f32x4 acc[2][2][4][2];
#pragma unroll
    for (int a = 0; a < 2; ++a)
#pragma unroll
        for (int b = 0; b < 2; ++b)
#pragma unroll
            for (int m = 0; m < 4; ++m)
#pragma unroll
                for (int n = 0; n < 2; ++n) acc[a][b][m][n] = (f32x4){0.f, 0.f, 0.f, 0.f};
    bf16x8 At[4][2], B0[2][2], B1[2][2];
    const char* cA = (const char*)g.A + (size_t)cur.pm * tstep; const char* cB = (const char*)g.Bt + (size_t)cur.pn * tstep;
    S.a_ready(cur);
    if constexpr (SP2) {
        PG8_STAGE(PG8_SB(0, 0), cB, voffB); PG8_STAGE(PG8_SB(0, 1), cB + hstep, voffB); PG8_STAGE(PG8_SA(0, 0), cA, voffA); PG8_STAGE(PG8_SA(0, 1), cA + hstep, voffA);
        if (wr == 1) PG8_BAR;
        PG8_WAIT_V(2); PG8_BAR;
        PG8_STAGE(PG8_SB(1, 0), cB + kstep, voffB); PG8_STAGE(PG8_SA(1, 0), cA + kstep, voffA); PG8_STAGE(PG8_SB(1, 1), cB + hstep + kstep, voffB);
        PG8_WAIT_V(6); PG8_BAR;
    } else {
        PG8_STAGE(PG8_SB(0, 0), cB, voffB); PG8_STAGE(PG8_SA(0, 0), cA, voffA); PG8_STAGE(PG8_SB(0, 1), cB + hstep, voffB); PG8_STAGE(PG8_SA(0, 1), cA + hstep, voffA);
        if (wr == 1) PG8_BAR;
        PG8_WAIT_V(4); PG8_BAR;
        PG8_STAGE(PG8_SB(1, 0), cB + kstep, voffB); PG8_STAGE(PG8_SA(1, 0), cA + kstep, voffA); PG8_STAGE(PG8_SB(1, 1), cB + hstep + kstep, voffB);
        PG8_WAIT_V(6); PG8_BAR;
    }
    for (;;) {
        const bool has_next = S.next(ui + 1, nxt);
        const char* nA = has_next ? (const char*)g.A + (size_t)nxt.pm * tstep : cA; const char* nB = has_next ? (const char*)g.Bt + (size_t)nxt.pn * tstep : cB;
        for (int t = 0; t < nt; t += 2) {
            const bool last = (t == nt - 2);
            const char* a1 = cA + (size_t)(t + 1) * kstep;
            const char* a2 = last ? nA : cA + (size_t)(t + 2) * kstep; const char* b2 = last ? nB : cB + (size_t)(t + 2) * kstep;
            const char* a3 = a2 + kstep; const char* b3 = b2 + kstep;
            if (last && has_next) S.a_ready(nxt);
            if constexpr (SP2) {
            PG8_LDB(B0, 0, 0); PG8_LDB(B1, 0, 1); PG8_SCHED; PG8_LDA(At, 0, 0); PG8_STAGE(PG8_SA(1, 1), a1 + hstep, voffA);
            PG8_WAIT_V(8); PG8_WAIT_L(0); PG8_BAR; PG8_MMA(0, 0, At, B0); PG8_MMA(0, 1, At, B1); PG8_BAR; PG8_SCHED;
            PG8_LDA(At, 0, 1); PG8_STAGE(PG8_SB(0, 0), b2, voffB); PG8_STAGE(PG8_SB(0, 1), b2 + hstep, voffB); PG8_STAGE(PG8_SA(0, 0), a2, voffA);
            PG8_WAIT_V(8); PG8_WAIT_L(0); PG8_BAR; PG8_MMA(1, 0, At, B0); PG8_MMA(1, 1, At, B1); PG8_BAR; PG8_SCHED;
            PG8_LDB(B0, 1, 0); PG8_LDB(B1, 1, 1); PG8_SCHED; PG8_LDA(At, 1, 0); PG8_STAGE(PG8_SA(0, 1), a2 + hstep, voffA);
            PG8_WAIT_V(8); PG8_WAIT_L(0); PG8_BAR; PG8_MMA(0, 0, At, B0); PG8_MMA(0, 1, At, B1); PG8_BAR; PG8_SCHED;
            PG8_LDA(At, 1, 1); PG8_STAGE(PG8_SB(1, 0), b3, voffB); PG8_STAGE(PG8_SB(1, 1), b3 + hstep, voffB); PG8_STAGE(PG8_SA(1, 0), a3, voffA);
            PG8_WAIT_V(8); PG8_WAIT_L(0); PG8_BAR; PG8_MMA(1, 0, At, B0); PG8_MMA(1, 1, At, B1); PG8_BAR; PG8_SCHED;
            } else {
            PG8_LDB(B0, 0, 0); PG8_SCHED; PG8_LDA(At, 0, 0); PG8_STAGE(PG8_SA(1, 1), a1 + hstep, voffA);
            PG8_WAIT_L(8); PG8_BAR; PG8_WAIT_L(0); PG8_MMA(0, 0, At, B0); PG8_BAR; PG8_SCHED;
            PG8_LDB(B1, 0, 1); PG8_STAGE(PG8_SB(0, 0), b2, voffB);
            PG8_BAR; PG8_WAIT_L(0); PG8_MMA(0, 1, At, B1); PG8_BAR;
            PG8_LDA(At, 0, 1); PG8_STAGE(PG8_SA(0, 0), a2, voffA);
            PG8_BAR; PG8_WAIT_L(0); PG8_MMA(1, 0, At, B0); PG8_BAR; PG8_SCHED;
            PG8_STAGE(PG8_SB(0, 1), b2 + hstep, voffB);
            PG8_WAIT_V(6); PG8_BAR; PG8_MMA(1, 1, At, B1); PG8_BAR;
            PG8_LDB(B0, 1, 0); PG8_SCHED; PG8_LDA(At, 1, 0); PG8_STAGE(PG8_SA(0, 1), a2 + hstep, voffA);
            PG8_WAIT_L(8); PG8_BAR; PG8_WAIT_L(0); PG8_MMA(0, 0, At, B0); PG8_BAR; PG8_SCHED;
            PG8_LDB(B1, 1, 1); PG8_STAGE(PG8_SB(1, 0), b3, voffB);
            PG8_BAR; PG8_WAIT_L(0); PG8_MMA(0, 1, At, B1); PG8_BAR;
            PG8_LDA(At, 1, 1); PG8_STAGE(PG8_SA(1, 0), a3, voffA);
            PG8_BAR; PG8_WAIT_L(0); PG8_MMA(1, 0, At, B0); PG8_BAR; PG8_SCHED;
            PG8_STAGE(PG8_SB(1, 1), b3 + hstep, voffB);
            PG8_WAIT_V(6); PG8_BAR; PG8_MMA(1, 1, At, B1); PG8_BAR;
            }
        }
        if constexpr (ALIGN_EPI) { if (wr == 0) PG8_BAR; }
        if constexpr (!Epi::AFTER_DRAIN) { E(acc, cur, wr, wc, fr, fq); S.done(cur); }
        if (!has_next) break;
#pragma unroll
        for (int a = 0; a < 2; ++a)
#pragma unroll
            for (int b = 0; b < 2; ++b)
#pragma unroll
                for (int m = 0; m < 4; ++m)
#pragma unroll
                    for (int n = 0; n < 2; ++n) acc[a][b][m][n] = (f32x4){0.f, 0.f, 0.f, 0.f};
        cur = nxt; cA = nA; cB = nB; ++ui;
        if constexpr (ALIGN_EPI) { if (wr == 1) PG8_BAR; }
    }
    PG8_WAIT_V(0);
    if constexpr (!ALIGN_EPI) { if (wr == 0) PG8_BAR; }
    PG8_BAR;
    if constexpr (Epi::AFTER_DRAIN) { E.fused(acc, cur, wr, wc, fr, fq, lds, wid, lane); S.done(cur); }
#undef PG8_SA
#undef PG8_SB
#undef PG8_STAGE
#undef PG8_LDA
#undef PG8_LDB
#undef PG8_MMA
#undef PG8_WAIT_V
#undef PG8_WAIT_L
#undef PG8_BAR
#undef PG8_SCHED
}
}
#define GAS __attribute__((address_space(1)))
#define LAS __attribute__((address_space(3)))
typedef unsigned short bf16;
typedef unsigned v4u __attribute__((ext_vector_type(4)));
typedef float f32x4 __attribute__((ext_vector_type(4)));
typedef short bf16x8 __attribute__((ext_vector_type(8)));
typedef GAS unsigned gu32;
typedef GAS unsigned long long gu64;
#define RLX_AGENT __ATOMIC_RELAXED, __HIP_MEMORY_SCOPE_AGENT
#define LDS_WAIT() asm volatile("s_waitcnt lgkmcnt(0)" ::: "memory")
#define VM_WAIT() asm volatile("s_waitcnt vmcnt(0)" ::: "memory")
__device__ __forceinline__ unsigned long long rt() { return __builtin_amdgcn_s_memrealtime(); }
__device__ __forceinline__ unsigned f2bf(float f) { unsigned u = __builtin_bit_cast(unsigned, f); return (u + 0x7fffu + ((u >> 16) & 1u)) >> 16; }
__device__ __forceinline__ unsigned pk2(float lo, float hi) { return f2bf(lo) | (f2bf(hi) << 16); }
#define XB_TMO      128
#define XB_XCNT(j)  (256  + 64 * (j))
#define XB_XSUB(j)  (1280 + 64 * (j))
#define XB_XGEN(j)  (2304 + 64 * (j))
#define XB_TOP      3328
#define XB_TOPGEN   3392
#define XCD_BAR_WORDS 3456
#define XB_SPIN_CAP (1u << 18)

__device__ __forceinline__ unsigned xb_ld(unsigned* p)              { return __hip_atomic_load(p, __ATOMIC_RELAXED, __HIP_MEMORY_SCOPE_AGENT); }
__device__ __forceinline__ unsigned xb_add(unsigned* p, unsigned v) { return __hip_atomic_fetch_add(p, v, __ATOMIC_RELAXED, __HIP_MEMORY_SCOPE_AGENT); }
__device__ __forceinline__ unsigned xb_xcc_id() { return (unsigned)__builtin_amdgcn_s_getreg((3 << 11) | 20) & 0xFu; }
#define XB_SPIN(cond, bar) do { unsigned _sp = 0; while (cond) { __builtin_amdgcn_s_sleep(1); \
    if ((++_sp & 255u) == 0u) { if (xb_ld(&(bar)[XB_TMO])) break; if (_sp > XB_SPIN_CAP) { atomicAdd(&(bar)[XB_TMO], 1u); break; } } } } while (0)

struct XcdBarrier {
    unsigned* bar; unsigned x;
    volatile LAS unsigned* st;
};

__device__ __forceinline__ XcdBarrier xcd_barrier_post(unsigned* bar, volatile LAS unsigned* st) {
    XcdBarrier b; b.bar = bar; b.x = xb_xcc_id(); b.st = st;
    if (threadIdx.x == 0) (void)xb_add(&bar[XB_XCNT(b.x)], 1u);
    return b;
}
__device__ __forceinline__ void xcd_barrier_complete(unsigned* bar, unsigned x, unsigned& nloc, unsigned& nx) {
    const unsigned G = gridDim.x * gridDim.y * gridDim.z;
    unsigned sum, cnt, mine, sp = 0u;
    for (;;) {
        sum = 0u; cnt = 0u; mine = 0u;
#pragma unroll
        for (unsigned j = 0; j < 16; ++j) { const unsigned c = xb_ld(&bar[XB_XCNT(j)]); sum += c; cnt += (c > 0u) ? 1u : 0u; mine = (j == x) ? c : mine; }
        if (sum == G) break;
        __builtin_amdgcn_s_sleep(1);
        if ((++sp & 255u) == 0u) { if (xb_ld(&bar[XB_TMO])) break; if (sp > XB_SPIN_CAP) { atomicAdd(&bar[XB_TMO], 1u); break; } }
    }
    nloc = mine > 0u ? mine : 1u; nx = cnt > 0u ? cnt : 1u;
}

__device__ __forceinline__ void xcd_barrier(const XcdBarrier& b) {
    asm volatile("s_waitcnt vmcnt(0)" ::: "memory");
    __syncthreads();
    if (threadIdx.x == 0) {
        unsigned* bar = b.bar;
        __builtin_amdgcn_s_waitcnt(0);
        unsigned nloc = b.st[0], nx = b.st[1];
        if (nloc == 0u) { xcd_barrier_complete(bar, b.x, nloc, nx); b.st[0] = nloc; b.st[1] = nx; }
        const unsigned old = xb_add(&bar[XB_XSUB(b.x)], 1u);
        const unsigned gen = old / nloc;
        if (old + 1u == (gen + 1u) * nloc) {
            __builtin_amdgcn_fence(__ATOMIC_RELEASE, "agent");
            asm volatile("s_waitcnt vmcnt(0)" ::: "memory");
            const unsigned og = xb_add(&bar[XB_TOP], 1u);
            const unsigned tg = og / nx;
            if (og + 1u == (tg + 1u) * nx) xb_add(&bar[XB_TOPGEN], 1u);
            else XB_SPIN(xb_ld(&bar[XB_TOPGEN]) == tg, bar);
            __builtin_amdgcn_fence(__ATOMIC_ACQUIRE, "agent");
            xb_add(&bar[XB_XGEN(b.x)], 1u);
            asm volatile("s_waitcnt vmcnt(0)" ::: "memory");
        } else {
            XB_SPIN(xb_ld(&bar[XB_XGEN(b.x)]) == gen, bar);
            __builtin_amdgcn_fence(__ATOMIC_ACQUIRE, "agent");
            asm volatile("s_waitcnt vmcnt(0)" ::: "memory");
        }
    }
    __syncthreads();
}

constexpr int NWAVES = 8;
#ifndef MK_MULTI
#define MK_MULTI 0
#endif
#ifndef SCAN_DPP
#define SCAN_DPP 1
#endif

#ifndef EXTRA_BAR
#define EXTRA_BAR 0
#endif
#ifndef REP_PRO
#define REP_PRO 1
#endif
#ifndef REP_GU
#define REP_GU 1
#endif
#ifndef REP_DN
#define REP_DN 1
#endif
#ifndef REP_ROW
#define REP_ROW 1
#endif
#ifndef REP_WIN
#define REP_WIN 1
#endif
#ifndef REP_PREP
#define REP_PREP 1
#endif
#ifndef REP_LORA
#define REP_LORA 1
#endif
#ifndef REP_MIX
#define REP_MIX 1
#endif
#ifndef REP_ATT
#define REP_ATT 1
#endif
#ifndef REP_S1
#define REP_S1 1
#endif
#ifndef REP_S2
#define REP_S2 1
#endif
#ifndef REP_S3
#define REP_S3 1
#endif
#ifndef REP_COMB
#define REP_COMB 1
#endif
#ifndef REP_WOUT
#define REP_WOUT 1
#endif

constexpr int BATCH = 8, SEQ = 2048, D = 2048, M = BATCH * SEQ, FF = 5632, NL = 4;
constexpr int NH = 12, HD = 64, DATT = 768, DRW = 768, DPOOL = 512;
constexpr int DRWIN = 2752, DIN = 5568, DINP = 5632, ZRP = 2816;
constexpr int LORA_K = 512, LORA_N = 2304;
constexpr float NORM_EPS = 1e-6f, GN_EPS = 64e-5f;
constexpr float QSCALE = 0.125f * 1.4426950408889634f;
constexpr int NPH = 1 + 8 * 2 + 4 * 7;

constexpr size_t MiB = 1u << 20;
constexpr size_t WS_CTL = 0, CTL_ZERO_BYTES = 1 * MiB;
constexpr size_t WS_COS = 1 * MiB, WS_SIN = 1 * MiB + 256 * 1024, WS_RS = 1 * MiB + 512 * 1024;
constexpr size_t WS_W = 2 * MiB, LW = 165 * MiB;
constexpr size_t LW_GU1 = 0, LW_D1 = 44 * MiB, LW_IN = 66 * MiB, LW_OUT = 88 * MiB, LW_GU2 = 96 * MiB, LW_D2 = 140 * MiB, LW_LORA = 162 * MiB, LW_POOL = 164 * MiB + 256 * 1024;
constexpr size_t WS_H = WS_W + NL * LW;
constexpr size_t WS_HID = WS_H + 64 * MiB;
constexpr size_t SQ_STRIDE = 22 * MiB, SQ_Q = 0, SQ_K = 3 * MiB, SQ_V = 6 * MiB, SQ_ZR = 9 * MiB, SQ_ZP = 20 * MiB;
static_assert((size_t)SEQ * FF * 2 == SQ_STRIDE && SQ_ZR + (size_t)SEQ * ZRP * 2 == SQ_ZP && SQ_ZP + (size_t)SEQ * 512 * 2 == SQ_STRIDE && (size_t)NH * SEQ * 64 * 2 == 3 * MiB, "per-sequence overlay");
constexpr size_t WS_Y = WS_HID + 176 * MiB;
constexpr size_t WS_CAT = WS_Y + 64 * MiB;
constexpr size_t WS_OG = WS_CAT + 64 * MiB;
constexpr size_t WS_LSE = WS_OG + 72 * MiB;
constexpr size_t WS_LA = WS_LSE + 3 * MiB;
constexpr size_t WS_PP = WS_LA + 16 * MiB;
constexpr size_t WS_L = WS_PP + 16 * MiB, WS_LB = WS_L, WS_XB = WS_L + 72 * MiB;
constexpr size_t WS_END = WS_L + 144 * MiB;
static_assert(WS_HID + BATCH * SQ_STRIDE <= WS_Y && LW_POOL + 512 * 512 * 2 <= LW && LW_LORA + (size_t)LORA_N * LORA_K * 2 <= LW_POOL, "d_ws map");
constexpr int CW_TMO = 0, CW_CODE = 1, CW_BAR = 4096, CW_ATTQ = 8192  , CW_RANK = 11264  , CW_GB = 12288  , CW_XC = 16384, XC_USE = 2 * 64 * 64;
static_assert((CW_XC + 12 * XC_USE) * 4 <= (int)CTL_ZERO_BYTES, "control words");

constexpr int RING_OFF = 0, RING_BYTES = 131072;
constexpr int LDSCTL_OFF = RING_BYTES, MISC_OFF = LDSCTL_OFF + 320;
constexpr int LDS_BYTES = 147456;

struct Args { const float* in[28]; float* out; unsigned char* ws; int ph_lo, ph_hi; };
struct ArgsD { const __attribute__((address_space(1))) float* in[28]; __attribute__((address_space(1))) float* out; __attribute__((address_space(1))) unsigned char* ws; int ph_lo, ph_hi; };
static_assert(sizeof(ArgsD) == sizeof(Args), "Args views");
typedef const __attribute__((address_space(4))) ArgsD KArgs;
#define INP(A, k) ((const float*)(A)->in[k])

typedef unsigned long long u64t;
typedef float f32x2g __attribute__((ext_vector_type(2)));
struct Frame {
    LAS unsigned char* lds;
    int wave, vcu, G, tid;
    int bi, nb, seq;
    float* X;
    unsigned char* ws;
};
__device__ __forceinline__ float bf2f(bf16 u) { return __uint_as_float((unsigned)u << 16); }
__device__ __forceinline__ float wave_sum(float v) {
#pragma unroll
    for (int o = 1; o < 64; o <<= 1) v += __shfl_xor(v, o);
    return v;
}
__device__ __forceinline__ float sigmoid_f(float x) { return __builtin_amdgcn_rcpf(1.0f + __builtin_amdgcn_exp2f(-1.4426950408889634f * x)); }

template <class SrcF>
__device__ __forceinline__ void transpose_item(const SrcF src, int ldw, int K, bf16* WT, LAS float* scr, int item, int nblk, int lane, const float* kgain = nullptr) {
    const int kb = item / nblk, nb = item % nblk, k0 = 64 * kb, n0 = 32 * nb;
    const float* colp = src(n0 + (lane & 31));
    float tv[32];
    const GAS float* cp = (const GAS float*)colp + (size_t)(k0 + (lane >> 5)) * ldw;
#pragma unroll
    for (int i = 0; i < 32; ++i) tv[i] = colp ? cp[(size_t)(2 * i) * ldw] : 0.f;
#pragma unroll
    for (int i = 0; i < 32; ++i) scr[(2 * i + (lane >> 5)) * 33 + (lane & 31)] = tv[i];
    LDS_WAIT(); asm volatile("" ::: "memory");
    const int c = lane & 7;
    f32x4 g0 = (f32x4){1.f, 1.f, 1.f, 1.f}, g1 = g0;
    if (kgain) { g0 = *(const GAS f32x4*)(kgain + k0 + 8 * c); g1 = *(const GAS f32x4*)(kgain + k0 + 8 * c + 4); }
#pragma unroll
    for (int j = 0; j < 4; ++j) { const int n = (lane >> 3) + 8 * j; const LAS float* s = scr + (8 * c) * 33 + n;
        v4u o; o.x = pk2(s[0 * 33] * g0[0], s[1 * 33] * g0[1]); o.y = pk2(s[2 * 33] * g0[2], s[3 * 33] * g0[3]); o.z = pk2(s[4 * 33] * g1[0], s[5 * 33] * g1[1]); o.w = pk2(s[6 * 33] * g1[2], s[7 * 33] * g1[3]);
        *(GAS v4u*)(WT + (size_t)(n0 + n) * K + k0 + 8 * c) = o; }
    LDS_WAIT(); asm volatile("" ::: "memory");
}
struct SrcGU { const float* g; long du;
    __device__ __forceinline__ const float* operator()(int n) const { const int col = 128 * (n >> 8) + (n & 127); const long off = ((n >> 7) & 1) ? du : 0l; return (const float*)((const char*)g + off) + col; } };
struct SrcPlain { const float* w; __device__ __forceinline__ const float* operator()(int n) const { return w + n; } };
struct SrcWin { const float* w;
    __device__ __forceinline__ const float* operator()(int n) const {
        if (n < 1536) { const int sec = n / 768, r = n % 768, h = r >> 6, j = r & 63, d = 4 * (j >> 3) + (j & 3) + 32 * ((j >> 2) & 1); return w + sec * 768 + h * 64 + d; }
        if (n < 2304 + DRWIN) return w + n;
        if (n < 2304 + ZRP) return nullptr;
        return w + (n - (ZRP - DRWIN));
    } };

__device__ __forceinline__ void x_row_init(Frame& F, const float* xrow, bf16* xb, float* rs) {
    const GAS f32x4* xr = (const GAS f32x4*)xrow + (F.tid & 63);
    f32x4 v[8]; float s = 0.f;
#pragma unroll
    for (int j = 0; j < 8; ++j) { v[j] = xr[64 * j]; s += (v[j].x * v[j].x + v[j].y * v[j].y) + (v[j].z * v[j].z + v[j].w * v[j].w); }
    const float rstd = 1.0f / sqrtf(wave_sum(s) * (1.f / D) + NORM_EPS);
    GAS u64t* o8 = (GAS u64t*)xb + (F.tid & 63);
#pragma unroll
    for (int j = 0; j < 8; ++j) o8[64 * j] = (u64t)pk2(v[j].x, v[j].y) | ((u64t)pk2(v[j].z, v[j].w) << 32);
    if ((F.tid & 63) == 0) *rs = rstd;
}

__device__ __forceinline__ void p0_prologue_w(Frame& F, KArgs* A);
__device__ __forceinline__ void p0_prologue(Frame& F, KArgs* A) {
    p0_prologue_w(F, A);
    const int gw = F.vcu * NWAVES + F.wave, NGW = F.G * NWAVES;
    for (int m = gw; m < M; m += NGW) x_row_init(F, INP(A, 0) + (size_t)m * D, ((bf16*)(F.ws + WS_XB)) + (size_t)m * D, ((float*)(F.ws + WS_RS)) + m);
}
__device__ __forceinline__ void p0_prologue_w(Frame& F, KArgs* A) {
    LAS float* scr = (LAS float*)(F.lds + RING_OFF + F.wave * 16384);
    const int gw = F.vcu * NWAVES + F.wave, NGW = F.G * NWAVES;
    constexpr int I_GU = (D / 64) * (2 * FF / 32), I_D = (FF / 64) * (D / 32), I_IN = (D / 64) * (DINP / 32), I_OUT = (D / 64) * (D / 32);
    constexpr int I_L = 2 * I_GU + 2 * I_D + I_IN + I_OUT;
    for (int it = gw; it < NL * I_L; it += NGW) {
        const int l = it / I_L; int r = it % I_L;
        unsigned char* wl = F.ws + WS_W + (size_t)l * LW;
        const size_t offF = (size_t)l * D * FF;
        if (r < I_GU) { transpose_item(SrcGU{INP(A, 3) + offF, (long)((const char*)INP(A, 4) - (const char*)INP(A, 3))}, FF, D, (bf16*)(wl + LW_GU1), scr, r, 2 * FF / 32, (F.tid & 63), INP(A, 1) + (size_t)l * D); continue; } r -= I_GU;
        if (r < I_D) { transpose_item(SrcPlain{INP(A, 5) + offF}, D, FF, (bf16*)(wl + LW_D1), scr, r, D / 32, (F.tid & 63)); continue; } r -= I_D;
        if (r < I_IN) { transpose_item(SrcWin{INP(A, 8) + (size_t)l * D * DIN}, DIN, D, (bf16*)(wl + LW_IN), scr, r, DINP / 32, (F.tid & 63), INP(A, 6) + (size_t)l * D); continue; } r -= I_IN;
        if (r < I_OUT) { transpose_item(SrcPlain{INP(A, 9) + (size_t)l * D * D}, D, D, (bf16*)(wl + LW_OUT), scr, r, D / 32, (F.tid & 63)); continue; } r -= I_OUT;
        if (r < I_GU) { transpose_item(SrcGU{INP(A, 25) + offF, (long)((const char*)INP(A, 26) - (const char*)INP(A, 25))}, FF, D, (bf16*)(wl + LW_GU2), scr, r, 2 * FF / 32, (F.tid & 63), INP(A, 23) + (size_t)l * D); continue; } r -= I_GU;
        transpose_item(SrcPlain{INP(A, 27) + offF}, D, FF, (bf16*)(wl + LW_D2), scr, r, D / 32, (F.tid & 63));
    }
    const int gt = F.vcu * (NWAVES * 64) + F.tid, NGT = F.G * NWAVES * 64;
    constexpr int E_LORA = LORA_N * LORA_K, E_POOL = 512 * 512, E_L = E_LORA + E_POOL;
    for (int e = gt; e < NL * E_L; e += NGT) {
        const int l = e / E_L; int r = e % E_L;
        unsigned char* wl = F.ws + WS_W + (size_t)l * LW;
        if (r < E_LORA) { const int n = r / LORA_K, k = r % LORA_K; float v = 0.f;
            if (n < 768) { if (k < 96) v = INP(A, 11)[(size_t)l * 96 * 768 + k * 768 + n]; }
            else if (n < 1536) { if (k >= 96 && k < 192) v = INP(A, 13)[(size_t)l * 96 * 768 + (k - 96) * 768 + (n - 768)]; }
            else { if (k >= 192 && k < 448) v = INP(A, 15)[(size_t)l * 256 * 768 + (k - 192) * 768 + (n - 1536)]; }
            ((bf16*)(wl + LW_LORA))[r] = (bf16)f2bf(v);
        } else { r -= E_LORA; const int n = r / 512, k = r % 512; float v = 0.f;
            if ((n >> 7) == (k >> 7)) v = INP(A, 21)[(size_t)l * 4 * 128 * 128 + (size_t)(n >> 7) * 128 * 128 + (k & 127) * 128 + (n & 127)];
            ((bf16*)(wl + LW_POOL))[r] = (bf16)f2bf(v);
        }
    }
    for (int e = gt; e < SEQ * 32; e += NGT) {
        const int pos = e >> 5, i = e & 31;
        const float invf = powf(10000.0f, -(float)i / 32.0f);
        const double rev = (double)pos * (double)invf * 0.15915494309189535;
        const float fr = (float)(rev - rint(rev));
        ((float*)(F.ws + WS_COS))[e] = __builtin_amdgcn_cosf(fr); ((float*)(F.ws + WS_SIN))[e] = __builtin_amdgcn_sinf(fr);
    }
}

__device__ __forceinline__ void row_pass(Frame& F, float coef, const float* gpost, bool last) {
    const int gw = F.vcu * NWAVES + F.wave, NGW = F.G * NWAVES, lane = F.tid & 63;
    for (int m = gw; m < M; m += NGW) {
        GAS u64t* xr = (GAS u64t*)(((bf16*)(F.ws + WS_XB)) + (size_t)m * D) + lane; const GAS u64t* yr = (const GAS u64t*)(((bf16*)(F.ws + WS_Y)) + (size_t)m * D) + lane;
        const GAS f32x4* gp = (const GAS f32x4*)gpost + lane;
        f32x4 xv[8], yv[8]; float s = 0.f;
#pragma unroll
        for (int j = 0; j < 8; ++j) { const u64t xw = xr[64 * j], w = yr[64 * j];
            xv[j].x = __uint_as_float((unsigned)(xw << 16)); xv[j].y = __uint_as_float((unsigned)xw & 0xffff0000u); xv[j].z = __uint_as_float((unsigned)(xw >> 32) << 16); xv[j].w = __uint_as_float((unsigned)(xw >> 32) & 0xffff0000u);
            yv[j].x = __uint_as_float((unsigned)(w << 16)); yv[j].y = __uint_as_float((unsigned)w & 0xffff0000u); yv[j].z = __uint_as_float((unsigned)(w >> 32) << 16); yv[j].w = __uint_as_float((unsigned)(w >> 32) & 0xffff0000u);
            s += (yv[j].x * yv[j].x + yv[j].y * yv[j].y) + (yv[j].z * yv[j].z + yv[j].w * yv[j].w); }
        const float cr = coef / sqrtf(wave_sum(s) * (1.f / D) + NORM_EPS); float s2 = 0.f;
        if (last) {
            GAS f32x4* xo = (GAS f32x4*)(F.X + (size_t)m * D) + lane;
#pragma unroll
            for (int j = 0; j < 8; ++j) { const f32x4 g = gp[64 * j]; xo[64 * j] = xv[j] + yv[j] * g * cr; }
        } else {
#pragma unroll
            for (int j = 0; j < 8; ++j) { const f32x4 g = gp[64 * j]; xv[j] = xv[j] + yv[j] * g * cr;
                const unsigned lo = pk2(xv[j].x, xv[j].y), hi = pk2(xv[j].z, xv[j].w); xr[64 * j] = (u64t)lo | ((u64t)hi << 32);
                const float a0 = __uint_as_float(lo << 16), a1 = __uint_as_float(lo & 0xffff0000u), a2 = __uint_as_float(hi << 16), a3 = __uint_as_float(hi & 0xffff0000u);
                s2 += (a0 * a0 + a1 * a1) + (a2 * a2 + a3 * a3); }
            const float rstd = 1.0f / sqrtf(wave_sum(s2) * (1.f / D) + NORM_EPS);
            if (lane == 0) ((float*)(F.ws + WS_RS))[m] = rstd;
        }
    }
}
__device__ __forceinline__ float tanh_f(float x) { return 1.0f - 2.0f * __builtin_amdgcn_rcpf(1.0f + __builtin_amdgcn_exp2f(2.8853900817779268f * x)); }
__device__ __forceinline__ void unpack8(const v4u z, float (&f)[8]) {
#pragma unroll
    for (int e = 0; e < 4; ++e) { f[2 * e] = __uint_as_float(z[e] << 16); f[2 * e + 1] = __uint_as_float(z[e] & 0xffff0000u); }
}
__device__ __forceinline__ void mix_prep(Frame& F, KArgs* A, int l) {
    const int gw = F.bi * NWAVES + F.wave, NGW = F.nb * NWAVES, lane = F.tid & 63;
    const float* mu = INP(A, 10) + (size_t)l * DRWIN + 2304;
    f32x4 mu0 = (f32x4){0.f, 0.f, 0.f, 0.f}, mu1 = mu0;
    if (lane < 56) { mu0 = *(const GAS f32x4*)(mu + 8 * lane); mu1 = *(const GAS f32x4*)(mu + 8 * lane + 4); }
    const int pw = 2 << (lane >> 4);
    const int per = (SEQ + NGW - 1) / NGW, r_lo = gw * per, r_hi = (r_lo + per < SEQ) ? r_lo + per : SEQ, m_lo = F.seq * SEQ + r_lo, m_hi = F.seq * SEQ + r_hi;
    for (int m = m_lo; m < m_hi; ++m) {
        const int s = m & (SEQ - 1);
        const unsigned char* sqb = F.ws + WS_HID + (size_t)(m >> 11) * SQ_STRIDE;
        const bf16* zr = ((const bf16*)(sqb + SQ_ZR)) + (size_t)s * ZRP + 2304 + 8 * (lane < 56 ? lane : 0);
        const bf16* zp = ((const bf16*)(sqb + SQ_ZP)) + (size_t)s * 512 + 8 * lane;
        const int cnt = (s + 1 < pw) ? s + 1 : pw;
        v4u zc = (v4u){0u, 0u, 0u, 0u}, zq = zc, zw[16];
        if (lane < 56) { zc = *(const GAS v4u*)zr; if (s > 0) zq = *(const GAS v4u*)(zr - ZRP); }
#pragma unroll
        for (int i = 0; i < 16; ++i) { zw[i] = (v4u){0u, 0u, 0u, 0u}; if (i < cnt) zw[i] = *(const GAS v4u*)(zp - (size_t)i * 512); }
        v4u outv = (v4u){0u, 0u, 0u, 0u};
        if (lane < 56) {
            float z[8], zpv[8], v[8]; unpack8(zc, z); unpack8(zq, zpv);
#pragma unroll
            for (int e = 0; e < 8; ++e) { const float mm = e < 4 ? mu0[e] : mu1[e - 4], zs = z[e] + (zpv[e] - z[e]) * mm; v[e] = lane < 12 ? tanh_f(zs) : (lane < 24 ? zs : sigmoid_f(zs)); }
            outv.x = pk2(v[0], v[1]); outv.y = pk2(v[2], v[3]); outv.z = pk2(v[4], v[5]); outv.w = pk2(v[6], v[7]);
        }
        *(GAS v4u*)(((bf16*)(F.ws + WS_LA)) + (size_t)m * LORA_K + 8 * lane) = outv;
        float acc[8], u[8]; unpack8(zw[0], u);
#pragma unroll
        for (int e = 0; e < 8; ++e) acc[e] = u[e];
#pragma unroll
        for (int i = 1; i < 16; ++i) { float t[8]; unpack8(zw[i], t);
#pragma unroll
            for (int e = 0; e < 8; ++e) acc[e] += t[e]; }
        const float ic = 1.0f / (float)cnt;
        v4u pv; pv.x = pk2(acc[0] * ic - u[0], acc[1] * ic - u[1]); pv.y = pk2(acc[2] * ic - u[2], acc[3] * ic - u[3]); pv.z = pk2(acc[4] * ic - u[4], acc[5] * ic - u[5]); pv.w = pk2(acc[6] * ic - u[6], acc[7] * ic - u[7]);
        *(GAS v4u*)(((bf16*)(F.ws + WS_PP)) + (size_t)m * 512 + 8 * lane) = pv;
    }
}
__device__ __forceinline__ void attn_combine(Frame& F) {
    const int gw = F.bi * NWAVES + F.wave, NGW = F.nb * NWAVES, lane = F.tid & 63;
    const float* LSE = (const float*)(F.ws + WS_LSE); const bf16* OG = (const bf16*)(F.ws + WS_OG); bf16* CAT = (bf16*)(F.ws + WS_CAT);
    const int per = (SEQ + NGW - 1) / NGW, r_lo = gw * per, r_hi = (r_lo + per < SEQ) ? r_lo + per : SEQ, m_lo = F.seq * SEQ + r_lo, m_hi = F.seq * SEQ + r_hi;
    constexpr int RB = 4;
    for (int m0 = m_lo; m0 < m_hi; m0 += RB) {
        u64t a[RB][3], b[RB][3], c[RB][3]; float l0[RB][3], l1[RB][3], l2[RB][3];
#pragma unroll
        for (int r = 0; r < RB; ++r) { const int m = (m0 + r < m_hi) ? m0 + r : m_hi - 1;
#pragma unroll
            for (int p = 0; p < 3; ++p) {
                const int h = 4 * p + (lane >> 4); const size_t o = (size_t)m * DATT + 256 * p + 4 * lane;
                l0[r][p] = LSE[(size_t)m * NH + h]; l1[r][p] = LSE[(size_t)(M + m) * NH + h]; l2[r][p] = LSE[(size_t)(2 * M + m) * NH + h];
                a[r][p] = *(const GAS u64t*)(OG + o); b[r][p] = *(const GAS u64t*)(OG + (size_t)M * DATT + o); c[r][p] = *(const GAS u64t*)(OG + (size_t)2 * M * DATT + o); } }
#pragma unroll
        for (int r = 0; r < RB; ++r) { if (m0 + r >= m_hi) break; const int m = m0 + r;
#pragma unroll
            for (int p = 0; p < 3; ++p) {
                const float mx = fmaxf(l0[r][p], fmaxf(l1[r][p], l2[r][p]));
                float e0 = __builtin_amdgcn_exp2f(l0[r][p] - mx), e1 = __builtin_amdgcn_exp2f(l1[r][p] - mx), e2 = __builtin_amdgcn_exp2f(l2[r][p] - mx); const float inv = __builtin_amdgcn_rcpf(e0 + e1 + e2);
                e0 *= inv; e1 *= inv; e2 *= inv;
                float rr[4];
#pragma unroll
                for (int e = 0; e < 4; ++e) rr[e] = e0 * bf2f((bf16)(a[r][p] >> (16 * e))) + e1 * bf2f((bf16)(b[r][p] >> (16 * e))) + e2 * bf2f((bf16)(c[r][p] >> (16 * e)));
                *(GAS u64t*)(CAT + (size_t)m * D + 256 * p + 4 * lane) = (u64t)pk2(rr[0], rr[1]) | ((u64t)pk2(rr[2], rr[3]) << 32); } }
    }
}
constexpr int MP = 64;
__device__ __forceinline__ int swz(int row, int col) { return row * MP + ((((col >> 3) ^ (row >> 1)) & 7) << 3) + (col & 7); }
constexpr int ATT_K_OFF = 0, ATT_V_OFF = 256 * 64 * 2;
constexpr int ATT_UNITS = 3 * BATCH * NH * 16;
static_assert(ATT_V_OFF + 256 * 64 * 2 <= RING_BYTES, "attention LDS");
typedef short s16x4v __attribute__((ext_vector_type(4)));
__device__ __forceinline__ int swzv(int key, int d) { return key * 64 + ((((d >> 3) ^ (2 * ((key >> 1) & 3))) & 7) << 3) + (d & 7); }
struct AttnIn { v4u kv[4], vv[4]; bf16x8 q0, q1; };
struct AttnUnit { int g, bh, dl, r, blk; };
constexpr int ATT_SEQ_UNITS = 3 * NH * 16;
__device__ __forceinline__ AttnUnit attn_decode(int lu, int seq) { AttnUnit u; u.g = lu / (NH * 16); const int rem = lu % (NH * 16), rb = rem & 15; u.bh = seq * NH + (rem >> 4);
    if (u.g == 0) { u.dl = 1; u.r = 0; u.blk = rb; } else if (u.g == 1) { u.dl = 4; u.r = rb & 3; u.blk = rb >> 2; } else { u.dl = 16; u.r = rb; u.blk = 0; } return u; }
__device__ __forceinline__ void attn_fetch(Frame& F, const AttnUnit& u, AttnIn& R) {
    const unsigned char* sqb = F.ws + WS_HID + (size_t)(u.bh / NH) * SQ_STRIDE; const size_t ho = (size_t)(u.bh % NH) * SEQ * 64;
    const bf16* Qh = ((const bf16*)(sqb + SQ_Q)) + ho; const bf16* Kh = ((const bf16*)(sqb + SQ_K)) + ho; const bf16* Vh = ((const bf16*)(sqb + SQ_V)) + ho;
#pragma unroll
    for (int it = 0; it < 4; ++it) { const int idx = F.tid + it * 512, j = idx >> 3, ch = idx & 7, lk = (u.blk - 1) * 128 + j;
        R.kv[it] = (v4u){0u, 0u, 0u, 0u}; R.vv[it] = (v4u){0u, 0u, 0u, 0u};
        if (lk >= 0) { const size_t off = (size_t)(lk * u.dl + u.r) * 64 + ch * 8; R.kv[it] = *(const GAS v4u*)(Kh + off); R.vv[it] = *(const GAS v4u*)(Vh + off); } }
    const int fr = (F.tid & 63) & 15, fq = (F.tid & 63) >> 4, tq = (u.blk * 128 + 16 * F.wave + fr) * u.dl + u.r;
    R.q0 = *(const GAS bf16x8*)(Qh + (size_t)tq * 64 + 8 * fq); R.q1 = *(const GAS bf16x8*)(Qh + (size_t)tq * 64 + 32 + 8 * fq);
}
__device__ __forceinline__ void attn_stage(Frame& F, const AttnIn& R) {
    LAS bf16* KS = (LAS bf16*)(F.lds + ATT_K_OFF); LAS bf16* VS = (LAS bf16*)(F.lds + ATT_V_OFF);
#pragma unroll
    for (int it = 0; it < 4; ++it) { const int idx = F.tid + it * 512, j = idx >> 3, ch = idx & 7;
        *(LAS v4u*)(KS + swz(j, 8 * ch)) = R.kv[it]; *(LAS v4u*)(VS + swzv(j, 8 * ch)) = R.vv[it]; }
}
__device__ __forceinline__ void attn_compute(Frame& F, const AttnUnit& u, const bf16x8 q0, const bf16x8 q1) {
    const LAS bf16* KS = (const LAS bf16*)(F.lds + ATT_K_OFF); const LAS bf16* VS = (const LAS bf16*)(F.lds + ATT_V_OFF);
    const int w = F.wave, lane = F.tid & 63, fr = lane & 15, fq = lane >> 4, blk = u.blk;
    const int tq = (blk * 128 + 16 * w + fr) * u.dl + u.r;
    const int ko0 = swz(fr, 8 * fq), ko1 = swz(fr, 32 + 8 * fq);
    f32x4 s[9];
#pragma unroll
    for (int t = 0; t < 9; ++t) { const LAS bf16* kp = KS + 16 * (w + t) * 64;
        f32x4 z = (f32x4){0.f, 0.f, 0.f, 0.f};
        z = __builtin_amdgcn_mfma_f32_16x16x32_bf16(*(const LAS bf16x8*)(kp + ko0), q0, z, 0, 0, 0);
        s[t] = __builtin_amdgcn_mfma_f32_16x16x32_bf16(*(const LAS bf16x8*)(kp + ko1), q1, z, 0, 0, 0); }
    float mx = -INFINITY;
#pragma unroll
    for (int i = 0; i < 4; ++i) { s[0][i] = (4 * fq + i >= fr) ? s[0][i] : -INFINITY; s[8][i] = (4 * fq + i <= fr) ? s[8][i] : -INFINITY; }
    if (blk == 0) {
#pragma unroll
        for (int t = 0; t < 9; ++t)
#pragma unroll
            for (int i = 0; i < 4; ++i) s[t][i] = (16 * (w + t) + 4 * fq + i >= 128) ? s[t][i] : -INFINITY; }
#pragma unroll
    for (int t = 0; t < 9; ++t)
#pragma unroll
        for (int i = 0; i < 4; ++i) mx = fmaxf(mx, s[t][i]);
    mx = fmaxf(mx, __shfl_xor(mx, 16)); mx = fmaxf(mx, __shfl_xor(mx, 32));
    float lsum = 0.f;
#pragma unroll
    for (int t = 0; t < 9; ++t)
#pragma unroll
        for (int i = 0; i < 4; ++i) { s[t][i] = __builtin_amdgcn_exp2f(s[t][i] - mx); lsum += s[t][i]; }
    lsum += __shfl_xor(lsum, 16); lsum += __shfl_xor(lsum, 32);
    f32x4 o[4];
#pragma unroll
    for (int c = 0; c < 4; ++c) o[c] = (f32x4){0.f, 0.f, 0.f, 0.f};
    const int tq_ = (lane >> 2) & 3, tp = lane & 3;
#pragma unroll
    for (int pp = 0; pp < 5; ++pp) {
        v4u pw; pw.x = pg8::cvt_pk_bf16(s[2 * pp][0], s[2 * pp][1]); pw.y = pg8::cvt_pk_bf16(s[2 * pp][2], s[2 * pp][3]);
        if (pp < 4) { pw.z = pg8::cvt_pk_bf16(s[2 * pp + 1][0], s[2 * pp + 1][1]); pw.w = pg8::cvt_pk_bf16(s[2 * pp + 1][2], s[2 * pp + 1][3]); } else { pw.z = 0u; pw.w = 0u; }
        const bf16x8 pb = __builtin_bit_cast(bf16x8, pw);
        const int ka = 16 * (w + 2 * pp) + 4 * fq + tq_, kb = (pp < 4) ? ka + 16 : ka;
#pragma unroll
        for (int c = 0; c < 4; ++c) {
            const s16x4v lo = __builtin_bit_cast(s16x4v, __builtin_amdgcn_ds_read_tr16_b64_v4i16((LAS s16x4v*)(VS + swzv(ka, 16 * c + 4 * tp))));
            const s16x4v hi = __builtin_bit_cast(s16x4v, __builtin_amdgcn_ds_read_tr16_b64_v4i16((LAS s16x4v*)(VS + swzv(kb, 16 * c + 4 * tp))));
            const bf16x8 va = (bf16x8){lo[0], lo[1], lo[2], lo[3], hi[0], hi[1], hi[2], hi[3]};
            o[c] = __builtin_amdgcn_mfma_f32_16x16x32_bf16(va, pb, o[c], 0, 0, 0); }
    }
    const float inv = 1.0f / lsum;
    const int b = u.bh / NH, h = u.bh % NH; const size_t mq = (size_t)b * SEQ + tq;
    bf16* op = ((bf16*)(F.ws + WS_OG)) + (size_t)u.g * M * DATT + mq * DATT + h * 64 + 4 * fq;
#pragma unroll
    for (int c = 0; c < 4; ++c) { pg8::u32x2 wv; wv.x = pg8::cvt_pk_bf16(o[c][0] * inv, o[c][1] * inv); wv.y = pg8::cvt_pk_bf16(o[c][2] * inv, o[c][3] * inv); *(GAS pg8::u32x2*)(op + 16 * c) = wv; }
    if (fq == 0) ((float*)(F.ws + WS_LSE))[((size_t)u.g * M + mq) * NH + h] = mx + __builtin_amdgcn_logf(lsum);
}
__device__ __forceinline__ void attn_loop(Frame& F, gu32* ctr) {
    volatile LAS int* slot = (volatile LAS int*)(F.lds + MISC_OFF + 64);
    const int seq = F.seq;
    if (F.tid == 0) *slot = (int)__hip_atomic_fetch_add(ctr, 1u, __ATOMIC_RELAXED, __HIP_MEMORY_SCOPE_AGENT);
    __syncthreads();
    int cur = *slot;
    AttnIn R;
    if (cur < ATT_SEQ_UNITS) attn_fetch(F, attn_decode(cur, seq), R);
    while (cur < ATT_SEQ_UNITS) {
        const AttnUnit u = attn_decode(cur, seq);
        __syncthreads();
        if (F.tid == 0) *slot = (int)__hip_atomic_fetch_add(ctr, 1u, __ATOMIC_RELAXED, __HIP_MEMORY_SCOPE_AGENT);
        attn_stage(F, R);
        const bf16x8 q0 = R.q0, q1 = R.q1;
        __syncthreads();
        const int nxt = *slot;
        if (nxt < ATT_SEQ_UNITS) attn_fetch(F, attn_decode(nxt, seq), R);
        attn_compute(F, u, q0, q1);
        cur = nxt;
    }
}

constexpr int CH = 64, NCHUNK = SEQ / CH, SCAN_UNITS = BATCH * NH * NCHUNK;
constexpr int MB = 64 * MP * 2;
constexpr int LP = 68;
constexpr int S1_KT = 0, S1_BT = MB, S1_KK = 2 * MB, S1_RT = 3 * MB, S1_KTT = 4 * MB, S1_BTT = 5 * MB, S1_KKT = 6 * MB, S1_VT = 7 * MB, S1_AAK = 8 * MB, S1_ARB = 9 * MB, S1_ARK = 10 * MB;
constexpr int S1_P = 11 * MB, S1_PT = 12 * MB, S1_TM = 13 * MB, S1_GC = 14 * MB, S1_WT = S1_P  , S1_END = S1_GC + 256;
constexpr int S1_AKVT = S1_KT, S1_WTT = S1_KK, S1_UT = S1_AAK;
static_assert(S1_END <= RING_BYTES, "S1 LDS");
constexpr size_t WS_XS = WS_H + 50 * MiB;
constexpr size_t WS_MC = WS_H, WS_RK = WS_H + 48 * MiB, WS_NCT = WS_Y, WS_YL = WS_END, WS_QE = WS_YL + 48 * MiB, WS_VV = WS_QE + 24 * MiB, WS_GG = WS_VV + 24 * MiB, WS_H0T = WS_GG + 24 * MiB, WS_END2 = WS_H0T + 24 * MiB;
static_assert((size_t)SCAN_UNITS * 64 * 64 * 4 <= 48 * MiB && (size_t)SCAN_UNITS * 64 * 64 * 2 <= 24 * MiB && WS_RK + (size_t)BATCH * NH * SEQ * 4 <= WS_HID, "scan scratch map");

__device__ __forceinline__ f32x4 mm_tile(const LAS bf16* X, const LAS bf16* Y, int tn, int tm, int fr, int fq, f32x4 acc) {
    const int o0 = swz(fr, 8 * fq), o1 = swz(fr, 32 + 8 * fq);
    const LAS bf16* ap = Y + 16 * tm * MP; const LAS bf16* bp = X + 16 * tn * MP;
    acc = __builtin_amdgcn_mfma_f32_16x16x32_bf16(*(const LAS bf16x8*)(ap + o0), *(const LAS bf16x8*)(bp + o0), acc, 0, 0, 0);
    acc = __builtin_amdgcn_mfma_f32_16x16x32_bf16(*(const LAS bf16x8*)(ap + o1), *(const LAS bf16x8*)(bp + o1), acc, 0, 0, 0);
    return acc;
}
__device__ __forceinline__ void st_tile_bf16(LAS bf16* Z, int tn, int tm, int fr, int fq, f32x4 v) {
    pg8::u32x2 w; w.x = pg8::cvt_pk_bf16(v[0], v[1]); w.y = pg8::cvt_pk_bf16(v[2], v[3]); *(LAS pg8::u32x2*)(Z + swz(16 * tn + fr, 16 * tm + 4 * fq)) = w;
}
constexpr f32x4 F4Z = {0.f, 0.f, 0.f, 0.f};

__device__ __forceinline__ void wave_sum8(float (&v)[8]) {
#pragma unroll
    for (int i = 0; i < 8; ++i) {
        v[i] += __builtin_bit_cast(float, __builtin_amdgcn_update_dpp(0, __builtin_bit_cast(int, v[i]), 0xB1, 0xF, 0xF, true));
        v[i] += __builtin_bit_cast(float, __builtin_amdgcn_update_dpp(0, __builtin_bit_cast(int, v[i]), 0x4E, 0xF, 0xF, true));
        v[i] += __builtin_bit_cast(float, __builtin_amdgcn_update_dpp(0, __builtin_bit_cast(int, v[i]), 0x141, 0xF, 0xF, true));
        v[i] += __builtin_bit_cast(float, __builtin_amdgcn_update_dpp(0, __builtin_bit_cast(int, v[i]), 0x140, 0xF, 0xF, true)); }
    float t[8];
#pragma unroll
    for (int i = 0; i < 8; ++i) t[i] = __shfl_xor(v[i], 16);
#pragma unroll
    for (int i = 0; i < 8; ++i) v[i] += t[i];
#pragma unroll
    for (int i = 0; i < 8; ++i) t[i] = __shfl_xor(v[i], 32);
#pragma unroll
    for (int i = 0; i < 8; ++i) v[i] += t[i];
}
constexpr int LAP = 456, PPP = 520;
constexpr int MF_STG = 64 * PPP * 2;
static_assert(MF_STG + 8 * 4096 <= RING_BYTES && 64 * LAP * 2 <= MF_STG, "mixer-front LDS");
__device__ __forceinline__ void mf_store_rows(int lane, LAS bf16* stg, bf16* dst, size_t pitch) {
    asm volatile("s_waitcnt lgkmcnt(0)" ::: "memory");
#pragma unroll
    for (int i = 0; i < 4; ++i) { const int row = 8 * i + (lane >> 3), ch = lane & 7; const v4u v = *(const LAS v4u*)(stg + row * 64 + ch * 8); *(GAS v4u*)(dst + (size_t)row * pitch + ch * 8) = v; }
    asm volatile("s_waitcnt lgkmcnt(0)" ::: "memory");
}
template <int PARTS  > __device__ __forceinline__ void mix_front(Frame& F, KArgs* A, int l, int seq, int c) {
    int tid_ = F.tid; asm volatile("" : "+v"(tid_));
    const int tid = tid_, lane = tid & 63, w = F.wave, fr = lane & 15, fq = lane >> 4;
    LAS bf16* TL = (LAS bf16*)F.lds; LAS bf16* stg = (LAS bf16*)(F.lds + MF_STG + w * 4096);
    const int s00 = c * CH; const size_t m0 = (size_t)seq * SEQ + s00;
    const unsigned char* sqb = F.ws + WS_HID + (size_t)seq * SQ_STRIDE;
    const int row = tid >> 3, sub = tid & 7;
    if (PARTS & 1) { const float* mu = INP(A, 10) + (size_t)l * DRWIN + 2304; const int s = s00 + row;
      const bf16* zr = ((const bf16*)(sqb + SQ_ZR)) + (size_t)s * ZRP + 2304;
      v4u zc[7], zq[7]; f32x4 mu0[7], mu1[7];
#pragma unroll
      for (int i = 0; i < 7; ++i) { const int j = sub + 8 * i;
          zc[i] = *(const GAS v4u*)(zr + 8 * j); zq[i] = (v4u){0u, 0u, 0u, 0u}; if (s > 0) zq[i] = *(const GAS v4u*)(zr + 8 * j - ZRP);
          mu0[i] = *(const GAS f32x4*)(mu + 8 * j); mu1[i] = *(const GAS f32x4*)(mu + 8 * j + 4); }
#pragma unroll
      for (int i = 0; i < 7; ++i) { const int j = sub + 8 * i;
          float z[8], zp[8], v[8]; unpack8(zc[i], z); unpack8(zq[i], zp);
#pragma unroll
          for (int e = 0; e < 8; ++e) { const float mm = e < 4 ? mu0[i][e] : mu1[i][e - 4], zs = z[e] + (zp[e] - z[e]) * mm; v[e] = j < 12 ? tanh_f(zs) : (j < 24 ? zs : sigmoid_f(zs)); }
          v4u o; o.x = pk2(v[0], v[1]); o.y = pk2(v[2], v[3]); o.z = pk2(v[4], v[5]); o.w = pk2(v[6], v[7]);
          *(LAS v4u*)(TL + row * LAP + 8 * j) = o; } }
    __syncthreads();
    if (PARTS & 1) { const bf16* WL = (const bf16*)(F.ws + WS_W + (size_t)l * LW + LW_LORA);
#define MF_WL_LOAD(STEP, DST) do { const int it_ = w + NWAVES * ((STEP) >> 2), cb_ = it_ >> 1, g_ = cb_ / 12, kb_ = g_ == 0 ? 0 : (g_ == 1 ? 96 : 192), nk_ = g_ == 2 ? 8 : 3; \
        const bf16* p_ = WL + (size_t)(cb_ * 64 + ((STEP) & 3) * 16 + fr) * LORA_K + kb_ + 8 * fq; \
        _Pragma("unroll") for (int ks_ = 0; ks_ < 8; ++ks_) if (ks_ < nk_) DST[ks_] = *(const GAS bf16x8*)(p_ + 32 * ks_); } while (0)
#define MF_WL_STEP(STEP, CUR) do { const int it_ = w + NWAVES * ((STEP) >> 2), cb_ = it_ >> 1, th_ = it_ & 1, ct_ = (STEP) & 3, g_ = cb_ / 12, kb_ = g_ == 0 ? 0 : (g_ == 1 ? 96 : 192), nk_ = g_ == 2 ? 8 : 3; \
        f32x4 acc_[2] = {F4Z, F4Z}; \
        _Pragma("unroll") for (int ks_ = 0; ks_ < 8; ++ks_) if (ks_ < nk_) { _Pragma("unroll") for (int tt_ = 0; tt_ < 2; ++tt_) \
            acc_[tt_] = __builtin_amdgcn_mfma_f32_16x16x32_bf16(CUR[ks_], *(const LAS bf16x8*)(TL + (32 * th_ + 16 * tt_ + fr) * LAP + kb_ + 32 * ks_ + 8 * fq), acc_[tt_], 0, 0, 0); } \
        _Pragma("unroll") for (int tt_ = 0; tt_ < 2; ++tt_) { pg8::u32x2 o_; o_.x = pg8::cvt_pk_bf16(acc_[tt_][0], acc_[tt_][1]); o_.y = pg8::cvt_pk_bf16(acc_[tt_][2], acc_[tt_][3]); *(LAS pg8::u32x2*)(stg + (16 * tt_ + fr) * 64 + ct_ * 16 + 4 * fq) = o_; } \
        if (ct_ == 3) mf_store_rows(lane, stg, ((bf16*)(F.ws + WS_LB)) + (m0 + 32 * th_) * LORA_N + cb_ * 64, LORA_N); } while (0)
      bf16x8 wa[8], wb[8];
      MF_WL_LOAD(0, wa);
      for (int st = 0; st < 36; st += 2) { MF_WL_LOAD(st + 1, wb); MF_WL_STEP(st, wa); if (st + 2 < 36) MF_WL_LOAD(st + 2, wa); MF_WL_STEP(st + 1, wb); }
#undef MF_WL_LOAD
#undef MF_WL_STEP
    }
    __syncthreads();
    if (PARTS & 2) { const int s = s00 + row; const bf16* zpb = ((const bf16*)(sqb + SQ_ZP)) + (size_t)s * 512;
#define MF_PW_LOAD(I, DST) do { constexpr int pw_ = 2 << ((I) >> 1); const int j_ = sub + 8 * (I); \
        _Pragma("unroll") for (int r_ = 0; r_ < pw_; ++r_) { DST[r_] = (v4u){0u, 0u, 0u, 0u}; if (r_ <= s) DST[r_] = *(const GAS v4u*)(zpb + 8 * j_ - (size_t)r_ * 512); } } while (0)
#define MF_PW_STEP(I, CUR) do { constexpr int pw_ = 2 << ((I) >> 1); const int j_ = sub + 8 * (I), cnt_ = (s + 1 < pw_) ? s + 1 : pw_; \
        float acc_[8], u_[8]; unpack8(CUR[0], u_); \
        _Pragma("unroll") for (int e_ = 0; e_ < 8; ++e_) acc_[e_] = u_[e_]; \
        _Pragma("unroll") for (int r_ = 1; r_ < pw_; ++r_) { float t_[8]; unpack8(CUR[r_], t_); _Pragma("unroll") for (int e_ = 0; e_ < 8; ++e_) acc_[e_] += t_[e_]; } \
        const float ic_ = 1.0f / (float)cnt_; v4u pv_; \
        pv_.x = pk2(acc_[0] * ic_ - u_[0], acc_[1] * ic_ - u_[1]); pv_.y = pk2(acc_[2] * ic_ - u_[2], acc_[3] * ic_ - u_[3]); pv_.z = pk2(acc_[4] * ic_ - u_[4], acc_[5] * ic_ - u_[5]); pv_.w = pk2(acc_[6] * ic_ - u_[6], acc_[7] * ic_ - u_[7]); \
        *(LAS v4u*)(TL + row * PPP + 8 * j_) = pv_; } while (0)
      { v4u z0[2], z1[2], z2[4], z3[4], z4[8], z5[8];
        MF_PW_LOAD(0, z0); MF_PW_LOAD(1, z1); MF_PW_LOAD(2, z2); MF_PW_LOAD(3, z3); MF_PW_LOAD(4, z4); MF_PW_LOAD(5, z5);
        MF_PW_STEP(0, z0); MF_PW_STEP(1, z1); MF_PW_STEP(2, z2); MF_PW_STEP(3, z3); MF_PW_STEP(4, z4); MF_PW_STEP(5, z5); }
      { v4u z6[16]; MF_PW_LOAD(6, z6); MF_PW_STEP(6, z6); }
      { v4u z7[16]; MF_PW_LOAD(7, z7); MF_PW_STEP(7, z7); }
#undef MF_PW_LOAD
#undef MF_PW_STEP
    }
    __syncthreads();
    if (PARTS & 2) { const bf16* WP = (const bf16*)(F.ws + WS_W + (size_t)l * LW + LW_POOL); const float* psc = INP(A, 22) + (size_t)l * DPOOL;
      for (int it = w; it < 16; it += NWAVES) { const int cb = it >> 1, th = it & 1, kbeg = 128 * (cb >> 1);
          bf16x8 wa[4][4]; f32x4 sc[4];
#pragma unroll
          for (int ct = 0; ct < 4; ++ct) { sc[ct] = *(const GAS f32x4*)(psc + cb * 64 + ct * 16 + 4 * fq);
#pragma unroll
              for (int ks = 0; ks < 4; ++ks) wa[ct][ks] = *(const GAS bf16x8*)(WP + (size_t)(cb * 64 + ct * 16 + fr) * 512 + kbeg + 32 * ks + 8 * fq); }
#pragma unroll
          for (int ct = 0; ct < 4; ++ct) { f32x4 acc[2] = {F4Z, F4Z};
#pragma unroll
              for (int ks = 0; ks < 4; ++ks)
#pragma unroll
                  for (int tt = 0; tt < 2; ++tt) acc[tt] = __builtin_amdgcn_mfma_f32_16x16x32_bf16(wa[ct][ks], *(const LAS bf16x8*)(TL + (32 * th + 16 * tt + fr) * PPP + kbeg + 32 * ks + 8 * fq), acc[tt], 0, 0, 0);
#pragma unroll
              for (int tt = 0; tt < 2; ++tt) { pg8::u32x2 o; o.x = pg8::cvt_pk_bf16(acc[tt][0] * sc[ct][0], acc[tt][1] * sc[ct][1]); o.y = pg8::cvt_pk_bf16(acc[tt][2] * sc[ct][2], acc[tt][3] * sc[ct][3]); *(LAS pg8::u32x2*)(stg + (16 * tt + fr) * 64 + ct * 16 + 4 * fq) = o; } }
          mf_store_rows(lane, stg, ((bf16*)(F.ws + WS_CAT)) + (m0 + 32 * th) * D + DATT + DRW + cb * 64, D); } }
    asm volatile("s_waitcnt vmcnt(0)" ::: "memory");
    __syncthreads();
}

struct S1Raw { unsigned zr[9], zk[9], zv[9], dw[8], da[8], gg[8]; float mu_r, mu_k, mu_v, w0, a0, k_k, k_a, r_k; };
__device__ __forceinline__ void s1_fetch(Frame& F, KArgs* A, int l, int unit, S1Raw& R) {
    const int hb = unit / NCHUNK, c = unit % NCHUNK, b = hb / NH, h = hb % NH, lane = F.tid & 63, hc = h * 64 + lane;
    const int s0 = c * CH + 8 * F.wave; const size_t m0 = (size_t)b * SEQ + s0;
    const GAS bf16* zr = (const GAS bf16*)(((const bf16*)(F.ws + WS_HID + (size_t)b * SQ_STRIDE + SQ_ZR)) + (size_t)s0 * ZRP); const GAS bf16* Lr = (const GAS bf16*)(((const bf16*)(F.ws + WS_LB)) + m0 * LORA_N);
#pragma unroll
    for (int q = 0; q < 9; ++q) { if (q == 0 && s0 == 0) { R.zr[0] = 0u; R.zk[0] = 0u; R.zv[0] = 0u; } else { const GAS bf16* zp = zr + (q - 1) * ZRP; R.zr[q] = zp[hc]; R.zk[q] = zp[768 + hc]; R.zv[q] = zp[1536 + hc]; } }
#pragma unroll
    for (int q = 0; q < 8; ++q) { R.dw[q] = Lr[q * LORA_N + hc]; R.da[q] = Lr[q * LORA_N + 768 + hc]; R.gg[q] = Lr[q * LORA_N + 1536 + hc]; }
    const float* mu = INP(A, 10) + (size_t)l * DRWIN; const size_t lo = (size_t)l * DRW + hc;
    R.mu_r = mu[hc]; R.mu_k = mu[768 + hc]; R.mu_v = mu[1536 + hc];
    R.w0 = INP(A, 12)[lo]; R.a0 = INP(A, 14)[lo]; R.k_k = INP(A, 16)[lo]; R.k_a = INP(A, 17)[lo]; R.r_k = INP(A, 18)[lo];
}
__device__ __forceinline__ int tslot(int tn, int tm, int lane) { return (tn * 4 + tm) * 64 + lane; }

template <int PMODE  > __device__ __forceinline__ void scan_s1_phase(Frame& F, KArgs* A, int l) {
    const int lane = F.tid & 63, w = F.wave;
    const int fr = lane & 15, fq = lane >> 4, tn = w & 3, tm0 = 2 * (w >> 2);
    LAS bf16* KT = (LAS bf16*)(F.lds + S1_KT); LAS bf16* BT = (LAS bf16*)(F.lds + S1_BT); LAS bf16* KK = (LAS bf16*)(F.lds + S1_KK); LAS bf16* RT = (LAS bf16*)(F.lds + S1_RT);
    LAS bf16* KTT = (LAS bf16*)(F.lds + S1_KTT); LAS bf16* BTT = (LAS bf16*)(F.lds + S1_BTT); LAS bf16* KKT = (LAS bf16*)(F.lds + S1_KKT); LAS bf16* VT = (LAS bf16*)(F.lds + S1_VT);
    LAS bf16* AAK = (LAS bf16*)(F.lds + S1_AAK); LAS bf16* ARB = (LAS bf16*)(F.lds + S1_ARB); LAS bf16* ARK = (LAS bf16*)(F.lds + S1_ARK);
    LAS bf16* AKVT = (LAS bf16*)(F.lds + S1_AKVT); LAS bf16* TM = (LAS bf16*)(F.lds + S1_TM); LAS bf16* WTT = (LAS bf16*)(F.lds + S1_WTT); LAS bf16* UT = (LAS bf16*)(F.lds + S1_UT);
    LAS bf16* PM = (LAS bf16*)(F.lds + S1_P); LAS bf16* PT = (LAS bf16*)(F.lds + S1_PT);
    LAS float* GC = (LAS float*)(F.lds + S1_GC); LAS float* WTOT = (LAS float*)(F.lds + S1_WT);
    for (int cc = F.bi; cc < NCHUNK; cc += F.nb) {
    mix_front<3>(F, A, l, F.seq, cc);
    S1Raw R; s1_fetch(F, A, l, (F.seq * NH) * NCHUNK + cc, R);
    for (int hh = 0; hh < NH; ++hh) {
    const int unit = (F.seq * NH + hh) * NCHUNK + cc;
    const int hb = unit / NCHUNK, c = unit % NCHUNK;
    {
        const int s0 = c * CH + 8 * w;
        float rr[8], kap[8], kp[8], aa[8], vv[8], lw[8], cl[8], kk0[8], red[8];
#pragma unroll
        for (int q = 0; q < 8; ++q) {
            const float zr1 = __uint_as_float(R.zr[q + 1] << 16), zr0 = __uint_as_float(R.zr[q] << 16), zk1 = __uint_as_float(R.zk[q + 1] << 16), zk0 = __uint_as_float(R.zk[q] << 16), zv1 = __uint_as_float(R.zv[q + 1] << 16), zv0 = __uint_as_float(R.zv[q] << 16);
            rr[q] = zr1 + (zr0 - zr1) * R.mu_r; kk0[q] = zk1 + (zk0 - zk1) * R.mu_k; vv[q] = zv1 + (zv0 - zv1) * R.mu_v;
            lw[q] = -0.6065306597126334f * 1.4426950408889634f * sigmoid_f(R.w0 + __uint_as_float(R.dw[q] << 16));
            aa[q] = sigmoid_f(R.a0 + __uint_as_float(R.da[q] << 16));
            kp[q] = kk0[q] * (1.0f + (aa[q] - 1.0f) * R.k_a);
            const float kkn = kk0[q] * R.k_k; red[q] = kkn * kkn;
        }
        wave_sum8(red);
        float run = 0.f;
#pragma unroll
        for (int q = 0; q < 8; ++q) { kap[q] = kk0[q] * R.k_k * __builtin_amdgcn_rsqf(fmaxf(red[q], 1e-24f)); red[q] = rr[q] * kp[q] * R.r_k; run += lw[q]; cl[q] = run; }
        wave_sum8(red);
#pragma unroll
        for (int q = 0; q < 8; ++q) {
            const size_t tok = (size_t)hb * SEQ + s0 + q;
            ((bf16*)(F.ws + WS_VV))[tok * 64 + lane] = (bf16)(pg8::cvt_pk_bf16(vv[q], vv[q]) & 0xffffu); ((bf16*)(F.ws + WS_GG))[tok * 64 + lane] = (bf16)R.gg[q];
            if (lane == 0) ((float*)(F.ws + WS_RK))[tok] = red[q];
        }
        if (hh + 1 < NH) s1_fetch(F, A, l, unit + NCHUNK, R);
        WTOT[w * 64 + lane] = run;
        __syncthreads();
        float off = 0.f;
#pragma unroll
        for (int w2 = 0; w2 < 7; ++w2) off += (w2 < w) ? WTOT[w2 * 64 + lane] : 0.f;
        if (w == 7) GC[lane] = __builtin_amdgcn_exp2f(off + run);
        float fkt[8], fbt[8], fkk[8], frt[8];
#pragma unroll
        for (int q = 0; q < 8; ++q) {
            const float ct = off + cl[q], ctm1 = ct - lw[q];
            const float gp = __builtin_amdgcn_exp2f(ct), gm = __builtin_amdgcn_exp2f(ctm1), gi = __builtin_amdgcn_exp2f(-ct);
            fkt[q] = kap[q] * gm; fbt[q] = kap[q] * aa[q] * gi; fkk[q] = kp[q] * gi; frt[q] = rr[q] * gp;
        }
        v4u pkt, pbt, pkk, pvt, prt;
#pragma unroll
        for (int i = 0; i < 4; ++i) { pkt[i] = pg8::cvt_pk_bf16(fkt[2 * i], fkt[2 * i + 1]); pbt[i] = pg8::cvt_pk_bf16(fbt[2 * i], fbt[2 * i + 1]); pkk[i] = pg8::cvt_pk_bf16(fkk[2 * i], fkk[2 * i + 1]);
            prt[i] = pg8::cvt_pk_bf16(frt[2 * i], frt[2 * i + 1]); pvt[i] = pg8::cvt_pk_bf16(vv[2 * i], vv[2 * i + 1]); }
#pragma unroll
        for (int q = 0; q < 8; ++q) { const int o = swz(8 * w + q, lane), sh = 16 * (q & 1);
            KT[o] = (bf16)(pkt[q >> 1] >> sh); BT[o] = (bf16)(pbt[q >> 1] >> sh); KK[o] = (bf16)(pkk[q >> 1] >> sh); RT[o] = (bf16)(prt[q >> 1] >> sh); }
        { const int o = swz(lane, 8 * w); *(LAS v4u*)(KTT + o) = pkt; *(LAS v4u*)(BTT + o) = pbt; *(LAS v4u*)(KKT + o) = pkk; *(LAS v4u*)(VT + o) = pvt; }
    }
    __syncthreads();
    if (PMODE == 1) continue;
    f32x4 Treg[2];
#pragma unroll
    for (int d = 0; d < 2; ++d) { const int tm = tm0 + d; const int t = 16 * tn + fr, sb = 16 * tm + 4 * fq;
        const f32x4 aL = mm_tile(KT, BT, tn, tm, fr, fq, F4Z), aLt = mm_tile(BT, KT, tn, tm, fr, fq, F4Z);
        f32x4 aK = mm_tile(KT, KK, tn, tm, fr, fq, F4Z), aRB = mm_tile(RT, BT, tn, tm, fr, fq, F4Z), aRK = mm_tile(RT, KK, tn, tm, fr, fq, F4Z);
        f32x4 pl, plt;
#pragma unroll
        for (int e = 0; e < 4; ++e) { const bool st = (sb + e) < t, inc = (sb + e) <= t;
            pl[e] = st ? -aL[e] : 0.f; plt[e] = (t < sb + e) ? -aLt[e] : 0.f; Treg[d][e] = ((sb + e) == t ? 1.0f : 0.0f) + pl[e];
            aK[e] = st ? aK[e] : 0.f; aRB[e] = inc ? aRB[e] : 0.f; aRK[e] = inc ? aRK[e] : 0.f; }
        st_tile_bf16(PM, tn, tm, fr, fq, pl); st_tile_bf16(PT, tn, tm, fr, fq, plt); st_tile_bf16(TM, tn, tm, fr, fq, Treg[d]);
        st_tile_bf16(AAK, tn, tm, fr, fq, aK); st_tile_bf16(ARB, tn, tm, fr, fq, aRB); st_tile_bf16(ARK, tn, tm, fr, fq, aRK); }
    __syncthreads();
    {
        f32x4 p2[2], p2t[2];
#pragma unroll
        for (int d = 0; d < 2; ++d) { p2[d] = mm_tile(PM, PT, tn, tm0 + d, fr, fq, F4Z); p2t[d] = mm_tile(PT, PM, tn, tm0 + d, fr, fq, F4Z);
            st_tile_bf16(AKVT, tn, tm0 + d, fr, fq, mm_tile(VT, AAK, tn, tm0 + d, fr, fq, F4Z)); }
        __syncthreads();
#pragma unroll
        for (int d = 0; d < 2; ++d) { st_tile_bf16(PM, tn, tm0 + d, fr, fq, p2[d]); st_tile_bf16(PT, tn, tm0 + d, fr, fq, p2t[d]); }
        __syncthreads();
#pragma unroll
        for (int it = 1; it <= 5; ++it) {
#pragma unroll
            for (int d = 0; d < 2; ++d) { Treg[d] = mm_tile(TM, PT, tn, tm0 + d, fr, fq, Treg[d]);
                if (it < 5) { p2[d] = mm_tile(PM, PT, tn, tm0 + d, fr, fq, F4Z); p2t[d] = mm_tile(PT, PM, tn, tm0 + d, fr, fq, F4Z); } }
            __syncthreads();
#pragma unroll
            for (int d = 0; d < 2; ++d) { st_tile_bf16(TM, tn, tm0 + d, fr, fq, Treg[d]);
                if (it < 5) { st_tile_bf16(PM, tn, tm0 + d, fr, fq, p2[d]); st_tile_bf16(PT, tn, tm0 + d, fr, fq, p2t[d]); } }
            __syncthreads();
        }
    }
    if (PMODE == 2) { __syncthreads(); continue; }
    {
        f32x4 aw[2], au[2];
#pragma unroll
        for (int d = 0; d < 2; ++d) { aw[d] = mm_tile(KTT, TM, tn, tm0 + d, fr, fq, F4Z); au[d] = mm_tile(AKVT, TM, tn, tm0 + d, fr, fq, F4Z); }
#pragma unroll
        for (int d = 0; d < 2; ++d) { st_tile_bf16(WTT, tn, tm0 + d, fr, fq, aw[d]); st_tile_bf16(UT, tn, tm0 + d, fr, fq, au[d]); }
    }
    __syncthreads();
    {
        const size_t ub = (size_t)unit * 64 * 64;
        GAS f32x4* MC = (GAS f32x4*)((float*)(F.ws + WS_MC) + ub); GAS pg8::u32x2* NCT = (GAS pg8::u32x2*)((bf16*)(F.ws + WS_NCT) + ub);
        GAS pg8::u32x2* YL = (GAS pg8::u32x2*)((bf16*)(F.ws + WS_YL) + ub); GAS pg8::u32x2* QE = (GAS pg8::u32x2*)((bf16*)(F.ws + WS_QE) + ub);
#pragma unroll
        for (int d = 0; d < 2; ++d) { const int tm = tm0 + d, i = 16 * tn + fr, j = 16 * tm + 4 * fq, ts = tslot(tn, tm, lane);
            { const f32x4 a = mm_tile(ARB, WTT, tn, tm, fr, fq, F4Z); const pg8::u32x2 rv = *(const LAS pg8::u32x2*)(RT + swz(i, j));
              const float r0 = __uint_as_float(rv.x << 16), r1 = __uint_as_float(rv.x & 0xffff0000u), r2 = __uint_as_float(rv.y << 16), r3 = __uint_as_float(rv.y & 0xffff0000u);
              pg8::u32x2 o; o.x = pg8::cvt_pk_bf16(r0 - a[0], r1 - a[1]); o.y = pg8::cvt_pk_bf16(r2 - a[2], r3 - a[3]); if (PMODE != 3) QE[ts] = o; else asm volatile("" :: "v"(o.x), "v"(o.y)); }
            { const f32x4 a = mm_tile(ARK, VT, tn, tm, fr, fq, F4Z), a2 = mm_tile(ARB, UT, tn, tm, fr, fq, F4Z);
              pg8::u32x2 o; o.x = pg8::cvt_pk_bf16(a[0] - a2[0], a[1] - a2[1]); o.y = pg8::cvt_pk_bf16(a[2] - a2[2], a[3] - a2[3]); if (PMODE != 3) YL[ts] = o; else asm volatile("" :: "v"(o.x), "v"(o.y)); }
            { const f32x4 a = mm_tile(BTT, WTT, tn, tm, fr, fq, F4Z); const float gc = GC[i]; f32x4 o;
#pragma unroll
              for (int e = 0; e < 4; ++e) o[e] = gc * (((j + e) == i ? 1.0f : 0.0f) - a[e]);
              if (PMODE != 3) MC[ts] = o; else asm volatile("" :: "v"(o[0]), "v"(o[1]), "v"(o[2]), "v"(o[3])); }
            { const f32x4 a = mm_tile(VT, KKT, tn, tm, fr, fq, F4Z), a2 = mm_tile(UT, BTT, tn, tm, fr, fq, F4Z); const f32x4 gc = *(const LAS f32x4*)(GC + j);
              pg8::u32x2 o; o.x = pg8::cvt_pk_bf16((a[0] - a2[0]) * gc[0], (a[1] - a2[1]) * gc[1]); o.y = pg8::cvt_pk_bf16((a[2] - a2[2]) * gc[2], (a[3] - a2[3]) * gc[3]);
              if (PMODE != 3) NCT[ts] = o; else asm volatile("" :: "v"(o.x), "v"(o.y)); }
        }
    }
    __syncthreads();
    }
    }
}

__device__ __forceinline__ void scan_s2_head(Frame& F, int hb) {
    if (F.wave >= 4) return;
    const int lane = F.tid & 63, fr = lane & 15, fq = lane >> 4, w = F.wave;
    f32x4 Hs[4];
#pragma unroll
    for (int t = 0; t < 4; ++t) Hs[t] = F4Z;
    for (int c = 0; c < NCHUNK; ++c) {
        const size_t ub = ((size_t)hb * NCHUNK + c) * 64 * 64;
        const float* MC = (const float*)(F.ws + WS_MC) + ub; const bf16* NCT = (const bf16*)(F.ws + WS_NCT) + ub; bf16* H0T = (bf16*)(F.ws + WS_H0T) + ub;
        f32x4 mc[4][4], nn[4];
#pragma unroll
        for (int to = 0; to < 4; ++to) { const pg8::u32x2 nv = ((const GAS pg8::u32x2*)NCT)[tslot(w, to, lane)];
            nn[to] = (f32x4){__uint_as_float(nv.x << 16), __uint_as_float(nv.x & 0xffff0000u), __uint_as_float(nv.y << 16), __uint_as_float(nv.y & 0xffff0000u)};
#pragma unroll
            for (int t = 0; t < 4; ++t) mc[to][t] = ((const GAS f32x4*)MC)[tslot(to, t, lane)]; }
#pragma unroll
        for (int t = 0; t < 4; ++t) { pg8::u32x2 o; o.x = pg8::cvt_pk_bf16(Hs[t][0], Hs[t][1]); o.y = pg8::cvt_pk_bf16(Hs[t][2], Hs[t][3]); ((GAS pg8::u32x2*)H0T)[tslot(w, t, lane)] = o; }
        if (c + 1 == NCHUNK) break;
#pragma unroll
        for (int to = 0; to < 4; ++to)
#pragma unroll
            for (int t = 0; t < 4; ++t)
#pragma unroll
                for (int i = 0; i < 4; ++i) nn[to] = __builtin_amdgcn_mfma_f32_16x16x4f32(mc[to][t][i], Hs[t][i], nn[to], 0, 0, 0);
#pragma unroll
        for (int t = 0; t < 4; ++t) Hs[t] = nn[t];
    }
}

__device__ __forceinline__ void scan_s3_pair(Frame& F, KArgs* A, int l, int pair) {
    const int lane = F.tid & 63, fr = lane & 15, fq = lane >> 4, w = F.wave, unit = 2 * pair + (w >> 2), tn = w & 3;
    const int hb = unit / NCHUNK, c = unit % NCHUNK, b = hb / NH, h = hb % NH;
    const size_t ub = (size_t)unit * 64 * 64;
    const GAS pg8::u32x2* QE = (const GAS pg8::u32x2*)((const bf16*)(F.ws + WS_QE) + ub); const GAS pg8::u32x2* H0T = (const GAS pg8::u32x2*)((const bf16*)(F.ws + WS_H0T) + ub);
    const GAS pg8::u32x2* YL = (const GAS pg8::u32x2*)((const bf16*)(F.ws + WS_YL) + ub);
    const int t = 16 * tn + fr; const size_t tok = (size_t)hb * SEQ + c * CH + t;
    const bf16* vp = (const bf16*)(F.ws + WS_VV) + tok * 64; const bf16* gp = (const bf16*)(F.ws + WS_GG) + tok * 64;
    const float* gnw = INP(A, 19) + (size_t)l * DRW + h * 64; const float* gnb = INP(A, 20) + (size_t)l * DRW + h * 64;
    pg8::u32x2 qv[4], hv[4][4], yv[4], vv[4], gg[4]; f32x4 gw[4], gb[4];
#pragma unroll
    for (int i = 0; i < 4; ++i) { qv[i] = QE[tslot(tn, i, lane)]; yv[i] = YL[tslot(tn, i, lane)]; const int v0 = 16 * i + 4 * fq;
        vv[i] = *(const GAS pg8::u32x2*)(vp + v0); gg[i] = *(const GAS pg8::u32x2*)(gp + v0); gw[i] = *(const GAS f32x4*)(gnw + v0); gb[i] = *(const GAS f32x4*)(gnb + v0);
#pragma unroll
        for (int k = 0; k < 4; ++k) hv[i][k] = H0T[tslot(i, k, lane)]; }
    const float rk = ((const float*)(F.ws + WS_RK))[tok];
    bf16x8 qb[2];
#pragma unroll
    for (int p = 0; p < 2; ++p) qb[p] = __builtin_bit_cast(bf16x8, (v4u){qv[2 * p].x, qv[2 * p].y, qv[2 * p + 1].x, qv[2 * p + 1].y});
    f32x4 y[4]; float s1 = 0.f;
#pragma unroll
    for (int tm = 0; tm < 4; ++tm) {
        f32x4 acc = (f32x4){__uint_as_float(yv[tm].x << 16), __uint_as_float(yv[tm].x & 0xffff0000u), __uint_as_float(yv[tm].y << 16), __uint_as_float(yv[tm].y & 0xffff0000u)};
#pragma unroll
        for (int p = 0; p < 2; ++p) acc = __builtin_amdgcn_mfma_f32_16x16x32_bf16(__builtin_bit_cast(bf16x8, (v4u){hv[tm][2 * p].x, hv[tm][2 * p].y, hv[tm][2 * p + 1].x, hv[tm][2 * p + 1].y}), qb[p], acc, 0, 0, 0);
        y[tm] = acc; s1 += (acc[0] + acc[1]) + (acc[2] + acc[3]); }
    s1 += __shfl_xor(s1, 16); s1 += __shfl_xor(s1, 32);
    const float mean = s1 * (1.f / 64.f); float s2 = 0.f;
#pragma unroll
    for (int tm = 0; tm < 4; ++tm)
#pragma unroll
        for (int e = 0; e < 4; ++e) { const float d = y[tm][e] - mean; s2 += d * d; }
    s2 += __shfl_xor(s2, 16); s2 += __shfl_xor(s2, 32);
    const float rstd = __builtin_amdgcn_rsqf(s2 * (1.f / 64.f) + GN_EPS);
    bf16* out = (bf16*)(F.ws + WS_CAT) + ((size_t)b * SEQ + c * CH + t) * D + DATT + h * 64;
#pragma unroll
    for (int tm = 0; tm < 4; ++tm) { const int v0 = 16 * tm + 4 * fq;
        const float vf[4] = {__uint_as_float(vv[tm].x << 16), __uint_as_float(vv[tm].x & 0xffff0000u), __uint_as_float(vv[tm].y << 16), __uint_as_float(vv[tm].y & 0xffff0000u)};
        const float gf[4] = {__uint_as_float(gg[tm].x << 16), __uint_as_float(gg[tm].x & 0xffff0000u), __uint_as_float(gg[tm].y << 16), __uint_as_float(gg[tm].y & 0xffff0000u)};
        float o[4];
#pragma unroll
        for (int e = 0; e < 4; ++e) o[e] = ((y[tm][e] - mean) * rstd * gw[tm][e] + gb[tm][e] + rk * vf[e]) * gf[e];
        pg8::u32x2 ow; ow.x = pg8::cvt_pk_bf16(o[0], o[1]); ow.y = pg8::cvt_pk_bf16(o[2], o[3]); *(GAS pg8::u32x2*)(out + v0) = ow; }
}

__device__ __forceinline__ void grp_barrier(unsigned* cnt, unsigned nb, unsigned* tmo) {
    asm volatile("s_waitcnt vmcnt(0)" ::: "memory");
    __syncthreads();
    if (threadIdx.x == 0) {
        const unsigned old = __hip_atomic_fetch_add(cnt, 1u, __ATOMIC_RELAXED, __HIP_MEMORY_SCOPE_AGENT), target = (old / nb + 1u) * nb; unsigned sp = 0;
        while (__hip_atomic_load(cnt, __ATOMIC_RELAXED, __HIP_MEMORY_SCOPE_AGENT) < target) { __builtin_amdgcn_s_sleep(1); if (++sp > (1u << 22)) { __hip_atomic_store(tmo, 1u, __ATOMIC_RELAXED, __HIP_MEMORY_SCOPE_AGENT); break; } }
        __builtin_amdgcn_fence(__ATOMIC_ACQUIRE, "agent");
        asm volatile("s_waitcnt vmcnt(0)" ::: "memory");
    }
    __syncthreads();
}
__global__ void __launch_bounds__(NWAVES * 64, 2) fwd_kernel(Args args) {
    extern __shared__ __attribute__((aligned(16))) unsigned char lds[];
    Frame F;
    F.lds = (LAS unsigned char*)lds;
    F.wave = __builtin_amdgcn_readfirstlane(threadIdx.x >> 6); F.tid = threadIdx.x;
    F.G = gridDim.x; { const int bx = blockIdx.x; F.vcu = (F.G % 8 == 0) ? (bx % 8) * (F.G / 8) + bx / 8 : bx; }
    F.bi = 0; F.nb = 1; F.seq = 0;
    unsigned char* ws = args.ws; F.ws = ws;
    F.X = args.out;
    for (int u = threadIdx.x; u < (LDS_BYTES - LDSCTL_OFF) / 4; u += NWAVES * 64) ((LAS unsigned*)(F.lds + LDSCTL_OFF))[u] = 0u;
    __syncthreads();
    volatile LAS unsigned* MISC = (volatile LAS unsigned*)(F.lds + MISC_OFF);
    XcdBarrier bar = xcd_barrier_post((unsigned*)(ws + WS_CTL) + CW_BAR, MISC + 8);
    if (threadIdx.x == 0) MISC[20] = __hip_atomic_fetch_add((unsigned*)(ws + WS_CTL) + CW_RANK + 64 * bar.x, 1u, __ATOMIC_RELAXED, __HIP_MEMORY_SCOPE_AGENT);
    KArgs* const ka0 = (KArgs*)__builtin_amdgcn_kernarg_segment_ptr();
#define PH_BEGIN { Frame F = F0; KArgs* ka = ka0; F.tid = threadIdx.x; asm volatile("" : "+v"(F.tid)); GAS unsigned char* wsg_ = (GAS unsigned char*)F0.ws; GAS float* xg_ = (GAS float*)F0.X; asm volatile("" : "+s"(wsg_), "+s"(xg_), "+s"(F.wave), "+s"(F.bi), "+s"(F.nb), "+s"(F.seq), "+s"(ka)); F.ws = (unsigned char*)wsg_; F.X = (float*)xg_; unsigned char* const ws = F.ws; (void)ws;
#define PH_END   grp_barrier(gcnt, (unsigned)F0.nb, (unsigned*)(F0.ws + WS_CTL) + CW_TMO); }

    { const Frame F0 = F; { Frame F = F0; KArgs* ka = ka0; F.tid = threadIdx.x; asm volatile("" : "+v"(F.tid)); p0_prologue(F, ka); } }
    xcd_barrier(bar);
    if (threadIdx.x == 0) { unsigned g = 0, ng = 0, nbk = 1; unsigned* bw = (unsigned*)(ws + WS_CTL) + CW_BAR;
        for (unsigned j = 0; j < 16; ++j) { const unsigned c = xb_ld(&bw[XB_XCNT(j)]); if (c) { if (j < bar.x) ++g; ++ng; } if (j == bar.x) nbk = c ? c : 1u; }
        MISC[16] = g; MISC[17] = ng ? ng : 1u; MISC[18] = nbk; }
    __syncthreads();
    const int grp = __builtin_amdgcn_readfirstlane((int)MISC[16]), ngrp = __builtin_amdgcn_readfirstlane((int)MISC[17]);
    F.nb = __builtin_amdgcn_readfirstlane((int)MISC[18]); F.bi = __builtin_amdgcn_readfirstlane((int)MISC[20]);
    unsigned* const gcnt = (unsigned*)(ws + WS_CTL) + CW_GB + 64 * bar.x;

    for (int seq = grp; seq < BATCH; seq += ngrp) {
    F.seq = seq; const Frame F0 = F;
    for (int j = 0; j < 2 * NL; ++j) {
        const int l = j >> 1; const bool second = (j & 1) != 0;
        PH_BEGIN {
            pg8::Gemm g{((bf16*)(F.ws + WS_XB)), (const bf16*)(ws + WS_W + (size_t)l * LW + (second ? LW_GU2 : LW_GU1)), M, 2 * FF, D}; pg8::GroupOrder S; S.init(2 * FF / 256, F.nb, F.bi, F.seq);
            pg8::EpiSwiglu E{((bf16*)(F.ws + WS_HID)), FF, (const float*)(F.ws + WS_RS)};
            pg8::gemm_phase<pg8::EpiSwiglu, pg8::GroupOrder, true, true>(F.lds + RING_OFF, g, S, E);
        } PH_END
        PH_BEGIN {
            const int q = 3 * l + (second ? 2 : 0); const bool lastsub = second && (l + 1 == NL);
            pg8::Gemm g{((bf16*)(F.ws + WS_HID)), (const bf16*)(ws + WS_W + (size_t)l * LW + (second ? LW_D2 : LW_D1)), M, D, FF};
            pg8::EpiRes E{((bf16*)(F.ws + WS_XB)), lastsub ? F.X : nullptr, (second ? INP(ka, 24) : INP(ka, 2)) + (size_t)l * D, 0.5f, (float*)(F.ws + WS_RS),
                          (float*)(F.ws + WS_XS + (size_t)q * MiB), (unsigned*)(ws + WS_CTL) + CW_XC + q * XC_USE, (unsigned*)(ws + WS_CTL) + CW_TMO};
            const int P = F.nb >> 3, nsl = P > 0 ? (8 + P - 1) / P : 0;
            for (int sl = 0; sl < nsl; ++sl) { pg8::PanelOrder S{sl, F.nb, F.bi, 8 * F.seq}; pg8::gemm_phase<pg8::EpiRes, pg8::PanelOrder, false, true>(F.lds + RING_OFF, g, S, E); __syncthreads(); }
        } PH_END
        if (!second) {
            PH_BEGIN {
                pg8::Gemm g{((bf16*)(F.ws + WS_XB)), (const bf16*)(ws + WS_W + (size_t)l * LW + LW_IN), M, DINP, D}; pg8::GroupOrder S; S.init(DINP / 256, F.nb, F.bi, F.seq);
                pg8::EpiWin E{F.ws + WS_HID, ((float*)(F.ws + WS_COS)), ((float*)(F.ws + WS_SIN)), QSCALE, (const float*)(F.ws + WS_RS)};
                pg8::gemm_phase<pg8::EpiWin, pg8::GroupOrder, true, true>(F.lds + RING_OFF, g, S, E);
            } PH_END
            PH_BEGIN scan_s1_phase<0>(F, ka, l); PH_END
            PH_BEGIN {
                for (int h = F.bi; h < NH; h += F.nb) scan_s2_head(F, F.seq * NH + h);
                attn_loop(F, (gu32*)(ws + WS_CTL) + CW_ATTQ + 64 * (l * BATCH + F.seq));
            } PH_END
            PH_BEGIN { for (int p = F.bi; p < NH * NCHUNK / 2; p += F.nb) scan_s3_pair(F, ka, l, F.seq * (NH * NCHUNK / 2) + p); attn_combine(F); } PH_END
            PH_BEGIN {
                const int q = 3 * l + 1;
                pg8::Gemm g{((bf16*)(F.ws + WS_CAT)), (const bf16*)(ws + WS_W + (size_t)l * LW + LW_OUT), M, D, D};
                pg8::EpiRes E{((bf16*)(F.ws + WS_XB)), nullptr, INP(ka, 7) + (size_t)l * D, 1.0f, (float*)(F.ws + WS_RS),
                              (float*)(F.ws + WS_XS + (size_t)q * MiB), (unsigned*)(ws + WS_CTL) + CW_XC + q * XC_USE, (unsigned*)(ws + WS_CTL) + CW_TMO};
                const int P = F.nb >> 3, nsl = P > 0 ? (8 + P - 1) / P : 0;
                for (int sl = 0; sl < nsl; ++sl) { pg8::PanelOrder S{sl, F.nb, F.bi, 8 * F.seq}; pg8::gemm_phase<pg8::EpiRes, pg8::PanelOrder, false, true>(F.lds + RING_OFF, g, S, E); __syncthreads(); }
            } PH_END
        }
    }
    }
#undef PH_BEGIN
#undef PH_END
}

extern "C" void kernel_launch(void* const* d_in, const int* in_sizes, int n_in, void* d_out, int out_size, void* d_ws, size_t ws_size, hipStream_t stream) {
    static int grid = 0;
    if (grid == 0) {
        if (n_in != 28 || in_sizes[0] != M * D || out_size != M * D || ws_size < WS_END2) { fprintf(stderr, "kernel_launch: unexpected problem (n_in %d, in0 %d, out %d, ws %zu < %zu); nothing launched\n", n_in, n_in > 0 ? in_sizes[0] : -1, out_size, ws_size, (size_t)WS_END2); grid = -1; return; }
        int dev = 0, cus = 0, per_cu = 0;
        if (hipGetDevice(&dev) != hipSuccess || hipDeviceGetAttribute(&cus, hipDeviceAttributeMultiprocessorCount, dev) != hipSuccess) { grid = -1; return; }
        if (hipFuncSetAttribute((const void*)fwd_kernel, hipFuncAttributeMaxDynamicSharedMemorySize, LDS_BYTES) != hipSuccess) { fprintf(stderr, "kernel_launch: hipFuncSetAttribute failed\n"); grid = -1; return; }
        if (hipOccupancyMaxActiveBlocksPerMultiprocessor(&per_cu, (const void*)fwd_kernel, NWAVES * 64, LDS_BYTES) != hipSuccess || per_cu < 1)
            fprintf(stderr, "kernel_launch: note: occupancy query reports %d workgroups per CU\n", per_cu);
        (void)hipGetLastError();
        grid = cus;
    }
    if (grid < 0) return;
    if (hipMemsetAsync((char*)d_ws + WS_CTL, 0, CTL_ZERO_BYTES, stream) != hipSuccess) return;
    Args a{};
    for (int i = 0; i < 28; ++i) a.in[i] = (const float*)d_in[i];
    a.out = (float*)d_out; a.ws = (unsigned char*)d_ws; a.ph_lo = 0; a.ph_hi = 0;
    hipLaunchKernelGGL(fwd_kernel, dim3(grid), dim3(NWAVES * 64), LDS_BYTES, stream, a);
}
```

```cpp
#include <hip/hip_runtime.h>
#include <cstdio>
#include <cstdint>
#include <cmath>
namespace pg8 {
#define PG8_LAS __attribute__((address_space(3)))
typedef unsigned short bf16_t;
typedef short bf16x8 __attribute__((ext_vector_type(8)));
typedef float f32x4 __attribute__((ext_vector_type(4)));
typedef unsigned u32x4 __attribute__((ext_vector_type(4)));
constexpr int BM = 256, BK = 64, HALF = 128, HTB = HALF * BK * 2  , STAGE_BYTES = 8 * HTB, NXCD = 8, WGM = 8;

__host__ __device__ __forceinline__ int lds_byte(int r, int c) { const int st = (r >> 4) * 2 + (c >> 5), rr = r & 15, cc = c & 31, ob = rr * 64 + cc * 2; return st * 1024 + (ob ^ (((ob >> 9) & 1) << 5)); }
__host__ __device__ __forceinline__ void stage_rc(int b, int& R, int& C) { const int st = b / 1024, sb = b % 1024, swz = sb ^ (((sb >> 9) & 1) << 5); R = (st >> 1) * 16 + swz / 64; C = (st & 1) * 32 + (swz % 64) / 2; }
__host__ __device__ __forceinline__ int perm32(int rho) { const int n = rho >> 4, i = rho & 15; return 8 * (i >> 2) + 4 * n + (i & 3); }

struct Unit { int pm, pn; };
struct Gemm { const bf16_t* A; const bf16_t* Bt; int M, N, K; };

struct StaticOrder {
    int nM, nN, nwg, G, c;
    __host__ __device__ void init(int M, int N, int G_, int c_) { nM = M / BM; nN = N / BM; nwg = nM * nN; G = G_; c = c_; }
    __host__ __device__ bool next(int i, Unit& u) const {
        const long L = (long)i * G + c; if (L >= nwg) return false;
        int wgid = (int)L; { const int q = nwg / NXCD, r = nwg % NXCD, xcd = wgid % NXCD, off = wgid / NXCD; wgid = (xcd < r ? xcd * (q + 1) : r * (q + 1) + (xcd - r) * q) + off; }
        const int nig = WGM * nN, gid = wgid / nig, fm = gid * WGM, gsz = (nM - fm) < WGM ? (nM - fm) : WGM;
        u.pm = fm + ((wgid % nig) % gsz); u.pn = (wgid % nig) / gsz; return true;
    }
    __device__ __forceinline__ void a_ready(const Unit&) const {}
    __device__ __forceinline__ void done(const Unit&) const {}
};

typedef float cvt_f32x2_t __attribute__((ext_vector_type(2))); typedef __bf16 cvt_bf16x2_t __attribute__((ext_vector_type(2)));
__device__ __forceinline__ unsigned cvt_pk_bf16(float lo, float hi) { const cvt_f32x2_t v = {lo, hi}; const cvt_bf16x2_t b = __builtin_convertvector(v, cvt_bf16x2_t); return __builtin_bit_cast(unsigned, b); }
typedef float f32x2 __attribute__((ext_vector_type(2)));
typedef unsigned u32x2 __attribute__((ext_vector_type(2)));
__device__ __forceinline__ float silu_f(float x) { return x * __builtin_amdgcn_rcpf(1.0f + __builtin_amdgcn_exp2f(-1.4426950408889634f * x)); }
__device__ __forceinline__ u32x4 pack8(const f32x4 v0, const f32x4 v1) { u32x4 w; w.x = cvt_pk_bf16(v0[0], v0[1]); w.y = cvt_pk_bf16(v0[2], v0[3]); w.z = cvt_pk_bf16(v1[0], v1[1]); w.w = cvt_pk_bf16(v1[2], v1[3]); return w; }

struct EpiF32 {
    static constexpr bool PERM = false, AFTER_DRAIN = false;
    float* C; int ldc;
    __device__ __forceinline__ void operator()(const f32x4 (&acc)[2][2][4][2], const Unit& u, int wr, int wc, int fr, int fq) const {
        asm volatile("" : "+v"(fr), "+v"(fq));
        const int row0 = u.pm * BM + wr * 64 + fr, col0 = u.pn * BM + wc * 32 + 4 * fq;
#pragma unroll
        for (int ai = 0; ai < 2; ++ai)
#pragma unroll
            for (int m = 0; m < 4; ++m) { float* rowp = C + (size_t)(row0 + ai * HALF + m * 16) * ldc + col0;
#pragma unroll
                for (int bj = 0; bj < 2; ++bj)
#pragma unroll
                    for (int n = 0; n < 2; ++n) *(f32x4*)(rowp + bj * HALF + n * 16) = acc[ai][bj][m][n]; }
    }
};
struct EpiBf16Plain {
    static constexpr bool PERM = true, AFTER_DRAIN = false;
    bf16_t* O; int ldc;
    __device__ __forceinline__ void operator()(const f32x4 (&acc)[2][2][4][2], const Unit& u, int wr, int wc, int fr, int fq) const {
        asm volatile("" : "+v"(fr), "+v"(fq));
        const int row0 = u.pm * BM + wr * 64 + fr, col0 = u.pn * BM + wc * 32 + 8 * fq;
#pragma unroll
        for (int ai = 0; ai < 2; ++ai)
#pragma unroll
            for (int m = 0; m < 4; ++m) { bf16_t* rowp = O + (size_t)(row0 + ai * HALF + m * 16) * ldc + col0;
#pragma unroll
                for (int bj = 0; bj < 2; ++bj) *(u32x4*)(rowp + bj * HALF) = pack8(acc[ai][bj][m][0], acc[ai][bj][m][1]); }
    }
};
struct EpiBf16Scale {
    static constexpr bool PERM = true, AFTER_DRAIN = false;
    bf16_t* O; int ldc; const float* scale;
    __device__ __forceinline__ void operator()(const f32x4 (&acc)[2][2][4][2], const Unit& u, int wr, int wc, int fr, int fq) const {
        asm volatile("" : "+v"(fr), "+v"(fq));
        const int row0 = u.pm * BM + wr * 64 + fr, col0 = u.pn * BM + wc * 32 + 8 * fq;
        f32x4 sv[2][2];
#pragma unroll
        for (int bj = 0; bj < 2; ++bj)
#pragma unroll
            for (int n = 0; n < 2; ++n) sv[bj][n] = *(const f32x4*)(scale + col0 + bj * HALF + 4 * n);
#pragma unroll
        for (int ai = 0; ai < 2; ++ai)
#pragma unroll
            for (int m = 0; m < 4; ++m) { bf16_t* rowp = O + (size_t)(row0 + ai * HALF + m * 16) * ldc + col0;
#pragma unroll
                for (int bj = 0; bj < 2; ++bj) *(u32x4*)(rowp + bj * HALF) = pack8(acc[ai][bj][m][0] * sv[bj][0], acc[ai][bj][m][1] * sv[bj][1]); }
    }
};
struct EpiSwiglu {
    static constexpr bool PERM = true, AFTER_DRAIN = false;
    bf16_t* O; int ldc; const float* rs;
    __device__ __forceinline__ void operator()(const f32x4 (&acc)[2][2][4][2], const Unit& u, int wr, int wc, int fr, int fq) const {
        asm volatile("" : "+v"(fr), "+v"(fq));
        const int row0 = u.pm * BM + wr * 64 + fr, col0 = u.pn * HALF + wc * 32 + 8 * fq;
        float rv[2][4];
#pragma unroll
        for (int ai = 0; ai < 2; ++ai)
#pragma unroll
            for (int m = 0; m < 4; ++m) rv[ai][m] = rs[row0 + ai * HALF + m * 16];
#pragma unroll
        for (int ai = 0; ai < 2; ++ai)
#pragma unroll
            for (int m = 0; m < 4; ++m) asm volatile("" : "+v"(rv[ai][m]));
#pragma unroll
        for (int ai = 0; ai < 2; ++ai)
#pragma unroll
            for (int m = 0; m < 4; ++m) { bf16_t* rowp = O + (size_t)(row0 + ai * HALF + m * 16) * ldc + col0; const float r = rv[ai][m];
                f32x4 v0, v1;
#pragma unroll
                for (int e = 0; e < 4; ++e) { v0[e] = silu_f(acc[ai][0][m][0][e] * r) * (acc[ai][1][m][0][e] * r); v1[e] = silu_f(acc[ai][0][m][1][e] * r) * (acc[ai][1][m][1][e] * r); }
                *(u32x4*)rowp = pack8(v0, v1); }
    }
};
struct EpiWin {
    static constexpr bool PERM = true, AFTER_DRAIN = false;
    unsigned char* hid;
    static constexpr size_t SQS = 22u << 20, OQ = 0, OK_ = 3u << 20, OV = 6u << 20, OZR = 9u << 20, OZP = 20u << 20;
    const float *cs, *sn;
    float qscale; const float* rs;
    __device__ __forceinline__ void operator()(const f32x4 (&acc)[2][2][4][2], const Unit& u, int wr, int wc, int fr, int fq) const {
        asm volatile("" : "+v"(fr), "+v"(fq));
        const int row0 = u.pm * BM + wr * 64 + fr, pn = u.pn;
        float rv[2][4];
#pragma unroll
        for (int ai = 0; ai < 2; ++ai)
#pragma unroll
            for (int m = 0; m < 4; ++m) rv[ai][m] = rs[row0 + ai * HALF + m * 16];
#pragma unroll
        for (int ai = 0; ai < 2; ++ai)
#pragma unroll
            for (int m = 0; m < 4; ++m) asm volatile("" : "+v"(rv[ai][m]));
        if (pn < 6) {
            const size_t dsto = pn < 3 ? OQ : OK_; const int pt = pn < 3 ? pn : pn - 3; const float sc = pn < 3 ? qscale : 1.0f;
            const int d0 = 16 * (wc & 1) + 4 * fq;
#pragma unroll
            for (int ai = 0; ai < 2; ++ai) {
                f32x4 c4v[4], s4v[4];
#pragma unroll
                for (int m = 0; m < 4; ++m) { const int s = (row0 + ai * HALF + m * 16) & 2047; c4v[m] = *(const f32x4*)(cs + s * 32 + d0); s4v[m] = *(const f32x4*)(sn + s * 32 + d0); }
#pragma unroll
                for (int m = 0; m < 4; ++m) asm volatile("" : "+v"(c4v[m]), "+v"(s4v[m]));
#pragma unroll
                for (int m = 0; m < 4; ++m) { const int row = row0 + ai * HALF + m * 16, b = row >> 11, s = row & 2047; const float rsc = rv[ai][m] * sc;
                    const f32x4 c4 = c4v[m], s4 = s4v[m];
#pragma unroll
                    for (int bj = 0; bj < 2; ++bj) { const int head = pt * 4 + bj * 2 + (wc >> 1);
                        const f32x4 x1 = acc[ai][bj][m][0], x2 = acc[ai][bj][m][1];
                        const f32x4 o1 = (x1 * c4 - x2 * s4) * rsc, o2 = (x2 * c4 + x1 * s4) * rsc;
                        bf16_t* p = (bf16_t*)(hid + (size_t)b * SQS + dsto) + ((size_t)head * 2048 + s) * 64 + d0;
                        u32x2 w1, w2; w1.x = cvt_pk_bf16(o1[0], o1[1]); w1.y = cvt_pk_bf16(o1[2], o1[3]); w2.x = cvt_pk_bf16(o2[0], o2[1]); w2.y = cvt_pk_bf16(o2[2], o2[3]);
                        *(u32x2*)p = w1; *(u32x2*)(p + 32) = w2; } } }
        } else if (pn < 9) {
            const int d0 = 32 * (wc & 1) + 8 * fq;
#pragma unroll
            for (int ai = 0; ai < 2; ++ai)
#pragma unroll
                for (int m = 0; m < 4; ++m) { const int row = row0 + ai * HALF + m * 16, b = row >> 11, s = row & 2047; const float r = rv[ai][m];
#pragma unroll
                    for (int bj = 0; bj < 2; ++bj) { const int head = (pn - 6) * 4 + bj * 2 + (wc >> 1);
                        *(u32x4*)((bf16_t*)(hid + (size_t)b * SQS + OV) + ((size_t)head * 2048 + s) * 64 + d0) = pack8(acc[ai][bj][m][0] * r, acc[ai][bj][m][1] * r); } }
        } else {
            size_t oo; int ldc, colt;
            if (pn < 20) { oo = OZR; ldc = 2816; colt = (pn - 9) * BM; } else { oo = OZP; ldc = 512; colt = (pn - 20) * BM; }
            const int col0 = colt + wc * 32 + 8 * fq;
#pragma unroll
            for (int ai = 0; ai < 2; ++ai)
#pragma unroll
                for (int m = 0; m < 4; ++m) { const int row = row0 + ai * HALF + m * 16; bf16_t* rowp = (bf16_t*)(hid + (size_t)(row >> 11) * SQS + oo) + (size_t)(row & 2047) * ldc + col0; const float r = rv[ai][m];
#pragma unroll
                    for (int bj = 0; bj < 2; ++bj) *(u32x4*)(rowp + bj * HALF) = pack8(acc[ai][bj][m][0] * r, acc[ai][bj][m][1] * r); }
        }
    }
};

struct GroupOrder {
    int nN, nb, bi, pm0;
    __device__ __forceinline__ void init(int ntiles, int nb_, int bi_, int seq) { nN = ntiles; nb = nb_; bi = bi_; pm0 = 8 * seq; }
    __device__ __forceinline__ bool next(int i, Unit& u) const { const int L = i * nb + bi; if (L >= 8 * nN) return false; u.pm = pm0 + (L & 7); u.pn = L >> 3; return true; }
    __device__ __forceinline__ void a_ready(const Unit&) const {}
    __device__ __forceinline__ void done(const Unit&) const {}
};
struct PanelOrder {
    int slice, nb, bi, pm0;
    __device__ __forceinline__ bool next(int i, Unit& u) const { if (i) return false; const int P = nb >> 3, p = slice * P + (bi >> 3); if ((bi >> 3) >= P || p >= 8) return false; u.pm = pm0 + p; u.pn = bi & 7; return true; }
    __device__ __forceinline__ void a_ready(const Unit&) const {}
    __device__ __forceinline__ void done(const Unit&) const {}
};
struct EpiRes {
    static constexpr bool PERM = true, AFTER_DRAIN = true;
    bf16_t* X; float* OUT;
    const float* gpost; float coef; float* rs;
    float* slots;
    unsigned* cnt;
    unsigned* tmo;
    __device__ __forceinline__ float exchange(float part, int ex, const Unit& u, PG8_LAS float* P, PG8_LAS float* S, int wid, int lane, int wc, int rowl, bool writer) const {
        if (writer) P[rowl * 4 + wc] = part;
        asm volatile("s_waitcnt lgkmcnt(0)" ::: "memory"); __builtin_amdgcn_s_barrier(); asm volatile("" ::: "memory");
        const int tid = wid * 64 + lane;
        float* sl = slots + ((size_t)ex * 16384 * 8);
        if (tid < 256) { const float t4 = (P[tid * 4 + 0] + P[tid * 4 + 1]) + (P[tid * 4 + 2] + P[tid * 4 + 3]);
            __hip_atomic_store(sl + (size_t)(u.pm * BM + tid) * 8 + u.pn, t4, __ATOMIC_RELAXED, __HIP_MEMORY_SCOPE_AGENT);
            asm volatile("s_waitcnt vmcnt(0)" ::: "memory");
            if (lane == 0) __hip_atomic_fetch_add(cnt + 64 * (ex * 64 + u.pm), 1u, __ATOMIC_RELAXED, __HIP_MEMORY_SCOPE_AGENT); }
        if (wid == 0) { unsigned sp = 0;
            while ((unsigned)__builtin_amdgcn_readfirstlane(__hip_atomic_load(cnt + 64 * (ex * 64 + u.pm), __ATOMIC_RELAXED, __HIP_MEMORY_SCOPE_AGENT)) < 32u) {
                __builtin_amdgcn_s_sleep(1); if (++sp > (1u << 22)) { if (lane == 0) __hip_atomic_store(tmo, 1u, __ATOMIC_RELAXED, __HIP_MEMORY_SCOPE_AGENT); break; } } }
        asm volatile("s_waitcnt vmcnt(0) lgkmcnt(0)" ::: "memory"); __builtin_amdgcn_s_barrier(); asm volatile("" ::: "memory");
        if (tid < 256) { const unsigned long long* q = (const unsigned long long*)(sl + (size_t)(u.pm * BM + tid) * 8); unsigned long long v[4];
#pragma unroll
            for (int k = 0; k < 4; ++k) v[k] = __hip_atomic_load(q + k, __ATOMIC_RELAXED, __HIP_MEMORY_SCOPE_AGENT);
            float h[4];
#pragma unroll
            for (int k = 0; k < 4; ++k) h[k] = __uint_as_float((unsigned)v[k]) + __uint_as_float((unsigned)(v[k] >> 32));
            S[tid] = (h[0] + h[1]) + (h[2] + h[3]); }
        asm volatile("s_waitcnt vmcnt(0) lgkmcnt(0)" ::: "memory"); __builtin_amdgcn_s_barrier(); asm volatile("" ::: "memory");
        return S[rowl];
    }
    __device__ __forceinline__ void fused(f32x4 (&acc)[2][2][4][2], const Unit& u, int wr, int wc, int fr, int fq, PG8_LAS unsigned char* lds, int wid, int lane) const {
        PG8_LAS float* P = (PG8_LAS float*)lds; PG8_LAS float* S = (PG8_LAS float*)(lds + 4096);
        const int col0 = u.pn * BM + wc * 32 + 8 * fq;
        f32x4 gv[2][2];
#pragma unroll
        for (int bj = 0; bj < 2; ++bj)
#pragma unroll
            for (int n = 0; n < 2; ++n) gv[bj][n] = *(const f32x4*)(gpost + col0 + bj * HALF + 4 * n);
        u32x4 xw_[2][4][2];
#pragma unroll
        for (int ai = 0; ai < 2; ++ai)
#pragma unroll
            for (int m = 0; m < 4; ++m)
#pragma unroll
                for (int bj = 0; bj < 2; ++bj) xw_[ai][m][bj] = *(const u32x4*)(X + ((size_t)u.pm * BM + ai * HALF + wr * 64 + m * 16 + fr) * 2048 + col0 + bj * HALF);
        float ssq[2][4];
#pragma unroll
        for (int ai = 0; ai < 2; ++ai)
#pragma unroll
            for (int m = 0; m < 4; ++m) { float s = 0.f;
#pragma unroll
                for (int bj = 0; bj < 2; ++bj)
#pragma unroll
                    for (int n = 0; n < 2; ++n) { const f32x4 v = acc[ai][bj][m][n]; s += (v[0] * v[0] + v[1] * v[1]) + (v[2] * v[2] + v[3] * v[3]); }
                s += __shfl_xor(s, 16); s += __shfl_xor(s, 32); ssq[ai][m] = s; }
#pragma unroll
        for (int ai = 0; ai < 2; ++ai)
#pragma unroll
            for (int m = 0; m < 4; ++m) if (fq == 0) P[(ai * HALF + wr * 64 + m * 16 + fr) * 4 + wc] = ssq[ai][m];
        const float dummy1 = exchange(0.f, 0, u, P, S, wid, lane, wc, 0, false); (void)dummy1;
        float ss2[2][4];
#pragma unroll
        for (int ai = 0; ai < 2; ++ai)
#pragma unroll
            for (int m = 0; m < 4; ++m) { const int rl = ai * HALF + wr * 64 + m * 16 + fr; const size_t row = (size_t)u.pm * BM + rl;
                const float cr = coef * __builtin_amdgcn_rsqf(S[rl] * (1.0f / 2048.0f) + 1e-6f); float s2 = 0.f;
#pragma unroll
                for (int bj = 0; bj < 2; ++bj) { bf16_t* xp = X + row * 2048 + col0 + bj * HALF; const u32x4 xw = xw_[ai][m][bj];
                    f32x4 x0 = {__uint_as_float(xw.x << 16), __uint_as_float(xw.x & 0xffff0000u), __uint_as_float(xw.y << 16), __uint_as_float(xw.y & 0xffff0000u)};
                    f32x4 x1 = {__uint_as_float(xw.z << 16), __uint_as_float(xw.z & 0xffff0000u), __uint_as_float(xw.w << 16), __uint_as_float(xw.w & 0xffff0000u)};
                    x0 = x0 + acc[ai][bj][m][0] * gv[bj][0] * cr; x1 = x1 + acc[ai][bj][m][1] * gv[bj][1] * cr;
                    if (OUT) { float* op = OUT + row * 2048 + col0 + bj * HALF; *(f32x4*)op = x0; *(f32x4*)(op + 4) = x1; }
                    else { const u32x4 w = pack8(x0, x1); *(u32x4*)xp = w;
                        const float a0 = __uint_as_float(w.x << 16), a1 = __uint_as_float(w.x & 0xffff0000u), a2 = __uint_as_float(w.y << 16), a3 = __uint_as_float(w.y & 0xffff0000u);
                        const float a4 = __uint_as_float(w.z << 16), a5 = __uint_as_float(w.z & 0xffff0000u), a6 = __uint_as_float(w.w << 16), a7 = __uint_as_float(w.w & 0xffff0000u);
                        s2 += ((a0 * a0 + a1 * a1) + (a2 * a2 + a3 * a3)) + ((a4 * a4 + a5 * a5) + (a6 * a6 + a7 * a7)); } }
                s2 += __shfl_xor(s2, 16); s2 += __shfl_xor(s2, 32); ss2[ai][m] = s2; }
        if (OUT) return;
        asm volatile("s_waitcnt lgkmcnt(0)" ::: "memory"); __builtin_amdgcn_s_barrier(); asm volatile("" ::: "memory");
#pragma unroll
        for (int ai = 0; ai < 2; ++ai)
#pragma unroll
            for (int m = 0; m < 4; ++m) if (fq == 0) P[(ai * HALF + wr * 64 + m * 16 + fr) * 4 + wc] = ss2[ai][m];
        const float dummy2 = exchange(0.f, 1, u, P, S, wid, lane, wc, 0, false); (void)dummy2;
        if (u.pn == 0) { const int tid = wid * 64 + lane; if (tid < 256) rs[(size_t)u.pm * BM + tid] = __builtin_amdgcn_rsqf(S[tid] * (1.0f / 2048.0f) + 1e-6f); }
    }
};

template <class Epi, class Sched, bool ALIGN_EPI = false, bool SP2 = false>
__device__ __forceinline__ void gemm_phase(PG8_LAS unsigned char* lds, const Gemm g, const Sched& S, const Epi& E) {
    int tid_ = threadIdx.x; asm volatile("" : "+v"(tid_));
    const int tid = tid_, wid = __builtin_amdgcn_readfirstlane(tid >> 6), lane = tid & 63, wr = wid >> 2, wc = wid & 3, fr = lane & 15, fq = lane >> 4;
    int K_ = g.K; asm volatile("" : "+s"(K_));
    const int K = K_, nt = K / BK;
    unsigned voffA[2], voffB[2];
#pragma unroll
    for (int i = 0; i < 2; ++i) { int R, C; stage_rc(tid * 16 + i * 8192, R, C); const int Rb = Epi::PERM ? ((R & ~31) + perm32(R & 31)) : R;
        voffA[i] = (unsigned)(R * K + C) * 2u; voffB[i] = (unsigned)(Rb * K + C) * 2u; }
    const size_t kstep = (size_t)(BK * 2);
    const size_t hstep = (size_t)HALF * K * 2;
    const size_t tstep = 2 * hstep;
    const unsigned ldsw = (unsigned)wid * 1024u;
    const int aoff = lds_byte(wr * 64 + fr, fq * 8), boff = lds_byte(wc * 32 + fr, fq * 8);
#define PG8_SA(b, h) (((b) * 2 + (h)) * HTB)
#define PG8_SB(b, h) ((4 + (b) * 2 + (h)) * HTB)
#define PG8_STAGE(bufoff, gbase, voff) do { _Pragma("unroll") for (int _i = 0; _i < 2; ++_i) \
        __builtin_amdgcn_global_load_lds((const unsigned*)((const char*)(gbase) + (voff)[_i]), (PG8_LAS unsigned*)(lds + (bufoff) + ldsw + _i * 8192), 16, 0, 0); } while (0)
#define PG8_LDA(dst, b, h) do { _Pragma("unroll") for (int m = 0; m < 4; ++m) _Pragma("unroll") for (int k = 0; k < 2; ++k) dst[m][k] = *(const PG8_LAS bf16x8*)(lds + PG8_SA(b, h) + aoff + m * 2048 + k * 1024); } while (0)
#define PG8_LDB(dst, b, h) do { _Pragma("unroll") for (int n = 0; n < 2; ++n) _Pragma("unroll") for (int k = 0; k < 2; ++k) dst[n][k] = *(const PG8_LAS bf16x8*)(lds + PG8_SB(b, h) + boff + n * 2048 + k * 1024); } while (0)
#define PG8_MMA(ai, bj, At, Bt) do { __builtin_amdgcn_s_setprio(1); _Pragma("unroll") for (int m = 0; m < 4; ++m) _Pragma("unroll") for (int n = 0; n < 2; ++n) _Pragma("unroll") for (int k = 0; k < 2; ++k) \
        acc[ai][bj][m][n] = __builtin_amdgcn_mfma_f32_16x16x32_bf16(Bt[n][k], At[m][k], acc[ai][bj][m][n], 0, 0, 0); __builtin_amdgcn_s_setprio(0); } while (0)
#define PG8_WAIT_V(n) asm volatile("s_waitcnt vmcnt(" #n ")" ::: "memory")
#define PG8_WAIT_L(n) asm volatile("s_waitcnt lgkmcnt(" #n ")" ::: "memory")
#define PG8_BAR __builtin_amdgcn_s_barrier()
#define PG8_SCHED __builtin_amdgcn_sched_barrier(0)
    Unit cur, nxt; int ui = 0;
    if (!S.next(0, cur)) return;
    f32x4 acc[2][2][4][2];
#pragma unroll
    for (int a = 0; a < 2; ++a)
#pragma unroll
        for (int b = 0; b < 2; ++b)
#pragma unroll
            for (int m = 0; m < 4; ++m)
#pragma unroll
                for (int n = 0; n < 2; ++n) acc[a][b][m][n] = (f32x4){0.f, 0.f, 0.f, 0.f};
    bf16x8 At[4][2], B0[2][2], B1[2][2];
    const char* cA = (const char*)g.A + (size_t)cur.pm * tstep; const char* cB = (const char*)g.Bt + (size_t)cur.pn * tstep;
    S.a_ready(cur);
    if constexpr (SP2) {
        PG8_STAGE(PG8_SB(0, 0), cB, voffB); PG8_STAGE(PG8_SB(0, 1), cB + hstep, voffB); PG8_STAGE(PG8_SA(0, 0), cA, voffA); PG8_STAGE(PG8_SA(0, 1), cA + hstep, voffA);
        if (wr == 1) PG8_BAR;
        PG8_WAIT_V(2); PG8_BAR;
        PG8_STAGE(PG8_SB(1, 0), cB + kstep, voffB); PG8_STAGE(PG8_SA(1, 0), cA + kstep, voffA); PG8_STAGE(PG8_SB(1, 1), cB + hstep + kstep, voffB);
        PG8_WAIT_V(6); PG8_BAR;
    } else {
        PG8_STAGE(PG8_SB(0, 0), cB, voffB); PG8_STAGE(PG8_SA(0, 0), cA, voffA); PG8_STAGE(PG8_SB(0, 1), cB + hstep, voffB); PG8_STAGE(PG8_SA(0, 1), cA + hstep, voffA);
        if (wr == 1) PG8_BAR;
        PG8_WAIT_V(4); PG8_BAR;
        PG8_STAGE(PG8_SB(1, 0), cB + kstep, voffB); PG8_STAGE(PG8_SA(1, 0), cA + kstep, voffA); PG8_STAGE(PG8_SB(1, 1), cB + hstep + kstep, voffB);
        PG8_WAIT_V(6); PG8_BAR;
    }
    for (;;) {
        const bool has_next = S.next(ui + 1, nxt);
        const char* nA = has_next ? (const char*)g.A + (size_t)nxt.pm * tstep : cA; const char* nB = has_next ? (const char*)g.Bt + (size_t)nxt.pn * tstep : cB;
        for (int t = 0; t < nt; t += 2) {
            const bool last = (t == nt - 2);
            const char* a1 = cA + (size_t)(t + 1) * kstep;
            const char* a2 = last ? nA : cA + (size_t)(t + 2) * kstep; const char* b2 = last ? nB : cB + (size_t)(t + 2) * kstep;
            const char* a3 = a2 + kstep; const char* b3 = b2 + kstep;
            if (last && has_next) S.a_ready(nxt);
            if constexpr (SP2) {
            PG8_LDB(B0, 0, 0); PG8_LDB(B1, 0, 1); PG8_SCHED; PG8_LDA(At, 0, 0); PG8_STAGE(PG8_SA(1, 1), a1 + hstep, voffA);
            PG8_WAIT_V(8); PG8_WAIT_L(0); PG8_BAR; PG8_MMA(0, 0, At, B0); PG8_MMA(0, 1, At, B1); PG8_BAR; PG8_SCHED;
            PG8_LDA(At, 0, 1); PG8_STAGE(PG8_SB(0, 0), b2, voffB); PG8_STAGE(PG8_SB(0, 1), b2 + hstep, voffB); PG8_STAGE(PG8_SA(0, 0), a2, voffA);
            PG8_WAIT_V(8); PG8_WAIT_L(0); PG8_BAR; PG8_MMA(1, 0, At, B0); PG8_MMA(1, 1, At, B1); PG8_BAR; PG8_SCHED;
            PG8_LDB(B0, 1, 0); PG8_LDB(B1, 1, 1); PG8_SCHED; PG8_LDA(At, 1, 0); PG8_STAGE(PG8_SA(0, 1), a2 + hstep, voffA);
            PG8_WAIT_V(8); PG8_WAIT_L(0); PG8_BAR; PG8_MMA(0, 0, At, B0); PG8_MMA(0, 1, At, B1); PG8_BAR; PG8_SCHED;
            PG8_LDA(At, 1, 1); PG8_STAGE(PG8_SB(1, 0), b3, voffB); PG8_STAGE(PG8_SB(1, 1), b3 + hstep, voffB); PG8_STAGE(PG8_SA(1, 0), a3, voffA);
            PG8_WAIT_V(8); PG8_WAIT_L(0); PG8_BAR; PG8_MMA(1, 0, At, B0); PG8_MMA(1, 1, At, B1); PG8_BAR; PG8_SCHED;
            } else {
            PG8_LDB(B0, 0, 0); PG8_SCHED; PG8_LDA(At, 0, 0); PG8_STAGE(PG8_SA(1, 1), a1 + hstep, voffA);
            PG8_WAIT_L(8); PG8_BAR; PG8_WAIT_L(0); PG8_MMA(0, 0, At, B0); PG8_BAR; PG8_SCHED;
            PG8_LDB(B1, 0, 1); PG8_STAGE(PG8_SB(0, 0), b2, voffB);
            PG8_BAR; PG8_WAIT_L(0); PG8_MMA(0, 1, At, B1); PG8_BAR;
            PG8_LDA(At, 0, 1); PG8_STAGE(PG8_SA(0, 0), a2, voffA);
            PG8_BAR; PG8_WAIT_L(0); PG8_MMA(1, 0, At, B0); PG8_BAR; PG8_SCHED;
            PG8_STAGE(PG8_SB(0, 1), b2 + hstep, voffB);
            PG8_WAIT_V(6); PG8_BAR; PG8_MMA(1, 1, At, B1); PG8_BAR;
            PG8_LDB(B0, 1, 0); PG8_SCHED; PG8_LDA(At, 1, 0); PG8_STAGE(PG8_SA(0, 1), a2 + hstep, voffA);
            PG8_WAIT_L(8); PG8_BAR; PG8_WAIT_L(0); PG8_MMA(0, 0, At, B0); PG8_BAR; PG8_SCHED;
            PG8_LDB(B1, 1, 1); PG8_STAGE(PG8_SB(1, 0), b3, voffB);
            PG8_BAR; PG8_WAIT_L(0); PG8_MMA(0, 1, At, B1); PG8_BAR;
            PG8_LDA(At, 1, 1); PG8_STAGE(PG8_SA(1, 0), a3, voffA);
            PG8_BAR; PG8_WAIT_L(0); PG8_MMA(1, 0, At, B0); PG8_BAR; PG8_SCHED;
            PG8_STAGE(PG8_SB(1, 1), b3 + hstep, voffB);
            PG8_WAIT_V(6); PG8_BAR; PG8_MMA(1, 1, At, B1); PG8_BAR;
            }
        }
        if constexpr (ALIGN_EPI) { if (wr == 0) PG8_BAR; }
        if constexpr (!Epi::AFTER_DRAIN) { E(acc, cur, wr, wc, fr, fq); S.done(cur); }
        if (!has_next) break;
#pragma unroll
        for (int a = 0; a < 2; ++a)
#pragma unroll
            for (int b = 0; b < 2; ++b)
#pragma unroll
                for (int m = 0; m < 4; ++m)
#pragma unroll
                    for (int n = 0; n < 2; ++n) acc[a][b][m][n] = (f32x4){0.f, 0.f, 0.f, 0.f};
        cur = nxt; cA = nA; cB = nB; ++ui;
        if constexpr (ALIGN_EPI) { if (wr == 1) PG8_BAR; }
    }
    PG8_WAIT_V(0);
    if constexpr (!ALIGN_EPI) { if (wr == 0) PG8_BAR; }
    PG8_BAR;
    if constexpr (Epi::AFTER_DRAIN) { E.fused(acc, cur, wr, wc, fr, fq, lds, wid, lane); S.done(cur); }
#undef PG8_SA
#undef PG8_SB
#undef PG8_STAGE
#undef PG8_LDA
#undef PG8_LDB
#undef PG8_MMA
#undef PG8_WAIT_V
#undef PG8_WAIT_L
#undef PG8_BAR
#undef PG8_SCHED
}
}
#define GAS __attribute__((address_space(1)))
#define LAS __attribute__((address_space(3)))
typedef unsigned short bf16;
typedef unsigned v4u __attribute__((ext_vector_type(4)));
typedef float f32x4 __attribute__((ext_vector_type(4)));
typedef short bf16x8 __attribute__((ext_vector_type(8)));
typedef GAS unsigned gu32;
typedef GAS unsigned long long gu64;
#define RLX_AGENT __ATOMIC_RELAXED, __HIP_MEMORY_SCOPE_AGENT
#define LDS_WAIT() asm volatile("s_waitcnt lgkmcnt(0)" ::: "memory")
#define VM_WAIT() asm volatile("s_waitcnt vmcnt(0)" ::: "memory")
__device__ __forceinline__ unsigned long long rt() { return __builtin_amdgcn_s_memrealtime(); }
__device__ __forceinline__ unsigned f2bf(float f) { unsigned u = __builtin_bit_cast(unsigned, f); return (u + 0x7fffu + ((u >> 16) & 1u)) >> 16; }
__device__ __forceinline__ unsigned pk2(float lo, float hi) { return f2bf(lo) | (f2bf(hi) << 16); }
#define XB_TMO      128
#define XB_XCNT(j)  (256  + 64 * (j))
#define XB_XSUB(j)  (1280 + 64 * (j))
#define XB_XGEN(j)  (2304 + 64 * (j))
#define XB_TOP      3328
#define XB_TOPGEN   3392
#define XCD_BAR_WORDS 3456
#define XB_SPIN_CAP (1u << 18)

__device__ __forceinline__ unsigned xb_ld(unsigned* p)              { return __hip_atomic_load(p, __ATOMIC_RELAXED, __HIP_MEMORY_SCOPE_AGENT); }
__device__ __forceinline__ unsigned xb_add(unsigned* p, unsigned v) { return __hip_atomic_fetch_add(p, v, __ATOMIC_RELAXED, __HIP_MEMORY_SCOPE_AGENT); }
__device__ __forceinline__ unsigned xb_xcc_id() { return (unsigned)__builtin_amdgcn_s_getreg((3 << 11) | 20) & 0xFu; }
#define XB_SPIN(cond, bar) do { unsigned _sp = 0; while (cond) { __builtin_amdgcn_s_sleep(1); \
    if ((++_sp & 255u) == 0u) { if (xb_ld(&(bar)[XB_TMO])) break; if (_sp > XB_SPIN_CAP) { atomicAdd(&(bar)[XB_TMO], 1u); break; } } } } while (0)

struct XcdBarrier {
    unsigned* bar; unsigned x;
    volatile LAS unsigned* st;
};

__device__ __forceinline__ XcdBarrier xcd_barrier_post(unsigned* bar, volatile LAS unsigned* st) {
    XcdBarrier b; b.bar = bar; b.x = xb_xcc_id(); b.st = st;
    if (threadIdx.x == 0) (void)xb_add(&bar[XB_XCNT(b.x)], 1u);
    return b;
}
__device__ __forceinline__ void xcd_barrier_complete(unsigned* bar, unsigned x, unsigned& nloc, unsigned& nx) {
    const unsigned G = gridDim.x * gridDim.y * gridDim.z;
    unsigned sum, cnt, mine, sp = 0u;
    for (;;) {
        sum = 0u; cnt = 0u; mine = 0u;
#pragma unroll
        for (unsigned j = 0; j < 16; ++j) { const unsigned c = xb_ld(&bar[XB_XCNT(j)]); sum += c; cnt += (c > 0u) ? 1u : 0u; mine = (j == x) ? c : mine; }
        if (sum == G) break;
        __builtin_amdgcn_s_sleep(1);
        if ((++sp & 255u) == 0u) { if (xb_ld(&bar[XB_TMO])) break; if (sp > XB_SPIN_CAP) { atomicAdd(&bar[XB_TMO], 1u); break; } }
    }
    nloc = mine > 0u ? mine : 1u; nx = cnt > 0u ? cnt : 1u;
}

__device__ __forceinline__ void xcd_barrier(const XcdBarrier& b) {
    asm volatile("s_waitcnt vmcnt(0)" ::: "memory");
    __syncthreads();
    if (threadIdx.x == 0) {
        unsigned* bar = b.bar;
        __builtin_amdgcn_s_waitcnt(0);
        unsigned nloc = b.st[0], nx = b.st[1];
        if (nloc == 0u) { xcd_barrier_complete(bar, b.x, nloc, nx); b.st[0] = nloc; b.st[1] = nx; }
        const unsigned old = xb_add(&bar[XB_XSUB(b.x)], 1u);
        const unsigned gen = old / nloc;
        if (old + 1u == (gen + 1u) * nloc) {
            __builtin_amdgcn_fence(__ATOMIC_RELEASE, "agent");
            asm volatile("s_waitcnt vmcnt(0)" ::: "memory");
            const unsigned og = xb_add(&bar[XB_TOP], 1u);
            const unsigned tg = og / nx;
            if (og + 1u == (tg + 1u) * nx) xb_add(&bar[XB_TOPGEN], 1u);
            else XB_SPIN(xb_ld(&bar[XB_TOPGEN]) == tg, bar);
            __builtin_amdgcn_fence(__ATOMIC_ACQUIRE, "agent");
            xb_add(&bar[XB_XGEN(b.x)], 1u);
            asm volatile("s_waitcnt vmcnt(0)" ::: "memory");
        } else {
            XB_SPIN(xb_ld(&bar[XB_XGEN(b.x)]) == gen, bar);
            __builtin_amdgcn_fence(__ATOMIC_ACQUIRE, "agent");
            asm volatile("s_waitcnt vmcnt(0)" ::: "memory");
        }
    }
    __syncthreads();
}

constexpr int NWAVES = 8;
#ifndef MK_MULTI
#define MK_MULTI 0
#endif
#ifndef SCAN_DPP
#define SCAN_DPP 1
#endif

#ifndef EXTRA_BAR
#define EXTRA_BAR 0
#endif
#ifndef REP_PRO
#define REP_PRO 1
#endif
#ifndef REP_GU
#define REP_GU 1
#endif
#ifndef REP_DN
#define REP_DN 1
#endif
#ifndef REP_ROW
#define REP_ROW 1
#endif
#ifndef REP_WIN
#define REP_WIN 1
#endif
#ifndef REP_PREP
#define REP_PREP 1
#endif
#ifndef REP_LORA
#define REP_LORA 1
#endif
#ifndef REP_MIX
#define REP_MIX 1
#endif
#ifndef REP_ATT
#define REP_ATT 1
#endif
#ifndef REP_S1
#define REP_S1 1
#endif
#ifndef REP_S2
#define REP_S2 1
#endif
#ifndef REP_S3
#define REP_S3 1
#endif
#ifndef REP_COMB
#define REP_COMB 1
#endif
#ifndef REP_WOUT
#define REP_WOUT 1
#endif

constexpr int BATCH = 8, SEQ = 2048, D = 2048, M = BATCH * SEQ, FF = 5632, NL = 4;
constexpr int NH = 12, HD = 64, DATT = 768, DRW = 768, DPOOL = 512;
constexpr int DRWIN = 2752, DIN = 5568, DINP = 5632, ZRP = 2816;
constexpr int LORA_K = 512, LORA_N = 2304;
constexpr float NORM_EPS = 1e-6f, GN_EPS = 64e-5f;
constexpr float QSCALE = 0.125f * 1.4426950408889634f;
constexpr int NPH = 1 + 8 * 2 + 4 * 7;

constexpr size_t MiB = 1u << 20;
constexpr size_t WS_CTL = 0, CTL_ZERO_BYTES = 1 * MiB;
constexpr size_t WS_COS = 1 * MiB, WS_SIN = 1 * MiB + 256 * 1024, WS_RS = 1 * MiB + 512 * 1024;
constexpr size_t WS_W = 2 * MiB, LW = 165 * MiB;
constexpr size_t LW_GU1 = 0, LW_D1 = 44 * MiB, LW_IN = 66 * MiB, LW_OUT = 88 * MiB, LW_GU2 = 96 * MiB, LW_D2 = 140 * MiB, LW_LORA = 162 * MiB, LW_POOL = 164 * MiB + 256 * 1024;
constexpr size_t WS_H = WS_W + NL * LW;
constexpr size_t WS_HID = WS_H + 64 * MiB;
constexpr size_t SQ_STRIDE = 22 * MiB, SQ_Q = 0, SQ_K = 3 * MiB, SQ_V = 6 * MiB, SQ_ZR = 9 * MiB, SQ_ZP = 20 * MiB;
static_assert((size_t)SEQ * FF * 2 == SQ_STRIDE && SQ_ZR + (size_t)SEQ * ZRP * 2 == SQ_ZP && SQ_ZP + (size_t)SEQ * 512 * 2 == SQ_STRIDE && (size_t)NH * SEQ * 64 * 2 == 3 * MiB, "per-sequence overlay");
constexpr size_t WS_Y = WS_HID + 176 * MiB;
constexpr size_t WS_CAT = WS_Y + 64 * MiB;
constexpr size_t WS_OG = WS_CAT + 64 * MiB;
constexpr size_t WS_LSE = WS_OG + 72 * MiB;
constexpr size_t WS_LA = WS_LSE + 3 * MiB;
constexpr size_t WS_PP = WS_LA + 16 * MiB;
constexpr size_t WS_L = WS_PP + 16 * MiB, WS_LB = WS_L, WS_XB = WS_L + 72 * MiB;
constexpr size_t WS_END = WS_L + 144 * MiB;
static_assert(WS_HID + BATCH * SQ_STRIDE <= WS_Y && LW_POOL + 512 * 512 * 2 <= LW && LW_LORA + (size_t)LORA_N * LORA_K * 2 <= LW_POOL, "d_ws map");
constexpr int CW_TMO = 0, CW_CODE = 1, CW_BAR = 4096, CW_ATTQ = 8192  , CW_RANK = 11264  , CW_GB = 12288  , CW_XC = 16384, XC_USE = 2 * 64 * 64;
static_assert((CW_XC + 12 * XC_USE) * 4 <= (int)CTL_ZERO_BYTES, "control words");
constexpr int CW_HR = 240000  , CW_HC = 240512  , CW_HB = 241024  ;
static_assert((CW_HB + 64 * 32 * 8) * 4 <= (int)CTL_ZERO_BYTES && CW_XC + 12 * XC_USE <= CW_HR, "control words");

constexpr int RING_OFF = 0, RING_BYTES = 131072;
constexpr int LDSCTL_OFF = RING_BYTES, MISC_OFF = LDSCTL_OFF + 320;
constexpr int LDS_BYTES = 147456;

struct Args { const float* in[28]; float* out; unsigned char* ws; int ph_lo, ph_hi; };
struct ArgsD { const __attribute__((address_space(1))) float* in[28]; __attribute__((address_space(1))) float* out; __attribute__((address_space(1))) unsigned char* ws; int ph_lo, ph_hi; };
static_assert(sizeof(ArgsD) == sizeof(Args), "Args views");
typedef const __attribute__((address_space(4))) ArgsD KArgs;
#define INP(A, k) ((const float*)(A)->in[k])

typedef unsigned long long u64t;
typedef float f32x2g __attribute__((ext_vector_type(2)));
struct Frame {
    LAS unsigned char* lds;
    int wave, vcu, G, tid;
    int bi, nb, seq;
    float* X;
    unsigned char* ws;
};
__device__ __forceinline__ float bf2f(bf16 u) { return __uint_as_float((unsigned)u << 16); }
__device__ __forceinline__ float wave_sum(float v) {
#pragma unroll
    for (int o = 1; o < 64; o <<= 1) v += __shfl_xor(v, o);
    return v;
}
__device__ __forceinline__ float sigmoid_f(float x) { return __builtin_amdgcn_rcpf(1.0f + __builtin_amdgcn_exp2f(-1.4426950408889634f * x)); }

template <class SrcF>
__device__ __forceinline__ void transpose_item(const SrcF src, int ldw, int K, bf16* WT, LAS float* scr, int item, int nblk, int lane, const float* kgain = nullptr) {
    const int kb = item / nblk, nb = item % nblk, k0 = 64 * kb, n0 = 32 * nb;
    const float* colp = src(n0 + (lane & 31));
    float tv[32];
    const GAS float* cp = (const GAS float*)colp + (size_t)(k0 + (lane >> 5)) * ldw;
#pragma unroll
    for (int i = 0; i < 32; ++i) tv[i] = colp ? cp[(size_t)(2 * i) * ldw] : 0.f;
#pragma unroll
    for (int i = 0; i < 32; ++i) scr[(2 * i + (lane >> 5)) * 33 + (lane & 31)] = tv[i];
    LDS_WAIT(); asm volatile("" ::: "memory");
    const int c = lane & 7;
    f32x4 g0 = (f32x4){1.f, 1.f, 1.f, 1.f}, g1 = g0;
    if (kgain) { g0 = *(const GAS f32x4*)(kgain + k0 + 8 * c); g1 = *(const GAS f32x4*)(kgain + k0 + 8 * c + 4); }
#pragma unroll
    for (int j = 0; j < 4; ++j) { const int n = (lane >> 3) + 8 * j; const LAS float* s = scr + (8 * c) * 33 + n;
        v4u o; o.x = pk2(s[0 * 33] * g0[0], s[1 * 33] * g0[1]); o.y = pk2(s[2 * 33] * g0[2], s[3 * 33] * g0[3]); o.z = pk2(s[4 * 33] * g1[0], s[5 * 33] * g1[1]); o.w = pk2(s[6 * 33] * g1[2], s[7 * 33] * g1[3]);
        *(GAS v4u*)(WT + (size_t)(n0 + n) * K + k0 + 8 * c) = o; }
    LDS_WAIT(); asm volatile("" ::: "memory");
}
struct SrcGU { const float* g; long du;
    __device__ __forceinline__ const float* operator()(int n) const { const int col = 128 * (n >> 8) + (n & 127); const long off = ((n >> 7) & 1) ? du : 0l; return (const float*)((const char*)g + off) + col; } };
struct SrcPlain { const float* w; __device__ __forceinline__ const float* operator()(int n) const { return w + n; } };
struct SrcWin { const float* w;
    __device__ __forceinline__ const float* operator()(int n) const {
        if (n < 1536) { const int sec = n / 768, r = n % 768, h = r >> 6, j = r & 63, d = 4 * (j >> 3) + (j & 3) + 32 * ((j >> 2) & 1); return w + sec * 768 + h * 64 + d; }
        if (n < 2304 + DRWIN) return w + n;
        if (n < 2304 + ZRP) return nullptr;
        return w + (n - (ZRP - DRWIN));
    } };

__device__ __forceinline__ void x_row_init(Frame& F, const float* xrow, bf16* xb, float* rs) {
    const GAS f32x4* xr = (const GAS f32x4*)xrow + (F.tid & 63);
    f32x4 v[8]; float s = 0.f;
#pragma unroll
    for (int j = 0; j < 8; ++j) { v[j] = xr[64 * j]; s += (v[j].x * v[j].x + v[j].y * v[j].y) + (v[j].z * v[j].z + v[j].w * v[j].w); }
    const float rstd = 1.0f / sqrtf(wave_sum(s) * (1.f / D) + NORM_EPS);
    GAS u64t* o8 = (GAS u64t*)xb + (F.tid & 63);
#pragma unroll
    for (int j = 0; j < 8; ++j) o8[64 * j] = (u64t)pk2(v[j].x, v[j].y) | ((u64t)pk2(v[j].z, v[j].w) << 32);
    if ((F.tid & 63) == 0) *rs = rstd;
}

__device__ __forceinline__ void p0_prologue_w(Frame& F, KArgs* A);
__device__ __forceinline__ void p0_prologue(Frame& F, KArgs* A) {
    p0_prologue_w(F, A);
    const int gw = F.vcu * NWAVES + F.wave, NGW = F.G * NWAVES;
    for (int m = gw; m < M; m += NGW) x_row_init(F, INP(A, 0) + (size_t)m * D, ((bf16*)(F.ws + WS_XB)) + (size_t)m * D, ((float*)(F.ws + WS_RS)) + m);
}
__device__ __forceinline__ void p0_prologue_w(Frame& F, KArgs* A) {
    LAS float* scr = (LAS float*)(F.lds + RING_OFF + F.wave * 16384);
    const int gw = F.vcu * NWAVES + F.wave, NGW = F.G * NWAVES;
    constexpr int I_GU = (D / 64) * (2 * FF / 32), I_D = (FF / 64) * (D / 32), I_IN = (D / 64) * (DINP / 32), I_OUT = (D / 64) * (D / 32);
    constexpr int I_L = 2 * I_GU + 2 * I_D + I_IN + I_OUT;
    for (int it = gw; it < NL * I_L; it += NGW) {
        const int l = it / I_L; int r = it % I_L;
        unsigned char* wl = F.ws + WS_W + (size_t)l * LW;
        const size_t offF = (size_t)l * D * FF;
        if (r < I_GU) { transpose_item(SrcGU{INP(A, 3) + offF, (long)((const char*)INP(A, 4) - (const char*)INP(A, 3))}, FF, D, (bf16*)(wl + LW_GU1), scr, r, 2 * FF / 32, (F.tid & 63), INP(A, 1) + (size_t)l * D); continue; } r -= I_GU;
        if (r < I_D) { transpose_item(SrcPlain{INP(A, 5) + offF}, D, FF, (bf16*)(wl + LW_D1), scr, r, D / 32, (F.tid & 63)); continue; } r -= I_D;
        if (r < I_IN) { transpose_item(SrcWin{INP(A, 8) + (size_t)l * D * DIN}, DIN, D, (bf16*)(wl + LW_IN), scr, r, DINP / 32, (F.tid & 63), INP(A, 6) + (size_t)l * D); continue; } r -= I_IN;
        if (r < I_OUT) { transpose_item(SrcPlain{INP(A, 9) + (size_t)l * D * D}, D, D, (bf16*)(wl + LW_OUT), scr, r, D / 32, (F.tid & 63)); continue; } r -= I_OUT;
        if (r < I_GU) { transpose_item(SrcGU{INP(A, 25) + offF, (long)((const char*)INP(A, 26) - (const char*)INP(A, 25))}, FF, D, (bf16*)(wl + LW_GU2), scr, r, 2 * FF / 32, (F.tid & 63), INP(A, 23) + (size_t)l * D); continue; } r -= I_GU;
        transpose_item(SrcPlain{INP(A, 27) + offF}, D, FF, (bf16*)(wl + LW_D2), scr, r, D / 32, (F.tid & 63));
    }
    const int gt = F.vcu * (NWAVES * 64) + F.tid, NGT = F.G * NWAVES * 64;
    constexpr int E_LORA = LORA_N * LORA_K, E_POOL = 512 * 512, E_L = E_LORA + E_POOL;
    for (int e = gt; e < NL * E_L; e += NGT) {
        const int l = e / E_L; int r = e % E_L;
        unsigned char* wl = F.ws + WS_W + (size_t)l * LW;
        if (r < E_LORA) { const int n = r / LORA_K, k = r % LORA_K; float v = 0.f; int kb = -1;
            if (n < 768) { if (k < 96) { v = INP(A, 11)[(size_t)l * 96 * 768 + k * 768 + n]; kb = 0; } }
            else if (n < 1536) { if (k >= 96 && k < 192) { v = INP(A, 13)[(size_t)l * 96 * 768 + (k - 96) * 768 + (n - 768)]; kb = 96; } }
            else { if (k >= 192 && k < 448) { v = INP(A, 15)[(size_t)l * 256 * 768 + (k - 192) * 768 + (n - 1536)]; kb = 192; } }
            if (kb >= 0) { const int kk = k - kb; ((bf16*)(wl + LW_LORA))[(((((n >> 6) * 4 + ((n >> 4) & 3)) * 8 + (kk >> 5)) * 64) + ((kk >> 3) & 3) * 16 + (n & 15)) * 8 + (kk & 7)] = (bf16)f2bf(v); }
        } else { r -= E_LORA; const int n = r / 512, k = r % 512; float v = 0.f;
            if ((n >> 7) == (k >> 7)) v = INP(A, 21)[(size_t)l * 4 * 128 * 128 + (size_t)(n >> 7) * 128 * 128 + (k & 127) * 128 + (n & 127)];
            ((bf16*)(wl + LW_POOL))[r] = (bf16)f2bf(v);
        }
    }
    for (int e = gt; e < SEQ * 32; e += NGT) {
        const int pos = e >> 5, i = e & 31;
        const float invf = powf(10000.0f, -(float)i / 32.0f);
        const double rev = (double)pos * (double)invf * 0.15915494309189535;
        const float fr = (float)(rev - rint(rev));
        ((float*)(F.ws + WS_COS))[e] = __builtin_amdgcn_cosf(fr); ((float*)(F.ws + WS_SIN))[e] = __builtin_amdgcn_sinf(fr);
    }
}

__device__ __forceinline__ void row_pass(Frame& F, float coef, const float* gpost, bool last) {
    const int gw = F.vcu * NWAVES + F.wave, NGW = F.G * NWAVES, lane = F.tid & 63;
    for (int m = gw; m < M; m += NGW) {
        GAS u64t* xr = (GAS u64t*)(((bf16*)(F.ws + WS_XB)) + (size_t)m * D) + lane; const GAS u64t* yr = (const GAS u64t*)(((bf16*)(F.ws + WS_Y)) + (size_t)m * D) + lane;
        const GAS f32x4* gp = (const GAS f32x4*)gpost + lane;
        f32x4 xv[8], yv[8]; float s = 0.f;
#pragma unroll
        for (int j = 0; j < 8; ++j) { const u64t xw = xr[64 * j], w = yr[64 * j];
            xv[j].x = __uint_as_float((unsigned)(xw << 16)); xv[j].y = __uint_as_float((unsigned)xw & 0xffff0000u); xv[j].z = __uint_as_float((unsigned)(xw >> 32) << 16); xv[j].w = __uint_as_float((unsigned)(xw >> 32) & 0xffff0000u);
            yv[j].x = __uint_as_float((unsigned)(w << 16)); yv[j].y = __uint_as_float((unsigned)w & 0xffff0000u); yv[j].z = __uint_as_float((unsigned)(w >> 32) << 16); yv[j].w = __uint_as_float((unsigned)(w >> 32) & 0xffff0000u);
            s += (yv[j].x * yv[j].x + yv[j].y * yv[j].y) + (yv[j].z * yv[j].z + yv[j].w * yv[j].w); }
        const float cr = coef / sqrtf(wave_sum(s) * (1.f / D) + NORM_EPS); float s2 = 0.f;
        if (last) {
            GAS f32x4* xo = (GAS f32x4*)(F.X + (size_t)m * D) + lane;
#pragma unroll
            for (int j = 0; j < 8; ++j) { const f32x4 g = gp[64 * j]; xo[64 * j] = xv[j] + yv[j] * g * cr; }
        } else {
#pragma unroll
            for (int j = 0; j < 8; ++j) { const f32x4 g = gp[64 * j]; xv[j] = xv[j] + yv[j] * g * cr;
                const unsigned lo = pk2(xv[j].x, xv[j].y), hi = pk2(xv[j].z, xv[j].w); xr[64 * j] = (u64t)lo | ((u64t)hi << 32);
                const float a0 = __uint_as_float(lo << 16), a1 = __uint_as_float(lo & 0xffff0000u), a2 = __uint_as_float(hi << 16), a3 = __uint_as_float(hi & 0xffff0000u);
                s2 += (a0 * a0 + a1 * a1) + (a2 * a2 + a3 * a3); }
            const float rstd = 1.0f / sqrtf(wave_sum(s2) * (1.f / D) + NORM_EPS);
            if (lane == 0) ((float*)(F.ws + WS_RS))[m] = rstd;
        }
    }
}
__device__ __forceinline__ float tanh_f(float x) { return 1.0f - 2.0f * __builtin_amdgcn_rcpf(1.0f + __builtin_amdgcn_exp2f(2.8853900817779268f * x)); }
__device__ __forceinline__ void unpack8(const v4u z, float (&f)[8]) {
#pragma unroll
    for (int e = 0; e < 4; ++e) { f[2 * e] = __uint_as_float(z[e] << 16); f[2 * e + 1] = __uint_as_float(z[e] & 0xffff0000u); }
}
__device__ __forceinline__ void mix_prep(Frame& F, KArgs* A, int l) {
    const int gw = F.bi * NWAVES + F.wave, NGW = F.nb * NWAVES, lane = F.tid & 63;
    const float* mu = INP(A, 10) + (size_t)l * DRWIN + 2304;
    f32x4 mu0 = (f32x4){0.f, 0.f, 0.f, 0.f}, mu1 = mu0;
    if (lane < 56) { mu0 = *(const GAS f32x4*)(mu + 8 * lane); mu1 = *(const GAS f32x4*)(mu + 8 * lane + 4); }
    const int pw = 2 << (lane >> 4);
    const int per = (SEQ + NGW - 1) / NGW, r_lo = gw * per, r_hi = (r_lo + per < SEQ) ? r_lo + per : SEQ, m_lo = F.seq * SEQ + r_lo, m_hi = F.seq * SEQ + r_hi;
    for (int m = m_lo; m < m_hi; ++m) {
        const int s = m & (SEQ - 1);
        const unsigned char* sqb = F.ws + WS_HID + (size_t)(m >> 11) * SQ_STRIDE;
        const bf16* zr = ((const bf16*)(sqb + SQ_ZR)) + (size_t)s * ZRP + 2304 + 8 * (lane < 56 ? lane : 0);
        const bf16* zp = ((const bf16*)(sqb + SQ_ZP)) + (size_t)s * 512 + 8 * lane;
        const int cnt = (s + 1 < pw) ? s + 1 : pw;
        v4u zc = (v4u){0u, 0u, 0u, 0u}, zq = zc, zw[16];
        if (lane < 56) { zc = *(const GAS v4u*)zr; if (s > 0) zq = *(const GAS v4u*)(zr - ZRP); }
#pragma unroll
        for (int i = 0; i < 16; ++i) { zw[i] = (v4u){0u, 0u, 0u, 0u}; if (i < cnt) zw[i] = *(const GAS v4u*)(zp - (size_t)i * 512); }
        v4u outv = (v4u){0u, 0u, 0u, 0u};
        if (lane < 56) {
            float z[8], zpv[8], v[8]; unpack8(zc, z); unpack8(zq, zpv);
#pragma unroll
            for (int e = 0; e < 8; ++e) { const float mm = e < 4 ? mu0[e] : mu1[e - 4], zs = z[e] + (zpv[e] - z[e]) * mm; v[e] = lane < 12 ? tanh_f(zs) : (lane < 24 ? zs : sigmoid_f(zs)); }
            outv.x = pk2(v[0], v[1]); outv.y = pk2(v[2], v[3]); outv.z = pk2(v[4], v[5]); outv.w = pk2(v[6], v[7]);
        }
        *(GAS v4u*)(((bf16*)(F.ws + WS_LA)) + (size_t)m * LORA_K + 8 * lane) = outv;
        float acc[8], u[8]; unpack8(zw[0], u);
#pragma unroll
        for (int e = 0; e < 8; ++e) acc[e] = u[e];
#pragma unroll
        for (int i = 1; i < 16; ++i) { float t[8]; unpack8(zw[i], t);
#pragma unroll
            for (int e = 0; e < 8; ++e) acc[e] += t[e]; }
        const float ic = 1.0f / (float)cnt;
        v4u pv; pv.x = pk2(acc[0] * ic - u[0], acc[1] * ic - u[1]); pv.y = pk2(acc[2] * ic - u[2], acc[3] * ic - u[3]); pv.z = pk2(acc[4] * ic - u[4], acc[5] * ic - u[5]); pv.w = pk2(acc[6] * ic - u[6], acc[7] * ic - u[7]);
        *(GAS v4u*)(((bf16*)(F.ws + WS_PP)) + (size_t)m * 512 + 8 * lane) = pv;
    }
}
__device__ __forceinline__ void attn_combine(Frame& F) {
    const int gw = F.bi * NWAVES + F.wave, NGW = F.nb * NWAVES, lane = F.tid & 63;
    const float* LSE = (const float*)(F.ws + WS_LSE); const bf16* OG = (const bf16*)(F.ws + WS_OG); bf16* CAT = (bf16*)(F.ws + WS_CAT);
    const int per = (SEQ + NGW - 1) / NGW, r_lo = gw * per, r_hi = (r_lo + per < SEQ) ? r_lo + per : SEQ, m_lo = F.seq * SEQ + r_lo, m_hi = F.seq * SEQ + r_hi;
    constexpr int RB = 4;
    for (int m0 = m_lo; m0 < m_hi; m0 += RB) {
        u64t a[RB][3], b[RB][3], c[RB][3]; float l0[RB][3], l1[RB][3], l2[RB][3];
#pragma unroll
        for (int r = 0; r < RB; ++r) { const int m = (m0 + r < m_hi) ? m0 + r : m_hi - 1;
#pragma unroll
            for (int p = 0; p < 3; ++p) {
                const int h = 4 * p + (lane >> 4); const size_t o = (size_t)m * DATT + 256 * p + 4 * lane;
                l0[r][p] = LSE[(size_t)m * NH + h]; l1[r][p] = LSE[(size_t)(M + m) * NH + h]; l2[r][p] = LSE[(size_t)(2 * M + m) * NH + h];
                a[r][p] = *(const GAS u64t*)(OG + o); b[r][p] = *(const GAS u64t*)(OG + (size_t)M * DATT + o); c[r][p] = *(const GAS u64t*)(OG + (size_t)2 * M * DATT + o); } }
#pragma unroll
        for (int r = 0; r < RB; ++r) { if (m0 + r >= m_hi) break; const int m = m0 + r;
#pragma unroll
            for (int p = 0; p < 3; ++p) {
                const float mx = fmaxf(l0[r][p], fmaxf(l1[r][p], l2[r][p]));
                float e0 = __builtin_amdgcn_exp2f(l0[r][p] - mx), e1 = __builtin_amdgcn_exp2f(l1[r][p] - mx), e2 = __builtin_amdgcn_exp2f(l2[r][p] - mx); const float inv = __builtin_amdgcn_rcpf(e0 + e1 + e2);
                e0 *= inv; e1 *= inv; e2 *= inv;
                float rr[4];
#pragma unroll
                for (int e = 0; e < 4; ++e) rr[e] = e0 * bf2f((bf16)(a[r][p] >> (16 * e))) + e1 * bf2f((bf16)(b[r][p] >> (16 * e))) + e2 * bf2f((bf16)(c[r][p] >> (16 * e)));
                *(GAS u64t*)(CAT + (size_t)m * D + 256 * p + 4 * lane) = (u64t)pk2(rr[0], rr[1]) | ((u64t)pk2(rr[2], rr[3]) << 32); } }
    }
}
constexpr int MP = 64;
__device__ __forceinline__ int swz(int row, int col) { return row * MP + ((((col >> 3) ^ (row >> 1)) & 7) << 3) + (col & 7); }
constexpr int ATT_K_OFF = 0, ATT_V_OFF = 256 * 64 * 2;
constexpr int ATT_UNITS = 3 * BATCH * NH * 16;
static_assert(ATT_V_OFF + 256 * 64 * 2 <= RING_BYTES, "attention LDS");
typedef short s16x4v __attribute__((ext_vector_type(4)));
__device__ __forceinline__ int swzv(int key, int d) { return key * 64 + ((((d >> 3) ^ (2 * ((key >> 1) & 3))) & 7) << 3) + (d & 7); }
struct AttnIn { v4u kv[4], vv[4]; bf16x8 q0, q1; };
struct AttnUnit { int g, bh, dl, r, blk; };
constexpr int ATT_SEQ_UNITS = 3 * NH * 16;
__device__ __forceinline__ AttnUnit attn_decode(int lu, int seq) { AttnUnit u; u.g = lu / (NH * 16); const int rem = lu % (NH * 16), rb = rem & 15; u.bh = seq * NH + (rem >> 4);
    if (u.g == 0) { u.dl = 1; u.r = 0; u.blk = rb; } else if (u.g == 1) { u.dl = 4; u.r = rb & 3; u.blk = rb >> 2; } else { u.dl = 16; u.r = rb; u.blk = 0; } return u; }
__device__ __forceinline__ void attn_fetch(Frame& F, const AttnUnit& u, AttnIn& R) {
    const unsigned char* sqb = F.ws + WS_HID + (size_t)(u.bh / NH) * SQ_STRIDE; const size_t ho = (size_t)(u.bh % NH) * SEQ * 64;
    const bf16* Qh = ((const bf16*)(sqb + SQ_Q)) + ho; const bf16* Kh = ((const bf16*)(sqb + SQ_K)) + ho; const bf16* Vh = ((const bf16*)(sqb + SQ_V)) + ho;
#pragma unroll
    for (int it = 0; it < 4; ++it) { const int idx = F.tid + it * 512, j = idx >> 3, ch = idx & 7, lk = (u.blk - 1) * 128 + j;
        R.kv[it] = (v4u){0u, 0u, 0u, 0u}; R.vv[it] = (v4u){0u, 0u, 0u, 0u};
        if (lk >= 0) { const size_t off = (size_t)(lk * u.dl + u.r) * 64 + ch * 8; R.kv[it] = *(const GAS v4u*)(Kh + off); R.vv[it] = *(const GAS v4u*)(Vh + off); } }
    const int fr = (F.tid & 63) & 15, fq = (F.tid & 63) >> 4, tq = (u.blk * 128 + 16 * F.wave + fr) * u.dl + u.r;
    R.q0 = *(const GAS bf16x8*)(Qh + (size_t)tq * 64 + 8 * fq); R.q1 = *(const GAS bf16x8*)(Qh + (size_t)tq * 64 + 32 + 8 * fq);
}
__device__ __forceinline__ void attn_stage(Frame& F, const AttnIn& R) {
    LAS bf16* KS = (LAS bf16*)(F.lds + ATT_K_OFF); LAS bf16* VS = (LAS bf16*)(F.lds + ATT_V_OFF);
#pragma unroll
    for (int it = 0; it < 4; ++it) { const int idx = F.tid + it * 512, j = idx >> 3, ch = idx & 7;
        *(LAS v4u*)(KS + swz(j, 8 * ch)) = R.kv[it]; *(LAS v4u*)(VS + swzv(j, 8 * ch)) = R.vv[it]; }
}
__device__ __forceinline__ void attn_compute(Frame& F, const AttnUnit& u, const bf16x8 q0, const bf16x8 q1) {
    const LAS bf16* KS = (const LAS bf16*)(F.lds + ATT_K_OFF); const LAS bf16* VS = (const LAS bf16*)(F.lds + ATT_V_OFF);
    const int w = F.wave, lane = F.tid & 63, fr = lane & 15, fq = lane >> 4, blk = u.blk;
    const int tq = (blk * 128 + 16 * w + fr) * u.dl + u.r;
    const int ko0 = swz(fr, 8 * fq), ko1 = swz(fr, 32 + 8 * fq);
    f32x4 s[9];
    { bf16x8 kf0[9], kf1[9];
#pragma unroll
      for (int t = 0; t < 9; ++t) { const LAS bf16* kp = KS + 16 * (w + t) * 64; kf0[t] = *(const LAS bf16x8*)(kp + ko0); kf1[t] = *(const LAS bf16x8*)(kp + ko1); }
      __builtin_amdgcn_sched_barrier(0);
#pragma unroll
      for (int t = 0; t < 9; ++t) { f32x4 z = (f32x4){0.f, 0.f, 0.f, 0.f};
        z = __builtin_amdgcn_mfma_f32_16x16x32_bf16(kf0[t], q0, z, 0, 0, 0);
        s[t] = __builtin_amdgcn_mfma_f32_16x16x32_bf16(kf1[t], q1, z, 0, 0, 0); } }
    const int tq_ = (lane >> 2) & 3, tp = lane & 3;
    s16x4v vlo[5][4], vhi[5][4];
#pragma unroll
    for (int pp = 0; pp < 5; ++pp) { const int ka = 16 * (w + 2 * pp) + 4 * fq + tq_, kb = (pp < 4) ? ka + 16 : ka;
#pragma unroll
        for (int c = 0; c < 4; ++c) { vlo[pp][c] = __builtin_bit_cast(s16x4v, __builtin_amdgcn_ds_read_tr16_b64_v4i16((LAS s16x4v*)(VS + swzv(ka, 16 * c + 4 * tp))));
            vhi[pp][c] = __builtin_bit_cast(s16x4v, __builtin_amdgcn_ds_read_tr16_b64_v4i16((LAS s16x4v*)(VS + swzv(kb, 16 * c + 4 * tp)))); } }
    __builtin_amdgcn_sched_barrier(0);
    float mx = -INFINITY;
#pragma unroll
    for (int i = 0; i < 4; ++i) { s[0][i] = (4 * fq + i >= fr) ? s[0][i] : -INFINITY; s[8][i] = (4 * fq + i <= fr) ? s[8][i] : -INFINITY; }
    if (blk == 0) {
#pragma unroll
        for (int t = 0; t < 9; ++t)
#pragma unroll
            for (int i = 0; i < 4; ++i) s[t][i] = (16 * (w + t) + 4 * fq + i >= 128) ? s[t][i] : -INFINITY; }
#pragma unroll
    for (int t = 0; t < 9; ++t)
#pragma unroll
        for (int i = 0; i < 4; ++i) mx = fmaxf(mx, s[t][i]);
    mx = fmaxf(mx, __shfl_xor(mx, 16)); mx = fmaxf(mx, __shfl_xor(mx, 32));
    float lsum = 0.f;
#pragma unroll
    for (int t = 0; t < 9; ++t)
#pragma unroll
        for (int i = 0; i < 4; ++i) { s[t][i] = __builtin_amdgcn_exp2f(s[t][i] - mx); lsum += s[t][i]; }
    lsum += __shfl_xor(lsum, 16); lsum += __shfl_xor(lsum, 32);
    f32x4 o[4];
#pragma unroll
    for (int c = 0; c < 4; ++c) o[c] = (f32x4){0.f, 0.f, 0.f, 0.f};
#pragma unroll
    for (int pp = 0; pp < 5; ++pp) {
        v4u pw; pw.x = pg8::cvt_pk_bf16(s[2 * pp][0], s[2 * pp][1]); pw.y = pg8::cvt_pk_bf16(s[2 * pp][2], s[2 * pp][3]);
        if (pp < 4) { pw.z = pg8::cvt_pk_bf16(s[2 * pp + 1][0], s[2 * pp + 1][1]); pw.w = pg8::cvt_pk_bf16(s[2 * pp + 1][2], s[2 * pp + 1][3]); } else { pw.z = 0u; pw.w = 0u; }
        const bf16x8 pb = __builtin_bit_cast(bf16x8, pw);
#pragma unroll
        for (int c = 0; c < 4; ++c) {
            const s16x4v lo = vlo[pp][c], hi = vhi[pp][c];
            const bf16x8 va = (bf16x8){lo[0], lo[1], lo[2], lo[3], hi[0], hi[1], hi[2], hi[3]};
            o[c] = __builtin_amdgcn_mfma_f32_16x16x32_bf16(va, pb, o[c], 0, 0, 0); }
    }
    const float inv = 1.0f / lsum;
    const int b = u.bh / NH, h = u.bh % NH; const size_t mq = (size_t)b * SEQ + tq;
    bf16* op = ((bf16*)(F.ws + WS_OG)) + (size_t)u.g * M * DATT + mq * DATT + h * 64 + 4 * fq;
#pragma unroll
    for (int c = 0; c < 4; ++c) { pg8::u32x2 wv; wv.x = pg8::cvt_pk_bf16(o[c][0] * inv, o[c][1] * inv); wv.y = pg8::cvt_pk_bf16(o[c][2] * inv, o[c][3] * inv); *(GAS pg8::u32x2*)(op + 16 * c) = wv; }
    if (fq == 0) ((float*)(F.ws + WS_LSE))[((size_t)u.g * M + mq) * NH + h] = mx + __builtin_amdgcn_logf(lsum);
}
__device__ __forceinline__ void attn_loop(Frame& F, gu32* ctr) {
    volatile LAS int* slot = (volatile LAS int*)(F.lds + MISC_OFF + 64);
    const int seq = F.seq;
    int pend = 0;
    if (F.tid == 0) { *slot = (int)__hip_atomic_fetch_add(ctr, 1u, __ATOMIC_RELAXED, __HIP_MEMORY_SCOPE_AGENT); pend = (int)__hip_atomic_fetch_add(ctr, 1u, __ATOMIC_RELAXED, __HIP_MEMORY_SCOPE_AGENT); }
    __syncthreads();
    int cur = *slot;
    AttnIn R;
    if (cur < ATT_SEQ_UNITS) attn_fetch(F, attn_decode(cur, seq), R);
    while (cur < ATT_SEQ_UNITS) {
        const AttnUnit u = attn_decode(cur, seq);
        __syncthreads();
        if (F.tid == 0) { *slot = pend; pend = (int)__hip_atomic_fetch_add(ctr, 1u, __ATOMIC_RELAXED, __HIP_MEMORY_SCOPE_AGENT); }
        attn_stage(F, R);
        const bf16x8 q0 = R.q0, q1 = R.q1;
        __syncthreads();
        const int nxt = *slot;
        if (nxt < ATT_SEQ_UNITS) attn_fetch(F, attn_decode(nxt, seq), R);
        attn_compute(F, u, q0, q1);
        cur = nxt;
    }
}

constexpr int CH = 64, NCHUNK = SEQ / CH, SCAN_UNITS = BATCH * NH * NCHUNK;
constexpr int MB = 64 * MP * 2;
constexpr int LP = 68;
constexpr int S1_KT = 0, S1_BT = MB, S1_KK = 2 * MB, S1_RT = 3 * MB, S1_KTT = 4 * MB, S1_BTT = 5 * MB, S1_KKT = 6 * MB, S1_VT = 7 * MB, S1_AAK = 8 * MB, S1_ARB = 9 * MB, S1_ARK = 10 * MB;
constexpr int S1_P = 11 * MB, S1_PT = 12 * MB, S1_TM = 13 * MB, S1_GC = 14 * MB, S1_WT = S1_P  , S1_END = S1_GC + 256;
constexpr int S1_AKVT = S1_KT, S1_WTT = S1_KK, S1_UT = S1_AAK;
static_assert(S1_END <= RING_BYTES, "S1 LDS");
constexpr size_t WS_XS = WS_H + 50 * MiB;
constexpr size_t WS_MC = WS_H, WS_RK = WS_H + 48 * MiB, WS_NCT = WS_Y, WS_YL = WS_END, WS_QE = WS_YL + 48 * MiB, WS_VV = WS_QE + 24 * MiB, WS_GG = WS_VV + 24 * MiB, WS_H0T = WS_GG + 24 * MiB, WS_END2 = WS_H0T + 24 * MiB;
static_assert((size_t)SCAN_UNITS * 64 * 64 * 4 <= 48 * MiB && (size_t)SCAN_UNITS * 64 * 64 * 2 <= 24 * MiB && WS_RK + (size_t)BATCH * NH * SEQ * 4 <= WS_HID, "scan scratch map");

__device__ __forceinline__ f32x4 mm_tile(const LAS bf16* X, const LAS bf16* Y, int tn, int tm, int fr, int fq, f32x4 acc) {
    const int o0 = swz(fr, 8 * fq), o1 = swz(fr, 32 + 8 * fq);
    const LAS bf16* ap = Y + 16 * tm * MP; const LAS bf16* bp = X + 16 * tn * MP;
    acc = __builtin_amdgcn_mfma_f32_16x16x32_bf16(*(const LAS bf16x8*)(ap + o0), *(const LAS bf16x8*)(bp + o0), acc, 0, 0, 0);
    acc = __builtin_amdgcn_mfma_f32_16x16x32_bf16(*(const LAS bf16x8*)(ap + o1), *(const LAS bf16x8*)(bp + o1), acc, 0, 0, 0);
    return acc;
}
__device__ __forceinline__ void st_tile_bf16(LAS bf16* Z, int tn, int tm, int fr, int fq, f32x4 v) {
    pg8::u32x2 w; w.x = pg8::cvt_pk_bf16(v[0], v[1]); w.y = pg8::cvt_pk_bf16(v[2], v[3]); *(LAS pg8::u32x2*)(Z + swz(16 * tn + fr, 16 * tm + 4 * fq)) = w;
}
constexpr f32x4 F4Z = {0.f, 0.f, 0.f, 0.f};

__device__ __forceinline__ void wave_sum8(float (&v)[8]) {
#pragma unroll
    for (int i = 0; i < 8; ++i) {
        v[i] += __builtin_bit_cast(float, __builtin_amdgcn_update_dpp(0, __builtin_bit_cast(int, v[i]), 0xB1, 0xF, 0xF, true));
        v[i] += __builtin_bit_cast(float, __builtin_amdgcn_update_dpp(0, __builtin_bit_cast(int, v[i]), 0x4E, 0xF, 0xF, true));
        v[i] += __builtin_bit_cast(float, __builtin_amdgcn_update_dpp(0, __builtin_bit_cast(int, v[i]), 0x141, 0xF, 0xF, true));
        v[i] += __builtin_bit_cast(float, __builtin_amdgcn_update_dpp(0, __builtin_bit_cast(int, v[i]), 0x140, 0xF, 0xF, true)); }
    float t[8];
#pragma unroll
    for (int i = 0; i < 8; ++i) t[i] = __shfl_xor(v[i], 16);
#pragma unroll
    for (int i = 0; i < 8; ++i) v[i] += t[i];
#pragma unroll
    for (int i = 0; i < 8; ++i) t[i] = __shfl_xor(v[i], 32);
#pragma unroll
    for (int i = 0; i < 8; ++i) v[i] += t[i];
}
constexpr int LAP = 456, PPP = 520;
constexpr int MF_STG = 64 * PPP * 2;
static_assert(MF_STG + 8 * 4096 <= RING_BYTES && 64 * LAP * 2 <= MF_STG, "mixer-front LDS");
__device__ __forceinline__ void mf_store_rows(int lane, LAS bf16* stg, bf16* dst, size_t pitch) {
    asm volatile("s_waitcnt lgkmcnt(0)" ::: "memory");
#pragma unroll
    for (int i = 0; i < 4; ++i) { const int row = 8 * i + (lane >> 3), ch = lane & 7; const v4u v = *(const LAS v4u*)(stg + row * 64 + ch * 8); *(GAS v4u*)(dst + (size_t)row * pitch + ch * 8) = v; }
    asm volatile("s_waitcnt lgkmcnt(0)" ::: "memory");
}
template <int PARTS  > __device__ __forceinline__ void mix_front(Frame& F, KArgs* A, int l, int seq, int c) {
    int tid_ = F.tid; asm volatile("" : "+v"(tid_));
    const int tid = tid_, lane = tid & 63, w = F.wave, fr = lane & 15, fq = lane >> 4;
    LAS bf16* TL = (LAS bf16*)F.lds; LAS bf16* stg = (LAS bf16*)(F.lds + MF_STG + w * 4096);
    const int s00 = c * CH; const size_t m0 = (size_t)seq * SEQ + s00;
    const unsigned char* sqb = F.ws + WS_HID + (size_t)seq * SQ_STRIDE;
    const int row = tid >> 3, sub = tid & 7;
    if (PARTS & 1) { const float* mu = INP(A, 10) + (size_t)l * DRWIN + 2304; const int s = s00 + row;
      const bf16* zr = ((const bf16*)(sqb + SQ_ZR)) + (size_t)s * ZRP + 2304;
      v4u zc[7], zq[7]; f32x4 mu0[7], mu1[7];
#pragma unroll
      for (int i = 0; i < 7; ++i) { const int j = sub + 8 * i;
          zc[i] = *(const GAS v4u*)(zr + 8 * j); zq[i] = (v4u){0u, 0u, 0u, 0u}; if (s > 0) zq[i] = *(const GAS v4u*)(zr + 8 * j - ZRP);
          mu0[i] = *(const GAS f32x4*)(mu + 8 * j); mu1[i] = *(const GAS f32x4*)(mu + 8 * j + 4); }
#pragma unroll
      for (int i = 0; i < 7; ++i) { const int j = sub + 8 * i;
          float z[8], zp[8], v[8]; unpack8(zc[i], z); unpack8(zq[i], zp);
#pragma unroll
          for (int e = 0; e < 8; ++e) { const float mm = e < 4 ? mu0[i][e] : mu1[i][e - 4], zs = z[e] + (zp[e] - z[e]) * mm; v[e] = j < 12 ? tanh_f(zs) : (j < 24 ? zs : sigmoid_f(zs)); }
          v4u o; o.x = pk2(v[0], v[1]); o.y = pk2(v[2], v[3]); o.z = pk2(v[4], v[5]); o.w = pk2(v[6], v[7]);
          *(LAS v4u*)(TL + row * LAP + 8 * j) = o; } }
    __syncthreads();
    if (PARTS & 1) { const bf16* WL = (const bf16*)(F.ws + WS_W + (size_t)l * LW + LW_LORA);
#define MF_WL_LOAD(STEP, DST, NK) do { const int it_ = w + NWAVES * ((STEP) >> 2), cb_ = it_ >> 1; \
        const bf16* p_ = WL + (size_t)((cb_ * 4 + ((STEP) & 3)) * 8) * 512 + lane * 8; \
        _Pragma("unroll") for (int ks_ = 0; ks_ < (NK); ++ks_) DST[ks_] = *(const GAS bf16x8*)(p_ + 512 * ks_); } while (0)
#define MF_LB_LOAD(STEP, NK) do { const int it_ = w + NWAVES * ((STEP) >> 2), cb_ = it_ >> 1, th_ = it_ & 1, g_ = cb_ / 12, kb_ = g_ == 0 ? 0 : (g_ == 1 ? 96 : 192); \
        _Pragma("unroll") for (int ks_ = 0; ks_ < (NK); ++ks_) { _Pragma("unroll") for (int tt_ = 0; tt_ < 2; ++tt_) lb[tt_][ks_] = *(const LAS bf16x8*)(TL + (32 * th_ + 16 * tt_ + fr) * LAP + kb_ + 32 * ks_ + 8 * fq); } } while (0)
#define MF_WL_STEP(STEP, CUR, NK) do { const int it_ = w + NWAVES * ((STEP) >> 2), cb_ = it_ >> 1, th_ = it_ & 1, ct_ = (STEP) & 3, g_ = cb_ / 12, kb_ = g_ == 0 ? 0 : (g_ == 1 ? 96 : 192); (void)kb_; \
        f32x4 acc_[2] = {F4Z, F4Z}; \
        _Pragma("unroll") for (int ks_ = 0; ks_ < (NK); ++ks_) { _Pragma("unroll") for (int tt_ = 0; tt_ < 2; ++tt_) acc_[tt_] = __builtin_amdgcn_mfma_f32_16x16x32_bf16(CUR[ks_], MF_LBOP(tt_, ks_), acc_[tt_], 0, 0, 0); } \
        _Pragma("unroll") for (int tt_ = 0; tt_ < 2; ++tt_) { pg8::u32x2 o_; o_.x = pg8::cvt_pk_bf16(acc_[tt_][0], acc_[tt_][1]); o_.y = pg8::cvt_pk_bf16(acc_[tt_][2], acc_[tt_][3]); *(LAS pg8::u32x2*)(stg + (16 * tt_ + fr) * 64 + ct_ * 16 + 4 * fq) = o_; } \
        if (ct_ == 3) mf_store_rows(lane, stg, ((bf16*)(F.ws + WS_LB)) + (m0 + 32 * th_) * LORA_N + cb_ * 64, LORA_N); } while (0)
#define MF_SB __builtin_amdgcn_sched_barrier(0)
#define MF_WL_RUN(S0, S1, NK) do { MF_WL_LOAD(S0, wa, NK); \
        for (int st = (S0); st < (S1); st += 4) { MF_LB_LOAD(st, NK); \
            MF_WL_LOAD(st + 1, wb, NK); MF_SB; MF_WL_STEP(st, wa, NK); MF_SB; \
            MF_WL_LOAD(st + 2, wa, NK); MF_SB; MF_WL_STEP(st + 1, wb, NK); MF_SB; \
            MF_WL_LOAD(st + 3, wb, NK); MF_SB; MF_WL_STEP(st + 2, wa, NK); MF_SB; \
            if (st + 4 < (S1)) MF_WL_LOAD(st + 4, wa, NK); \
            MF_SB; MF_WL_STEP(st + 3, wb, NK); MF_SB; } } while (0)
#define MF_LBOP(TT, KS) lb[TT][KS]
      { bf16x8 wa[3], wb[3], lb[2][3]; MF_WL_RUN(0, 24, 3); }
#undef MF_LBOP
#define MF_LBOP(TT, KS) (*(const LAS bf16x8*)(TL + (32 * th_ + 16 * (TT) + fr) * LAP + kb_ + 32 * (KS) + 8 * fq))
#undef MF_LB_LOAD
#define MF_LB_LOAD(STEP, NK) do { } while (0)
      { bf16x8 wa[8], wb[8]; MF_WL_RUN(24, 36, 8); }
#undef MF_LBOP
#undef MF_WL_RUN
#undef MF_SB
#undef MF_LB_LOAD
#undef MF_WL_LOAD
#undef MF_WL_STEP
    }
    __syncthreads();
    if (PARTS & 2) { const int s = s00 + row; const bf16* zpb = ((const bf16*)(sqb + SQ_ZP)) + (size_t)s * 512;
#define MF_PW_LOAD(I, DST) do { constexpr int pw_ = 2 << ((I) >> 1); const int j_ = sub + 8 * (I); \
        _Pragma("unroll") for (int r_ = 0; r_ < pw_; ++r_) { DST[r_] = (v4u){0u, 0u, 0u, 0u}; if (r_ <= s) DST[r_] = *(const GAS v4u*)(zpb + 8 * j_ - (size_t)r_ * 512); } } while (0)
#define MF_PW_STEP(I, CUR) do { constexpr int pw_ = 2 << ((I) >> 1); const int j_ = sub + 8 * (I), cnt_ = (s + 1 < pw_) ? s + 1 : pw_; \
        float acc_[8], u_[8]; unpack8(CUR[0], u_); \
        _Pragma("unroll") for (int e_ = 0; e_ < 8; ++e_) acc_[e_] = u_[e_]; \
        _Pragma("unroll") for (int r_ = 1; r_ < pw_; ++r_) { float t_[8]; unpack8(CUR[r_], t_); _Pragma("unroll") for (int e_ = 0; e_ < 8; ++e_) acc_[e_] += t_[e_]; } \
        const float ic_ = 1.0f / (float)cnt_; v4u pv_; \
        pv_.x = pk2(acc_[0] * ic_ - u_[0], acc_[1] * ic_ - u_[1]); pv_.y = pk2(acc_[2] * ic_ - u_[2], acc_[3] * ic_ - u_[3]); pv_.z = pk2(acc_[4] * ic_ - u_[4], acc_[5] * ic_ - u_[5]); pv_.w = pk2(acc_[6] * ic_ - u_[6], acc_[7] * ic_ - u_[7]); \
        *(LAS v4u*)(TL + row * PPP + 8 * j_) = pv_; } while (0)
      { v4u z0[2], z1[2], z2[4], z3[4], z4[8], z5[8];
        MF_PW_LOAD(0, z0); MF_PW_LOAD(1, z1); MF_PW_LOAD(2, z2); MF_PW_LOAD(3, z3); MF_PW_LOAD(4, z4); MF_PW_LOAD(5, z5);
        MF_PW_STEP(0, z0); MF_PW_STEP(1, z1); MF_PW_STEP(2, z2); MF_PW_STEP(3, z3); MF_PW_STEP(4, z4); MF_PW_STEP(5, z5); }
      { v4u z6[16]; MF_PW_LOAD(6, z6); MF_PW_STEP(6, z6); }
      { v4u z7[16]; MF_PW_LOAD(7, z7); MF_PW_STEP(7, z7); }
#undef MF_PW_LOAD
#undef MF_PW_STEP
    }
    __syncthreads();
    if (PARTS & 2) { const bf16* WP = (const bf16*)(F.ws + WS_W + (size_t)l * LW + LW_POOL); const float* psc = INP(A, 22) + (size_t)l * DPOOL;
      for (int it = w; it < 16; it += NWAVES) { const int cb = it >> 1, th = it & 1, kbeg = 128 * (cb >> 1);
          bf16x8 wa[4][4]; f32x4 sc[4];
#pragma unroll
          for (int ct = 0; ct < 4; ++ct) { sc[ct] = *(const GAS f32x4*)(psc + cb * 64 + ct * 16 + 4 * fq);
#pragma unroll
              for (int ks = 0; ks < 4; ++ks) wa[ct][ks] = *(const GAS bf16x8*)(WP + (size_t)(cb * 64 + ct * 16 + fr) * 512 + kbeg + 32 * ks + 8 * fq); }
#pragma unroll
          for (int ct = 0; ct < 4; ++ct) { f32x4 acc[2] = {F4Z, F4Z};
#pragma unroll
              for (int ks = 0; ks < 4; ++ks)
#pragma unroll
                  for (int tt = 0; tt < 2; ++tt) acc[tt] = __builtin_amdgcn_mfma_f32_16x16x32_bf16(wa[ct][ks], *(const LAS bf16x8*)(TL + (32 * th + 16 * tt + fr) * PPP + kbeg + 32 * ks + 8 * fq), acc[tt], 0, 0, 0);
#pragma unroll
              for (int tt = 0; tt < 2; ++tt) { pg8::u32x2 o; o.x = pg8::cvt_pk_bf16(acc[tt][0] * sc[ct][0], acc[tt][1] * sc[ct][1]); o.y = pg8::cvt_pk_bf16(acc[tt][2] * sc[ct][2], acc[tt][3] * sc[ct][3]); *(LAS pg8::u32x2*)(stg + (16 * tt + fr) * 64 + ct * 16 + 4 * fq) = o; } }
          mf_store_rows(lane, stg, ((bf16*)(F.ws + WS_CAT)) + (m0 + 32 * th) * D + DATT + DRW + cb * 64, D); } }
    if (PARTS & 1) { const float* muv = INP(A, 10) + (size_t)l * DRWIN + 1536;
#pragma unroll 4
      for (int i = 0; i < 12; ++i) { const int idx = tid + NWAVES * 64 * i, tok = idx / 96, c8 = idx % 96, s = s00 + tok;
          const bf16* zp = ((const bf16*)(sqb + SQ_ZR)) + (size_t)s * ZRP + 1536 + 8 * c8;
          const v4u cur = *(const GAS v4u*)zp; v4u prv = (v4u){0u, 0u, 0u, 0u}; if (s > 0) prv = *(const GAS v4u*)(zp - ZRP);
          const f32x4 ma = *(const GAS f32x4*)(muv + 8 * c8), mb = *(const GAS f32x4*)(muv + 8 * c8 + 4);
          float a[8], b[8]; unpack8(cur, a); unpack8(prv, b);
          v4u o; o.x = pg8::cvt_pk_bf16(a[0] + (b[0] - a[0]) * ma[0], a[1] + (b[1] - a[1]) * ma[1]); o.y = pg8::cvt_pk_bf16(a[2] + (b[2] - a[2]) * ma[2], a[3] + (b[3] - a[3]) * ma[3]);
          o.z = pg8::cvt_pk_bf16(a[4] + (b[4] - a[4]) * mb[0], a[5] + (b[5] - a[5]) * mb[1]); o.w = pg8::cvt_pk_bf16(a[6] + (b[6] - a[6]) * mb[2], a[7] + (b[7] - a[7]) * mb[3]);
          *(GAS v4u*)((bf16*)(F.ws + WS_VV) + ((size_t)(seq * NH + (c8 >> 3)) * SEQ + s) * 64 + 8 * (c8 & 7)) = o; } }
    asm volatile("s_waitcnt vmcnt(0)" ::: "memory");
    __syncthreads();
}

struct S1Raw { unsigned zr[9], zk[9], zv[9], dw[8], da[8]; float mu_r, mu_k, mu_v, w0, a0, k_k, k_a, r_k; };
__device__ __forceinline__ void s1_fetch(Frame& F, KArgs* A, int l, int unit, S1Raw& R) {
    const int hb = unit / NCHUNK, c = unit % NCHUNK, b = hb / NH, h = hb % NH, lane = F.tid & 63, hc = h * 64 + lane;
    const int s0 = c * CH + 8 * F.wave; const size_t m0 = (size_t)b * SEQ + s0;
    const GAS bf16* zr = (const GAS bf16*)(((const bf16*)(F.ws + WS_HID + (size_t)b * SQ_STRIDE + SQ_ZR)) + (size_t)s0 * ZRP); const GAS bf16* Lr = (const GAS bf16*)(((const bf16*)(F.ws + WS_LB)) + m0 * LORA_N);
#pragma unroll
    for (int q = 0; q < 9; ++q) { if (q == 0 && s0 == 0) { R.zr[0] = 0u; R.zk[0] = 0u; R.zv[0] = 0u; } else { const GAS bf16* zp = zr + (q - 1) * ZRP; R.zr[q] = zp[hc]; R.zk[q] = zp[768 + hc]; R.zv[q] = zp[1536 + hc]; } }
#pragma unroll
    for (int q = 0; q < 8; ++q) { R.dw[q] = Lr[q * LORA_N + hc]; R.da[q] = Lr[q * LORA_N + 768 + hc]; }
    const float* mu = INP(A, 10) + (size_t)l * DRWIN; const size_t lo = (size_t)l * DRW + hc;
    R.mu_r = mu[hc]; R.mu_k = mu[768 + hc]; R.mu_v = mu[1536 + hc];
    R.w0 = INP(A, 12)[lo]; R.a0 = INP(A, 14)[lo]; R.k_k = INP(A, 16)[lo]; R.k_a = INP(A, 17)[lo]; R.r_k = INP(A, 18)[lo];
}
__device__ __forceinline__ int tslot(int tn, int tm, int lane) { return (tn * 4 + tm) * 64 + lane; }

template <int PMODE  > __device__ __forceinline__ void scan_s1_phase(Frame& F, KArgs* A, int l) {
    const int lane = F.tid & 63, w = F.wave;
    const int fr = lane & 15, fq = lane >> 4, tn = w & 3, tm0 = 2 * (w >> 2);
    LAS bf16* KT = (LAS bf16*)(F.lds + S1_KT); LAS bf16* BT = (LAS bf16*)(F.lds + S1_BT); LAS bf16* KK = (LAS bf16*)(F.lds + S1_KK); LAS bf16* RT = (LAS bf16*)(F.lds + S1_RT);
    LAS bf16* KTT = (LAS bf16*)(F.lds + S1_KTT); LAS bf16* BTT = (LAS bf16*)(F.lds + S1_BTT); LAS bf16* KKT = (LAS bf16*)(F.lds + S1_KKT); LAS bf16* VT = (LAS bf16*)(F.lds + S1_VT);
    LAS bf16* AAK = (LAS bf16*)(F.lds + S1_AAK); LAS bf16* ARB = (LAS bf16*)(F.lds + S1_ARB); LAS bf16* ARK = (LAS bf16*)(F.lds + S1_ARK);
    LAS bf16* AKVT = (LAS bf16*)(F.lds + S1_AKVT); LAS bf16* TM = (LAS bf16*)(F.lds + S1_TM); LAS bf16* WTT = (LAS bf16*)(F.lds + S1_WTT); LAS bf16* UT = (LAS bf16*)(F.lds + S1_UT);
    LAS bf16* PM = (LAS bf16*)(F.lds + S1_P); LAS bf16* PT = (LAS bf16*)(F.lds + S1_PT);
    LAS float* GC = (LAS float*)(F.lds + S1_GC); LAS float* WTOT = (LAS float*)(F.lds + S1_WT);
    for (int cc = F.bi; cc < NCHUNK; cc += F.nb) {
    mix_front<3>(F, A, l, F.seq, cc);
    S1Raw R; s1_fetch(F, A, l, (F.seq * NH) * NCHUNK + cc, R);
    for (int hh = 0; hh < NH; ++hh) {
    const int unit = (F.seq * NH + hh) * NCHUNK + cc;
    const int hb = unit / NCHUNK, c = unit % NCHUNK;
    {
        const int s0 = c * CH + 8 * w;
        float rr[8], kap[8], kp[8], aa[8], vv[8], lw[8], cl[8], kk0[8], red[8];
#pragma unroll
        for (int q = 0; q < 8; ++q) {
            const float zr1 = __uint_as_float(R.zr[q + 1] << 16), zr0 = __uint_as_float(R.zr[q] << 16), zk1 = __uint_as_float(R.zk[q + 1] << 16), zk0 = __uint_as_float(R.zk[q] << 16), zv1 = __uint_as_float(R.zv[q + 1] << 16), zv0 = __uint_as_float(R.zv[q] << 16);
            rr[q] = zr1 + (zr0 - zr1) * R.mu_r; kk0[q] = zk1 + (zk0 - zk1) * R.mu_k; vv[q] = zv1 + (zv0 - zv1) * R.mu_v;
            lw[q] = -0.6065306597126334f * 1.4426950408889634f * sigmoid_f(R.w0 + __uint_as_float(R.dw[q] << 16));
            aa[q] = sigmoid_f(R.a0 + __uint_as_float(R.da[q] << 16));
            kp[q] = kk0[q] * (1.0f + (aa[q] - 1.0f) * R.k_a);
            const float kkn = kk0[q] * R.k_k; red[q] = kkn * kkn;
        }
        wave_sum8(red);
        float run = 0.f;
#pragma unroll
        for (int q = 0; q < 8; ++q) { kap[q] = kk0[q] * R.k_k * __builtin_amdgcn_rsqf(fmaxf(red[q], 1e-24f)); red[q] = rr[q] * kp[q] * R.r_k; run += lw[q]; cl[q] = run; }
        wave_sum8(red);
        { float rsel = red[0];
#pragma unroll
          for (int q = 1; q < 8; ++q) rsel = (lane == q) ? red[q] : rsel;
          if (lane < 8) ((float*)(F.ws + WS_RK))[(size_t)hb * SEQ + s0 + lane] = rsel; }
        if (hh + 1 < NH) s1_fetch(F, A, l, unit + NCHUNK, R);
        WTOT[w * 64 + lane] = run;
        __syncthreads();
        float off = 0.f;
#pragma unroll
        for (int w2 = 0; w2 < 7; ++w2) off += (w2 < w) ? WTOT[w2 * 64 + lane] : 0.f;
        if (w == 7) GC[lane] = __builtin_amdgcn_exp2f(off + run);
        float fkt[8], fbt[8], fkk[8], frt[8];
#pragma unroll
        for (int q = 0; q < 8; ++q) {
            const float ct = off + cl[q], ctm1 = ct - lw[q];
            const float gp = __builtin_amdgcn_exp2f(ct), gm = __builtin_amdgcn_exp2f(ctm1), gi = __builtin_amdgcn_exp2f(-ct);
            fkt[q] = kap[q] * gm; fbt[q] = kap[q] * aa[q] * gi; fkk[q] = kp[q] * gi; frt[q] = rr[q] * gp;
        }
        v4u pkt, pbt, pkk, pvt, prt;
#pragma unroll
        for (int i = 0; i < 4; ++i) { pkt[i] = pg8::cvt_pk_bf16(fkt[2 * i], fkt[2 * i + 1]); pbt[i] = pg8::cvt_pk_bf16(fbt[2 * i], fbt[2 * i + 1]); pkk[i] = pg8::cvt_pk_bf16(fkk[2 * i], fkk[2 * i + 1]);
            prt[i] = pg8::cvt_pk_bf16(frt[2 * i], frt[2 * i + 1]); pvt[i] = pg8::cvt_pk_bf16(vv[2 * i], vv[2 * i + 1]); }
#pragma unroll
        for (int q = 0; q < 8; ++q) { const int o = swz(8 * w + q, lane), sh = 16 * (q & 1);
            KT[o] = (bf16)(pkt[q >> 1] >> sh); BT[o] = (bf16)(pbt[q >> 1] >> sh); KK[o] = (bf16)(pkk[q >> 1] >> sh); RT[o] = (bf16)(prt[q >> 1] >> sh); }
        { const int o = swz(lane, 8 * w); *(LAS v4u*)(KTT + o) = pkt; *(LAS v4u*)(BTT + o) = pbt; *(LAS v4u*)(KKT + o) = pkk; *(LAS v4u*)(VT + o) = pvt; }
    }
    __syncthreads();
    if (PMODE == 1) continue;
    f32x4 Treg[2];
#pragma unroll
    for (int d = 0; d < 2; ++d) { const int tm = tm0 + d; const int t = 16 * tn + fr, sb = 16 * tm + 4 * fq;
        const f32x4 aL = mm_tile(KT, BT, tn, tm, fr, fq, F4Z), aLt = mm_tile(BT, KT, tn, tm, fr, fq, F4Z);
        f32x4 aK = mm_tile(KT, KK, tn, tm, fr, fq, F4Z), aRB = mm_tile(RT, BT, tn, tm, fr, fq, F4Z), aRK = mm_tile(RT, KK, tn, tm, fr, fq, F4Z);
        f32x4 pl, plt;
#pragma unroll
        for (int e = 0; e < 4; ++e) { const bool st = (sb + e) < t, inc = (sb + e) <= t;
            pl[e] = st ? -aL[e] : 0.f; plt[e] = (t < sb + e) ? -aLt[e] : 0.f; Treg[d][e] = ((sb + e) == t ? 1.0f : 0.0f) + pl[e];
            aK[e] = st ? aK[e] : 0.f; aRB[e] = inc ? aRB[e] : 0.f; aRK[e] = inc ? aRK[e] : 0.f; }
        st_tile_bf16(PM, tn, tm, fr, fq, pl); st_tile_bf16(PT, tn, tm, fr, fq, plt); st_tile_bf16(TM, tn, tm, fr, fq, Treg[d]);
        st_tile_bf16(AAK, tn, tm, fr, fq, aK); st_tile_bf16(ARB, tn, tm, fr, fq, aRB); st_tile_bf16(ARK, tn, tm, fr, fq, aRK); }
    __syncthreads();
    {
        f32x4 p2[2], p2t[2];
#pragma unroll
        for (int d = 0; d < 2; ++d) { p2[d] = mm_tile(PM, PT, tn, tm0 + d, fr, fq, F4Z); p2t[d] = mm_tile(PT, PM, tn, tm0 + d, fr, fq, F4Z);
            st_tile_bf16(AKVT, tn, tm0 + d, fr, fq, mm_tile(VT, AAK, tn, tm0 + d, fr, fq, F4Z)); }
        __syncthreads();
#pragma unroll
        for (int d = 0; d < 2; ++d) { st_tile_bf16(PM, tn, tm0 + d, fr, fq, p2[d]); st_tile_bf16(PT, tn, tm0 + d, fr, fq, p2t[d]); }
        __syncthreads();
#pragma unroll
        for (int it = 1; it <= 5; ++it) {
#pragma unroll
            for (int d = 0; d < 2; ++d) { Treg[d] = mm_tile(TM, PT, tn, tm0 + d, fr, fq, Treg[d]);
                if (it < 5) { p2[d] = mm_tile(PM, PT, tn, tm0 + d, fr, fq, F4Z); p2t[d] = mm_tile(PT, PM, tn, tm0 + d, fr, fq, F4Z); } }
            __syncthreads();
#pragma unroll
            for (int d = 0; d < 2; ++d) { st_tile_bf16(TM, tn, tm0 + d, fr, fq, Treg[d]);
                if (it < 5) { st_tile_bf16(PM, tn, tm0 + d, fr, fq, p2[d]); st_tile_bf16(PT, tn, tm0 + d, fr, fq, p2t[d]); } }
            __syncthreads();
        }
    }
    if (PMODE == 2) { __syncthreads(); continue; }
    {
        f32x4 aw[2], au[2];
#pragma unroll
        for (int d = 0; d < 2; ++d) { aw[d] = mm_tile(KTT, TM, tn, tm0 + d, fr, fq, F4Z); au[d] = mm_tile(AKVT, TM, tn, tm0 + d, fr, fq, F4Z); }
#pragma unroll
        for (int d = 0; d < 2; ++d) { st_tile_bf16(WTT, tn, tm0 + d, fr, fq, aw[d]); st_tile_bf16(UT, tn, tm0 + d, fr, fq, au[d]); }
    }
    __syncthreads();
    {
        const size_t ub = (size_t)unit * 64 * 64;
        GAS f32x4* MC = (GAS f32x4*)((float*)(F.ws + WS_MC) + ub); GAS pg8::u32x2* NCT = (GAS pg8::u32x2*)((bf16*)(F.ws + WS_NCT) + ub);
        GAS pg8::u32x2* YL = (GAS pg8::u32x2*)((bf16*)(F.ws + WS_YL) + ub); GAS pg8::u32x2* QE = (GAS pg8::u32x2*)((bf16*)(F.ws + WS_QE) + ub);
#pragma unroll
        for (int d = 0; d < 2; ++d) { const int tm = tm0 + d, i = 16 * tn + fr, j = 16 * tm + 4 * fq, ts = tslot(tn, tm, lane);
            { const f32x4 a = mm_tile(ARB, WTT, tn, tm, fr, fq, F4Z); const pg8::u32x2 rv = *(const LAS pg8::u32x2*)(RT + swz(i, j));
              const float r0 = __uint_as_float(rv.x << 16), r1 = __uint_as_float(rv.x & 0xffff0000u), r2 = __uint_as_float(rv.y << 16), r3 = __uint_as_float(rv.y & 0xffff0000u);
              pg8::u32x2 o; o.x = pg8::cvt_pk_bf16(r0 - a[0], r1 - a[1]); o.y = pg8::cvt_pk_bf16(r2 - a[2], r3 - a[3]); if (PMODE != 3) QE[ts] = o; else asm volatile("" :: "v"(o.x), "v"(o.y)); }
            { const f32x4 a = mm_tile(ARK, VT, tn, tm, fr, fq, F4Z), a2 = mm_tile(ARB, UT, tn, tm, fr, fq, F4Z);
              pg8::u32x2 o; o.x = pg8::cvt_pk_bf16(a[0] - a2[0], a[1] - a2[1]); o.y = pg8::cvt_pk_bf16(a[2] - a2[2], a[3] - a2[3]); if (PMODE != 3) YL[ts] = o; else asm volatile("" :: "v"(o.x), "v"(o.y)); }
            { const f32x4 a = mm_tile(BTT, WTT, tn, tm, fr, fq, F4Z); const float gc = GC[i]; f32x4 o;
#pragma unroll
              for (int e = 0; e < 4; ++e) o[e] = gc * (((j + e) == i ? 1.0f : 0.0f) - a[e]);
              if (PMODE != 3) MC[ts] = o; else asm volatile("" :: "v"(o[0]), "v"(o[1]), "v"(o[2]), "v"(o[3])); }
            { const f32x4 a = mm_tile(VT, KKT, tn, tm, fr, fq, F4Z), a2 = mm_tile(UT, BTT, tn, tm, fr, fq, F4Z); const f32x4 gc = *(const LAS f32x4*)(GC + j);
              pg8::u32x2 o; o.x = pg8::cvt_pk_bf16((a[0] - a2[0]) * gc[0], (a[1] - a2[1]) * gc[1]); o.y = pg8::cvt_pk_bf16((a[2] - a2[2]) * gc[2], (a[3] - a2[3]) * gc[3]);
              if (PMODE != 3) NCT[ts] = o; else asm volatile("" :: "v"(o.x), "v"(o.y)); }
        }
    }
    __syncthreads();
    }
    }
}

__device__ __forceinline__ void scan_s2_head(Frame& F, int hb) {
    if (F.wave >= 4) return;
    const int lane = F.tid & 63, fr = lane & 15, fq = lane >> 4, w = F.wave;
    f32x4 Hs[4];
#pragma unroll
    for (int t = 0; t < 4; ++t) Hs[t] = F4Z;
#define S2_LOAD(C, MCV, NV) do { const size_t ub_ = ((size_t)hb * NCHUNK + (C)) * 64 * 64; const GAS f32x4* MC_ = (const GAS f32x4*)((const float*)(F.ws + WS_MC) + ub_); const GAS pg8::u32x2* NCT_ = (const GAS pg8::u32x2*)((const bf16*)(F.ws + WS_NCT) + ub_); \
        _Pragma("unroll") for (int to = 0; to < 4; ++to) { NV[to] = NCT_[tslot(w, to, lane)]; _Pragma("unroll") for (int t = 0; t < 4; ++t) MCV[to][t] = MC_[tslot(to, t, lane)]; } } while (0)
#define S2_STEP(C, MCV, NV) do { GAS pg8::u32x2* H0T_ = (GAS pg8::u32x2*)((bf16*)(F.ws + WS_H0T) + ((size_t)hb * NCHUNK + (C)) * 64 * 64); \
          \
        _Pragma("unroll") for (int t = 0; t < 4; ++t) { pg8::u32x2 o; o.x = pg8::cvt_pk_bf16(Hs[t][0], Hs[t][1]); o.y = pg8::cvt_pk_bf16(Hs[t][2], Hs[t][3]); H0T_[tslot(w, t, lane)] = o; } \
        if ((C) + 1 < NCHUNK) {                                     \
            f32x4 nn[4]; \
            _Pragma("unroll") for (int to = 0; to < 4; ++to) nn[to] = (f32x4){__uint_as_float(NV[to].x << 16), __uint_as_float(NV[to].x & 0xffff0000u), __uint_as_float(NV[to].y << 16), __uint_as_float(NV[to].y & 0xffff0000u)}; \
            _Pragma("unroll") for (int to = 0; to < 4; ++to) _Pragma("unroll") for (int t = 0; t < 4; ++t) _Pragma("unroll") for (int i = 0; i < 4; ++i) nn[to] = __builtin_amdgcn_mfma_f32_16x16x4f32(MCV[to][t][i], Hs[t][i], nn[to], 0, 0, 0); \
            _Pragma("unroll") for (int t = 0; t < 4; ++t) Hs[t] = nn[t]; } } while (0)
    f32x4 mcA[4][4], mcB[4][4]; pg8::u32x2 nA[4], nB[4];
    S2_LOAD(0, mcA, nA);
    for (int c = 0; c < NCHUNK; c += 2) {
        S2_LOAD(c + 1, mcB, nB); __builtin_amdgcn_sched_barrier(0);
        S2_STEP(c, mcA, nA); __builtin_amdgcn_sched_barrier(0);
        if (c + 2 < NCHUNK) S2_LOAD(c + 2, mcA, nA);
        __builtin_amdgcn_sched_barrier(0);
        S2_STEP(c + 1, mcB, nB); __builtin_amdgcn_sched_barrier(0);
    }
#undef S2_LOAD
#undef S2_STEP
}

__device__ __forceinline__ void scan_s3_pair(Frame& F, KArgs* A, int l, int pair) {
    const int lane = F.tid & 63, fr = lane & 15, fq = lane >> 4, w = F.wave, unit = 2 * pair + (w >> 2), tn = w & 3;
    const int hb = unit / NCHUNK, c = unit % NCHUNK, b = hb / NH, h = hb % NH;
    const size_t ub = (size_t)unit * 64 * 64;
    const GAS pg8::u32x2* QE = (const GAS pg8::u32x2*)((const bf16*)(F.ws + WS_QE) + ub); const GAS pg8::u32x2* H0T = (const GAS pg8::u32x2*)((const bf16*)(F.ws + WS_H0T) + ub);
    const GAS pg8::u32x2* YL = (const GAS pg8::u32x2*)((const bf16*)(F.ws + WS_YL) + ub);
    const int t = 16 * tn + fr; const size_t tok = (size_t)hb * SEQ + c * CH + t;
    const bf16* vp = (const bf16*)(F.ws + WS_VV) + tok * 64; const bf16* gp = (const bf16*)(F.ws + WS_LB) + ((size_t)b * SEQ + c * CH + t) * LORA_N + 1536 + h * 64;
    const float* gnw = INP(A, 19) + (size_t)l * DRW + h * 64; const float* gnb = INP(A, 20) + (size_t)l * DRW + h * 64;
    pg8::u32x2 qv[4], hv[4][4], yv[4], vv[4], gg[4]; f32x4 gw[4], gb[4];
#pragma unroll
    for (int i = 0; i < 4; ++i) { qv[i] = QE[tslot(tn, i, lane)]; yv[i] = YL[tslot(tn, i, lane)]; const int v0 = 16 * i + 4 * fq;
        vv[i] = *(const GAS pg8::u32x2*)(vp + v0); gg[i] = *(const GAS pg8::u32x2*)(gp + v0); gw[i] = *(const GAS f32x4*)(gnw + v0); gb[i] = *(const GAS f32x4*)(gnb + v0);
#pragma unroll
        for (int k = 0; k < 4; ++k) hv[i][k] = H0T[tslot(i, k, lane)]; }
    const float rk = ((const float*)(F.ws + WS_RK))[tok];
    bf16x8 qb[2];
#pragma unroll
    for (int p = 0; p < 2; ++p) qb[p] = __builtin_bit_cast(bf16x8, (v4u){qv[2 * p].x, qv[2 * p].y, qv[2 * p + 1].x, qv[2 * p + 1].y});
    f32x4 y[4]; float s1 = 0.f;
#pragma unroll
    for (int tm = 0; tm < 4; ++tm) {
        f32x4 acc = (f32x4){__uint_as_float(yv[tm].x << 16), __uint_as_float(yv[tm].x & 0xffff0000u), __uint_as_float(yv[tm].y << 16), __uint_as_float(yv[tm].y & 0xffff0000u)};
#pragma unroll
        for (int p = 0; p < 2; ++p) acc = __builtin_amdgcn_mfma_f32_16x16x32_bf16(__builtin_bit_cast(bf16x8, (v4u){hv[tm][2 * p].x, hv[tm][2 * p].y, hv[tm][2 * p + 1].x, hv[tm][2 * p + 1].y}), qb[p], acc, 0, 0, 0);
        y[tm] = acc; s1 += (acc[0] + acc[1]) + (acc[2] + acc[3]); }
    s1 += __shfl_xor(s1, 16); s1 += __shfl_xor(s1, 32);
    const float mean = s1 * (1.f / 64.f); float s2 = 0.f;
#pragma unroll
    for (int tm = 0; tm < 4; ++tm)
#pragma unroll
        for (int e = 0; e < 4; ++e) { const float d = y[tm][e] - mean; s2 += d * d; }
    s2 += __shfl_xor(s2, 16); s2 += __shfl_xor(s2, 32);
    const float rstd = __builtin_amdgcn_rsqf(s2 * (1.f / 64.f) + GN_EPS);
    bf16* out = (bf16*)(F.ws + WS_CAT) + ((size_t)b * SEQ + c * CH + t) * D + DATT + h * 64;
#pragma unroll
    for (int tm = 0; tm < 4; ++tm) { const int v0 = 16 * tm + 4 * fq;
        const float vf[4] = {__uint_as_float(vv[tm].x << 16), __uint_as_float(vv[tm].x & 0xffff0000u), __uint_as_float(vv[tm].y << 16), __uint_as_float(vv[tm].y & 0xffff0000u)};
        const float gf[4] = {__uint_as_float(gg[tm].x << 16), __uint_as_float(gg[tm].x & 0xffff0000u), __uint_as_float(gg[tm].y << 16), __uint_as_float(gg[tm].y & 0xffff0000u)};
        float o[4];
#pragma unroll
        for (int e = 0; e < 4; ++e) o[e] = ((y[tm][e] - mean) * rstd * gw[tm][e] + gb[tm][e] + rk * vf[e]) * gf[e];
        pg8::u32x2 ow; ow.x = pg8::cvt_pk_bf16(o[0], o[1]); ow.y = pg8::cvt_pk_bf16(o[2], o[3]); *(GAS pg8::u32x2*)(out + v0) = ow; }
}

__device__ __forceinline__ void grp_barrier(unsigned* cnt, unsigned nb, unsigned* tmo) {
    asm volatile("s_waitcnt vmcnt(0)" ::: "memory");
    __syncthreads();
    if (threadIdx.x == 0) {
        const unsigned old = __hip_atomic_fetch_add(cnt, 1u, __ATOMIC_RELAXED, __HIP_MEMORY_SCOPE_AGENT), target = (old / nb + 1u) * nb; unsigned sp = 0;
        while (__hip_atomic_load(cnt, __ATOMIC_RELAXED, __HIP_MEMORY_SCOPE_AGENT) < target) { __builtin_amdgcn_s_sleep(1); if (++sp > (1u << 22)) { __hip_atomic_store(tmo, 1u, __ATOMIC_RELAXED, __HIP_MEMORY_SCOPE_AGENT); break; } }
        __builtin_amdgcn_fence(__ATOMIC_ACQUIRE, "agent");
        asm volatile("s_waitcnt vmcnt(0)" ::: "memory");
    }
    __syncthreads();
}
__device__ __forceinline__ unsigned tail_turn(unsigned* ctl, volatile LAS unsigned* MISC, int grp, int bi, int own, int turn) {
    if (threadIdx.x == 0) {
        unsigned* bw = ctl + CW_HB + 64 * (32 * grp + turn); unsigned code = 0xFFFFu, sp = 0;
        if (bi == 0) {
            for (;;) {
                bool found = false, alldone = true;
                for (int d = 0; d < BATCH; ++d) { const int s = (own + d) & (BATCH - 1);
                    if (__hip_atomic_load(ctl + CW_HC + 64 * s, __ATOMIC_RELAXED, __HIP_MEMORY_SCOPE_AGENT) >= 2u) continue;
                    alldone = false;
                    if (d != 0 && __hip_atomic_load(ctl + CW_HR + 64 * s, __ATOMIC_RELAXED, __HIP_MEMORY_SCOPE_AGENT) == 0u) continue;
                    const unsigned k = __hip_atomic_fetch_add(ctl + CW_HC + 64 * s, 1u, __ATOMIC_RELAXED, __HIP_MEMORY_SCOPE_AGENT);
                    if (k < 2u) { code = 1u + 2u * (unsigned)s + k; found = true; break; } }
                if (found || alldone) break;
                __builtin_amdgcn_s_sleep(8); if (++sp > (1u << 21)) { __hip_atomic_store(ctl + CW_TMO, 1u, __ATOMIC_RELAXED, __HIP_MEMORY_SCOPE_AGENT); break; } }
            if (turn < 31) __hip_atomic_store(bw, code, __ATOMIC_RELAXED, __HIP_MEMORY_SCOPE_AGENT);
        } else {
            while ((code = __hip_atomic_load(bw, __ATOMIC_RELAXED, __HIP_MEMORY_SCOPE_AGENT)) == 0u) { __builtin_amdgcn_s_sleep(2); if (++sp > (1u << 22)) { __hip_atomic_store(ctl + CW_TMO, 1u, __ATOMIC_RELAXED, __HIP_MEMORY_SCOPE_AGENT); code = 0xFFFFu; break; } }
        }
        __builtin_amdgcn_fence(__ATOMIC_ACQUIRE, "agent");
        asm volatile("s_waitcnt vmcnt(0)" ::: "memory");
        MISC[21] = code;
    }
    __syncthreads();
    const unsigned code = (unsigned)__builtin_amdgcn_readfirstlane((int)MISC[21]);
    __syncthreads();
    return code;
}
__global__ void __launch_bounds__(NWAVES * 64, 2) fwd_kernel(Args args) {
    extern __shared__ __attribute__((aligned(16))) unsigned char lds[];
    Frame F;
    F.lds = (LAS unsigned char*)lds;
    F.wave = __builtin_amdgcn_readfirstlane(threadIdx.x >> 6); F.tid = threadIdx.x;
    F.G = gridDim.x; { const int bx = blockIdx.x; F.vcu = (F.G % 8 == 0) ? (bx % 8) * (F.G / 8) + bx / 8 : bx; }
    F.bi = 0; F.nb = 1; F.seq = 0;
    unsigned char* ws = args.ws; F.ws = ws;
    F.X = args.out;
    for (int u = threadIdx.x; u < (LDS_BYTES - LDSCTL_OFF) / 4; u += NWAVES * 64) ((LAS unsigned*)(F.lds + LDSCTL_OFF))[u] = 0u;
    __syncthreads();
    volatile LAS unsigned* MISC = (volatile LAS unsigned*)(F.lds + MISC_OFF);
    XcdBarrier bar = xcd_barrier_post((unsigned*)(ws + WS_CTL) + CW_BAR, MISC + 8);
    if (threadIdx.x == 0) MISC[20] = __hip_atomic_fetch_add((unsigned*)(ws + WS_CTL) + CW_RANK + 64 * bar.x, 1u, __ATOMIC_RELAXED, __HIP_MEMORY_SCOPE_AGENT);
    KArgs* const ka0 = (KArgs*)__builtin_amdgcn_kernarg_segment_ptr();
#define PH_BEGIN { Frame F = F0; KArgs* ka = ka0; F.tid = threadIdx.x; asm volatile("" : "+v"(F.tid)); GAS unsigned char* wsg_ = (GAS unsigned char*)F0.ws; GAS float* xg_ = (GAS float*)F0.X; asm volatile("" : "+s"(wsg_), "+s"(xg_), "+s"(F.wave), "+s"(F.bi), "+s"(F.nb), "+s"(F.seq), "+s"(ka)); F.ws = (unsigned char*)wsg_; F.X = (float*)xg_; unsigned char* const ws = F.ws; (void)ws;
#define PH_END   grp_barrier(gcnt, (unsigned)F0.nb, (unsigned*)(F0.ws + WS_CTL) + CW_TMO); }

    { const Frame F0 = F; { Frame F = F0; KArgs* ka = ka0; F.tid = threadIdx.x; asm volatile("" : "+v"(F.tid)); p0_prologue(F, ka); } }
    xcd_barrier(bar);
    if (threadIdx.x == 0) { unsigned g = 0, ng = 0, nbk = 1; unsigned* bw = (unsigned*)(ws + WS_CTL) + CW_BAR;
        for (unsigned j = 0; j < 16; ++j) { const unsigned c = xb_ld(&bw[XB_XCNT(j)]); if (c) { if (j < bar.x) ++g; ++ng; } if (j == bar.x) nbk = c ? c : 1u; }
        unsigned even = 1u; for (unsigned j = 0; j < 16; ++j) { const unsigned c = xb_ld(&bw[XB_XCNT(j)]); if (c != 0u && c != 32u) even = 0u; }
        MISC[16] = g; MISC[17] = ng ? ng : 1u; MISC[18] = nbk; MISC[19] = (even && ng == (unsigned)BATCH) ? 1u : 0u; }
    __syncthreads();
    const int grp = __builtin_amdgcn_readfirstlane((int)MISC[16]), ngrp = __builtin_amdgcn_readfirstlane((int)MISC[17]);
    F.nb = __builtin_amdgcn_readfirstlane((int)MISC[18]); F.bi = __builtin_amdgcn_readfirstlane((int)MISC[20]);
    unsigned* const gcnt = (unsigned*)(ws + WS_CTL) + CW_GB + 64 * bar.x;

    for (int seq = grp; seq < BATCH; seq += ngrp) {
    F.seq = seq; const Frame F0 = F;
    for (int j = 0; j < 2 * NL; ++j) {
        const int l = j >> 1; const bool second = (j & 1) != 0;
        PH_BEGIN {
            pg8::Gemm g{((bf16*)(F.ws + WS_XB)), (const bf16*)(ws + WS_W + (size_t)l * LW + (second ? LW_GU2 : LW_GU1)), M, 2 * FF, D}; pg8::GroupOrder S; S.init(2 * FF / 256, F.nb, F.bi, F.seq);
            pg8::EpiSwiglu E{((bf16*)(F.ws + WS_HID)), FF, (const float*)(F.ws + WS_RS)};
            pg8::gemm_phase<pg8::EpiSwiglu, pg8::GroupOrder, true, true>(F.lds + RING_OFF, g, S, E);
        } PH_END
        if (j == 2 * NL - 1 && F0.bi == 0 && threadIdx.x == 0 && MISC[19]) {
            __builtin_amdgcn_fence(__ATOMIC_RELEASE, "agent"); asm volatile("s_waitcnt vmcnt(0)" ::: "memory");
            __hip_atomic_store((unsigned*)(F0.ws + WS_CTL) + CW_HR + 64 * F0.seq, 1u, __ATOMIC_RELAXED, __HIP_MEMORY_SCOPE_AGENT); }
        PH_BEGIN {
            const int q = 3 * l + (second ? 2 : 0); const bool lastsub = second && (l + 1 == NL);
            pg8::Gemm g{((bf16*)(F.ws + WS_HID)), (const bf16*)(ws + WS_W + (size_t)l * LW + (second ? LW_D2 : LW_D1)), M, D, FF};
            pg8::EpiRes E{((bf16*)(F.ws + WS_XB)), lastsub ? F.X : nullptr, (second ? INP(ka, 24) : INP(ka, 2)) + (size_t)l * D, 0.5f, (float*)(F.ws + WS_RS),
                          (float*)(F.ws + WS_XS + (size_t)q * MiB), (unsigned*)(ws + WS_CTL) + CW_XC + q * XC_USE, (unsigned*)(ws + WS_CTL) + CW_TMO};
            const int P = F.nb >> 3, nsl = P > 0 ? (8 + P - 1) / P : 0;
            const bool dyn = lastsub && __builtin_amdgcn_readfirstlane((int)MISC[19]) != 0;
            for (int turn = 0; turn < 32; ++turn) { int sx = F.seq, sl = turn;
                if (dyn) { const unsigned code = tail_turn((unsigned*)(ws + WS_CTL), MISC, grp, F.bi, F.seq, turn); if (code == 0xFFFFu) break; sx = (int)((code - 1u) >> 1); sl = (int)((code - 1u) & 1u); }
                else if (turn >= nsl) break;
                pg8::PanelOrder S{sl, F.nb, F.bi, 8 * sx}; pg8::gemm_phase<pg8::EpiRes, pg8::PanelOrder, false, true>(F.lds + RING_OFF, g, S, E); __syncthreads(); }
        } PH_END
        if (!second) {
            PH_BEGIN {
                pg8::Gemm g{((bf16*)(F.ws + WS_XB)), (const bf16*)(ws + WS_W + (size_t)l * LW + LW_IN), M, DINP, D}; pg8::GroupOrder S; S.init(DINP / 256, F.nb, F.bi, F.seq);
                pg8::EpiWin E{F.ws + WS_HID, ((float*)(F.ws + WS_COS)), ((float*)(F.ws + WS_SIN)), QSCALE, (const float*)(F.ws + WS_RS)};
                pg8::gemm_phase<pg8::EpiWin, pg8::GroupOrder, true, true>(F.lds + RING_OFF, g, S, E);
            } PH_END
            PH_BEGIN scan_s1_phase<0>(F, ka, l); PH_END
            PH_BEGIN {
                for (int h = F.bi; h < NH; h += F.nb) scan_s2_head(F, F.seq * NH + h);
                attn_loop(F, (gu32*)(ws + WS_CTL) + CW_ATTQ + 64 * (l * BATCH + F.seq));
            } PH_END
            PH_BEGIN { for (int p = F.bi; p < NH * NCHUNK / 2; p += F.nb) scan_s3_pair(F, ka, l, F.seq * (NH * NCHUNK / 2) + p); attn_combine(F); } PH_END
            PH_BEGIN {
                const int q = 3 * l + 1;
                pg8::Gemm g{((bf16*)(F.ws + WS_CAT)), (const bf16*)(ws + WS_W + (size_t)l * LW + LW_OUT), M, D, D};
                pg8::EpiRes E{((bf16*)(F.ws + WS_XB)), nullptr, INP(ka, 7) + (size_t)l * D, 1.0f, (float*)(F.ws + WS_RS),
                              (float*)(F.ws + WS_XS + (size_t)q * MiB), (unsigned*)(ws + WS_CTL) + CW_XC + q * XC_USE, (unsigned*)(ws + WS_CTL) + CW_TMO};
                const int P = F.nb >> 3, nsl = P > 0 ? (8 + P - 1) / P : 0;
                for (int sl = 0; sl < nsl; ++sl) { pg8::PanelOrder S{sl, F.nb, F.bi, 8 * F.seq}; pg8::gemm_phase<pg8::EpiRes, pg8::PanelOrder, false, true>(F.lds + RING_OFF, g, S, E); __syncthreads(); }
            } PH_END
        }
    }
    }
#undef PH_BEGIN
#undef PH_END
}

extern "C" void kernel_launch(void* const* d_in, const int* in_sizes, int n_in, void* d_out, int out_size, void* d_ws, size_t ws_size, hipStream_t stream) {
    static int grid = 0;
    if (grid == 0) {
        if (n_in != 28 || in_sizes[0] != M * D || out_size != M * D || ws_size < WS_END2) { fprintf(stderr, "kernel_launch: unexpected problem (n_in %d, in0 %d, out %d, ws %zu < %zu); nothing launched\n", n_in, n_in > 0 ? in_sizes[0] : -1, out_size, ws_size, (size_t)WS_END2); grid = -1; return; }
        int dev = 0, cus = 0, per_cu = 0;
        if (hipGetDevice(&dev) != hipSuccess || hipDeviceGetAttribute(&cus, hipDeviceAttributeMultiprocessorCount, dev) != hipSuccess) { grid = -1; return; }
        if (hipFuncSetAttribute((const void*)fwd_kernel, hipFuncAttributeMaxDynamicSharedMemorySize, LDS_BYTES) != hipSuccess) { fprintf(stderr, "kernel_launch: hipFuncSetAttribute failed\n"); grid = -1; return; }
        if (hipOccupancyMaxActiveBlocksPerMultiprocessor(&per_cu, (const void*)fwd_kernel, NWAVES * 64, LDS_BYTES) != hipSuccess || per_cu < 1)
            fprintf(stderr, "kernel_launch: note: occupancy query reports %d workgroups per CU\n", per_cu);
        (void)hipGetLastError();
        grid = cus;
    }
    if (grid < 0) return;
    if (hipMemsetAsync((char*)d_ws + WS_CTL, 0, CTL_ZERO_BYTES, stream) != hipSuccess) return;
    Args a{};
    for (int i = 0; i < 28; ++i) a.in[i] = (const float*)d_in[i];
    a.out = (float*)d_out; a.ws = (unsigned char*)d_ws; a.ph_lo = 0; a.ph_hi = 0;
    hipLaunchKernelGGL(fwd_kernel, dim3(grid), dim3(NWAVES * 64), LDS_BYTES, stream, a);
}
```
